# Optimizing an MI355X kernel written in HIP

```python
import jax, jax.numpy as jnp
from jax import lax
import numpy as np

D_MODEL = 1024
BATCH = 8
SEQ = 2048
DEPTH = 2

D_MIX = D_MODEL
CONV_CH = D_MIX // 2
SGU_CH = D_MIX - CONV_CH
CONV_GROUPS = 8
SGU_HEADS = 4
SGU_HEAD_DIM = SGU_CH // SGU_HEADS
CONV_WIDTH = 31
CHUNK = 128
D_IN = 2 * CONV_CH + 2 * SGU_CH
D_FF = 2816
N_EXPERTS = 8
TOP_K = 2
N_DENSE = (DEPTH + 1) // 2
N_MOE = DEPTH // 2
EPS = 1e-6

kernel_name = "hybrid_conv_gmlp_moe_block"


def rms_norm(x, g):
    xf = x.astype(jnp.float32)
    y = xf * lax.rsqrt(jnp.mean(xf * xf, axis=-1, keepdims=True) + EPS)
    return (y * g.astype(jnp.float32)).astype(x.dtype)


def group_layer_norm(x, n_groups, g, b):
    shp = x.shape
    xf = x.astype(jnp.float32).reshape(shp[:-1] + (n_groups, shp[-1] // n_groups))
    mu = jnp.mean(xf, axis=-1, keepdims=True)
    var = jnp.mean(jnp.square(xf - mu), axis=-1, keepdims=True)
    y = ((xf - mu) * lax.rsqrt(var + EPS)).reshape(shp)
    return (y * g.astype(jnp.float32) + b.astype(jnp.float32)).astype(x.dtype)


def causal_depthwise_conv(c, w, b):
    y = lax.conv_general_dilated(
        c, w, window_strides=(1,), padding=[(CONV_WIDTH - 1, 0)],
        dimension_numbers=('NWC', 'WIO', 'NWC'), feature_group_count=c.shape[-1])
    return y + b


def hybrid_mixer(h, w_in, conv_w, conv_b, conv_ng, conv_nb, sgu_ng, sgu_nb, sgu_w, sgu_b, w_out):
    B, S, _ = h.shape
    z = jnp.einsum('bsd,de->bse', h, w_in)
    a, gate, u, v = jnp.split(z, [CONV_CH, 2 * CONV_CH, 2 * CONV_CH + SGU_CH], axis=-1)
    c = a * jax.nn.sigmoid(gate)
    c = causal_depthwise_conv(c, conv_w, conv_b)
    c = jax.nn.silu(group_layer_norm(c, CONV_GROUPS, conv_ng, conv_nb))
    u = jax.nn.gelu(u, approximate=False)
    v = group_layer_norm(jax.nn.gelu(v, approximate=False), SGU_HEADS, sgu_ng, sgu_nb)
    n_chunks = S // CHUNK
    vc = v.reshape(B, n_chunks, CHUNK, SGU_HEADS, SGU_HEAD_DIM)
    mask = jnp.tril(jnp.ones((CHUNK, CHUNK), dtype=bool))
    ws = jnp.where(mask[None], sgu_w, jnp.zeros((), sgu_w.dtype))
    sp = jnp.einsum('hts,bnshd->bnthd', ws, vc) + jnp.transpose(sgu_b)[None, None, :, :, None]
    g_out = u * sp.reshape(B, S, SGU_CH)
    y = jnp.concatenate([c, g_out], axis=-1)
    return jnp.einsum('bse,ed->bsd', y, w_out)


def swiglu(h, wg, wu, wd):
    return jnp.einsum('...f,fd->...d', jax.nn.silu(h @ wg) * (h @ wu), wd)


def moe_swiglu(h, router, wg, wu, wd):
    B, S, D = h.shape
    ht = h.reshape(B * S, D)
    logits = jnp.einsum('td,de->te', ht, router).astype(jnp.float32)
    top_vals, top_idx = lax.top_k(logits, TOP_K)
    gates = jax.nn.softmax(top_vals, axis=-1)
    dense_gate = jnp.sum(jax.nn.one_hot(top_idx, N_EXPERTS, dtype=jnp.float32) * gates[..., None], axis=1)
    dense_gate = dense_gate.astype(h.dtype)
    out = jnp.zeros_like(ht)
    for e in range(N_EXPERTS):
        out = out + dense_gate[:, e:e + 1] * swiglu(ht, wg[e], wu[e], wd[e])
    return out.reshape(B, S, D)


def setup_inputs(seed: int = 0) -> dict:
    key = jax.random.key(seed)
    ks = jax.random.split(key, 24)
    nrm = lambda k, shp, s: jax.random.normal(k, shp, jnp.float32) * s
    L = DEPTH
    return {
        "x": nrm(ks[0], (BATCH, SEQ, D_MODEL), 1.0),
        "norm_mix": 1.0 + nrm(ks[1], (L, D_MODEL), 0.05),
        "w_in": nrm(ks[2], (L, D_MODEL, D_IN), D_MODEL ** -0.5),
        "conv_w": nrm(ks[3], (L, CONV_WIDTH, 1, CONV_CH), CONV_WIDTH ** -0.5),
        "conv_b": nrm(ks[4], (L, CONV_CH), 0.02),
        "conv_ng": 1.0 + nrm(ks[5], (L, CONV_CH), 0.05),
        "conv_nb": nrm(ks[6], (L, CONV_CH), 0.02),
        "sgu_ng": 1.0 + nrm(ks[7], (L, SGU_CH), 0.05),
        "sgu_nb": nrm(ks[8], (L, SGU_CH), 0.02),
        "sgu_w": nrm(ks[9], (L, SGU_HEADS, CHUNK, CHUNK), CHUNK ** -0.5),
        "sgu_b": 1.0 + nrm(ks[10], (L, SGU_HEADS, CHUNK), 0.1),
        "w_out": nrm(ks[11], (L, D_MIX, D_MODEL), D_MIX ** -0.5),
        "norm_ffn": 1.0 + nrm(ks[12], (L, D_MODEL), 0.05),
        "ffn_wg": nrm(ks[13], (N_DENSE, D_MODEL, D_FF), D_MODEL ** -0.5),
        "ffn_wu": nrm(ks[14], (N_DENSE, D_MODEL, D_FF), D_MODEL ** -0.5),
        "ffn_wd": nrm(ks[15], (N_DENSE, D_FF, D_MODEL), D_FF ** -0.5),
        "moe_router": nrm(ks[16], (N_MOE, D_MODEL, N_EXPERTS), D_MODEL ** -0.5),
        "moe_wg": nrm(ks[17], (N_MOE, N_EXPERTS, D_MODEL, D_FF), D_MODEL ** -0.5),
        "moe_wu": nrm(ks[18], (N_MOE, N_EXPERTS, D_MODEL, D_FF), D_MODEL ** -0.5),
        "moe_wd": nrm(ks[19], (N_MOE, N_EXPERTS, D_FF, D_MODEL), D_FF ** -0.5),
        "norm_final": 1.0 + nrm(ks[20], (D_MODEL,), 0.05),
    }


def reference(x, norm_mix, w_in, conv_w, conv_b, conv_ng, conv_nb, sgu_ng, sgu_nb, sgu_w, sgu_b,
              w_out, norm_ffn, ffn_wg, ffn_wu, ffn_wd, moe_router, moe_wg, moe_wu, moe_wd, norm_final):
    for l in range(DEPTH):
        h = rms_norm(x, norm_mix[l])
        x = x + hybrid_mixer(h, w_in[l], conv_w[l], conv_b[l], conv_ng[l], conv_nb[l],
                             sgu_ng[l], sgu_nb[l], sgu_w[l], sgu_b[l], w_out[l])
        h = rms_norm(x, norm_ffn[l])
        i = l // 2
        if l % 2 == 0:
            x = x + swiglu(h, ffn_wg[i], ffn_wu[i], ffn_wd[i])
        else:
            x = x + moe_swiglu(h, moe_router[i], moe_wg[i], moe_wu[i], moe_wd[i])
    return rms_norm(x, norm_final)
```

```cpp
#include <hip/hip_runtime.h>
#include <cstdio>
#include <cstdint>

#ifndef MK_N_LAUNCHES
#define MK_N_LAUNCHES 1
#endif
constexpr int N_PHASES = 13;

#define GAS __attribute__((address_space(1)))
#define LAS __attribute__((address_space(3)))
typedef unsigned short bf16_t;
typedef short bf16x8 __attribute__((ext_vector_type(8)));
typedef float f32x4 __attribute__((ext_vector_type(4)));
typedef float f32x2 __attribute__((ext_vector_type(2)));
typedef unsigned u32x4 __attribute__((ext_vector_type(4)));
typedef unsigned u32x2 __attribute__((ext_vector_type(2)));

constexpr int NB = 8, SEQ = 2048, T = NB * SEQ, D = 1024, DIN = 2048, CC = 512, FF = 2816, NE = 8, CW = 31, NFF2 = 2 * FF;
constexpr float EPS = 1e-6f;
constexpr int NWAVES = 8;

constexpr size_t KiB = 1024, MiB = 1024 * 1024;
constexpr size_t WS_CTL = 0, CTL_ZERO_BYTES = 64 * KiB;
constexpr int CW_BAR = 1024;
constexpr int CW_CNT = 8192;
constexpr size_t WS_TOKLIST = 64 * KiB;
constexpr size_t WS_TOKINFO = 576 * KiB;
constexpr size_t WS_RT = 832 * KiB;
constexpr size_t WS_SGUW = 1 * MiB;
constexpr size_t WS_RSS = 2 * MiB;
constexpr size_t WS_WIN = 6 * MiB;
constexpr size_t WS_WOUT = 14 * MiB;
constexpr size_t WS_FGU = 18 * MiB;
constexpr size_t WS_FD = 29 * MiB;
constexpr size_t WS_MGU = 35 * MiB;
constexpr size_t WS_MD = 123 * MiB;
constexpr size_t WS_XB = 167 * MiB;
constexpr size_t WS_ACT = 199 * MiB;
constexpr size_t WS_CG = WS_ACT, WS_UA = WS_ACT + 16 * MiB, WS_VA = WS_ACT + 32 * MiB, WS_Y = WS_ACT + 48 * MiB;
constexpr size_t WS_YS = WS_MGU;
constexpr size_t WS_END = WS_ACT + (size_t)(2 * T + 256) * FF * 2;
static_assert(WS_END <= 380 * MiB, "workspace map");
static_assert(WS_MGU + (size_t)NE * NFF2 * D * 2 <= WS_MD && WS_MD + (size_t)NE * D * FF * 2 <= WS_XB && WS_FD + (size_t)D * FF * 2 <= WS_MGU, "workspace map 2");

constexpr int RING_BYTES = 131072;
constexpr int LDSCTL_OFF = RING_BYTES;
constexpr int TOKTAB_OFF = RING_BYTES + 512;
constexpr int LDS_BYTES = 147456;
static_assert(TOKTAB_OFF + 12 * 256 * 4 <= LDS_BYTES, "LDS map");

#define RLX_AGENT __ATOMIC_RELAXED, __HIP_MEMORY_SCOPE_AGENT
__device__ __forceinline__ unsigned cvt_pk_bf16(float lo, float hi) { unsigned r; asm volatile("v_cvt_pk_bf16_f32 %0, %1, %2" : "=v"(r) : "v"(lo), "v"(hi)); return r; }
__device__ __forceinline__ float bf_lo(unsigned x) { return __uint_as_float(x << 16); }
__device__ __forceinline__ float bf_hi(unsigned x) { return __uint_as_float(x & 0xffff0000u); }
__device__ __forceinline__ float fast_sigmoid(float g) { return __builtin_amdgcn_rcpf(1.0f + __builtin_amdgcn_exp2f(-1.4426950408889634f * g)); }
__device__ __forceinline__ float wave_sum(float v) {
#pragma unroll
    for (int o = 1; o < 64; o <<= 1) v += __shfl_xor(v, o);
    return v;
}
__device__ __forceinline__ f32x2 gelu_pk(f32x2 v) {
    const f32x2 av = __builtin_elementwise_abs(v), d = av * 0.2316418882f + 1.0f;
    f32x2 t; t.x = __builtin_amdgcn_rcpf(d.x); t.y = __builtin_amdgcn_rcpf(d.y);
    f32x2 q = t * 0.5307027145f + (-0.7265760135f); q = q * t + 0.7107068705f; q = q * t + (-0.142248368f); q = q * t + 0.127414796f; q = q * t;
    const f32x2 s = (v * v) * (-0.72134752044f);
    f32x2 e; e.x = __builtin_amdgcn_exp2f(s.x); e.y = __builtin_amdgcn_exp2f(s.y);
    const f32x2 m = v * (q * e), r = v - m;
    f32x2 o; o.x = v.x < 0.f ? m.x : r.x; o.y = v.y < 0.f ? m.y : r.y; return o;
}

#define XB_TMO      128
#define XB_XCNT(j)  (256  + 64 * (j))
#define XB_XSUB(j)  (1280 + 64 * (j))
#define XB_XGEN(j)  (2304 + 64 * (j))
#define XB_TOP      3328
#define XB_TOPGEN   3392
#define XCD_BAR_WORDS 3456
#define XB_SPIN_CAP (1u << 18)
__device__ __forceinline__ unsigned xb_ld(unsigned* p)              { return __hip_atomic_load(p, __ATOMIC_RELAXED, __HIP_MEMORY_SCOPE_AGENT); }
__device__ __forceinline__ unsigned xb_add(unsigned* p, unsigned v) { return __hip_atomic_fetch_add(p, v, __ATOMIC_RELAXED, __HIP_MEMORY_SCOPE_AGENT); }
__device__ __forceinline__ unsigned xb_xcc_id() { return (unsigned)__builtin_amdgcn_s_getreg((3 << 11) | 20) & 0xFu; }
#define XB_SPIN(cond, bar) do { unsigned _sp = 0; while (cond) { __builtin_amdgcn_s_sleep(1); \
    if ((++_sp & 255u) == 0u) { if (xb_ld(&(bar)[XB_TMO])) break; if (_sp > XB_SPIN_CAP) { atomicAdd(&(bar)[XB_TMO], 1u); break; } } } } while (0)
struct XcdBarrier { unsigned* bar; unsigned x; volatile LAS unsigned* st; };
__device__ __forceinline__ XcdBarrier xcd_barrier_post(unsigned* bar, volatile LAS unsigned* st) {
    XcdBarrier b; b.bar = bar; b.x = xb_xcc_id(); b.st = st;
    if (threadIdx.x == 0) (void)xb_add(&bar[XB_XCNT(b.x)], 1u);
    return b;
}
__device__ __forceinline__ void xcd_barrier_complete(unsigned* bar, unsigned x, unsigned& nloc, unsigned& nx) {
    const unsigned G = gridDim.x * gridDim.y * gridDim.z;
    unsigned sum, cnt, mine, sp = 0u;
    for (;;) {
        sum = 0u; cnt = 0u; mine = 0u;
#pragma unroll
        for (unsigned j = 0; j < 16; ++j) { const unsigned c = xb_ld(&bar[XB_XCNT(j)]); sum += c; cnt += (c > 0u) ? 1u : 0u; mine = (j == x) ? c : mine; }
        if (sum == G) break;
        __builtin_amdgcn_s_sleep(1);
        if ((++sp & 255u) == 0u) { if (xb_ld(&bar[XB_TMO])) break; if (sp > XB_SPIN_CAP) { atomicAdd(&bar[XB_TMO], 1u); break; } }
    }
    nloc = mine > 0u ? mine : 1u; nx = cnt > 0u ? cnt : 1u;
}
__device__ __forceinline__ void xcd_barrier(const XcdBarrier& b) {
    asm volatile("s_waitcnt vmcnt(0)" ::: "memory");
    __syncthreads();
    if (threadIdx.x == 0) {
        unsigned* bar = b.bar;
        __builtin_amdgcn_s_waitcnt(0);
        unsigned nloc = b.st[0], nx = b.st[1];
        if (nloc == 0u) { xcd_barrier_complete(bar, b.x, nloc, nx); b.st[0] = nloc; b.st[1] = nx; }
        const unsigned old = xb_add(&bar[XB_XSUB(b.x)], 1u);
        const unsigned gen = old / nloc;
        if (old + 1u == (gen + 1u) * nloc) {
            __builtin_amdgcn_fence(__ATOMIC_RELEASE, "agent");
            asm volatile("s_waitcnt vmcnt(0)" ::: "memory");
            const unsigned og = xb_add(&bar[XB_TOP], 1u);
            const unsigned tg = og / nx;
            if (og + 1u == (tg + 1u) * nx) xb_add(&bar[XB_TOPGEN], 1u);
            else XB_SPIN(xb_ld(&bar[XB_TOPGEN]) == tg, bar);
            __builtin_amdgcn_fence(__ATOMIC_ACQUIRE, "agent");
            xb_add(&bar[XB_XGEN(b.x)], 1u);
            asm volatile("s_waitcnt vmcnt(0)" ::: "memory");
        } else {
            XB_SPIN(xb_ld(&bar[XB_XGEN(b.x)]) == gen, bar);
            __builtin_amdgcn_fence(__ATOMIC_ACQUIRE, "agent");
            asm volatile("s_waitcnt vmcnt(0)" ::: "memory");
        }
    }
    __syncthreads();
}

namespace pg8 {
constexpr int BM = 256, BK = 64, HALF = 128, HTB = HALF * BK * 2, STAGE_BYTES = 8 * HTB, NXCD = 8, WGM = 8;
__host__ __device__ __forceinline__ int lds_byte(int r, int c) { const int st = (r >> 4) * 2 + (c >> 5), rr = r & 15, cc = c & 31, ob = rr * 64 + cc * 2; return st * 1024 + (ob ^ (((ob >> 9) & 1) << 5)); }
__host__ __device__ __forceinline__ void stage_rc(int b, int& R, int& C) { const int st = b / 1024, sb = b % 1024, swz = sb ^ (((sb >> 9) & 1) << 5); R = (st >> 1) * 16 + swz / 64; C = (st & 1) * 32 + (swz % 64) / 2; }
__host__ __device__ __forceinline__ int perm32(int rho) { const int n = rho >> 4, i = rho & 15; return 8 * (i >> 2) + 4 * n + (i & 3); }

struct Unit { int pm, pn, e, valid, rb, ui; };

struct StaticOrder {
    int nM, nN, nwg, G, c;
    __device__ __forceinline__ void init(int nM_, int nN_, int G_, int c_) { nM = nM_; nN = nN_; nwg = nM * nN; G = G_; c = c_; }
    __device__ __forceinline__ bool map(int i, int& pm, int& pn) const {
        const long L = (long)i * G + c; if (L >= nwg) return false;
        int wgid = (int)L; { const int q = nwg / NXCD, r = nwg % NXCD, xcd = wgid % NXCD, off = wgid / NXCD; wgid = (xcd < r ? xcd * (q + 1) : r * (q + 1) + (xcd - r) * q) + off; }
        const int nig = WGM * nN, gid = wgid / nig, fm = gid * WGM, gsz = (nM - fm) < WGM ? (nM - fm) : WGM;
        pm = fm + ((wgid % nig) % gsz); pn = (wgid % nig) / gsz; return true;
    }
};

template <class Epi, class Sched, bool ALIGN_EPI>
__device__ __forceinline__ void gemm_phase(LAS unsigned char* lds, const int K, const Sched& S, const Epi& E) {
    const int tid = threadIdx.x, wid = __builtin_amdgcn_readfirstlane(tid >> 6), lane = tid & 63, wr = wid >> 2, wc = wid & 3, fr = lane & 15, fq = lane >> 4;
    const int nt = K / BK;
    int Rs[2], Cs[2]; unsigned voffB[2];
#pragma unroll
    for (int i = 0; i < 2; ++i) { stage_rc(tid * 16 + i * 8192, Rs[i], Cs[i]); voffB[i] = (unsigned)(Rs[i] * K + Cs[i]) * 2u; }
    const size_t kstep = (size_t)(BK * 2);
    const size_t hstep = (size_t)HALF * K * 2;
    const unsigned ldsw = (unsigned)wid * 1024u;
    const int aoff = lds_byte(wr * 64 + fr, fq * 8), boff = lds_byte(wc * 32 + fr, fq * 8);
#define PG8_SA(b, h) (((b) * 2 + (h)) * HTB)
#define PG8_SB(b, h) ((4 + (b) * 2 + (h)) * HTB)
#define PG8_STAGE(bufoff, gbase, voff) do { _Pragma("unroll") for (int _i = 0; _i < 2; ++_i) \
        __builtin_amdgcn_global_load_lds((const unsigned*)((const char*)(gbase) + (voff)[_i]), (LAS unsigned*)(lds + (bufoff) + ldsw + _i * 8192), 16, 0, 0); } while (0)
#define PG8_LDA(dst, b, h) do { _Pragma("unroll") for (int m = 0; m < 4; ++m) _Pragma("unroll") for (int k = 0; k < 2; ++k) dst[m][k] = *(const LAS bf16x8*)(lds + PG8_SA(b, h) + aoff + m * 2048 + k * 1024); } while (0)
#define PG8_LDB(dst, b, h) do { _Pragma("unroll") for (int n = 0; n < 2; ++n) _Pragma("unroll") for (int k = 0; k < 2; ++k) dst[n][k] = *(const LAS bf16x8*)(lds + PG8_SB(b, h) + boff + n * 2048 + k * 1024); } while (0)
#define PG8_MMA(ai, bj, At, Bt) do { __builtin_amdgcn_s_setprio(1); _Pragma("unroll") for (int m = 0; m < 4; ++m) _Pragma("unroll") for (int n = 0; n < 2; ++n) _Pragma("unroll") for (int k = 0; k < 2; ++k) \
        acc[ai][bj][m][n] = __builtin_amdgcn_mfma_f32_16x16x32_bf16(Bt[n][k], At[m][k], acc[ai][bj][m][n], 0, 0, 0); __builtin_amdgcn_s_setprio(0); } while (0)
#define PG8_WAIT_V(n) asm volatile("s_waitcnt vmcnt(" #n ")" ::: "memory")
#define PG8_WAIT_L(n) asm volatile("s_waitcnt lgkmcnt(" #n ")" ::: "memory")
#define PG8_BAR __builtin_amdgcn_s_barrier()
#define PG8_SCHED __builtin_amdgcn_sched_barrier(0)
    Unit cur, nxt; int ui = 0;
    if (!S.next(0, cur)) return;
    f32x4 acc[2][2][4][2];
#pragma unroll
    for (int a = 0; a < 2; ++a)
#pragma unroll
        for (int b = 0; b < 2; ++b)
#pragma unroll
            for (int m = 0; m < 4; ++m)
#pragma unroll
                for (int n = 0; n < 2; ++n) acc[a][b][m][n] = (f32x4){0.f, 0.f, 0.f, 0.f};
    bf16x8 At[4][2], B0[2][2], B1[2][2];
    const char* cA = S.a_ptr(cur); const char* cB = S.b_ptr(cur);
    unsigned offC[2][2], offN[2][2];
    S.a_offs(cur, Rs, Cs, offC);
    PG8_STAGE(PG8_SB(0, 0), cB, voffB); PG8_STAGE(PG8_SB(0, 1), cB + hstep, voffB); PG8_STAGE(PG8_SA(0, 0), cA, offC[0]); PG8_STAGE(PG8_SA(0, 1), cA, offC[1]);
    if (wr == 1) PG8_BAR;
    PG8_WAIT_V(2); PG8_BAR;
    PG8_STAGE(PG8_SB(1, 0), cB + kstep, voffB); PG8_STAGE(PG8_SA(1, 0), cA + kstep, offC[0]); PG8_STAGE(PG8_SB(1, 1), cB + hstep + kstep, voffB);
    PG8_WAIT_V(6); PG8_BAR;
    for (;;) {
        const bool has_next = S.next(ui + 1, nxt);
        const char* nA = has_next ? S.a_ptr(nxt) : cA; const char* nB = has_next ? S.b_ptr(nxt) : cB;
        if (has_next) S.a_offs(nxt, Rs, Cs, offN);
        else {
#pragma unroll
            for (int h = 0; h < 2; ++h)
#pragma unroll
                for (int i = 0; i < 2; ++i) offN[h][i] = offC[h][i]; }
        for (int t = 0; t < nt; t += 2) {
            const bool last = (t == nt - 2);
            const char* a1 = cA + (size_t)(t + 1) * kstep;
            const char* a2 = last ? nA : cA + (size_t)(t + 2) * kstep; const char* b2 = last ? nB : cB + (size_t)(t + 2) * kstep;
            const char* a3 = a2 + kstep; const char* b3 = b2 + kstep;
            unsigned o2[2][2];
#pragma unroll
            for (int h = 0; h < 2; ++h)
#pragma unroll
                for (int i = 0; i < 2; ++i) o2[h][i] = last ? offN[h][i] : offC[h][i];
            PG8_LDB(B0, 0, 0); PG8_LDB(B1, 0, 1); PG8_SCHED; PG8_LDA(At, 0, 0); PG8_STAGE(PG8_SA(1, 1), a1, offC[1]);
            PG8_WAIT_V(8); PG8_WAIT_L(0); PG8_BAR; PG8_MMA(0, 0, At, B0); PG8_MMA(0, 1, At, B1); PG8_BAR; PG8_SCHED;
            PG8_LDA(At, 0, 1); PG8_STAGE(PG8_SB(0, 0), b2, voffB); PG8_STAGE(PG8_SB(0, 1), b2 + hstep, voffB); PG8_STAGE(PG8_SA(0, 0), a2, o2[0]);
            PG8_WAIT_V(8); PG8_WAIT_L(0); PG8_BAR; PG8_MMA(1, 0, At, B0); PG8_MMA(1, 1, At, B1); PG8_BAR; PG8_SCHED;
            PG8_LDB(B0, 1, 0); PG8_LDB(B1, 1, 1); PG8_SCHED; PG8_LDA(At, 1, 0); PG8_STAGE(PG8_SA(0, 1), a2, o2[1]);
            PG8_WAIT_V(8); PG8_WAIT_L(0); PG8_BAR; PG8_MMA(0, 0, At, B0); PG8_MMA(0, 1, At, B1); PG8_BAR; PG8_SCHED;
            PG8_LDA(At, 1, 1); PG8_STAGE(PG8_SB(1, 0), b3, voffB); PG8_STAGE(PG8_SB(1, 1), b3 + hstep, voffB); PG8_STAGE(PG8_SA(1, 0), a3, o2[0]);
            PG8_WAIT_V(8); PG8_WAIT_L(0); PG8_BAR; PG8_MMA(1, 0, At, B0); PG8_MMA(1, 1, At, B1); PG8_BAR; PG8_SCHED;
        }
        if constexpr (ALIGN_EPI) { if (wr == 0) PG8_BAR; }
        E(acc, cur, wr, wc, fr, fq);
        if (!has_next) break;
#pragma unroll
        for (int a = 0; a < 2; ++a)
#pragma unroll
            for (int b = 0; b < 2; ++b)
#pragma unroll
                for (int m = 0; m < 4; ++m)
#pragma unroll
                    for (int n = 0; n < 2; ++n) acc[a][b][m][n] = (f32x4){0.f, 0.f, 0.f, 0.f};
        cur = nxt; cA = nA; cB = nB; ++ui;
#pragma unroll
        for (int h = 0; h < 2; ++h)
#pragma unroll
            for (int i = 0; i < 2; ++i) offC[h][i] = offN[h][i];
        if constexpr (ALIGN_EPI) { if (wr == 1) PG8_BAR; }
    }
    PG8_WAIT_V(0);
    if constexpr (!ALIGN_EPI) { if (wr == 0) PG8_BAR; }
    PG8_BAR;
#undef PG8_SA
#undef PG8_SB
#undef PG8_STAGE
#undef PG8_LDA
#undef PG8_LDB
#undef PG8_MMA
#undef PG8_WAIT_V
#undef PG8_WAIT_L
#undef PG8_BAR
#undef PG8_SCHED
}

struct DenseSched {
    const char* A; const char* Bt; int K; StaticOrder so;
    __device__ __forceinline__ bool next(int i, Unit& u) const { int pm, pn; if (!so.map(i, pm, pn)) return false; u.pm = pm; u.pn = pn; u.e = 0; u.valid = 256; u.rb = pm * 256; u.ui = i; return true; }
    __device__ __forceinline__ const char* a_ptr(const Unit& u) const { return A + (size_t)u.pm * 256 * K * 2; }
    __device__ __forceinline__ const char* b_ptr(const Unit& u) const { return Bt + (size_t)u.pn * 256 * K * 2; }
    __device__ __forceinline__ void a_offs(const Unit&, const int (&R)[2], const int (&C)[2], unsigned (&off)[2][2]) const {
#pragma unroll
        for (int h = 0; h < 2; ++h)
#pragma unroll
            for (int i = 0; i < 2; ++i) off[h][i] = (unsigned)((h * 128 + R[i]) * K + C[i]) * 2u; }
};
__device__ __forceinline__ void moe_lookup(const LAS int* tab, int vt, Unit& u) {
    int e = 0;
#pragma unroll
    for (int k = 1; k < 8; ++k) e += (vt >= tab[16 + k]) ? 1 : 0;
    e = __builtin_amdgcn_readfirstlane(e);
    const int tpe = __builtin_amdgcn_readfirstlane(tab[16 + e]), ce = __builtin_amdgcn_readfirstlane(tab[e]), be = __builtin_amdgcn_readfirstlane(tab[8 + e]);
    const int li = vt - tpe; u.pm = li; u.e = e; const int rem = ce - 256 * li; u.valid = rem < 256 ? rem : 256; u.rb = be + 256 * li;
}
struct MoeUpSched {
    const char* XB; const char* W; const LAS int* toktab; const LAS int* tab; StaticOrder so;
    __device__ __forceinline__ bool next(int i, Unit& u) const { int vt, pn; if (!so.map(i, vt, pn)) return false; moe_lookup(tab, vt, u); u.pn = pn; u.ui = i; return true; }
    __device__ __forceinline__ const char* a_ptr(const Unit&) const { return XB; }
    __device__ __forceinline__ const char* b_ptr(const Unit& u) const { return W + ((size_t)u.e * NFF2 + (size_t)u.pn * 256) * D * 2; }
    __device__ __forceinline__ void a_offs(const Unit& u, const int (&R)[2], const int (&C)[2], unsigned (&off)[2][2]) const {
#pragma unroll
        for (int h = 0; h < 2; ++h)
#pragma unroll
            for (int i = 0; i < 2; ++i) off[h][i] = (unsigned)toktab[u.ui * 256 + h * 128 + R[i]] * (unsigned)(D * 2) + (unsigned)C[i] * 2u; }
};
struct MoeDownSched {
    const char* ACT; const char* W; const LAS int* tab; StaticOrder so;
    __device__ __forceinline__ bool next(int i, Unit& u) const { int vt, pn; if (!so.map(i, vt, pn)) return false; moe_lookup(tab, vt, u); u.pn = pn; u.ui = i; return true; }
    __device__ __forceinline__ const char* a_ptr(const Unit& u) const { return ACT + (size_t)u.rb * FF * 2; }
    __device__ __forceinline__ const char* b_ptr(const Unit& u) const { return W + ((size_t)u.e * D + (size_t)u.pn * 256) * FF * 2; }
    __device__ __forceinline__ void a_offs(const Unit&, const int (&R)[2], const int (&C)[2], unsigned (&off)[2][2]) const {
#pragma unroll
        for (int h = 0; h < 2; ++h)
#pragma unroll
            for (int i = 0; i < 2; ++i) off[h][i] = (unsigned)((h * 128 + R[i]) * FF + C[i]) * 2u; }
};

__device__ __forceinline__ float row_rstd(const float* rss, int row, int fq) {
    const f32x4 p = *(const f32x4*)(rss + (size_t)row * 16 + 4 * fq);
    float s = (p.x + p.y) + (p.z + p.w); s += __shfl_xor(s, 16); s += __shfl_xor(s, 32);
    return 1.0f / sqrtf(s * (1.0f / D) + EPS);
}
struct EpiMix {
    bf16_t* CG; bf16_t* UA; bf16_t* VA; const float* rss;
    __device__ __forceinline__ void operator()(const f32x4 (&acc)[2][2][4][2], const Unit& u, int wr, int wc, int fr, int fq) const {
        const int row0 = u.rb + wr * 64 + fr;
#pragma unroll
        for (int ai = 0; ai < 2; ++ai)
#pragma unroll
            for (int m = 0; m < 4; ++m) {
                const int row = row0 + ai * HALF + m * 16; const float rs = row_rstd(rss, row, fq);
                if (u.pn < 4) {
                    float o[8];
#pragma unroll
                    for (int n = 0; n < 2; ++n)
#pragma unroll
                        for (int j = 0; j < 4; ++j) { const float a = acc[ai][0][m][n][j] * rs, g = acc[ai][1][m][n][j] * rs; o[4 * n + j] = a * fast_sigmoid(g); }
                    u32x4 w; w.x = cvt_pk_bf16(o[0], o[1]); w.y = cvt_pk_bf16(o[2], o[3]); w.z = cvt_pk_bf16(o[4], o[5]); w.w = cvt_pk_bf16(o[6], o[7]);
                    *(u32x4*)(CG + (size_t)row * CC + u.pn * 128 + wc * 32 + 8 * fq) = w;
                } else {
                    bf16_t* dst = (u.pn < 6 ? UA : VA) + (size_t)row * CC + (u.pn & 1) * 256 + wc * 32 + 8 * fq;
#pragma unroll
                    for (int bj = 0; bj < 2; ++bj) {
                        const f32x4 v0 = acc[ai][bj][m][0] * rs, v1 = acc[ai][bj][m][1] * rs;
                        const f32x2 a = gelu_pk((f32x2){v0[0], v0[1]}), b = gelu_pk((f32x2){v0[2], v0[3]}), c = gelu_pk((f32x2){v1[0], v1[1]}), d = gelu_pk((f32x2){v1[2], v1[3]});
                        u32x4 w; w.x = cvt_pk_bf16(a.x, a.y); w.y = cvt_pk_bf16(b.x, b.y); w.z = cvt_pk_bf16(c.x, c.y); w.w = cvt_pk_bf16(d.x, d.y);
                        *(u32x4*)(dst + bj * HALF) = w; }
                }
            }
    }
};
struct EpiRes {
    const float* XIN; float* XOUT; bf16_t* XB; float* rss_out;
    __device__ __forceinline__ void operator()(const f32x4 (&acc)[2][2][4][2], const Unit& u, int wr, int wc, int fr, int fq) const {
        const int row0 = u.rb + wr * 64 + fr, col0 = u.pn * 256 + wc * 32 + 8 * fq;
#pragma unroll
        for (int ai = 0; ai < 2; ++ai)
#pragma unroll
            for (int m = 0; m < 4; ++m) {
                const int row = row0 + ai * HALF + m * 16; float ss = 0.f;
#pragma unroll
                for (int bj = 0; bj < 2; ++bj) {
                    const size_t off = (size_t)row * D + col0 + bj * HALF;
                    const f32x4 x0 = *(const f32x4*)(XIN + off) + acc[ai][bj][m][0], x1 = *(const f32x4*)(XIN + off + 4) + acc[ai][bj][m][1];
                    *(f32x4*)(XOUT + off) = x0; *(f32x4*)(XOUT + off + 4) = x1;
                    u32x4 w; w.x = cvt_pk_bf16(x0[0], x0[1]); w.y = cvt_pk_bf16(x0[2], x0[3]); w.z = cvt_pk_bf16(x1[0], x1[1]); w.w = cvt_pk_bf16(x1[2], x1[3]);
                    *(u32x4*)(XB + off) = w;
                    ss += (x0[0] * x0[0] + x0[1] * x0[1]) + (x0[2] * x0[2] + x0[3] * x0[3]) + (x1[0] * x1[0] + x1[1] * x1[1]) + (x1[2] * x1[2] + x1[3] * x1[3]); }
                ss += __shfl_xor(ss, 16); ss += __shfl_xor(ss, 32);
                if (fq == 0) rss_out[(size_t)row * 16 + u.pn * 4 + wc] = ss;
            }
    }
};
template <bool MOE> struct EpiSwiglu {
    bf16_t* ACT; const float* rss; const LAS int* toktab;
    __device__ __forceinline__ void operator()(const f32x4 (&acc)[2][2][4][2], const Unit& u, int wr, int wc, int fr, int fq) const {
        const int col = u.pn * 128 + wc * 32 + 8 * fq;
#pragma unroll
        for (int ai = 0; ai < 2; ++ai)
#pragma unroll
            for (int m = 0; m < 4; ++m) {
                const int lr = ai * HALF + wr * 64 + m * 16 + fr;
                const int srow = MOE ? toktab[u.ui * 256 + lr] : u.rb + lr;
                const float rs = row_rstd(rss, srow, fq);
                float o[8];
#pragma unroll
                for (int n = 0; n < 2; ++n)
#pragma unroll
                    for (int j = 0; j < 4; ++j) { const float g = acc[ai][0][m][n][j] * rs, up = acc[ai][1][m][n][j] * rs; o[4 * n + j] = g * fast_sigmoid(g) * up; }
                u32x4 w; w.x = cvt_pk_bf16(o[0], o[1]); w.y = cvt_pk_bf16(o[2], o[3]); w.z = cvt_pk_bf16(o[4], o[5]); w.w = cvt_pk_bf16(o[6], o[7]);
                if (!MOE || lr < u.valid) *(u32x4*)(ACT + (size_t)(u.rb + lr) * FF + col) = w;
            }
    }
};
struct EpiSlot {
    bf16_t* YS;
    __device__ __forceinline__ void operator()(const f32x4 (&acc)[2][2][4][2], const Unit& u, int wr, int wc, int fr, int fq) const {
        const int col0 = u.pn * 256 + wc * 32 + 8 * fq;
#pragma unroll
        for (int ai = 0; ai < 2; ++ai)
#pragma unroll
            for (int m = 0; m < 4; ++m) {
                const int lr = ai * HALF + wr * 64 + m * 16 + fr;
                if (lr < u.valid) {
#pragma unroll
                    for (int bj = 0; bj < 2; ++bj) {
                        const f32x4 x0 = acc[ai][bj][m][0], x1 = acc[ai][bj][m][1];
                        u32x4 w; w.x = cvt_pk_bf16(x0[0], x0[1]); w.y = cvt_pk_bf16(x0[2], x0[3]); w.z = cvt_pk_bf16(x1[0], x1[1]); w.w = cvt_pk_bf16(x1[2], x1[3]);
                        *(u32x4*)(YS + (size_t)(u.rb + lr) * D + col0 + bj * HALF) = w; }
                }
            }
    }
};
}

struct Args { const float* in[21]; float* out; unsigned char* ws; int ph_lo, ph_hi; };
enum { I_X = 0, I_NMIX, I_WIN, I_CONVW, I_CONVB, I_CONVNG, I_CONVNB, I_SGUNG, I_SGUNB, I_SGUW, I_SGUB, I_WOUT, I_NFFN, I_FWG, I_FWU, I_FWD, I_ROUTER, I_MWG, I_MWU, I_MWD, I_NFINAL };

__device__ __forceinline__ void p0_item(const float* __restrict__ W, int N, int K, const float* __restrict__ gain, bf16_t* dst_g0, int c0, int k0, LAS float* scr, int lane) {
#pragma unroll 8
    for (int i = 0; i < 32; ++i) { const int kk = 2 * i + (lane >> 5); float v = W[(size_t)(k0 + kk) * N + c0 + (lane & 31)]; if (gain) v *= gain[k0 + kk]; scr[kk * 33 + (lane & 31)] = v; }
    asm volatile("s_waitcnt lgkmcnt(0)" ::: "memory");
    const int c = lane & 7;
#pragma unroll
    for (int j = 0; j < 4; ++j) { const int rho = (lane >> 3) + 8 * j; const LAS float* s = scr + (8 * c) * 33 + pg8::perm32(rho);
        u32x4 o; o.x = cvt_pk_bf16(s[0 * 33], s[1 * 33]); o.y = cvt_pk_bf16(s[2 * 33], s[3 * 33]); o.z = cvt_pk_bf16(s[4 * 33], s[5 * 33]); o.w = cvt_pk_bf16(s[6 * 33], s[7 * 33]);
        *(u32x4*)(dst_g0 + (size_t)rho * K + k0 + 8 * c) = o; }
    asm volatile("s_waitcnt lgkmcnt(0)" ::: "memory");
}
__device__ __forceinline__ void prologue_phase(const Args& args, LAS unsigned char* lds, int gw, int NGW, int lane) {
    unsigned char* ws = args.ws;
    LAS float* scr = (LAS float*)(lds + (threadIdx.x >> 6) * 16384);
    constexpr int IT_WIN = 16 * 64, IT_WOUT = 16 * 32, IT_GU = 16 * 176, IT_DN = 44 * 32;
    constexpr int NITEMS = 2 * IT_WIN + 2 * IT_WOUT + IT_GU + IT_DN + NE * IT_GU + NE * IT_DN;
    for (int it = gw; it < NITEMS; it += NGW) {
        int r = it;
        if (r < 2 * IT_WIN) { const int l = r / IT_WIN; r -= l * IT_WIN; const int kb = r / 64, g32 = r % 64, Lb = 32 * g32;
            const int c0 = Lb < 1024 ? ((Lb >> 7) & 1) * 512 + (Lb >> 8) * 128 + (Lb & 127) : Lb;
            p0_item(args.in[I_WIN] + (size_t)l * D * DIN, DIN, D, args.in[I_NMIX] + l * D, (bf16_t*)(ws + WS_WIN) + ((size_t)l * DIN + Lb) * D, c0, 64 * kb, scr, lane); continue; }
        r -= 2 * IT_WIN;
        if (r < 2 * IT_WOUT) { const int l = r / IT_WOUT; r -= l * IT_WOUT; const int kb = r / 32, g32 = r % 32, Lb = 32 * g32;
            p0_item(args.in[I_WOUT] + (size_t)l * D * D, D, D, nullptr, (bf16_t*)(ws + WS_WOUT) + ((size_t)l * D + Lb) * D, Lb, 64 * kb, scr, lane); continue; }
        r -= 2 * IT_WOUT;
        if (r < IT_GU) { const int kb = r / 176, g32 = r % 176, Lb = 32 * g32; const int kind = (Lb >> 7) & 1, f = (Lb >> 8) * 128 + (Lb & 127);
            p0_item(args.in[kind ? I_FWU : I_FWG], FF, D, args.in[I_NFFN], (bf16_t*)(ws + WS_FGU) + (size_t)Lb * D, f, 64 * kb, scr, lane); continue; }
        r -= IT_GU;
        if (r < IT_DN) { const int kb = r / 32, g32 = r % 32, Lb = 32 * g32;
            p0_item(args.in[I_FWD], D, FF, nullptr, (bf16_t*)(ws + WS_FD) + (size_t)Lb * FF, Lb, 64 * kb, scr, lane); continue; }
        r -= IT_DN;
        if (r < NE * IT_GU) { const int e = r / IT_GU; r -= e * IT_GU; const int kb = r / 176, g32 = r % 176, Lb = 32 * g32; const int kind = (Lb >> 7) & 1, f = (Lb >> 8) * 128 + (Lb & 127);
            p0_item(args.in[kind ? I_MWU : I_MWG] + (size_t)e * D * FF, FF, D, args.in[I_NFFN] + D, (bf16_t*)(ws + WS_MGU) + ((size_t)e * NFF2 + Lb) * D, f, 64 * kb, scr, lane); continue; }
        r -= NE * IT_GU;
        { const int e = r / IT_DN; r -= e * IT_DN; const int kb = r / 32, g32 = r % 32, Lb = 32 * g32;
            p0_item(args.in[I_MWD] + (size_t)e * FF * D, D, FF, nullptr, (bf16_t*)(ws + WS_MD) + ((size_t)e * D + Lb) * FF, Lb, 64 * kb, scr, lane); }
    }
    { const float* x = args.in[I_X]; bf16_t* XB = (bf16_t*)(ws + WS_XB); float* rss = (float*)(ws + WS_RSS);
      for (int m = gw; m < T; m += NGW) {
          const f32x4* xr = (const f32x4*)(x + (size_t)m * D) + lane; f32x4 v[4]; float s = 0.f;
#pragma unroll
          for (int j = 0; j < 4; ++j) { v[j] = xr[64 * j]; s += (v[j].x * v[j].x + v[j].y * v[j].y) + (v[j].z * v[j].z + v[j].w * v[j].w); }
          s = wave_sum(s);
          u32x2* o8 = (u32x2*)(XB + (size_t)m * D) + lane;
#pragma unroll
          for (int j = 0; j < 4; ++j) { u32x2 w; w.x = cvt_pk_bf16(v[j].x, v[j].y); w.y = cvt_pk_bf16(v[j].z, v[j].w); o8[64 * j] = w; }
          if (lane < 16) rss[(size_t)m * 16 + lane] = lane == 0 ? s : 0.f; } }
    { float* RT = (float*)(ws + WS_RT); const float* rt = args.in[I_ROUTER]; const float* g = args.in[I_NFFN] + D;
      for (int i = gw * 64 + lane; i < NE * D; i += NGW * 64) { const int e = i / D, k = i % D; RT[i] = rt[k * NE + e] * g[k]; } }
    { bf16_t* SW = (bf16_t*)(ws + WS_SGUW); const float* sw = args.in[I_SGUW];
      for (int i = gw * 64 + lane; i < 2 * 4 * 128 * 128 / 2; i += NGW * 64) { const int e0 = 2 * i, tt = (e0 >> 7) & 127, s0 = e0 & 127;
          const float a = s0 <= tt ? sw[e0] : 0.f, b = (s0 + 1) <= tt ? sw[e0 + 1] : 0.f; ((unsigned*)SW)[i] = cvt_pk_bf16(a, b); } }
}

__device__ __forceinline__ void mid_phase(const Args& args, LAS unsigned char* lds, int l, int gw, int NGW, int lane, int wave) {
    unsigned char* ws = args.ws;
    const bf16_t* CG = (const bf16_t*)(ws + WS_CG); const bf16_t* UA = (const bf16_t*)(ws + WS_UA); const bf16_t* VA = (const bf16_t*)(ws + WS_VA); bf16_t* Y = (bf16_t*)(ws + WS_Y);
    const int fr = lane & 15, fq = lane >> 4;
    {
        constexpr int VST = 264;
        const bf16_t* Wb = (const bf16_t*)(ws + WS_SGUW) + (size_t)l * 4 * 128 * 128;
        const float* ng = args.in[I_SGUNG] + l * CC; const float* nb = args.in[I_SGUNB] + l * CC; const float* sb = args.in[I_SGUB] + l * 4 * 128;
        for (int unit = blockIdx.x; unit < NB * 16 * 4; unit += gridDim.x) {
            const int b = unit >> 6, n = (unit >> 2) & 15, h = unit & 3; const int R0 = b * SEQ + n * 128;
            const float g0 = ng[h * 128 + 2 * lane], g1 = ng[h * 128 + 2 * lane + 1], b0 = nb[h * 128 + 2 * lane], b1 = nb[h * 128 + 2 * lane + 1];
#pragma unroll 4
            for (int rr = 0; rr < 16; ++rr) {
                const int s = wave * 16 + rr;
                const unsigned pv = *(const unsigned*)(VA + (size_t)(R0 + s) * CC + h * 128 + 2 * lane);
                const float v0 = bf_lo(pv), v1 = bf_hi(pv);
                const float mean = wave_sum(v0 + v1) * (1.0f / 128.0f);
                const float d0 = v0 - mean, d1 = v1 - mean;
                const float rstd = 1.0f / sqrtf(wave_sum(d0 * d0 + d1 * d1) * (1.0f / 128.0f) + EPS);
                const unsigned pk = cvt_pk_bf16(d0 * rstd * g0 + b0, d1 * rstd * g1 + b1);
                *(LAS unsigned short*)(lds + (2 * lane) * VST + s * 2) = (unsigned short)(pk & 0xffffu);
                *(LAS unsigned short*)(lds + (2 * lane + 1) * VST + s * 2) = (unsigned short)(pk >> 16);
            }
            __syncthreads();
            f32x4 acc[8];
#pragma unroll
            for (int db = 0; db < 8; ++db) acc[db] = (f32x4){0.f, 0.f, 0.f, 0.f};
            const int nks = ((16 * wave + 15) >> 5) + 1;
            for (int ks = 0; ks < nks; ++ks) {
                const bf16x8 bfrag = *(const bf16x8*)(Wb + (size_t)h * 16384 + (16 * wave + fr) * 128 + 32 * ks + 8 * fq);
#pragma unroll
                for (int db = 0; db < 8; ++db) {
                    const LAS unsigned char* ap = lds + (16 * db + fr) * VST + (32 * ks + 8 * fq) * 2;
                    union { bf16x8 v; u32x2 h[2]; } af; af.h[0] = *(const LAS u32x2*)ap; af.h[1] = *(const LAS u32x2*)(ap + 8);
                    acc[db] = __builtin_amdgcn_mfma_f32_16x16x32_bf16(af.v, bfrag, acc[db], 0, 0, 0);
                }
            }
            { const int t = 16 * wave + fr; const float bias = sb[h * 128 + t]; const size_t row = (size_t)(R0 + t);
#pragma unroll
              for (int db = 0; db < 8; ++db) { const int d = 16 * db + 4 * fq;
                  const u32x2 uu = *(const u32x2*)(UA + row * CC + h * 128 + d);
                  const float o0 = bf_lo(uu.x) * (acc[db][0] + bias), o1 = bf_hi(uu.x) * (acc[db][1] + bias), o2 = bf_lo(uu.y) * (acc[db][2] + bias), o3 = bf_hi(uu.y) * (acc[db][3] + bias);
                  u32x2 w; w.x = cvt_pk_bf16(o0, o1); w.y = cvt_pk_bf16(o2, o3);
                  *(u32x2*)(Y + row * D + CC + h * 128 + d) = w; } }
            __syncthreads();
        }
    }
    {
        const int cg = gw & 3, ch = cg * 128 + 2 * lane;
        const float* cwp = args.in[I_CONVW] + (size_t)l * CW * CC + ch;
        const f32x2 cb = *(const f32x2*)(args.in[I_CONVB] + l * CC + ch), ng = *(const f32x2*)(args.in[I_CONVNG] + l * CC + ch), nb = *(const f32x2*)(args.in[I_CONVNB] + l * CC + ch);
        for (int item = gw >> 2; item < NB * (SEQ / 16); item += NGW >> 2) {
            const int b = item >> 7, t0 = (item & 127) * 16; const size_t rowb = (size_t)b * SEQ;
            unsigned in[46];
#pragma unroll
            for (int i = 0; i < 46; ++i) { const int t = t0 - 30 + i; in[i] = t >= 0 ? *(const unsigned*)(CG + (rowb + t) * CC + ch) : 0u; }
            float a0[16], a1[16];
#pragma unroll
            for (int tt = 0; tt < 16; ++tt) { a0[tt] = cb.x; a1[tt] = cb.y; }
#pragma unroll
            for (int j = 0; j < CW; ++j) {
                const f32x2 w = *(const f32x2*)(cwp + j * CC);
#pragma unroll
                for (int tt = 0; tt < 16; ++tt) { a0[tt] += w.x * bf_lo(in[tt + j]); a1[tt] += w.y * bf_hi(in[tt + j]); }
            }
#pragma unroll
            for (int tt = 0; tt < 16; ++tt) {
                float s = a0[tt] + a1[tt];
#pragma unroll
                for (int o = 1; o < 32; o <<= 1) s += __shfl_xor(s, o);
                const float mean = s * (1.0f / 64.0f); const float d0 = a0[tt] - mean, d1 = a1[tt] - mean; float q = d0 * d0 + d1 * d1;
#pragma unroll
                for (int o = 1; o < 32; o <<= 1) q += __shfl_xor(q, o);
                const float rstd = 1.0f / sqrtf(q * (1.0f / 64.0f) + EPS);
                const float y0 = d0 * rstd * ng.x + nb.x, y1 = d1 * rstd * ng.y + nb.y;
                *(unsigned*)(Y + (rowb + t0 + tt) * D + ch) = cvt_pk_bf16(y0 * fast_sigmoid(y0), y1 * fast_sigmoid(y1));
            }
        }
    }
}

__device__ __forceinline__ void router_phase(const Args& args, LAS unsigned char* lds, int lane, int wave) {
    unsigned char* ws = args.ws;
    const bf16_t* XB = (const bf16_t*)(ws + WS_XB); const float* RT = (const float*)(ws + WS_RT); const float* rss = (const float*)(ws + WS_RSS) + (size_t)3 * T * 16;
    int* toklist = (int*)(ws + WS_TOKLIST); u32x4* tokinfo = (u32x4*)(ws + WS_TOKINFO); unsigned* cntw = (unsigned*)(ws + WS_CTL) + CW_CNT;
    LAS int* wcnt = (LAS int*)lds;
    LAS int* wbase = (LAS int*)(lds + 256);
    f32x4 rw[NE][2][2];
#pragma unroll
    for (int e = 0; e < NE; ++e)
#pragma unroll
        for (int i = 0; i < 2; ++i) { rw[e][i][0] = *(const f32x4*)(RT + e * D + 512 * i + 8 * lane); rw[e][i][1] = *(const f32x4*)(RT + e * D + 512 * i + 8 * lane + 4); }
    for (int blk = blockIdx.x; blk < T / 64; blk += gridDim.x) {
        int my_e0 = 0, my_e1 = 0; float my_g0 = 0.f, my_g1 = 0.f;
        const int tbase = blk * 64 + wave * 8;
        for (int j = 0; j < 8; ++j) {
            const int t = tbase + j;
            float a[NE];
#pragma unroll
            for (int e = 0; e < NE; ++e) a[e] = 0.f;
#pragma unroll
            for (int i = 0; i < 2; ++i) {
                const u32x4 xv = *(const u32x4*)(XB + (size_t)t * D + 512 * i + 8 * lane);
                const float x0 = bf_lo(xv.x), x1 = bf_hi(xv.x), x2 = bf_lo(xv.y), x3 = bf_hi(xv.y), x4 = bf_lo(xv.z), x5 = bf_hi(xv.z), x6 = bf_lo(xv.w), x7 = bf_hi(xv.w);
#pragma unroll
                for (int e = 0; e < NE; ++e) { const f32x4 wa = rw[e][i][0], wb = rw[e][i][1];
                    a[e] += (x0 * wa.x + x1 * wa.y) + (x2 * wa.z + x3 * wa.w) + (x4 * wb.x + x5 * wb.y) + (x6 * wb.z + x7 * wb.w); }
            }
            float p = lane < 16 ? rss[(size_t)t * 16 + lane] : 0.f;
            p = wave_sum(p);
            const float rstd = 1.0f / sqrtf(p * (1.0f / D) + EPS);
#pragma unroll
            for (int e = 0; e < NE; ++e) a[e] = wave_sum(a[e]) * rstd;
            int e0 = 0; float l0 = a[0];
#pragma unroll
            for (int e = 1; e < NE; ++e) if (a[e] > l0) { l0 = a[e]; e0 = e; }
            int e1 = -1; float l1 = -3.0e38f;
#pragma unroll
            for (int e = 0; e < NE; ++e) if (e != e0 && a[e] > l1) { l1 = a[e]; e1 = e; }
            const float g0 = 1.0f / (1.0f + __expf(l1 - l0)), g1 = 1.0f - g0;
            if (lane == j) { my_e0 = e0; my_e1 = e1; my_g0 = g0; my_g1 = g1; }
        }
        const bool act = lane < 8;
        unsigned long long m0[NE], m1[NE];
#pragma unroll
        for (int e = 0; e < NE; ++e) { m0[e] = __ballot(act && my_e0 == e); m1[e] = __ballot(act && my_e1 == e); }
        if (lane < NE) { int c = 0;
#pragma unroll
            for (int e = 0; e < NE; ++e) if (lane == e) c = __popcll(m0[e]) + __popcll(m1[e]);
            wcnt[wave * 8 + lane] = c; }
        __syncthreads();
        if (threadIdx.x < NE) { const int e = threadIdx.x; int tot = 0; int pre[8];
#pragma unroll
            for (int w = 0; w < 8; ++w) { pre[w] = tot; tot += wcnt[w * 8 + e]; }
            const int base = (int)__hip_atomic_fetch_add(cntw + 64 * e, (unsigned)tot, RLX_AGENT);
#pragma unroll
            for (int w = 0; w < 8; ++w) wbase[w * 8 + e] = base + pre[w]; }
        __syncthreads();
        if (act) {
            const unsigned long long lt = (1ull << lane) - 1ull;
            int pos0 = 0, pos1 = 0;
#pragma unroll
            for (int e = 0; e < NE; ++e) { const int wb = wbase[wave * 8 + e];
                if (my_e0 == e) pos0 = wb + __popcll(m0[e] & lt);
                if (my_e1 == e) pos1 = wb + __popcll(m0[e]) + __popcll(m1[e] & lt); }
            const int t = tbase + lane;
            toklist[my_e0 * T + pos0] = t; toklist[my_e1 * T + pos1] = t;
            u32x4 inf; inf.x = ((unsigned)my_e0 << 16) | (unsigned)pos0; inf.y = ((unsigned)my_e1 << 16) | (unsigned)pos1; inf.z = __float_as_uint(my_g0); inf.w = __float_as_uint(my_g1);
            tokinfo[t] = inf;
        }
        __syncthreads();
    }
}
__device__ __forceinline__ void moe_tab_build(const unsigned char* ws, LAS int* tab) {
    if (threadIdx.x == 0) {
        unsigned* cntw = (unsigned*)(ws + WS_CTL) + CW_CNT; int b = 0, p = 0;
        for (int e = 0; e < NE; ++e) { const int c = (int)__hip_atomic_load(cntw + 64 * e, RLX_AGENT); tab[e] = c; tab[8 + e] = b; tab[16 + e] = p; b += c; p += (c + 255) >> 8; }
        tab[24] = p;
    }
    __syncthreads();
}

__device__ __forceinline__ void final_phase(const Args& args, const LAS int* tab, int gw, int NGW, int lane) {
    unsigned char* ws = args.ws; float* out = args.out; const bf16_t* YS = (const bf16_t*)(ws + WS_YS); const u32x4* tokinfo = (const u32x4*)(ws + WS_TOKINFO);
    f32x4 gn[4];
#pragma unroll
    for (int j = 0; j < 4; ++j) gn[j] = *((const f32x4*)args.in[I_NFINAL] + lane + 64 * j);
    for (int t = gw; t < T; t += NGW) {
        const u32x4 inf = tokinfo[t];
        const int e0 = __builtin_amdgcn_readfirstlane((int)(inf.x >> 16)), p0 = __builtin_amdgcn_readfirstlane((int)(inf.x & 0xffffu)), e1 = __builtin_amdgcn_readfirstlane((int)(inf.y >> 16)), p1 = __builtin_amdgcn_readfirstlane((int)(inf.y & 0xffffu));
        const float g0 = __uint_as_float(inf.z), g1 = __uint_as_float(inf.w);
        const int b0 = __builtin_amdgcn_readfirstlane(tab[8 + e0]), b1 = __builtin_amdgcn_readfirstlane(tab[8 + e1]);
        const size_t s0 = (size_t)(b0 + p0), s1 = (size_t)(b1 + p1);
        f32x4* xr = (f32x4*)(out + (size_t)t * D) + lane; const u32x2* y0 = (const u32x2*)(YS + s0 * D) + lane; const u32x2* y1 = (const u32x2*)(YS + s1 * D) + lane;
        f32x4 v[4]; float ss = 0.f;
#pragma unroll
        for (int j = 0; j < 4; ++j) { const f32x4 x = xr[64 * j]; const u32x2 a = y0[64 * j], b = y1[64 * j];
            v[j].x = x.x + g0 * bf_lo(a.x) + g1 * bf_lo(b.x); v[j].y = x.y + g0 * bf_hi(a.x) + g1 * bf_hi(b.x); v[j].z = x.z + g0 * bf_lo(a.y) + g1 * bf_lo(b.y); v[j].w = x.w + g0 * bf_hi(a.y) + g1 * bf_hi(b.y);
            ss += (v[j].x * v[j].x + v[j].y * v[j].y) + (v[j].z * v[j].z + v[j].w * v[j].w); }
        const float rstd = 1.0f / sqrtf(wave_sum(ss) * (1.0f / D) + EPS);
#pragma unroll
        for (int j = 0; j < 4; ++j) xr[64 * j] = v[j] * rstd * gn[j];
    }
}

__global__ void __launch_bounds__(NWAVES * 64, 2) mega_fwd(Args args) {
    extern __shared__ __attribute__((aligned(16))) unsigned char lds_raw[];
    LAS unsigned char* lds = (LAS unsigned char*)lds_raw;
    const int tid = threadIdx.x, lane = tid & 63, wave = __builtin_amdgcn_readfirstlane(tid >> 6);
    const int G = gridDim.x, bx = blockIdx.x;
    const int vcu = (G % 8 == 0) ? (bx % 8) * (G / 8) + bx / 8 : bx;
    const int gw = vcu * NWAVES + wave, NGW = G * NWAVES;
    unsigned char* ws = args.ws;
    unsigned* ctl = (unsigned*)(ws + WS_CTL);
    for (int u = tid; u < 512 / 4; u += NWAVES * 64) ((LAS unsigned*)(lds + LDSCTL_OFF))[u] = 0u;
    __syncthreads();
    XcdBarrier bar; bar.bar = ctl + CW_BAR; bar.x = 0; bar.st = nullptr;
    if (MK_N_LAUNCHES == 1) bar = xcd_barrier_post(ctl + CW_BAR, (volatile LAS unsigned*)(lds + LDSCTL_OFF) + 8);
    const int lo = args.ph_lo, hi = args.ph_hi;
#define IN(k) (lo <= (k) && (k) < hi)
#define SEAM(k) do { if (MK_N_LAUNCHES == 1 && IN((k) + 1)) xcd_barrier(bar); } while (0)
    float* rss = (float*)(ws + WS_RSS);
    bf16_t* XB = (bf16_t*)(ws + WS_XB);

    if (IN(0)) { prologue_phase(args, lds, gw, NGW, lane); SEAM(0); }

#define LAYER_MIX(l, pb) \
    if (IN(pb)) {       \
        pg8::DenseSched S; S.A = (const char*)XB; S.Bt = (const char*)(ws + WS_WIN) + (size_t)(l) * DIN * D * 2; S.K = D; S.so.init(T / 256, DIN / 256, G, bx); \
        pg8::EpiMix E{(bf16_t*)(ws + WS_CG), (bf16_t*)(ws + WS_UA), (bf16_t*)(ws + WS_VA), rss + (size_t)(2 * (l)) * T * 16}; \
        pg8::gemm_phase<pg8::EpiMix, pg8::DenseSched, true>(lds, D, S, E); \
        SEAM(pb); \
    } \
    if (IN((pb) + 1)) { mid_phase(args, lds, (l), gw, NGW, lane, wave); SEAM((pb) + 1); } \
    if (IN((pb) + 2)) {       \
        pg8::DenseSched S; S.A = (const char*)(ws + WS_Y); S.Bt = (const char*)(ws + WS_WOUT) + (size_t)(l) * D * D * 2; S.K = D; S.so.init(T / 256, D / 256, G, bx); \
        pg8::EpiRes E{(l) == 0 ? args.in[I_X] : args.out, args.out, XB, rss + (size_t)(2 * (l) + 1) * T * 16}; \
        pg8::gemm_phase<pg8::EpiRes, pg8::DenseSched, false>(lds, D, S, E); \
        SEAM((pb) + 2); \
    }
    LAYER_MIX(0, 1)
    if (IN(4)) {
        pg8::DenseSched S; S.A = (const char*)XB; S.Bt = (const char*)(ws + WS_FGU); S.K = D; S.so.init(T / 256, NFF2 / 256, G, bx);
        pg8::EpiSwiglu<false> E{(bf16_t*)(ws + WS_ACT), rss + (size_t)1 * T * 16, nullptr};
        pg8::gemm_phase<pg8::EpiSwiglu<false>, pg8::DenseSched, true>(lds, D, S, E);
        SEAM(4);
    }
    if (IN(5)) {
        pg8::DenseSched S; S.A = (const char*)(ws + WS_ACT); S.Bt = (const char*)(ws + WS_FD); S.K = FF; S.so.init(T / 256, D / 256, G, bx);
        pg8::EpiRes E{args.out, args.out, XB, rss + (size_t)2 * T * 16};
        pg8::gemm_phase<pg8::EpiRes, pg8::DenseSched, false>(lds, FF, S, E);
        SEAM(5);
    }
    LAYER_MIX(1, 6)
    LAS int* mtab = (LAS int*)(lds + LDSCTL_OFF + 64);
    if (IN(9)) { router_phase(args, lds, lane, wave); SEAM(9); }
    if (IN(10)) {
        moe_tab_build(ws, mtab);
        pg8::MoeUpSched S; S.tab = mtab;
        S.XB = (const char*)XB; S.W = (const char*)(ws + WS_MGU); S.toktab = (const LAS int*)(lds + TOKTAB_OFF); S.so.init(__builtin_amdgcn_readfirstlane(mtab[24]), NFF2 / 256, G, bx);
        { const int* toklist = (const int*)(ws + WS_TOKLIST); LAS int* tt = (LAS int*)(lds + TOKTAB_OFF); pg8::Unit u;
          for (int i = 0; i < 12 && S.next(i, u); ++i) if (tid < 256) tt[i * 256 + tid] = tid < u.valid ? toklist[u.e * T + u.pm * 256 + tid] : 0;
          __syncthreads(); }
        pg8::EpiSwiglu<true> E{(bf16_t*)(ws + WS_ACT), rss + (size_t)3 * T * 16, (const LAS int*)(lds + TOKTAB_OFF)};
        pg8::gemm_phase<pg8::EpiSwiglu<true>, pg8::MoeUpSched, true>(lds, D, S, E);
        SEAM(10);
    }
    if (IN(11)) {
        moe_tab_build(ws, mtab);
        pg8::MoeDownSched S; S.tab = mtab;
        S.ACT = (const char*)(ws + WS_ACT); S.W = (const char*)(ws + WS_MD); S.so.init(__builtin_amdgcn_readfirstlane(mtab[24]), D / 256, G, bx);
        pg8::EpiSlot E{(bf16_t*)(ws + WS_YS)};
        pg8::gemm_phase<pg8::EpiSlot, pg8::MoeDownSched, true>(lds, FF, S, E);
        SEAM(11);
    }
    if (IN(12)) { moe_tab_build(ws, mtab); final_phase(args, mtab, gw, NGW, lane); }
#undef IN
#undef SEAM
}

extern "C" void kernel_launch(void* const* d_in, const int* in_sizes, int n_in, void* d_out, int out_size, void* d_ws, size_t ws_size, hipStream_t stream) {
    static int grid = 0;
    if (grid == 0) {
        if (n_in != 21 || in_sizes[0] != T * D || out_size != T * D || ws_size < WS_END) { fprintf(stderr, "kernel_launch: unexpected shapes (n_in %d, in0 %d, out %d, ws %zu < %zu); nothing launched\n", n_in, n_in > 0 ? in_sizes[0] : -1, out_size, ws_size, (size_t)WS_END); grid = -1; return; }
        int dev = 0, cus = 0, per_cu = 0;
        if (hipGetDevice(&dev) != hipSuccess || hipDeviceGetAttribute(&cus, hipDeviceAttributeMultiprocessorCount, dev) != hipSuccess) { grid = -1; return; }
        if (hipFuncSetAttribute((const void*)mega_fwd, hipFuncAttributeMaxDynamicSharedMemorySize, LDS_BYTES) != hipSuccess) { fprintf(stderr, "kernel_launch: hipFuncSetAttribute failed\n"); grid = -1; return; }
        if (hipOccupancyMaxActiveBlocksPerMultiprocessor(&per_cu, (const void*)mega_fwd, NWAVES * 64, LDS_BYTES) != hipSuccess || per_cu < 1) { fprintf(stderr, "kernel_launch: occupancy query reports %d\n", per_cu); }
        (void)hipGetLastError();
        grid = cus;
    }
    if (grid < 0) return;
    if (hipMemsetAsync((char*)d_ws + WS_CTL, 0, CTL_ZERO_BYTES, stream) != hipSuccess) return;
    Args a{};
    for (int i = 0; i < 21; ++i) a.in[i] = (const float*)d_in[i];
    a.out = (float*)d_out; a.ws = (unsigned char*)d_ws;
    if (MK_N_LAUNCHES == 1) { a.ph_lo = 0; a.ph_hi = N_PHASES; hipLaunchKernelGGL(mega_fwd, dim3(grid), dim3(NWAVES * 64), LDS_BYTES, stream, a); }
    else for (int p = 0; p < N_PHASES; ++p) { a.ph_lo = p; a.ph_hi = p + 1; hipLaunchKernelGGL(mega_fwd, dim3(grid), dim3(NWAVES * 64), LDS_BYTES, stream, a); }
}
```

```cpp
#include <hip/hip_runtime.h>
#include <cstdio>
#include <cstdint>

#ifndef PROBE_NULL
#define PROBE_NULL -1
#endif
#ifndef MK_N_LAUNCHES
#define MK_N_LAUNCHES 1
#endif
constexpr int N_PHASES = 13;

#define GAS __attribute__((address_space(1)))
#define LAS __attribute__((address_space(3)))
typedef unsigned short bf16_t;
typedef short bf16x8 __attribute__((ext_vector_type(8)));
typedef float f32x4 __attribute__((ext_vector_type(4)));
typedef float f32x2 __attribute__((ext_vector_type(2)));
typedef unsigned u32x4 __attribute__((ext_vector_type(4)));
typedef unsigned u32x2 __attribute__((ext_vector_type(2)));

constexpr int NB = 8, SEQ = 2048, T = NB * SEQ, D = 1024, DIN = 2048, CC = 512, FF = 2816, NE = 8, CW = 31, NFF2 = 2 * FF;
constexpr float EPS = 1e-6f;
constexpr int NWAVES = 8;

constexpr size_t KiB = 1024, MiB = 1024 * 1024;
constexpr size_t WS_CTL = 0, CTL_ZERO_BYTES = 64 * KiB;
constexpr int CW_BAR = 1024;
constexpr int CW_CNT = 8192;
constexpr size_t WS_TOKLIST = 64 * KiB;
constexpr size_t WS_TOKINFO = 576 * KiB;
constexpr size_t WS_RT = 832 * KiB;
constexpr size_t WS_SGUW = 1 * MiB;
constexpr size_t WS_RSS = 2 * MiB;
constexpr size_t WS_WIN = 6 * MiB;
constexpr size_t WS_WOUT = 14 * MiB;
constexpr size_t WS_FGU = 18 * MiB;
constexpr size_t WS_FD = 29 * MiB;
constexpr size_t WS_MGU = 35 * MiB;
constexpr size_t WS_MD = 123 * MiB;
constexpr size_t WS_XB = 167 * MiB;
constexpr size_t WS_ACT = 199 * MiB;
constexpr size_t WS_CG = WS_ACT, WS_UA = WS_ACT + 16 * MiB, WS_VA = WS_ACT + 32 * MiB, WS_Y = WS_ACT + 48 * MiB;
constexpr size_t WS_YS = WS_MGU;
constexpr size_t WS_END = WS_ACT + (size_t)(2 * T + 256) * FF * 2;
static_assert(WS_END <= 380 * MiB, "workspace map");
static_assert(WS_MGU + (size_t)NE * NFF2 * D * 2 <= WS_MD && WS_MD + (size_t)NE * D * FF * 2 <= WS_XB && WS_FD + (size_t)D * FF * 2 <= WS_MGU, "workspace map 2");

constexpr int RING_BYTES = 131072;
constexpr int LDSCTL_OFF = RING_BYTES;
constexpr int TOKTAB_OFF = RING_BYTES + 512;
constexpr int LDS_BYTES = 147456;
static_assert(TOKTAB_OFF + 12 * 256 * 4 <= LDS_BYTES, "LDS map");

#define RLX_AGENT __ATOMIC_RELAXED, __HIP_MEMORY_SCOPE_AGENT
__device__ __forceinline__ unsigned cvt_pk_bf16(float lo, float hi) { unsigned r; asm volatile("v_cvt_pk_bf16_f32 %0, %1, %2" : "=v"(r) : "v"(lo), "v"(hi)); return r; }
__device__ __forceinline__ float bf_lo(unsigned x) { return __uint_as_float(x << 16); }
__device__ __forceinline__ float bf_hi(unsigned x) { return __uint_as_float(x & 0xffff0000u); }
__device__ __forceinline__ float fast_sigmoid(float g) { return __builtin_amdgcn_rcpf(1.0f + __builtin_amdgcn_exp2f(-1.4426950408889634f * g)); }
__device__ __forceinline__ float wave_sum(float v) {
#pragma unroll
    for (int o = 1; o < 64; o <<= 1) v += __shfl_xor(v, o);
    return v;
}
__device__ __forceinline__ float dpp_add(float v, const int ctrl_sel) {
    int r;
    if (ctrl_sel == 0) r = __builtin_amdgcn_update_dpp(0, __float_as_int(v), 0xB1, 0xF, 0xF, false);
    else if (ctrl_sel == 1) r = __builtin_amdgcn_update_dpp(0, __float_as_int(v), 0x4E, 0xF, 0xF, false);
    else if (ctrl_sel == 2) r = __builtin_amdgcn_update_dpp(0, __float_as_int(v), 0x141, 0xF, 0xF, false);
    else r = __builtin_amdgcn_update_dpp(0, __float_as_int(v), 0x140, 0xF, 0xF, false);
    return v + __int_as_float(r);
}
__device__ __forceinline__ float row16_allsum(float v) { v = dpp_add(v, 0); v = dpp_add(v, 1); v = dpp_add(v, 2); v = dpp_add(v, 3); return v; }
__device__ __forceinline__ f32x2 gelu_pk(f32x2 v) {
    const f32x2 av = __builtin_elementwise_abs(v), d = av * 0.2316418882f + 1.0f;
    f32x2 t; t.x = __builtin_amdgcn_rcpf(d.x); t.y = __builtin_amdgcn_rcpf(d.y);
    f32x2 q = t * 0.5307027145f + (-0.7265760135f); q = q * t + 0.7107068705f; q = q * t + (-0.142248368f); q = q * t + 0.127414796f; q = q * t;
    const f32x2 s = (v * v) * (-0.72134752044f);
    f32x2 e; e.x = __builtin_amdgcn_exp2f(s.x); e.y = __builtin_amdgcn_exp2f(s.y);
    const f32x2 m = v * (q * e), r = v - m;
    f32x2 o; o.x = v.x < 0.f ? m.x : r.x; o.y = v.y < 0.f ? m.y : r.y; return o;
}

#ifndef WT_STORES
#define WT_STORES 0
#endif
struct WtBuf { __amdgpu_buffer_rsrc_t r; };
__device__ __forceinline__ WtBuf wt_buf(const void* base) { WtBuf b; b.r = __builtin_amdgcn_make_buffer_rsrc((void*)base, 0, 0xFFFFFFFFu, 0x00020000); return b; }
__device__ __forceinline__ void wt_store16(const WtBuf& b, const void* base, size_t byte_off, u32x4 v) {
#if WT_STORES
    __builtin_amdgcn_raw_buffer_store_b128(v, b.r, (int)(unsigned)byte_off, 0, 16);
#else
    *(u32x4*)((char*)base + byte_off) = v;
#endif
}
__device__ __forceinline__ void wt_store16f(const WtBuf& b, const void* base, size_t byte_off, f32x4 v) { wt_store16(b, base, byte_off, __builtin_bit_cast(u32x4, v)); }

#define XB_TMO      128
#define XB_XCNT(j)  (256  + 64 * (j))
#define XB_XSUB(j)  (1280 + 64 * (j))
#define XB_XGEN(j)  (2304 + 64 * (j))
#define XB_TOP      3328
#define XB_TOPGEN   3392
#define XCD_BAR_WORDS 3456
#define XB_SPIN_CAP (1u << 18)
__device__ __forceinline__ unsigned xb_ld(unsigned* p)              { return __hip_atomic_load(p, __ATOMIC_RELAXED, __HIP_MEMORY_SCOPE_AGENT); }
__device__ __forceinline__ unsigned xb_add(unsigned* p, unsigned v) { return __hip_atomic_fetch_add(p, v, __ATOMIC_RELAXED, __HIP_MEMORY_SCOPE_AGENT); }
__device__ __forceinline__ unsigned xb_xcc_id() { return (unsigned)__builtin_amdgcn_s_getreg((3 << 11) | 20) & 0xFu; }
#define XB_SPIN(cond, bar) do { unsigned _sp = 0; while (cond) { __builtin_amdgcn_s_sleep(1); \
    if ((++_sp & 255u) == 0u) { if (xb_ld(&(bar)[XB_TMO])) break; if (_sp > XB_SPIN_CAP) { atomicAdd(&(bar)[XB_TMO], 1u); break; } } } } while (0)
struct XcdBarrier { unsigned* bar; unsigned x; volatile LAS unsigned* st; };
__device__ __forceinline__ XcdBarrier xcd_barrier_post(unsigned* bar, volatile LAS unsigned* st) {
    XcdBarrier b; b.bar = bar; b.x = xb_xcc_id(); b.st = st;
    if (threadIdx.x == 0) (void)xb_add(&bar[XB_XCNT(b.x)], 1u);
    return b;
}
__device__ __forceinline__ void xcd_barrier_complete(unsigned* bar, unsigned x, unsigned& nloc, unsigned& nx) {
    const unsigned G = gridDim.x * gridDim.y * gridDim.z;
    unsigned sum, cnt, mine, sp = 0u;
    for (;;) {
        sum = 0u; cnt = 0u; mine = 0u;
#pragma unroll
        for (unsigned j = 0; j < 16; ++j) { const unsigned c = xb_ld(&bar[XB_XCNT(j)]); sum += c; cnt += (c > 0u) ? 1u : 0u; mine = (j == x) ? c : mine; }
        if (sum == G) break;
        __builtin_amdgcn_s_sleep(1);
        if ((++sp & 255u) == 0u) { if (xb_ld(&bar[XB_TMO])) break; if (sp > XB_SPIN_CAP) { atomicAdd(&bar[XB_TMO], 1u); break; } }
    }
    nloc = mine > 0u ? mine : 1u; nx = cnt > 0u ? cnt : 1u;
}
__device__ __forceinline__ void xcd_barrier(const XcdBarrier& b) {
    asm volatile("s_waitcnt vmcnt(0)" ::: "memory");
    __syncthreads();
    if (threadIdx.x == 0) {
        unsigned* bar = b.bar;
        __builtin_amdgcn_s_waitcnt(0);
        unsigned nloc = b.st[0], nx = b.st[1];
        if (nloc == 0u) { xcd_barrier_complete(bar, b.x, nloc, nx); b.st[0] = nloc; b.st[1] = nx; }
        const unsigned old = xb_add(&bar[XB_XSUB(b.x)], 1u);
        const unsigned gen = old / nloc;
        if (old + 1u == (gen + 1u) * nloc) {
            __builtin_amdgcn_fence(__ATOMIC_RELEASE, "agent");
            asm volatile("s_waitcnt vmcnt(0)" ::: "memory");
            const unsigned og = xb_add(&bar[XB_TOP], 1u);
            const unsigned tg = og / nx;
            if (og + 1u == (tg + 1u) * nx) xb_add(&bar[XB_TOPGEN], 1u);
            else XB_SPIN(xb_ld(&bar[XB_TOPGEN]) == tg, bar);
            __builtin_amdgcn_fence(__ATOMIC_ACQUIRE, "agent");
            xb_add(&bar[XB_XGEN(b.x)], 1u);
            asm volatile("s_waitcnt vmcnt(0)" ::: "memory");
        } else {
            XB_SPIN(xb_ld(&bar[XB_XGEN(b.x)]) == gen, bar);
            __builtin_amdgcn_fence(__ATOMIC_ACQUIRE, "agent");
            asm volatile("s_waitcnt vmcnt(0)" ::: "memory");
        }
    }
    __syncthreads();
}

namespace pg8 {
constexpr int BM = 256, BK = 64, HALF = 128, HTB = HALF * BK * 2, STAGE_BYTES = 8 * HTB, NXCD = 8, WGM = 8;
__host__ __device__ __forceinline__ int lds_byte(int r, int c) { const int st = (r >> 4) * 2 + (c >> 5), rr = r & 15, cc = c & 31, ob = rr * 64 + cc * 2; return st * 1024 + (ob ^ (((ob >> 9) & 1) << 5)); }
__host__ __device__ __forceinline__ void stage_rc(int b, int& R, int& C) { const int st = b / 1024, sb = b % 1024, swz = sb ^ (((sb >> 9) & 1) << 5); R = (st >> 1) * 16 + swz / 64; C = (st & 1) * 32 + (swz % 64) / 2; }
__host__ __device__ __forceinline__ int perm32(int rho) { const int n = rho >> 4, i = rho & 15; return 8 * (i >> 2) + 4 * n + (i & 3); }

struct Unit { int pm, pn, e, valid, rb, ui; };

struct StaticOrder {
    int nM, nN, nwg, G, c, i0, nmax;
    __device__ __forceinline__ void init(int nM_, int nN_, int G_, int c_) { nM = nM_; nN = nN_; nwg = nM * nN; G = G_; c = c_; i0 = 0; nmax = 1 << 30; }
    __device__ __forceinline__ bool map(int i, int& pm, int& pn) const {
        if (i >= nmax) return false;
        const long L = (long)(i + i0) * G + c; if (L >= nwg) return false;
        int wgid = (int)L; { const int q = nwg / NXCD, r = nwg % NXCD, xcd = wgid % NXCD, off = wgid / NXCD; wgid = (xcd < r ? xcd * (q + 1) : r * (q + 1) + (xcd - r) * q) + off; }
        const int nig = WGM * nN, gid = wgid / nig, fm = gid * WGM, gsz = (nM - fm) < WGM ? (nM - fm) : WGM;
        pm = fm + ((wgid % nig) % gsz); pn = (wgid % nig) / gsz; return true;
    }
};

template <class Epi, class Sched, bool ALIGN_EPI>
__device__ __forceinline__ void gemm_phase(LAS unsigned char* lds, const int K, const Sched& S, const Epi& E) {
    const int tid = threadIdx.x, wid = __builtin_amdgcn_readfirstlane(tid >> 6), lane = tid & 63, wr = wid >> 2, wc = wid & 3, fr = lane & 15, fq = lane >> 4;
    const int nt = K / BK;
    int Rs[2], Cs[2]; unsigned voffB[2];
#pragma unroll
    for (int i = 0; i < 2; ++i) { stage_rc(tid * 16 + i * 8192, Rs[i], Cs[i]); voffB[i] = (unsigned)(Rs[i] * K + Cs[i]) * 2u; }
    const size_t kstep = (size_t)(BK * 2);
    const size_t hstep = (size_t)HALF * K * 2;
    const unsigned ldsw = (unsigned)wid * 1024u;
    const int aoff = lds_byte(wr * 64 + fr, fq * 8), boff = lds_byte(wc * 32 + fr, fq * 8);
#define PG8_SA(b, h) (((b) * 2 + (h)) * HTB)
#define PG8_SB(b, h) ((4 + (b) * 2 + (h)) * HTB)
#define PG8_STAGE(bufoff, gbase, voff) do { _Pragma("unroll") for (int _i = 0; _i < 2; ++_i) \
        __builtin_amdgcn_global_load_lds((const unsigned*)((const char*)(gbase) + (voff)[_i]), (LAS unsigned*)(lds + (bufoff) + ldsw + _i * 8192), 16, 0, 0); } while (0)
#define PG8_LDA(dst, b, h) do { _Pragma("unroll") for (int m = 0; m < 4; ++m) _Pragma("unroll") for (int k = 0; k < 2; ++k) dst[m][k] = *(const LAS bf16x8*)(lds + PG8_SA(b, h) + aoff + m * 2048 + k * 1024); } while (0)
#define PG8_LDB(dst, b, h) do { _Pragma("unroll") for (int n = 0; n < 2; ++n) _Pragma("unroll") for (int k = 0; k < 2; ++k) dst[n][k] = *(const LAS bf16x8*)(lds + PG8_SB(b, h) + boff + n * 2048 + k * 1024); } while (0)
#define PG8_MMA(ai, bj, At, Bt) do { __builtin_amdgcn_s_setprio(1); _Pragma("unroll") for (int m = 0; m < 4; ++m) _Pragma("unroll") for (int n = 0; n < 2; ++n) _Pragma("unroll") for (int k = 0; k < 2; ++k) \
        acc[ai][bj][m][n] = __builtin_amdgcn_mfma_f32_16x16x32_bf16(Bt[n][k], At[m][k], acc[ai][bj][m][n], 0, 0, 0); __builtin_amdgcn_s_setprio(0); } while (0)
#define PG8_WAIT_V(n) asm volatile("s_waitcnt vmcnt(" #n ")" ::: "memory")
#define PG8_WAIT_L(n) asm volatile("s_waitcnt lgkmcnt(" #n ")" ::: "memory")
#define PG8_BAR __builtin_amdgcn_s_barrier()
#define PG8_SCHED __builtin_amdgcn_sched_barrier(0)
    Unit cur, nxt; int ui = 0;
    if (!S.next(0, cur)) return;
    f32x4 acc[2][2][4][2];
    E.init_acc(acc, cur, wr, wc, fr, fq);
    bf16x8 At[4][2], B0[2][2], B1[2][2];
    const char* cA = S.a_ptr(cur); const char* cB = S.b_ptr(cur);
    unsigned offC[2][2], offN[2][2];
    S.a_offs(cur, Rs, Cs, offC);
    PG8_STAGE(PG8_SB(0, 0), cB, voffB); PG8_STAGE(PG8_SB(0, 1), cB + hstep, voffB); PG8_STAGE(PG8_SA(0, 0), cA, offC[0]); PG8_STAGE(PG8_SA(0, 1), cA, offC[1]);
    if (wr == 1) PG8_BAR;
    PG8_WAIT_V(2); PG8_BAR;
    PG8_STAGE(PG8_SB(1, 0), cB + kstep, voffB); PG8_STAGE(PG8_SA(1, 0), cA + kstep, offC[0]); PG8_STAGE(PG8_SB(1, 1), cB + hstep + kstep, voffB);
    PG8_WAIT_V(6); PG8_BAR;
    for (;;) {
        const bool has_next = S.next(ui + 1, nxt);
        const char* nA = has_next ? S.a_ptr(nxt) : cA; const char* nB = has_next ? S.b_ptr(nxt) : cB;
        if (has_next) S.a_offs(nxt, Rs, Cs, offN);
        else {
#pragma unroll
            for (int h = 0; h < 2; ++h)
#pragma unroll
                for (int i = 0; i < 2; ++i) offN[h][i] = offC[h][i]; }
        for (int t = 0; t < nt; t += 2) {
            const bool last = (t == nt - 2);
            const char* a1 = cA + (size_t)(t + 1) * kstep;
            const char* a2 = last ? nA : cA + (size_t)(t + 2) * kstep; const char* b2 = last ? nB : cB + (size_t)(t + 2) * kstep;
            const char* a3 = a2 + kstep; const char* b3 = b2 + kstep;
            unsigned o2[2][2];
#pragma unroll
            for (int h = 0; h < 2; ++h)
#pragma unroll
                for (int i = 0; i < 2; ++i) o2[h][i] = last ? offN[h][i] : offC[h][i];
            PG8_LDB(B0, 0, 0); PG8_LDB(B1, 0, 1); PG8_SCHED; PG8_LDA(At, 0, 0); PG8_STAGE(PG8_SA(1, 1), a1, offC[1]);
            PG8_WAIT_V(8); PG8_WAIT_L(0); PG8_BAR; PG8_MMA(0, 0, At, B0); PG8_MMA(0, 1, At, B1); PG8_BAR; PG8_SCHED;
            PG8_LDA(At, 0, 1); PG8_STAGE(PG8_SB(0, 0), b2, voffB); PG8_STAGE(PG8_SB(0, 1), b2 + hstep, voffB); PG8_STAGE(PG8_SA(0, 0), a2, o2[0]);
            PG8_WAIT_V(8); PG8_WAIT_L(0); PG8_BAR; PG8_MMA(1, 0, At, B0); PG8_MMA(1, 1, At, B1); PG8_BAR; PG8_SCHED;
            PG8_LDB(B0, 1, 0); PG8_LDB(B1, 1, 1); PG8_SCHED; PG8_LDA(At, 1, 0); PG8_STAGE(PG8_SA(0, 1), a2, o2[1]);
            PG8_WAIT_V(8); PG8_WAIT_L(0); PG8_BAR; PG8_MMA(0, 0, At, B0); PG8_MMA(0, 1, At, B1); PG8_BAR; PG8_SCHED;
            PG8_LDA(At, 1, 1); PG8_STAGE(PG8_SB(1, 0), b3, voffB); PG8_STAGE(PG8_SB(1, 1), b3 + hstep, voffB); PG8_STAGE(PG8_SA(1, 0), a3, o2[0]);
            PG8_WAIT_V(8); PG8_WAIT_L(0); PG8_BAR; PG8_MMA(1, 0, At, B0); PG8_MMA(1, 1, At, B1); PG8_BAR; PG8_SCHED;
        }
        if constexpr (ALIGN_EPI) { if (wr == 0) PG8_BAR; }
        if constexpr (!Epi::AFTER_DRAIN) E(acc, cur, wr, wc, fr, fq);
        if (!has_next) break;
        E.init_acc(acc, nxt, wr, wc, fr, fq);
        cur = nxt; cA = nA; cB = nB; ++ui;
#pragma unroll
        for (int h = 0; h < 2; ++h)
#pragma unroll
            for (int i = 0; i < 2; ++i) offC[h][i] = offN[h][i];
        if constexpr (ALIGN_EPI) { if (wr == 1) PG8_BAR; }
    }
    PG8_WAIT_V(0);
    if constexpr (!ALIGN_EPI) { if (wr == 0) PG8_BAR; }
    PG8_BAR;
    if constexpr (Epi::AFTER_DRAIN) E.fused(acc, cur, wr, wc, fr, fq, lds);
#undef PG8_SA
#undef PG8_SB
#undef PG8_STAGE
#undef PG8_LDA
#undef PG8_LDB
#undef PG8_MMA
#undef PG8_WAIT_V
#undef PG8_WAIT_L
#undef PG8_BAR
#undef PG8_SCHED
}

struct DenseSched {
    const char* A; const char* Bt; int K; StaticOrder so;
    __device__ __forceinline__ bool next(int i, Unit& u) const { int pm, pn; if (!so.map(i, pm, pn)) return false; u.pm = pm; u.pn = pn; u.e = 0; u.valid = 256; u.rb = pm * 256; u.ui = i; return true; }
    __device__ __forceinline__ const char* a_ptr(const Unit& u) const { return A + (size_t)u.pm * 256 * K * 2; }
    __device__ __forceinline__ const char* b_ptr(const Unit& u) const { return Bt + (size_t)u.pn * 256 * K * 2; }
    __device__ __forceinline__ void a_offs(const Unit&, const int (&R)[2], const int (&C)[2], unsigned (&off)[2][2]) const {
#pragma unroll
        for (int h = 0; h < 2; ++h)
#pragma unroll
            for (int i = 0; i < 2; ++i) off[h][i] = (unsigned)((h * 128 + R[i]) * K + C[i]) * 2u; }
};
__device__ __forceinline__ void moe_lookup(const LAS int* tab, int vt, Unit& u) {
    int e = 0;
#pragma unroll
    for (int k = 1; k < 8; ++k) e += (vt >= tab[16 + k]) ? 1 : 0;
    e = __builtin_amdgcn_readfirstlane(e);
    const int tpe = __builtin_amdgcn_readfirstlane(tab[16 + e]), ce = __builtin_amdgcn_readfirstlane(tab[e]), be = __builtin_amdgcn_readfirstlane(tab[8 + e]);
    const int li = vt - tpe; u.pm = li; u.e = e; const int rem = ce - 256 * li; u.valid = rem < 256 ? rem : 256; u.rb = be + 256 * li;
}
struct MoeUpSched {
    const char* XB; const char* W; const LAS int* toktab; const LAS int* tab; StaticOrder so;
    __device__ __forceinline__ bool next(int i, Unit& u) const { int vt, pn; if (!so.map(i, vt, pn)) return false; moe_lookup(tab, vt, u); u.pn = pn; u.ui = i; return true; }
    __device__ __forceinline__ const char* a_ptr(const Unit&) const { return XB; }
    __device__ __forceinline__ const char* b_ptr(const Unit& u) const { return W + ((size_t)u.e * NFF2 + (size_t)u.pn * 256) * D * 2; }
    __device__ __forceinline__ void a_offs(const Unit& u, const int (&R)[2], const int (&C)[2], unsigned (&off)[2][2]) const {
#pragma unroll
        for (int h = 0; h < 2; ++h)
#pragma unroll
            for (int i = 0; i < 2; ++i) off[h][i] = (unsigned)toktab[u.ui * 256 + h * 128 + R[i]] * (unsigned)(D * 2) + (unsigned)C[i] * 2u; }
};
struct MoeDownSched {
    const char* ACT; const char* W; const LAS int* tab; StaticOrder so;
    __device__ __forceinline__ bool next(int i, Unit& u) const { int vt, pn; if (!so.map(i, vt, pn)) return false; moe_lookup(tab, vt, u); u.pn = pn; u.ui = i; return true; }
    __device__ __forceinline__ const char* a_ptr(const Unit& u) const { return ACT + (size_t)u.rb * FF * 2; }
    __device__ __forceinline__ const char* b_ptr(const Unit& u) const { return W + ((size_t)u.e * D + (size_t)u.pn * 256) * FF * 2; }
    __device__ __forceinline__ void a_offs(const Unit&, const int (&R)[2], const int (&C)[2], unsigned (&off)[2][2]) const {
#pragma unroll
        for (int h = 0; h < 2; ++h)
#pragma unroll
            for (int i = 0; i < 2; ++i) off[h][i] = (unsigned)((h * 128 + R[i]) * FF + C[i]) * 2u; }
};

__device__ __forceinline__ void zero_acc(f32x4 (&acc)[2][2][4][2]) {
#pragma unroll
    for (int a = 0; a < 2; ++a)
#pragma unroll
        for (int b = 0; b < 2; ++b)
#pragma unroll
            for (int m = 0; m < 4; ++m)
#pragma unroll
                for (int n = 0; n < 2; ++n) acc[a][b][m][n] = (f32x4){0.f, 0.f, 0.f, 0.f};
}
__device__ __forceinline__ float rstd_of(float p) { p += __shfl_xor(p, 16); p += __shfl_xor(p, 32); return 1.0f / sqrtf(p * (1.0f / D) + EPS); }
struct EpiMix {
    static constexpr bool AFTER_DRAIN = false;
    bf16_t* CG; bf16_t* UA; bf16_t* VA; const float* rss;
    __device__ __forceinline__ void init_acc(f32x4 (&acc)[2][2][4][2], const Unit&, int, int, int, int) const { zero_acc(acc); }
    __device__ __forceinline__ void operator()(const f32x4 (&acc)[2][2][4][2], const Unit& u, int wr, int wc, int fr, int fq) const {
        const int row0 = u.rb + wr * 64 + fr;
        const WtBuf bcg = wt_buf(CG), bdst = wt_buf(u.pn < 6 ? UA : VA);
        float ps[2][4];
#pragma unroll
        for (int ai = 0; ai < 2; ++ai)
#pragma unroll
            for (int m = 0; m < 4; ++m) ps[ai][m] = rss[(size_t)(row0 + ai * HALF + m * 16) * 4 + fq];
#pragma unroll
        for (int ai = 0; ai < 2; ++ai)
#pragma unroll
            for (int m = 0; m < 4; ++m) {
                const int row = row0 + ai * HALF + m * 16; const float rs = rstd_of(ps[ai][m]);
                if (u.pn < 4) {
                    float o[8];
#pragma unroll
                    for (int n = 0; n < 2; ++n)
#pragma unroll
                        for (int j = 0; j < 4; ++j) { const float a = acc[ai][0][m][n][j] * rs, g = acc[ai][1][m][n][j] * rs; o[4 * n + j] = a * fast_sigmoid(g); }
                    u32x4 w; w.x = cvt_pk_bf16(o[0], o[1]); w.y = cvt_pk_bf16(o[2], o[3]); w.z = cvt_pk_bf16(o[4], o[5]); w.w = cvt_pk_bf16(o[6], o[7]);
                    wt_store16(bcg, CG, ((size_t)row * CC + u.pn * 128 + wc * 32 + 8 * fq) * 2, w);
                } else {
                    bf16_t* dbase = (u.pn < 6 ? UA : VA); const size_t doff = ((size_t)row * CC + (u.pn & 1) * 256 + wc * 32 + 8 * fq) * 2;
#pragma unroll
                    for (int bj = 0; bj < 2; ++bj) {
                        const f32x4 v0 = acc[ai][bj][m][0] * rs, v1 = acc[ai][bj][m][1] * rs;
                        const f32x2 a = gelu_pk((f32x2){v0[0], v0[1]}), b = gelu_pk((f32x2){v0[2], v0[3]}), c = gelu_pk((f32x2){v1[0], v1[1]}), d = gelu_pk((f32x2){v1[2], v1[3]});
                        u32x4 w; w.x = cvt_pk_bf16(a.x, a.y); w.y = cvt_pk_bf16(b.x, b.y); w.z = cvt_pk_bf16(c.x, c.y); w.w = cvt_pk_bf16(d.x, d.y);
                        wt_store16(bdst, dbase, doff + bj * HALF * 2, w); }
                }
            }
    }
};
struct EpiRes {
    static constexpr bool AFTER_DRAIN = true;
    const float* XIN; float* XOUT; bf16_t* XB; float* rss_out;
    __device__ __forceinline__ void init_acc(f32x4 (&acc)[2][2][4][2], const Unit& u, int wr, int wc, int fr, int fq) const {
        const int row0 = u.rb + wr * 64 + fr, col0 = u.pn * 256 + wc * 32 + 8 * fq;
#pragma unroll
        for (int ai = 0; ai < 2; ++ai)
#pragma unroll
            for (int m = 0; m < 4; ++m)
#pragma unroll
                for (int bj = 0; bj < 2; ++bj) { const size_t off = (size_t)(row0 + ai * HALF + m * 16) * D + col0 + bj * HALF;
                    acc[ai][bj][m][0] = *(const f32x4*)(XIN + off); acc[ai][bj][m][1] = *(const f32x4*)(XIN + off + 4); }
    }
    __device__ __forceinline__ void fused(const f32x4 (&acc)[2][2][4][2], const Unit& u, int wr, int wc, int fr, int fq, LAS unsigned char* lds) const {
        const int row0 = u.rb + wr * 64 + fr, col0 = u.pn * 256 + wc * 32 + 8 * fq;
        LAS float* P = (LAS float*)lds;
        const WtBuf bxo = wt_buf(XOUT), bxb = wt_buf(XB);
#pragma unroll
        for (int ai = 0; ai < 2; ++ai)
#pragma unroll
            for (int m = 0; m < 4; ++m) {
                const int lr = ai * HALF + wr * 64 + m * 16 + fr, row = u.rb + lr; float ss = 0.f;
#pragma unroll
                for (int bj = 0; bj < 2; ++bj) {
                    const size_t off = (size_t)row * D + col0 + bj * HALF;
                    const f32x4 x0 = acc[ai][bj][m][0], x1 = acc[ai][bj][m][1];
                    wt_store16f(bxo, XOUT, off * 4, x0); wt_store16f(bxo, XOUT, off * 4 + 16, x1);
                    u32x4 w; w.x = cvt_pk_bf16(x0[0], x0[1]); w.y = cvt_pk_bf16(x0[2], x0[3]); w.z = cvt_pk_bf16(x1[0], x1[1]); w.w = cvt_pk_bf16(x1[2], x1[3]);
                    wt_store16(bxb, XB, off * 2, w);
                    ss += (x0[0] * x0[0] + x0[1] * x0[1]) + (x0[2] * x0[2] + x0[3] * x0[3]) + (x1[0] * x1[0] + x1[1] * x1[1]) + (x1[2] * x1[2] + x1[3] * x1[3]); }
                ss += __shfl_xor(ss, 16); ss += __shfl_xor(ss, 32);
                if (fq == 0) P[lr * 4 + wc] = ss;
            }
        (void)row0;
        __syncthreads();
        if (threadIdx.x < 256) { const f32x4 p = *(const LAS f32x4*)(P + threadIdx.x * 4); rss_out[(size_t)(u.rb + threadIdx.x) * 4 + u.pn] = (p.x + p.y) + (p.z + p.w); }
        __syncthreads();
    }
};
template <bool MOE> struct EpiSwiglu {
    static constexpr bool AFTER_DRAIN = false;
    bf16_t* ACT; const float* rss; const LAS int* toktab;
    __device__ __forceinline__ void init_acc(f32x4 (&acc)[2][2][4][2], const Unit&, int, int, int, int) const { zero_acc(acc); }
    __device__ __forceinline__ void operator()(const f32x4 (&acc)[2][2][4][2], const Unit& u, int wr, int wc, int fr, int fq) const {
        const int col = u.pn * 128 + wc * 32 + 8 * fq;
        const WtBuf bact = wt_buf(ACT);
        float ps[2][4];
#pragma unroll
        for (int ai = 0; ai < 2; ++ai)
#pragma unroll
            for (int m = 0; m < 4; ++m) { const int lr = ai * HALF + wr * 64 + m * 16 + fr; const int srow = MOE ? toktab[u.ui * 256 + lr] : u.rb + lr; ps[ai][m] = rss[(size_t)srow * 4 + fq]; }
#pragma unroll
        for (int ai = 0; ai < 2; ++ai)
#pragma unroll
            for (int m = 0; m < 4; ++m) {
                const int lr = ai * HALF + wr * 64 + m * 16 + fr;
                const float rs = rstd_of(ps[ai][m]);
                float o[8];
#pragma unroll
                for (int n = 0; n < 2; ++n)
#pragma unroll
                    for (int j = 0; j < 4; ++j) { const float g = acc[ai][0][m][n][j] * rs, up = acc[ai][1][m][n][j] * rs; o[4 * n + j] = g * fast_sigmoid(g) * up; }
                u32x4 w; w.x = cvt_pk_bf16(o[0], o[1]); w.y = cvt_pk_bf16(o[2], o[3]); w.z = cvt_pk_bf16(o[4], o[5]); w.w = cvt_pk_bf16(o[6], o[7]);
                if (!MOE || lr < u.valid) wt_store16(bact, ACT, ((size_t)(u.rb + lr) * FF + col) * 2, w);
            }
    }
};
struct EpiSlot {
    static constexpr bool AFTER_DRAIN = false;
    bf16_t* YS;
    __device__ __forceinline__ void init_acc(f32x4 (&acc)[2][2][4][2], const Unit&, int, int, int, int) const { zero_acc(acc); }
    __device__ __forceinline__ void operator()(const f32x4 (&acc)[2][2][4][2], const Unit& u, int wr, int wc, int fr, int fq) const {
        const int col0 = u.pn * 256 + wc * 32 + 8 * fq;
        const WtBuf bys = wt_buf(YS);
#pragma unroll
        for (int ai = 0; ai < 2; ++ai)
#pragma unroll
            for (int m = 0; m < 4; ++m) {
                const int lr = ai * HALF + wr * 64 + m * 16 + fr;
                if (lr < u.valid) {
#pragma unroll
                    for (int bj = 0; bj < 2; ++bj) {
                        const f32x4 x0 = acc[ai][bj][m][0], x1 = acc[ai][bj][m][1];
                        u32x4 w; w.x = cvt_pk_bf16(x0[0], x0[1]); w.y = cvt_pk_bf16(x0[2], x0[3]); w.z = cvt_pk_bf16(x1[0], x1[1]); w.w = cvt_pk_bf16(x1[2], x1[3]);
                        wt_store16(bys, YS, ((size_t)(u.rb + lr) * D + col0 + bj * HALF) * 2, w); }
                }
            }
    }
};
struct EpiNull {
    static constexpr bool AFTER_DRAIN = false;
    float* sink;
    __device__ __forceinline__ void init_acc(f32x4 (&acc)[2][2][4][2], const Unit&, int, int, int, int) const { zero_acc(acc); }
    __device__ __forceinline__ void operator()(const f32x4 (&acc)[2][2][4][2], const Unit& u, int wr, int wc, int fr, int fq) const {
        f32x4 s = (f32x4){0.f, 0.f, 0.f, 0.f};
#pragma unroll
        for (int a = 0; a < 2; ++a)
#pragma unroll
            for (int b = 0; b < 2; ++b)
#pragma unroll
                for (int m = 0; m < 4; ++m)
#pragma unroll
                    for (int n = 0; n < 2; ++n) s += acc[a][b][m][n];
        const float t = (s.x + s.y) + (s.z + s.w);
        if (t == 1.2345678e30f) sink[threadIdx.x] = t;
    }
};
}

struct Args { const float* in[21]; float* out; unsigned char* ws; int ph_lo, ph_hi; };
enum { I_X = 0, I_NMIX, I_WIN, I_CONVW, I_CONVB, I_CONVNG, I_CONVNB, I_SGUNG, I_SGUNB, I_SGUW, I_SGUB, I_WOUT, I_NFFN, I_FWG, I_FWU, I_FWD, I_ROUTER, I_MWG, I_MWU, I_MWD, I_NFINAL };

struct P0Item { const float* W; const float* gain; bf16_t* dst; int N, K, c0, k0; };
__device__ __forceinline__ void p0_load(const P0Item& p, int lane, float (&v)[32]) {
    const float* s = p.W + (size_t)(p.k0 + (lane >> 5)) * p.N + p.c0 + (lane & 31);
#pragma unroll
    for (int i = 0; i < 32; ++i) v[i] = s[(size_t)(2 * i) * p.N];
}
__device__ __forceinline__ void p0_finish(const P0Item& p, const float (&v)[32], LAS float* scr, int lane) {
    const int c = lane & 7;
    f32x4 g0 = (f32x4){1.f, 1.f, 1.f, 1.f}, g1 = g0;
    if (p.gain) { g0 = *(const f32x4*)(p.gain + p.k0 + 8 * c); g1 = *(const f32x4*)(p.gain + p.k0 + 8 * c + 4); }
#pragma unroll
    for (int i = 0; i < 32; ++i) scr[(2 * i + (lane >> 5)) * 33 + (lane & 31)] = v[i];
    asm volatile("s_waitcnt lgkmcnt(0)" ::: "memory");
    const WtBuf bd = wt_buf(p.dst);
#pragma unroll
    for (int j = 0; j < 4; ++j) { const int rho = (lane >> 3) + 8 * j; const LAS float* s = scr + (8 * c) * 33 + pg8::perm32(rho);
        u32x4 o; o.x = cvt_pk_bf16(s[0 * 33] * g0.x, s[1 * 33] * g0.y); o.y = cvt_pk_bf16(s[2 * 33] * g0.z, s[3 * 33] * g0.w); o.z = cvt_pk_bf16(s[4 * 33] * g1.x, s[5 * 33] * g1.y); o.w = cvt_pk_bf16(s[6 * 33] * g1.z, s[7 * 33] * g1.w);
        wt_store16(bd, p.dst, ((size_t)rho * p.K + p.k0 + 8 * c) * 2, o); }
    asm volatile("s_waitcnt lgkmcnt(0)" ::: "memory");
}
constexpr int IT_WIN = 16 * 64, IT_WOUT = 16 * 32, IT_GU = 16 * 176, IT_DN = 44 * 32;
constexpr int P0_NITEMS = 2 * IT_WIN + 2 * IT_WOUT + IT_GU + IT_DN + NE * IT_GU + NE * IT_DN;
__device__ __forceinline__ bool p0_decode(const Args& args, int it, P0Item& p) {
    if (it >= P0_NITEMS) return false;
    unsigned char* ws = args.ws; int r = it;
    if (r < 2 * IT_WIN) { const int l = r / IT_WIN; r -= l * IT_WIN; const int kb = r / 64, g32 = r % 64, Lb = 32 * g32;
        p.c0 = Lb < 1024 ? ((Lb >> 7) & 1) * 512 + (Lb >> 8) * 128 + (Lb & 127) : Lb;
        p.W = args.in[I_WIN] + (size_t)l * D * DIN; p.N = DIN; p.K = D; p.gain = args.in[I_NMIX] + l * D; p.dst = (bf16_t*)(ws + WS_WIN) + ((size_t)l * DIN + Lb) * D; p.k0 = 64 * kb; return true; }
    r -= 2 * IT_WIN;
    if (r < 2 * IT_WOUT) { const int l = r / IT_WOUT; r -= l * IT_WOUT; const int kb = r / 32, g32 = r % 32, Lb = 32 * g32;
        p.c0 = Lb; p.W = args.in[I_WOUT] + (size_t)l * D * D; p.N = D; p.K = D; p.gain = nullptr; p.dst = (bf16_t*)(ws + WS_WOUT) + ((size_t)l * D + Lb) * D; p.k0 = 64 * kb; return true; }
    r -= 2 * IT_WOUT;
    if (r < IT_GU) { const int kb = r / 176, g32 = r % 176, Lb = 32 * g32; const int kind = (Lb >> 7) & 1;
        p.c0 = (Lb >> 8) * 128 + (Lb & 127); p.W = args.in[kind ? I_FWU : I_FWG]; p.N = FF; p.K = D; p.gain = args.in[I_NFFN]; p.dst = (bf16_t*)(ws + WS_FGU) + (size_t)Lb * D; p.k0 = 64 * kb; return true; }
    r -= IT_GU;
    if (r < IT_DN) { const int kb = r / 32, g32 = r % 32, Lb = 32 * g32;
        p.c0 = Lb; p.W = args.in[I_FWD]; p.N = D; p.K = FF; p.gain = nullptr; p.dst = (bf16_t*)(ws + WS_FD) + (size_t)Lb * FF; p.k0 = 64 * kb; return true; }
    r -= IT_DN;
    if (r < NE * IT_GU) { const int e = r / IT_GU; r -= e * IT_GU; const int kb = r / 176, g32 = r % 176, Lb = 32 * g32; const int kind = (Lb >> 7) & 1;
        p.c0 = (Lb >> 8) * 128 + (Lb & 127); p.W = args.in[kind ? I_MWU : I_MWG] + (size_t)e * D * FF; p.N = FF; p.K = D; p.gain = args.in[I_NFFN] + D; p.dst = (bf16_t*)(ws + WS_MGU) + ((size_t)e * NFF2 + Lb) * D; p.k0 = 64 * kb; return true; }
    r -= NE * IT_GU;
    { const int e = r / IT_DN; r -= e * IT_DN; const int kb = r / 32, g32 = r % 32, Lb = 32 * g32;
        p.c0 = Lb; p.W = args.in[I_MWD] + (size_t)e * FF * D; p.N = D; p.K = FF; p.gain = nullptr; p.dst = (bf16_t*)(ws + WS_MD) + ((size_t)e * D + Lb) * FF; p.k0 = 64 * kb; return true; }
}
__device__ __forceinline__ void prologue_phase(const Args& args, LAS unsigned char* lds, int gw, int NGW, int lane) {
    unsigned char* ws = args.ws;
    LAS float* scr = (LAS float*)(lds + (threadIdx.x >> 6) * 16384);
    {
        P0Item pa, pb; float va[32], vb[32]; int it = gw;
        bool ha = p0_decode(args, it, pa); if (ha) p0_load(pa, lane, va);
        while (ha) {
            it += NGW; const bool hb = p0_decode(args, it, pb); if (hb) p0_load(pb, lane, vb);
            p0_finish(pa, va, scr, lane);
            if (!hb) break;
            it += NGW; ha = p0_decode(args, it, pa); if (ha) p0_load(pa, lane, va);
            p0_finish(pb, vb, scr, lane);
        }
    }
    { const float* x = args.in[I_X]; bf16_t* XB = (bf16_t*)(ws + WS_XB); float* rss = (float*)(ws + WS_RSS);
      for (int m = gw; m < T; m += NGW) {
          const f32x4* xr = (const f32x4*)(x + (size_t)m * D) + lane; f32x4 v[4]; float s = 0.f;
#pragma unroll
          for (int j = 0; j < 4; ++j) { v[j] = xr[64 * j]; s += (v[j].x * v[j].x + v[j].y * v[j].y) + (v[j].z * v[j].z + v[j].w * v[j].w); }
          s = wave_sum(s);
          u32x2* o8 = (u32x2*)(XB + (size_t)m * D) + lane;
#pragma unroll
          for (int j = 0; j < 4; ++j) { u32x2 w; w.x = cvt_pk_bf16(v[j].x, v[j].y); w.y = cvt_pk_bf16(v[j].z, v[j].w); o8[64 * j] = w; }
          if (lane < 4) rss[(size_t)m * 4 + lane] = lane == 0 ? s : 0.f; } }
    { float* RT = (float*)(ws + WS_RT); const float* rt = args.in[I_ROUTER]; const float* g = args.in[I_NFFN] + D;
      for (int i = gw * 64 + lane; i < NE * D; i += NGW * 64) { const int e = i / D, k = i % D; RT[i] = rt[k * NE + e] * g[k]; } }
    { bf16_t* SW = (bf16_t*)(ws + WS_SGUW); const float* sw = args.in[I_SGUW];
      for (int i = gw * 64 + lane; i < 2 * 4 * 128 * 128 / 2; i += NGW * 64) { const int e0 = 2 * i, tt = (e0 >> 7) & 127, s0 = e0 & 127;
          const float a = s0 <= tt ? sw[e0] : 0.f, b = (s0 + 1) <= tt ? sw[e0 + 1] : 0.f; ((unsigned*)SW)[i] = cvt_pk_bf16(a, b); } }
}

__device__ __forceinline__ void mid_phase(const Args& args, LAS unsigned char* lds, int l, int gw, int NGW, int lane, int wave) {
    unsigned char* ws = args.ws;
    const bf16_t* CG = (const bf16_t*)(ws + WS_CG); const bf16_t* UA = (const bf16_t*)(ws + WS_UA); const bf16_t* VA = (const bf16_t*)(ws + WS_VA); bf16_t* Y = (bf16_t*)(ws + WS_Y);
    const int fr = lane & 15, fq = lane >> 4;
    {
        constexpr int VST = 264;
        const bf16_t* Wb = (const bf16_t*)(ws + WS_SGUW) + (size_t)l * 4 * 128 * 128;
        const float* ng = args.in[I_SGUNG] + l * CC; const float* nb = args.in[I_SGUNB] + l * CC; const float* sb = args.in[I_SGUB] + l * 4 * 128;
        for (int unit = blockIdx.x; unit < NB * 16 * 4; unit += gridDim.x) {
            const int b = unit >> 6, n = (unit >> 2) & 15, h = unit & 3; const int R0 = b * SEQ + n * 128;
            const f32x2 gg = *(const f32x2*)(ng + h * 128 + 2 * lane), bb = *(const f32x2*)(nb + h * 128 + 2 * lane);
            unsigned pv[16];
#pragma unroll
            for (int rr = 0; rr < 16; ++rr) pv[rr] = *(const unsigned*)(VA + (size_t)(R0 + wave * 16 + rr) * CC + h * 128 + 2 * lane);
            const int nks = ((16 * wave + 15) >> 5) + 1;
            bf16x8 bfrag[4];
#pragma unroll
            for (int ks = 0; ks < 4; ++ks) if (ks < nks) bfrag[ks] = *(const bf16x8*)(Wb + (size_t)h * 16384 + (16 * wave + fr) * 128 + 32 * ks + 8 * fq);
            float s1[16], s2[16];
#pragma unroll
            for (int rr = 0; rr < 16; ++rr) { const float v0 = bf_lo(pv[rr]), v1 = bf_hi(pv[rr]); s1[rr] = v0 + v1; s2[rr] = v0 * v0 + v1 * v1; }
#pragma unroll
            for (int rr = 0; rr < 16; ++rr) { s1[rr] = row16_allsum(s1[rr]); s2[rr] = row16_allsum(s2[rr]); }
#pragma unroll
            for (int rr = 0; rr < 16; ++rr) { s1[rr] += __shfl_xor(s1[rr], 16); s2[rr] += __shfl_xor(s2[rr], 16); }
#pragma unroll
            for (int rr = 0; rr < 16; ++rr) { s1[rr] += __shfl_xor(s1[rr], 32); s2[rr] += __shfl_xor(s2[rr], 32); }
#pragma unroll
            for (int rp = 0; rp < 8; ++rp) {
                float y[2][2];
#pragma unroll
                for (int q = 0; q < 2; ++q) { const int rr = 2 * rp + q; const float mean = s1[rr] * (1.0f / 128.0f); const float var = fmaxf(s2[rr] * (1.0f / 128.0f) - mean * mean, 0.f);
                    const float rstd = 1.0f / sqrtf(var + EPS); y[q][0] = (bf_lo(pv[rr]) - mean) * rstd * gg.x + bb.x; y[q][1] = (bf_hi(pv[rr]) - mean) * rstd * gg.y + bb.y; }
                const int s = wave * 16 + 2 * rp;
                *(LAS unsigned*)(lds + (2 * lane) * VST + s * 2) = cvt_pk_bf16(y[0][0], y[1][0]);
                *(LAS unsigned*)(lds + (2 * lane + 1) * VST + s * 2) = cvt_pk_bf16(y[0][1], y[1][1]);
            }
            const int t = 16 * wave + fr; const size_t row = (size_t)(R0 + t);
            u32x2 uu[8];
#pragma unroll
            for (int db = 0; db < 8; ++db) uu[db] = *(const u32x2*)(UA + row * CC + h * 128 + 16 * db + 4 * fq);
            const float bias = sb[h * 128 + t];
            __syncthreads();
            f32x4 acc[8];
#pragma unroll
            for (int db = 0; db < 8; ++db) acc[db] = (f32x4){0.f, 0.f, 0.f, 0.f};
#pragma unroll
            for (int ks = 0; ks < 4; ++ks) if (ks < nks) {
#pragma unroll
                for (int db = 0; db < 8; ++db) {
                    const LAS unsigned char* ap = lds + (16 * db + fr) * VST + (32 * ks + 8 * fq) * 2;
                    union { bf16x8 v; u32x2 h[2]; } af; af.h[0] = *(const LAS u32x2*)ap; af.h[1] = *(const LAS u32x2*)(ap + 8);
                    acc[db] = __builtin_amdgcn_mfma_f32_16x16x32_bf16(af.v, bfrag[ks], acc[db], 0, 0, 0);
                }
            }
#pragma unroll
            for (int db = 0; db < 8; ++db) { const int d = 16 * db + 4 * fq;
                const float o0 = bf_lo(uu[db].x) * (acc[db][0] + bias), o1 = bf_hi(uu[db].x) * (acc[db][1] + bias), o2 = bf_lo(uu[db].y) * (acc[db][2] + bias), o3 = bf_hi(uu[db].y) * (acc[db][3] + bias);
                u32x2 w; w.x = cvt_pk_bf16(o0, o1); w.y = cvt_pk_bf16(o2, o3);
                *(u32x2*)(Y + row * D + CC + h * 128 + d) = w; }
            __syncthreads();
        }
    }
    {
        const int cg = gw & 3, ch = cg * 128 + 2 * lane;
        const float* cwp = args.in[I_CONVW] + (size_t)l * CW * CC + ch;
        const f32x2 cb = *(const f32x2*)(args.in[I_CONVB] + l * CC + ch), ng = *(const f32x2*)(args.in[I_CONVNG] + l * CC + ch), nb = *(const f32x2*)(args.in[I_CONVNB] + l * CC + ch);
        for (int item = gw >> 2; item < NB * (SEQ / 16); item += NGW >> 2) {
            const int b = item >> 7, t0 = (item & 127) * 16; const size_t rowb = (size_t)b * SEQ;
            unsigned in[46];
#pragma unroll
            for (int i = 0; i < 46; ++i) { const int t = t0 - 30 + i; in[i] = t >= 0 ? *(const unsigned*)(CG + (rowb + t) * CC + ch) : 0u; }
            float a0[16], a1[16];
#pragma unroll
            for (int tt = 0; tt < 16; ++tt) { a0[tt] = cb.x; a1[tt] = cb.y; }
#pragma unroll
            for (int j = 0; j < CW; ++j) {
                const f32x2 w = *(const f32x2*)(cwp + j * CC);
#pragma unroll
                for (int tt = 0; tt < 16; ++tt) { a0[tt] += w.x * bf_lo(in[tt + j]); a1[tt] += w.y * bf_hi(in[tt + j]); }
            }
            float s1[16], s2[16];
#pragma unroll
            for (int tt = 0; tt < 16; ++tt) { s1[tt] = row16_allsum(a0[tt] + a1[tt]); s2[tt] = row16_allsum(a0[tt] * a0[tt] + a1[tt] * a1[tt]); }
#pragma unroll
            for (int tt = 0; tt < 16; ++tt) { s1[tt] += __shfl_xor(s1[tt], 16); s2[tt] += __shfl_xor(s2[tt], 16); }
#pragma unroll
            for (int tt = 0; tt < 16; ++tt) {
                const float mean = s1[tt] * (1.0f / 64.0f); const float var = fmaxf(s2[tt] * (1.0f / 64.0f) - mean * mean, 0.f);
                const float rstd = 1.0f / sqrtf(var + EPS);
                const float y0 = (a0[tt] - mean) * rstd * ng.x + nb.x, y1 = (a1[tt] - mean) * rstd * ng.y + nb.y;
                *(unsigned*)(Y + (rowb + t0 + tt) * D + ch) = cvt_pk_bf16(y0 * fast_sigmoid(y0), y1 * fast_sigmoid(y1));
            }
        }
    }
}

__device__ __forceinline__ void router_phase(const Args& args, LAS unsigned char* lds, int lane, int wave) {
    unsigned char* ws = args.ws;
    const bf16_t* XB = (const bf16_t*)(ws + WS_XB); const float* RT = (const float*)(ws + WS_RT); const float* rss = (const float*)(ws + WS_RSS) + (size_t)3 * T * 4;
    int* toklist = (int*)(ws + WS_TOKLIST); u32x4* tokinfo = (u32x4*)(ws + WS_TOKINFO); unsigned* cntw = (unsigned*)(ws + WS_CTL) + CW_CNT;
    LAS int* wcnt = (LAS int*)lds;
    LAS int* wbase = (LAS int*)(lds + 256);
    f32x4 rw[NE][2][2];
#pragma unroll
    for (int e = 0; e < NE; ++e)
#pragma unroll
        for (int i = 0; i < 2; ++i) { rw[e][i][0] = *(const f32x4*)(RT + e * D + 512 * i + 8 * lane); rw[e][i][1] = *(const f32x4*)(RT + e * D + 512 * i + 8 * lane + 4); }
    for (int blk = blockIdx.x; blk < T / 64; blk += gridDim.x) {
        int my_e0 = 0, my_e1 = 0; float my_g0 = 0.f, my_g1 = 0.f;
        const int tbase = blk * 64 + wave * 8;
        for (int j = 0; j < 8; ++j) {
            const int t = tbase + j;
            float a[NE];
#pragma unroll
            for (int e = 0; e < NE; ++e) a[e] = 0.f;
#pragma unroll
            for (int i = 0; i < 2; ++i) {
                const u32x4 xv = *(const u32x4*)(XB + (size_t)t * D + 512 * i + 8 * lane);
                const float x0 = bf_lo(xv.x), x1 = bf_hi(xv.x), x2 = bf_lo(xv.y), x3 = bf_hi(xv.y), x4 = bf_lo(xv.z), x5 = bf_hi(xv.z), x6 = bf_lo(xv.w), x7 = bf_hi(xv.w);
#pragma unroll
                for (int e = 0; e < NE; ++e) { const f32x4 wa = rw[e][i][0], wb = rw[e][i][1];
                    a[e] += (x0 * wa.x + x1 * wa.y) + (x2 * wa.z + x3 * wa.w) + (x4 * wb.x + x5 * wb.y) + (x6 * wb.z + x7 * wb.w); }
            }
            float p = lane < 4 ? rss[(size_t)t * 4 + lane] : 0.f;
            p = wave_sum(p);
            const float rstd = 1.0f / sqrtf(p * (1.0f / D) + EPS);
#pragma unroll
            for (int e = 0; e < NE; ++e) a[e] = wave_sum(a[e]) * rstd;
            int e0 = 0; float l0 = a[0];
#pragma unroll
            for (int e = 1; e < NE; ++e) if (a[e] > l0) { l0 = a[e]; e0 = e; }
            int e1 = -1; float l1 = -3.0e38f;
#pragma unroll
            for (int e = 0; e < NE; ++e) if (e != e0 && a[e] > l1) { l1 = a[e]; e1 = e; }
            const float g0 = 1.0f / (1.0f + __expf(l1 - l0)), g1 = 1.0f - g0;
            if (lane == j) { my_e0 = e0; my_e1 = e1; my_g0 = g0; my_g1 = g1; }
        }
        const bool act = lane < 8;
        unsigned long long m0[NE], m1[NE];
#pragma unroll
        for (int e = 0; e < NE; ++e) { m0[e] = __ballot(act && my_e0 == e); m1[e] = __ballot(act && my_e1 == e); }
        if (lane < NE) { int c = 0;
#pragma unroll
            for (int e = 0; e < NE; ++e) if (lane == e) c = __popcll(m0[e]) + __popcll(m1[e]);
            wcnt[wave * 8 + lane] = c; }
        __syncthreads();
        if (threadIdx.x < NE) { const int e = threadIdx.x; int tot = 0; int pre[8];
#pragma unroll
            for (int w = 0; w < 8; ++w) { pre[w] = tot; tot += wcnt[w * 8 + e]; }
            const int base = (int)__hip_atomic_fetch_add(cntw + 64 * e, (unsigned)tot, RLX_AGENT);
#pragma unroll
            for (int w = 0; w < 8; ++w) wbase[w * 8 + e] = base + pre[w]; }
        __syncthreads();
        if (act) {
            const unsigned long long lt = (1ull << lane) - 1ull;
            int pos0 = 0, pos1 = 0;
#pragma unroll
            for (int e = 0; e < NE; ++e) { const int wb = wbase[wave * 8 + e];
                if (my_e0 == e) pos0 = wb + __popcll(m0[e] & lt);
                if (my_e1 == e) pos1 = wb + __popcll(m0[e]) + __popcll(m1[e] & lt); }
            const int t = tbase + lane;
            toklist[my_e0 * T + pos0] = t; toklist[my_e1 * T + pos1] = t;
            u32x4 inf; inf.x = ((unsigned)my_e0 << 16) | (unsigned)pos0; inf.y = ((unsigned)my_e1 << 16) | (unsigned)pos1; inf.z = __float_as_uint(my_g0); inf.w = __float_as_uint(my_g1);
            tokinfo[t] = inf;
        }
        __syncthreads();
    }
}
__device__ __forceinline__ void moe_tab_build(const unsigned char* ws, LAS int* tab) {
    if (threadIdx.x == 0) {
        unsigned* cntw = (unsigned*)(ws + WS_CTL) + CW_CNT; int b = 0, p = 0;
        for (int e = 0; e < NE; ++e) { const int c = (int)__hip_atomic_load(cntw + 64 * e, RLX_AGENT); tab[e] = c; tab[8 + e] = b; tab[16 + e] = p; b += c; p += (c + 255) >> 8; }
        tab[24] = p;
    }
    __syncthreads();
}

__device__ __forceinline__ void final_phase(const Args& args, const LAS int* tab, int gw, int NGW, int lane) {
    unsigned char* ws = args.ws; float* out = args.out; const bf16_t* YS = (const bf16_t*)(ws + WS_YS); const u32x4* tokinfo = (const u32x4*)(ws + WS_TOKINFO);
    f32x4 gn[4];
#pragma unroll
    for (int j = 0; j < 4; ++j) gn[j] = *((const f32x4*)args.in[I_NFINAL] + lane + 64 * j);
    for (int t = gw; t < T; t += NGW) {
        const u32x4 inf = tokinfo[t];
        const int e0 = __builtin_amdgcn_readfirstlane((int)(inf.x >> 16)), p0 = __builtin_amdgcn_readfirstlane((int)(inf.x & 0xffffu)), e1 = __builtin_amdgcn_readfirstlane((int)(inf.y >> 16)), p1 = __builtin_amdgcn_readfirstlane((int)(inf.y & 0xffffu));
        const float g0 = __uint_as_float(inf.z), g1 = __uint_as_float(inf.w);
        const int b0 = __builtin_amdgcn_readfirstlane(tab[8 + e0]), b1 = __builtin_amdgcn_readfirstlane(tab[8 + e1]);
        const size_t s0 = (size_t)(b0 + p0), s1 = (size_t)(b1 + p1);
        f32x4* xr = (f32x4*)(out + (size_t)t * D) + lane; const u32x2* y0 = (const u32x2*)(YS + s0 * D) + lane; const u32x2* y1 = (const u32x2*)(YS + s1 * D) + lane;
        f32x4 v[4]; float ss = 0.f;
#pragma unroll
        for (int j = 0; j < 4; ++j) { const f32x4 x = xr[64 * j]; const u32x2 a = y0[64 * j], b = y1[64 * j];
            v[j].x = x.x + g0 * bf_lo(a.x) + g1 * bf_lo(b.x); v[j].y = x.y + g0 * bf_hi(a.x) + g1 * bf_hi(b.x); v[j].z = x.z + g0 * bf_lo(a.y) + g1 * bf_lo(b.y); v[j].w = x.w + g0 * bf_hi(a.y) + g1 * bf_hi(b.y);
            ss += (v[j].x * v[j].x + v[j].y * v[j].y) + (v[j].z * v[j].z + v[j].w * v[j].w); }
        const float rstd = 1.0f / sqrtf(wave_sum(ss) * (1.0f / D) + EPS);
#pragma unroll
        for (int j = 0; j < 4; ++j) xr[64 * j] = v[j] * rstd * gn[j];
    }
}

__global__ void __launch_bounds__(NWAVES * 64, 2) mega_fwd(Args args) {
    extern __shared__ __attribute__((aligned(16))) unsigned char lds_raw[];
    LAS unsigned char* lds = (LAS unsigned char*)lds_raw;
    const int tid = threadIdx.x, lane = tid & 63, wave = __builtin_amdgcn_readfirstlane(tid >> 6);
    const int G = gridDim.x, bx = blockIdx.x;
    const int vcu = (G % 8 == 0) ? (bx % 8) * (G / 8) + bx / 8 : bx;
    const int gw = vcu * NWAVES + wave, NGW = G * NWAVES;
    unsigned char* ws = args.ws;
    unsigned* ctl = (unsigned*)(ws + WS_CTL);
    for (int u = tid; u < 512 / 4; u += NWAVES * 64) ((LAS unsigned*)(lds + LDSCTL_OFF))[u] = 0u;
    __syncthreads();
    XcdBarrier bar; bar.bar = ctl + CW_BAR; bar.x = 0; bar.st = nullptr;
    if (MK_N_LAUNCHES == 1) bar = xcd_barrier_post(ctl + CW_BAR, (volatile LAS unsigned*)(lds + LDSCTL_OFF) + 8);
    const int lo = args.ph_lo, hi = args.ph_hi;
#define IN(k) (lo <= (k) && (k) < hi)
#ifndef DUP_PHASE
#define DUP_PHASE -1
#endif
#define REP(k) for (int rep_ = 0; rep_ < ((DUP_PHASE) == (k) ? 2 : 1); ++rep_)
#define SEAM(k) do { if (MK_N_LAUNCHES == 1 && IN((k) + 1)) xcd_barrier(bar); } while (0)
    float* rss = (float*)(ws + WS_RSS);
    bf16_t* XB = (bf16_t*)(ws + WS_XB);

    if (IN(0)) { REP(0) prologue_phase(args, lds, gw, NGW, lane); SEAM(0); }

#define LAYER_MIX(l, pb) \
    if (IN(pb)) {       \
        pg8::DenseSched S; S.A = (const char*)XB; S.Bt = (const char*)(ws + WS_WIN) + (size_t)(l) * DIN * D * 2; S.K = D; S.so.init(T / 256, DIN / 256, G, bx); \
        pg8::EpiMix E{(bf16_t*)(ws + WS_CG), (bf16_t*)(ws + WS_UA), (bf16_t*)(ws + WS_VA), rss + (size_t)(2 * (l)) * T * 4}; \
        REP(pb) pg8::gemm_phase<pg8::EpiMix, pg8::DenseSched, true>(lds, D, S, E); \
        SEAM(pb); \
    } \
    if (IN((pb) + 1)) { REP((pb) + 1) mid_phase(args, lds, (l), gw, NGW, lane, wave); SEAM((pb) + 1); } \
    if (IN((pb) + 2)) {       \
        pg8::DenseSched S; S.A = (const char*)(ws + WS_Y); S.Bt = (const char*)(ws + WS_WOUT) + (size_t)(l) * D * D * 2; S.K = D; S.so.init(T / 256, D / 256, G, bx); \
        pg8::EpiRes E{(l) == 0 ? args.in[I_X] : args.out, args.out, XB, rss + (size_t)(2 * (l) + 1) * T * 4}; \
        REP((pb) + 2) for (int r_ = 0; r_ * G < S.so.nwg; ++r_) { S.so.i0 = r_; S.so.nmax = 1; pg8::gemm_phase<pg8::EpiRes, pg8::DenseSched, false>(lds, D, S, E); } \
        SEAM((pb) + 2); \
    }
    LAYER_MIX(0, 1)
    if (IN(4)) {
        pg8::DenseSched S; S.A = (const char*)XB; S.Bt = (const char*)(ws + WS_FGU); S.K = D; S.so.init(T / 256, NFF2 / 256, G, bx);
        pg8::EpiSwiglu<false> E{(bf16_t*)(ws + WS_ACT), rss + (size_t)1 * T * 4, nullptr};
        REP(4) pg8::gemm_phase<pg8::EpiSwiglu<false>, pg8::DenseSched, true>(lds, D, S, E);
        SEAM(4);
    }
    if (IN(5)) {
        pg8::DenseSched S; S.A = (const char*)(ws + WS_ACT); S.Bt = (const char*)(ws + WS_FD); S.K = FF; S.so.init(T / 256, D / 256, G, bx);
        pg8::EpiRes E{args.out, args.out, XB, rss + (size_t)2 * T * 4};
        for (int r_ = 0; r_ * G < S.so.nwg; ++r_) { S.so.i0 = r_; S.so.nmax = 1; pg8::gemm_phase<pg8::EpiRes, pg8::DenseSched, false>(lds, FF, S, E); }
        SEAM(5);
    }
    LAYER_MIX(1, 6)
    LAS int* mtab = (LAS int*)(lds + LDSCTL_OFF + 64);
    if (IN(9)) { router_phase(args, lds, lane, wave); SEAM(9); }
    if (IN(10)) {
        moe_tab_build(ws, mtab);
        pg8::MoeUpSched S; S.tab = mtab;
        S.XB = (const char*)XB; S.W = (const char*)(ws + WS_MGU); S.toktab = (const LAS int*)(lds + TOKTAB_OFF); S.so.init(__builtin_amdgcn_readfirstlane(mtab[24]), NFF2 / 256, G, bx);
        { const int* toklist = (const int*)(ws + WS_TOKLIST); LAS int* tt = (LAS int*)(lds + TOKTAB_OFF); pg8::Unit u;
          for (int i = 0; i < 12 && S.next(i, u); ++i) if (tid < 256) tt[i * 256 + tid] = tid < u.valid ? toklist[u.e * T + u.pm * 256 + tid] : 0;
          __syncthreads(); }
        pg8::EpiSwiglu<true> E{(bf16_t*)(ws + WS_ACT), rss + (size_t)3 * T * 4, (const LAS int*)(lds + TOKTAB_OFF)};
#if PROBE_NULL == 10
        { pg8::EpiNull EN{(float*)(ws + WS_TOKINFO)}; pg8::gemm_phase<pg8::EpiNull, pg8::MoeUpSched, true>(lds, D, S, EN); }
#endif
        REP(10) pg8::gemm_phase<pg8::EpiSwiglu<true>, pg8::MoeUpSched, true>(lds, D, S, E);
        SEAM(10);
    }
    if (IN(11)) {
        moe_tab_build(ws, mtab);
        pg8::MoeDownSched S; S.tab = mtab;
        S.ACT = (const char*)(ws + WS_ACT); S.W = (const char*)(ws + WS_MD); S.so.init(__builtin_amdgcn_readfirstlane(mtab[24]), D / 256, G, bx);
        pg8::EpiSlot E{(bf16_t*)(ws + WS_YS)};
#if PROBE_NULL == 11
        { pg8::EpiNull EN{(float*)(ws + WS_TOKINFO)}; pg8::gemm_phase<pg8::EpiNull, pg8::MoeDownSched, true>(lds, FF, S, EN); }
#endif
        REP(11) pg8::gemm_phase<pg8::EpiSlot, pg8::MoeDownSched, true>(lds, FF, S, E);
        SEAM(11);
    }
    if (IN(12)) { moe_tab_build(ws, mtab); final_phase(args, mtab, gw, NGW, lane); }
#undef IN
#undef SEAM
}

extern "C" void kernel_launch(void* const* d_in, const int* in_sizes, int n_in, void* d_out, int out_size, void* d_ws, size_t ws_size, hipStream_t stream) {
    static int grid = 0;
    if (grid == 0) {
        if (n_in != 21 || in_sizes[0] != T * D || out_size != T * D || ws_size < WS_END) { fprintf(stderr, "kernel_launch: unexpected shapes (n_in %d, in0 %d, out %d, ws %zu < %zu); nothing launched\n", n_in, n_in > 0 ? in_sizes[0] : -1, out_size, ws_size, (size_t)WS_END); grid = -1; return; }
        int dev = 0, cus = 0, per_cu = 0;
        if (hipGetDevice(&dev) != hipSuccess || hipDeviceGetAttribute(&cus, hipDeviceAttributeMultiprocessorCount, dev) != hipSuccess) { grid = -1; return; }
        if (hipFuncSetAttribute((const void*)mega_fwd, hipFuncAttributeMaxDynamicSharedMemorySize, LDS_BYTES) != hipSuccess) { fprintf(stderr, "kernel_launch: hipFuncSetAttribute failed\n"); grid = -1; return; }
        if (hipOccupancyMaxActiveBlocksPerMultiprocessor(&per_cu, (const void*)mega_fwd, NWAVES * 64, LDS_BYTES) != hipSuccess || per_cu < 1) { fprintf(stderr, "kernel_launch: occupancy query reports %d\n", per_cu); }
        (void)hipGetLastError();
        grid = cus;
    }
    if (grid < 0) return;
    if (hipMemsetAsync((char*)d_ws + WS_CTL, 0, CTL_ZERO_BYTES, stream) != hipSuccess) return;
    Args a{};
    for (int i = 0; i < 21; ++i) a.in[i] = (const float*)d_in[i];
    a.out = (float*)d_out; a.ws = (unsigned char*)d_ws;
    if (MK_N_LAUNCHES == 1) { a.ph_lo = 0; a.ph_hi = N_PHASES; hipLaunchKernelGGL(mega_fwd, dim3(grid), dim3(NWAVES * 64), LDS_BYTES, stream, a); }
    else for (int p = 0; p < N_PHASES; ++p) { a.ph_lo = p; a.ph_hi = p + 1; hipLaunchKernelGGL(mega_fwd, dim3(grid), dim3(NWAVES * 64), LDS_BYTES, stream, a); }
}
```

```cpp
#include <hip/hip_runtime.h>
#include <cstdio>
#include <cstdint>

#ifndef PROBE_NULL
#define PROBE_NULL -1
#endif
#ifndef MK_N_LAUNCHES
#define MK_N_LAUNCHES 1
#endif
constexpr int N_PHASES = 13;

#define GAS __attribute__((address_space(1)))
#define LAS __attribute__((address_space(3)))
typedef unsigned short bf16_t;
typedef short bf16x8 __attribute__((ext_vector_type(8)));
typedef float f32x4 __attribute__((ext_vector_type(4)));
typedef float f32x2 __attribute__((ext_vector_type(2)));
typedef unsigned u32x4 __attribute__((ext_vector_type(4)));
typedef unsigned u32x2 __attribute__((ext_vector_type(2)));

constexpr int NB = 8, SEQ = 2048, T = NB * SEQ, D = 1024, DIN = 2048, CC = 512, FF = 2816, NE = 8, CW = 31, NFF2 = 2 * FF;
constexpr float EPS = 1e-6f;
constexpr int NWAVES = 8;

constexpr size_t KiB = 1024, MiB = 1024 * 1024;
constexpr size_t WS_CTL = 0, CTL_ZERO_BYTES = 64 * KiB;
constexpr int CW_BAR = 1024;
constexpr int CW_CNT = 8192;
constexpr size_t WS_TOKLIST = 64 * KiB;
constexpr size_t WS_TOKINFO = 576 * KiB;
constexpr size_t WS_RT = 832 * KiB;
constexpr size_t WS_SGUW = 1 * MiB;
constexpr size_t WS_RSS = 2 * MiB;
constexpr size_t WS_WIN = 6 * MiB;
constexpr size_t WS_WOUT = 14 * MiB;
constexpr size_t WS_FGU = 18 * MiB;
constexpr size_t WS_FD = 29 * MiB;
constexpr size_t WS_MGU = 35 * MiB;
constexpr size_t WS_MD = 79 * MiB;
constexpr size_t WS_XB = 101 * MiB;
constexpr size_t WS_XB8 = 133 * MiB;
constexpr size_t WS_ACT = 149 * MiB;
constexpr size_t WS_CG = WS_ACT, WS_UA = WS_ACT + 16 * MiB, WS_VA = WS_ACT + 32 * MiB, WS_Y = WS_ACT + 48 * MiB;
constexpr size_t WS_YS = 238 * MiB;
constexpr size_t WS_END = WS_YS + (size_t)2 * T * D * 2;
constexpr float MOE_SW = 32.0f, MOE_SA = 8.0f;
static_assert(WS_END <= 380 * MiB, "workspace map");
static_assert(WS_MGU + (size_t)NE * NFF2 * D <= WS_MD && WS_MD + (size_t)NE * D * FF <= WS_XB && WS_FD + (size_t)D * FF * 2 <= WS_MGU && WS_ACT + (size_t)T * FF * 2 <= WS_YS && WS_ACT + (size_t)(2 * T + 256) * FF <= WS_YS, "workspace map 2");

constexpr int RING_BYTES = 131072;
constexpr int LDSCTL_OFF = RING_BYTES;
constexpr int TOKTAB_OFF = RING_BYTES + 512;
constexpr int LDS_BYTES = 147456;
static_assert(TOKTAB_OFF + 12 * 256 * 4 <= LDS_BYTES, "LDS map");

#define RLX_AGENT __ATOMIC_RELAXED, __HIP_MEMORY_SCOPE_AGENT
__device__ __forceinline__ unsigned cvt_pk_bf16(float lo, float hi) { unsigned r; asm volatile("v_cvt_pk_bf16_f32 %0, %1, %2" : "=v"(r) : "v"(lo), "v"(hi)); return r; }
__device__ __forceinline__ float clamp448(float v) { return __builtin_amdgcn_fmed3f(v, -448.0f, 448.0f); }
__device__ __forceinline__ unsigned pk_fp8x4(float a, float b, float c, float d) {
    int p = __builtin_amdgcn_cvt_pk_fp8_f32(clamp448(a), clamp448(b), 0, false); p = __builtin_amdgcn_cvt_pk_fp8_f32(clamp448(c), clamp448(d), p, true); return (unsigned)p; }
__device__ __forceinline__ float bf_lo(unsigned x) { return __uint_as_float(x << 16); }
__device__ __forceinline__ float bf_hi(unsigned x) { return __uint_as_float(x & 0xffff0000u); }
__device__ __forceinline__ float fast_sigmoid(float g) { return __builtin_amdgcn_rcpf(1.0f + __builtin_amdgcn_exp2f(-1.4426950408889634f * g)); }
__device__ __forceinline__ float wave_sum(float v) {
#pragma unroll
    for (int o = 1; o < 64; o <<= 1) v += __shfl_xor(v, o);
    return v;
}
__device__ __forceinline__ float dpp_add(float v, const int ctrl_sel) {
    int r;
    if (ctrl_sel == 0) r = __builtin_amdgcn_update_dpp(0, __float_as_int(v), 0xB1, 0xF, 0xF, false);
    else if (ctrl_sel == 1) r = __builtin_amdgcn_update_dpp(0, __float_as_int(v), 0x4E, 0xF, 0xF, false);
    else if (ctrl_sel == 2) r = __builtin_amdgcn_update_dpp(0, __float_as_int(v), 0x141, 0xF, 0xF, false);
    else r = __builtin_amdgcn_update_dpp(0, __float_as_int(v), 0x140, 0xF, 0xF, false);
    return v + __int_as_float(r);
}
__device__ __forceinline__ float row16_allsum(float v) { v = dpp_add(v, 0); v = dpp_add(v, 1); v = dpp_add(v, 2); v = dpp_add(v, 3); return v; }
__device__ __forceinline__ f32x2 gelu_pk(f32x2 v) {
    const f32x2 av = __builtin_elementwise_abs(v), d = av * 0.2316418882f + 1.0f;
    f32x2 t; t.x = __builtin_amdgcn_rcpf(d.x); t.y = __builtin_amdgcn_rcpf(d.y);
    f32x2 q = t * 0.5307027145f + (-0.7265760135f); q = q * t + 0.7107068705f; q = q * t + (-0.142248368f); q = q * t + 0.127414796f; q = q * t;
    const f32x2 s = (v * v) * (-0.72134752044f);
    f32x2 e; e.x = __builtin_amdgcn_exp2f(s.x); e.y = __builtin_amdgcn_exp2f(s.y);
    const f32x2 m = v * (q * e), r = v - m;
    f32x2 o; o.x = v.x < 0.f ? m.x : r.x; o.y = v.y < 0.f ? m.y : r.y; return o;
}

#ifndef WT_STORES
#define WT_STORES 0
#endif
struct WtBuf { __amdgpu_buffer_rsrc_t r; };
__device__ __forceinline__ WtBuf wt_buf(const void* base) { WtBuf b; b.r = __builtin_amdgcn_make_buffer_rsrc((void*)base, 0, 0xFFFFFFFFu, 0x00020000); return b; }
__device__ __forceinline__ void wt_store16(const WtBuf& b, const void* base, size_t byte_off, u32x4 v) {
#if WT_STORES
    __builtin_amdgcn_raw_buffer_store_b128(v, b.r, (int)(unsigned)byte_off, 0, 16);
#else
    *(u32x4*)((char*)base + byte_off) = v;
#endif
}
__device__ __forceinline__ void wt_store16f(const WtBuf& b, const void* base, size_t byte_off, f32x4 v) { wt_store16(b, base, byte_off, __builtin_bit_cast(u32x4, v)); }

#define XB_TMO      128
#define XB_XCNT(j)  (256  + 64 * (j))
#define XB_XSUB(j)  (1280 + 64 * (j))
#define XB_XGEN(j)  (2304 + 64 * (j))
#define XB_TOP      3328
#define XB_TOPGEN   3392
#define XCD_BAR_WORDS 3456
#define XB_SPIN_CAP (1u << 18)
__device__ __forceinline__ unsigned xb_ld(unsigned* p)              { return __hip_atomic_load(p, __ATOMIC_RELAXED, __HIP_MEMORY_SCOPE_AGENT); }
__device__ __forceinline__ unsigned xb_add(unsigned* p, unsigned v) { return __hip_atomic_fetch_add(p, v, __ATOMIC_RELAXED, __HIP_MEMORY_SCOPE_AGENT); }
__device__ __forceinline__ unsigned xb_xcc_id() { return (unsigned)__builtin_amdgcn_s_getreg((3 << 11) | 20) & 0xFu; }
#define XB_SPIN(cond, bar) do { unsigned _sp = 0; while (cond) { __builtin_amdgcn_s_sleep(1); \
    if ((++_sp & 255u) == 0u) { if (xb_ld(&(bar)[XB_TMO])) break; if (_sp > XB_SPIN_CAP) { atomicAdd(&(bar)[XB_TMO], 1u); break; } } } } while (0)
struct XcdBarrier { unsigned* bar; unsigned x; volatile LAS unsigned* st; };
__device__ __forceinline__ XcdBarrier xcd_barrier_post(unsigned* bar, volatile LAS unsigned* st) {
    XcdBarrier b; b.bar = bar; b.x = xb_xcc_id(); b.st = st;
    if (threadIdx.x == 0) (void)xb_add(&bar[XB_XCNT(b.x)], 1u);
    return b;
}
__device__ __forceinline__ void xcd_barrier_complete(unsigned* bar, unsigned x, unsigned& nloc, unsigned& nx) {
    const unsigned G = gridDim.x * gridDim.y * gridDim.z;
    unsigned sum, cnt, mine, sp = 0u;
    for (;;) {
        sum = 0u; cnt = 0u; mine = 0u;
#pragma unroll
        for (unsigned j = 0; j < 16; ++j) { const unsigned c = xb_ld(&bar[XB_XCNT(j)]); sum += c; cnt += (c > 0u) ? 1u : 0u; mine = (j == x) ? c : mine; }
        if (sum == G) break;
        __builtin_amdgcn_s_sleep(1);
        if ((++sp & 255u) == 0u) { if (xb_ld(&bar[XB_TMO])) break; if (sp > XB_SPIN_CAP) { atomicAdd(&bar[XB_TMO], 1u); break; } }
    }
    nloc = mine > 0u ? mine : 1u; nx = cnt > 0u ? cnt : 1u;
}
__device__ __forceinline__ void xcd_barrier(const XcdBarrier& b) {
    asm volatile("s_waitcnt vmcnt(0)" ::: "memory");
    __syncthreads();
    if (threadIdx.x == 0) {
        unsigned* bar = b.bar;
        __builtin_amdgcn_s_waitcnt(0);
        unsigned nloc = b.st[0], nx = b.st[1];
        if (nloc == 0u) { xcd_barrier_complete(bar, b.x, nloc, nx); b.st[0] = nloc; b.st[1] = nx; }
        const unsigned old = xb_add(&bar[XB_XSUB(b.x)], 1u);
        const unsigned gen = old / nloc;
        if (old + 1u == (gen + 1u) * nloc) {
            __builtin_amdgcn_fence(__ATOMIC_RELEASE, "agent");
            asm volatile("s_waitcnt vmcnt(0)" ::: "memory");
            const unsigned og = xb_add(&bar[XB_TOP], 1u);
            const unsigned tg = og / nx;
            if (og + 1u == (tg + 1u) * nx) xb_add(&bar[XB_TOPGEN], 1u);
            else XB_SPIN(xb_ld(&bar[XB_TOPGEN]) == tg, bar);
            __builtin_amdgcn_fence(__ATOMIC_ACQUIRE, "agent");
            xb_add(&bar[XB_XGEN(b.x)], 1u);
            asm volatile("s_waitcnt vmcnt(0)" ::: "memory");
        } else {
            XB_SPIN(xb_ld(&bar[XB_XGEN(b.x)]) == gen, bar);
            __builtin_amdgcn_fence(__ATOMIC_ACQUIRE, "agent");
            asm volatile("s_waitcnt vmcnt(0)" ::: "memory");
        }
    }
    __syncthreads();
}

namespace pg8 {
constexpr int BM = 256, BK = 64, HALF = 128, HTB = HALF * BK * 2, STAGE_BYTES = 8 * HTB, NXCD = 8, WGM = 8;
__host__ __device__ __forceinline__ int lds_byte(int r, int c) { const int st = (r >> 4) * 2 + (c >> 5), rr = r & 15, cc = c & 31, ob = rr * 64 + cc * 2; return st * 1024 + (ob ^ (((ob >> 9) & 1) << 5)); }
__host__ __device__ __forceinline__ void stage_rc(int b, int& R, int& C) { const int st = b / 1024, sb = b % 1024, swz = sb ^ (((sb >> 9) & 1) << 5); R = (st >> 1) * 16 + swz / 64; C = (st & 1) * 32 + (swz % 64) / 2; }
__host__ __device__ __forceinline__ int perm32(int rho) { const int n = rho >> 4, i = rho & 15; return 8 * (i >> 2) + 4 * n + (i & 3); }

struct Unit { int pm, pn, e, valid, rb, ui; };

struct StaticOrder {
    int nM, nN, nwg, G, c, i0, nmax;
    __device__ __forceinline__ void init(int nM_, int nN_, int G_, int c_) { nM = nM_; nN = nN_; nwg = nM * nN; G = G_; c = c_; i0 = 0; nmax = 1 << 30; }
    __device__ __forceinline__ bool map(int i, int& pm, int& pn) const {
        if (i >= nmax) return false;
        const long L = (long)(i + i0) * G + c; if (L >= nwg) return false;
        int wgid = (int)L; { const int q = nwg / NXCD, r = nwg % NXCD, xcd = wgid % NXCD, off = wgid / NXCD; wgid = (xcd < r ? xcd * (q + 1) : r * (q + 1) + (xcd - r) * q) + off; }
        const int nig = WGM * nN, gid = wgid / nig, fm = gid * WGM, gsz = (nM - fm) < WGM ? (nM - fm) : WGM;
        pm = fm + ((wgid % nig) % gsz); pn = (wgid % nig) / gsz; return true;
    }
};

typedef int v4i32 __attribute__((ext_vector_type(4)));
typedef int v8i32 __attribute__((ext_vector_type(8)));
template <class Epi, class Sched, bool ALIGN_EPI, bool FP8>
__device__ __forceinline__ void gemm_phase(LAS unsigned char* lds, const int KB, const Sched& S, const Epi& E) {
    const int tid = threadIdx.x, wid = __builtin_amdgcn_readfirstlane(tid >> 6), lane = tid & 63, wr = wid >> 2, wc = wid & 3, fr = lane & 15, fq = lane >> 4;
    const int nt = KB / 128;
    int Rs[2], Cs[2]; unsigned voffB[2];
#pragma unroll
    for (int i = 0; i < 2; ++i) { stage_rc(tid * 16 + i * 8192, Rs[i], Cs[i]); voffB[i] = (unsigned)(Rs[i] * KB + Cs[i] * 2); }
    const size_t kstep = (size_t)(BK * 2);
    const size_t hstep = (size_t)HALF * KB;
    const unsigned ldsw = (unsigned)wid * 1024u;
    const int aoff = lds_byte(wr * 64 + fr, fq * 8), boff = lds_byte(wc * 32 + fr, fq * 8);
#define PG8_SA(b, h) (((b) * 2 + (h)) * HTB)
#define PG8_SB(b, h) ((4 + (b) * 2 + (h)) * HTB)
#define PG8_STAGE(bufoff, gbase, voff) do { _Pragma("unroll") for (int _i = 0; _i < 2; ++_i) \
        __builtin_amdgcn_global_load_lds((const unsigned*)((const char*)(gbase) + (voff)[_i]), (LAS unsigned*)(lds + (bufoff) + ldsw + _i * 8192), 16, 0, 0); } while (0)
#define PG8_LDA(dst, b, h) do { _Pragma("unroll") for (int m = 0; m < 4; ++m) dst[m] = __builtin_shufflevector(*(const LAS v4i32*)(lds + PG8_SA(b, h) + aoff + m * 2048), *(const LAS v4i32*)(lds + PG8_SA(b, h) + aoff + m * 2048 + 1024), 0, 1, 2, 3, 4, 5, 6, 7); } while (0)
#define PG8_LDB(dst, b, h) do { _Pragma("unroll") for (int n = 0; n < 2; ++n) dst[n] = __builtin_shufflevector(*(const LAS v4i32*)(lds + PG8_SB(b, h) + boff + n * 2048), *(const LAS v4i32*)(lds + PG8_SB(b, h) + boff + n * 2048 + 1024), 0, 1, 2, 3, 4, 5, 6, 7); } while (0)
#define PG8_MMA(ai, bj, At, Bt) do { __builtin_amdgcn_s_setprio(1); _Pragma("unroll") for (int m = 0; m < 4; ++m) _Pragma("unroll") for (int n = 0; n < 2; ++n) { \
        if constexpr (FP8) asm volatile("v_mfma_f32_16x16x128_f8f6f4 %0, %1, %2, %0" : "+v"(acc[ai][bj][m][n]) : "v"(Bt[n]), "v"(At[m]));   \
        else { acc[ai][bj][m][n] = __builtin_amdgcn_mfma_f32_16x16x32_bf16(__builtin_bit_cast(bf16x8, __builtin_shufflevector(Bt[n], Bt[n], 0, 1, 2, 3)), __builtin_bit_cast(bf16x8, __builtin_shufflevector(At[m], At[m], 0, 1, 2, 3)), acc[ai][bj][m][n], 0, 0, 0); \
               acc[ai][bj][m][n] = __builtin_amdgcn_mfma_f32_16x16x32_bf16(__builtin_bit_cast(bf16x8, __builtin_shufflevector(Bt[n], Bt[n], 4, 5, 6, 7)), __builtin_bit_cast(bf16x8, __builtin_shufflevector(At[m], At[m], 4, 5, 6, 7)), acc[ai][bj][m][n], 0, 0, 0); } } \
        __builtin_amdgcn_s_setprio(0); } while (0)
#define PG8_WAIT_V(n) asm volatile("s_waitcnt vmcnt(" #n ")" ::: "memory")
#define PG8_WAIT_L(n) asm volatile("s_waitcnt lgkmcnt(" #n ")" ::: "memory")
#define PG8_BAR __builtin_amdgcn_s_barrier()
#define PG8_SCHED __builtin_amdgcn_sched_barrier(0)
    Unit cur, nxt; int ui = 0;
    if (!S.next(0, cur)) return;
    f32x4 acc[2][2][4][2];
    E.init_acc(acc, cur, wr, wc, fr, fq);
    v8i32 At[4], B0[2], B1[2];
    const char* cA = S.a_ptr(cur); const char* cB = S.b_ptr(cur);
    unsigned offC[2][2], offN[2][2];
    S.a_offs(cur, Rs, Cs, offC);
    PG8_STAGE(PG8_SB(0, 0), cB, voffB); PG8_STAGE(PG8_SB(0, 1), cB + hstep, voffB); PG8_STAGE(PG8_SA(0, 0), cA, offC[0]); PG8_STAGE(PG8_SA(0, 1), cA, offC[1]);
    if (wr == 1) PG8_BAR;
    PG8_WAIT_V(2); PG8_BAR;
    PG8_STAGE(PG8_SB(1, 0), cB + kstep, voffB); PG8_STAGE(PG8_SA(1, 0), cA + kstep, offC[0]); PG8_STAGE(PG8_SB(1, 1), cB + hstep + kstep, voffB);
    PG8_WAIT_V(6); PG8_BAR;
    for (;;) {
        const bool has_next = S.next(ui + 1, nxt);
        const char* nA = has_next ? S.a_ptr(nxt) : cA; const char* nB = has_next ? S.b_ptr(nxt) : cB;
        if (has_next) S.a_offs(nxt, Rs, Cs, offN);
        else {
#pragma unroll
            for (int h = 0; h < 2; ++h)
#pragma unroll
                for (int i = 0; i < 2; ++i) offN[h][i] = offC[h][i]; }
        for (int t = 0; t < nt; t += 2) {
            const bool last = (t == nt - 2);
            const char* a1 = cA + (size_t)(t + 1) * kstep;
            const char* a2 = last ? nA : cA + (size_t)(t + 2) * kstep; const char* b2 = last ? nB : cB + (size_t)(t + 2) * kstep;
            const char* a3 = a2 + kstep; const char* b3 = b2 + kstep;
            unsigned o2[2][2];
#pragma unroll
            for (int h = 0; h < 2; ++h)
#pragma unroll
                for (int i = 0; i < 2; ++i) o2[h][i] = last ? offN[h][i] : offC[h][i];
            PG8_LDB(B0, 0, 0); PG8_LDB(B1, 0, 1); PG8_SCHED; PG8_LDA(At, 0, 0); PG8_STAGE(PG8_SA(1, 1), a1, offC[1]);
            PG8_WAIT_V(8); PG8_WAIT_L(0); PG8_BAR; PG8_MMA(0, 0, At, B0); PG8_MMA(0, 1, At, B1); PG8_BAR; PG8_SCHED;
            PG8_LDA(At, 0, 1); PG8_STAGE(PG8_SB(0, 0), b2, voffB); PG8_STAGE(PG8_SB(0, 1), b2 + hstep, voffB); PG8_STAGE(PG8_SA(0, 0), a2, o2[0]);
            PG8_WAIT_V(8); PG8_WAIT_L(0); PG8_BAR; PG8_MMA(1, 0, At, B0); PG8_MMA(1, 1, At, B1); PG8_BAR; PG8_SCHED;
            PG8_LDB(B0, 1, 0); PG8_LDB(B1, 1, 1); PG8_SCHED; PG8_LDA(At, 1, 0); PG8_STAGE(PG8_SA(0, 1), a2, o2[1]);
            PG8_WAIT_V(8); PG8_WAIT_L(0); PG8_BAR; PG8_MMA(0, 0, At, B0); PG8_MMA(0, 1, At, B1); PG8_BAR; PG8_SCHED;
            PG8_LDA(At, 1, 1); PG8_STAGE(PG8_SB(1, 0), b3, voffB); PG8_STAGE(PG8_SB(1, 1), b3 + hstep, voffB); PG8_STAGE(PG8_SA(1, 0), a3, o2[0]);
            PG8_WAIT_V(8); PG8_WAIT_L(0); PG8_BAR; PG8_MMA(1, 0, At, B0); PG8_MMA(1, 1, At, B1); PG8_BAR; PG8_SCHED;
        }
        if constexpr (ALIGN_EPI) { if (wr == 0) PG8_BAR; }
        if constexpr (FP8) asm volatile("s_nop 15\n\ts_nop 15" ::: "memory");
        if constexpr (!Epi::AFTER_DRAIN) E(acc, cur, wr, wc, fr, fq);
        if (!has_next) break;
        E.init_acc(acc, nxt, wr, wc, fr, fq);
        cur = nxt; cA = nA; cB = nB; ++ui;
#pragma unroll
        for (int h = 0; h < 2; ++h)
#pragma unroll
            for (int i = 0; i < 2; ++i) offC[h][i] = offN[h][i];
        if constexpr (ALIGN_EPI) { if (wr == 1) PG8_BAR; }
    }
    PG8_WAIT_V(0);
    if constexpr (!ALIGN_EPI) { if (wr == 0) PG8_BAR; }
    PG8_BAR;
    if constexpr (Epi::AFTER_DRAIN) E.fused(acc, cur, wr, wc, fr, fq, lds);
#undef PG8_SA
#undef PG8_SB
#undef PG8_STAGE
#undef PG8_LDA
#undef PG8_LDB
#undef PG8_MMA
#undef PG8_WAIT_V
#undef PG8_WAIT_L
#undef PG8_BAR
#undef PG8_SCHED
}

struct DenseSched {
    const char* A; const char* Bt; int KB; StaticOrder so;
    __device__ __forceinline__ bool next(int i, Unit& u) const { int pm, pn; if (!so.map(i, pm, pn)) return false; u.pm = pm; u.pn = pn; u.e = 0; u.valid = 256; u.rb = pm * 256; u.ui = i; return true; }
    __device__ __forceinline__ const char* a_ptr(const Unit& u) const { return A + (size_t)u.pm * 256 * KB; }
    __device__ __forceinline__ const char* b_ptr(const Unit& u) const { return Bt + (size_t)u.pn * 256 * KB; }
    __device__ __forceinline__ void a_offs(const Unit&, const int (&R)[2], const int (&C)[2], unsigned (&off)[2][2]) const {
#pragma unroll
        for (int h = 0; h < 2; ++h)
#pragma unroll
            for (int i = 0; i < 2; ++i) off[h][i] = (unsigned)((h * 128 + R[i]) * KB + C[i] * 2); }
};
__device__ __forceinline__ void moe_lookup(const LAS int* tab, int vt, Unit& u) {
    int e = 0;
#pragma unroll
    for (int k = 1; k < 8; ++k) e += (vt >= tab[16 + k]) ? 1 : 0;
    e = __builtin_amdgcn_readfirstlane(e);
    const int tpe = __builtin_amdgcn_readfirstlane(tab[16 + e]), ce = __builtin_amdgcn_readfirstlane(tab[e]), be = __builtin_amdgcn_readfirstlane(tab[8 + e]);
    const int li = vt - tpe; u.pm = li; u.e = e; const int rem = ce - 256 * li; u.valid = rem < 256 ? rem : 256; u.rb = be + 256 * li;
}
template <int ES> struct MoeUpSched {
    const char* XA; const char* W; const LAS int* toktab; const LAS int* tab; StaticOrder so;
    __device__ __forceinline__ bool next(int i, Unit& u) const { int vt, pn; if (!so.map(i, vt, pn)) return false; moe_lookup(tab, vt, u); u.pn = pn; u.ui = i; return true; }
    __device__ __forceinline__ const char* a_ptr(const Unit&) const { return XA; }
    __device__ __forceinline__ const char* b_ptr(const Unit& u) const { return W + ((size_t)u.e * NFF2 + (size_t)u.pn * 256) * D * ES; }
    __device__ __forceinline__ void a_offs(const Unit& u, const int (&R)[2], const int (&C)[2], unsigned (&off)[2][2]) const {
#pragma unroll
        for (int h = 0; h < 2; ++h)
#pragma unroll
            for (int i = 0; i < 2; ++i) off[h][i] = (unsigned)toktab[u.ui * 256 + h * 128 + R[i]] * (unsigned)(D * ES) + (unsigned)C[i] * 2u; }
};
template <int ES> struct MoeDownSched {
    const char* ACT; const char* W; const LAS int* tab; StaticOrder so;
    __device__ __forceinline__ bool next(int i, Unit& u) const { int vt, pn; if (!so.map(i, vt, pn)) return false; moe_lookup(tab, vt, u); u.pn = pn; u.ui = i; return true; }
    __device__ __forceinline__ const char* a_ptr(const Unit& u) const { return ACT + (size_t)u.rb * FF * ES; }
    __device__ __forceinline__ const char* b_ptr(const Unit& u) const { return W + ((size_t)u.e * D + (size_t)u.pn * 256) * FF * ES; }
    __device__ __forceinline__ void a_offs(const Unit&, const int (&R)[2], const int (&C)[2], unsigned (&off)[2][2]) const {
#pragma unroll
        for (int h = 0; h < 2; ++h)
#pragma unroll
            for (int i = 0; i < 2; ++i) off[h][i] = (unsigned)((h * 128 + R[i]) * FF * ES + C[i] * 2); }
};

__device__ __forceinline__ void zero_acc(f32x4 (&acc)[2][2][4][2]) {
#pragma unroll
    for (int a = 0; a < 2; ++a)
#pragma unroll
        for (int b = 0; b < 2; ++b)
#pragma unroll
            for (int m = 0; m < 4; ++m)
#pragma unroll
                for (int n = 0; n < 2; ++n) acc[a][b][m][n] = (f32x4){0.f, 0.f, 0.f, 0.f};
}
__device__ __forceinline__ float rstd_of(float p) { p += __shfl_xor(p, 16); p += __shfl_xor(p, 32); return 1.0f / sqrtf(p * (1.0f / D) + EPS); }
struct EpiMix {
    static constexpr bool AFTER_DRAIN = false;
    bf16_t* CG; bf16_t* UA; bf16_t* VA; const float* rss;
    __device__ __forceinline__ void init_acc(f32x4 (&acc)[2][2][4][2], const Unit&, int, int, int, int) const { zero_acc(acc); }
    __device__ __forceinline__ void operator()(const f32x4 (&acc)[2][2][4][2], const Unit& u, int wr, int wc, int fr, int fq) const {
        const int row0 = u.rb + wr * 64 + fr;
        const WtBuf bcg = wt_buf(CG), bdst = wt_buf(u.pn < 6 ? UA : VA);
        float ps[2][4];
#pragma unroll
        for (int ai = 0; ai < 2; ++ai)
#pragma unroll
            for (int m = 0; m < 4; ++m) ps[ai][m] = rss[(size_t)(row0 + ai * HALF + m * 16) * 4 + fq];
#pragma unroll
        for (int ai = 0; ai < 2; ++ai)
#pragma unroll
            for (int m = 0; m < 4; ++m) {
                const int row = row0 + ai * HALF + m * 16; const float rs = rstd_of(ps[ai][m]);
                if (u.pn < 4) {
                    float o[8];
#pragma unroll
                    for (int n = 0; n < 2; ++n)
#pragma unroll
                        for (int j = 0; j < 4; ++j) { const float a = acc[ai][0][m][n][j] * rs, g = acc[ai][1][m][n][j] * rs; o[4 * n + j] = a * fast_sigmoid(g); }
                    u32x4 w; w.x = cvt_pk_bf16(o[0], o[1]); w.y = cvt_pk_bf16(o[2], o[3]); w.z = cvt_pk_bf16(o[4], o[5]); w.w = cvt_pk_bf16(o[6], o[7]);
                    wt_store16(bcg, CG, ((size_t)row * CC + u.pn * 128 + wc * 32 + 8 * fq) * 2, w);
                } else {
                    bf16_t* dbase = (u.pn < 6 ? UA : VA); const size_t doff = ((size_t)row * CC + (u.pn & 1) * 256 + wc * 32 + 8 * fq) * 2;
#pragma unroll
                    for (int bj = 0; bj < 2; ++bj) {
                        const f32x4 v0 = acc[ai][bj][m][0] * rs, v1 = acc[ai][bj][m][1] * rs;
                        const f32x2 a = gelu_pk((f32x2){v0[0], v0[1]}), b = gelu_pk((f32x2){v0[2], v0[3]}), c = gelu_pk((f32x2){v1[0], v1[1]}), d = gelu_pk((f32x2){v1[2], v1[3]});
                        u32x4 w; w.x = cvt_pk_bf16(a.x, a.y); w.y = cvt_pk_bf16(b.x, b.y); w.z = cvt_pk_bf16(c.x, c.y); w.w = cvt_pk_bf16(d.x, d.y);
                        wt_store16(bdst, dbase, doff + bj * HALF * 2, w); }
                }
            }
    }
};
struct EpiRes {
    static constexpr bool AFTER_DRAIN = true;
    const float* XIN; float* XOUT; bf16_t* XB; float* rss_out; unsigned char* XB8;
    __device__ __forceinline__ void init_acc(f32x4 (&acc)[2][2][4][2], const Unit& u, int wr, int wc, int fr, int fq) const {
        const int row0 = u.rb + wr * 64 + fr, col0 = u.pn * 256 + wc * 32 + 8 * fq;
#pragma unroll
        for (int ai = 0; ai < 2; ++ai)
#pragma unroll
            for (int m = 0; m < 4; ++m)
#pragma unroll
                for (int bj = 0; bj < 2; ++bj) { const size_t off = (size_t)(row0 + ai * HALF + m * 16) * D + col0 + bj * HALF;
                    acc[ai][bj][m][0] = *(const f32x4*)(XIN + off); acc[ai][bj][m][1] = *(const f32x4*)(XIN + off + 4); }
    }
    __device__ __forceinline__ void fused(const f32x4 (&acc)[2][2][4][2], const Unit& u, int wr, int wc, int fr, int fq, LAS unsigned char* lds) const {
        const int row0 = u.rb + wr * 64 + fr, col0 = u.pn * 256 + wc * 32 + 8 * fq;
        LAS float* P = (LAS float*)lds;
        const WtBuf bxo = wt_buf(XOUT), bxb = wt_buf(XB);
#pragma unroll
        for (int ai = 0; ai < 2; ++ai)
#pragma unroll
            for (int m = 0; m < 4; ++m) {
                const int lr = ai * HALF + wr * 64 + m * 16 + fr, row = u.rb + lr; float ss = 0.f;
#pragma unroll
                for (int bj = 0; bj < 2; ++bj) {
                    const size_t off = (size_t)row * D + col0 + bj * HALF;
                    const f32x4 x0 = acc[ai][bj][m][0], x1 = acc[ai][bj][m][1];
                    wt_store16f(bxo, XOUT, off * 4, x0); wt_store16f(bxo, XOUT, off * 4 + 16, x1);
                    u32x4 w; w.x = cvt_pk_bf16(x0[0], x0[1]); w.y = cvt_pk_bf16(x0[2], x0[3]); w.z = cvt_pk_bf16(x1[0], x1[1]); w.w = cvt_pk_bf16(x1[2], x1[3]);
                    wt_store16(bxb, XB, off * 2, w);
                    if (XB8) { u32x2 q; q.x = pk_fp8x4(x0[0], x0[1], x0[2], x0[3]); q.y = pk_fp8x4(x1[0], x1[1], x1[2], x1[3]); *(u32x2*)(XB8 + off) = q; }
                    ss += (x0[0] * x0[0] + x0[1] * x0[1]) + (x0[2] * x0[2] + x0[3] * x0[3]) + (x1[0] * x1[0] + x1[1] * x1[1]) + (x1[2] * x1[2] + x1[3] * x1[3]); }
                ss += __shfl_xor(ss, 16); ss += __shfl_xor(ss, 32);
                if (fq == 0) P[lr * 4 + wc] = ss;
            }
        (void)row0;
        __syncthreads();
        if (threadIdx.x < 256) { const f32x4 p = *(const LAS f32x4*)(P + threadIdx.x * 4); rss_out[(size_t)(u.rb + threadIdx.x) * 4 + u.pn] = (p.x + p.y) + (p.z + p.w); }
        __syncthreads();
    }
};
template <bool MOE, bool F8> struct EpiSwiglu {
    static constexpr bool AFTER_DRAIN = false;
    void* ACT; const float* rss; const LAS int* toktab; float pre, post;
    __device__ __forceinline__ void init_acc(f32x4 (&acc)[2][2][4][2], const Unit&, int, int, int, int) const { zero_acc(acc); }
    __device__ __forceinline__ void operator()(const f32x4 (&acc)[2][2][4][2], const Unit& u, int wr, int wc, int fr, int fq) const {
        const int col = u.pn * 128 + wc * 32 + 8 * fq;
        const WtBuf bact = wt_buf(ACT);
        float ps[2][4];
#pragma unroll
        for (int ai = 0; ai < 2; ++ai)
#pragma unroll
            for (int m = 0; m < 4; ++m) { const int lr = ai * HALF + wr * 64 + m * 16 + fr; const int srow = MOE ? toktab[u.ui * 256 + lr] : u.rb + lr; ps[ai][m] = rss[(size_t)srow * 4 + fq]; }
#pragma unroll
        for (int ai = 0; ai < 2; ++ai)
#pragma unroll
            for (int m = 0; m < 4; ++m) {
                const int lr = ai * HALF + wr * 64 + m * 16 + fr;
                const float rs = rstd_of(ps[ai][m]) * pre;
                float o[8];
#pragma unroll
                for (int n = 0; n < 2; ++n)
#pragma unroll
                    for (int j = 0; j < 4; ++j) { const float g = acc[ai][0][m][n][j] * rs, up = acc[ai][1][m][n][j] * rs; o[4 * n + j] = g * fast_sigmoid(g) * up; }
                if constexpr (F8) {
                    u32x2 q; q.x = pk_fp8x4(o[0] * post, o[1] * post, o[2] * post, o[3] * post); q.y = pk_fp8x4(o[4] * post, o[5] * post, o[6] * post, o[7] * post);
                    if (!MOE || lr < u.valid) *(u32x2*)((unsigned char*)ACT + (size_t)(u.rb + lr) * FF + col) = q;
                } else {
                    u32x4 w; w.x = cvt_pk_bf16(o[0], o[1]); w.y = cvt_pk_bf16(o[2], o[3]); w.z = cvt_pk_bf16(o[4], o[5]); w.w = cvt_pk_bf16(o[6], o[7]);
                    if (!MOE || lr < u.valid) wt_store16(bact, ACT, ((size_t)(u.rb + lr) * FF + col) * 2, w);
                }
            }
    }
};
struct EpiSlot {
    static constexpr bool AFTER_DRAIN = false;
    bf16_t* YS; float sc;
    __device__ __forceinline__ void init_acc(f32x4 (&acc)[2][2][4][2], const Unit&, int, int, int, int) const { zero_acc(acc); }
    __device__ __forceinline__ void operator()(const f32x4 (&acc)[2][2][4][2], const Unit& u, int wr, int wc, int fr, int fq) const {
        const int col0 = u.pn * 256 + wc * 32 + 8 * fq;
        const WtBuf bys = wt_buf(YS);
#pragma unroll
        for (int ai = 0; ai < 2; ++ai)
#pragma unroll
            for (int m = 0; m < 4; ++m) {
                const int lr = ai * HALF + wr * 64 + m * 16 + fr;
                if (lr < u.valid) {
#pragma unroll
                    for (int bj = 0; bj < 2; ++bj) {
                        const f32x4 x0 = acc[ai][bj][m][0] * sc, x1 = acc[ai][bj][m][1] * sc;
                        u32x4 w; w.x = cvt_pk_bf16(x0[0], x0[1]); w.y = cvt_pk_bf16(x0[2], x0[3]); w.z = cvt_pk_bf16(x1[0], x1[1]); w.w = cvt_pk_bf16(x1[2], x1[3]);
                        wt_store16(bys, YS, ((size_t)(u.rb + lr) * D + col0 + bj * HALF) * 2, w); }
                }
            }
    }
};
struct EpiNull {
    static constexpr bool AFTER_DRAIN = false;
    float* sink;
    __device__ __forceinline__ void init_acc(f32x4 (&acc)[2][2][4][2], const Unit&, int, int, int, int) const { zero_acc(acc); }
    __device__ __forceinline__ void operator()(const f32x4 (&acc)[2][2][4][2], const Unit& u, int wr, int wc, int fr, int fq) const {
        f32x4 s = (f32x4){0.f, 0.f, 0.f, 0.f};
#pragma unroll
        for (int a = 0; a < 2; ++a)
#pragma unroll
            for (int b = 0; b < 2; ++b)
#pragma unroll
                for (int m = 0; m < 4; ++m)
#pragma unroll
                    for (int n = 0; n < 2; ++n) s += acc[a][b][m][n];
        const float t = (s.x + s.y) + (s.z + s.w);
        if (t == 1.2345678e30f) sink[threadIdx.x] = t;
    }
};
}

struct Args { const float* in[21]; float* out; unsigned char* ws; int ph_lo, ph_hi; };
enum { I_X = 0, I_NMIX, I_WIN, I_CONVW, I_CONVB, I_CONVNG, I_CONVNB, I_SGUNG, I_SGUNB, I_SGUW, I_SGUB, I_WOUT, I_NFFN, I_FWG, I_FWU, I_FWD, I_ROUTER, I_MWG, I_MWU, I_MWD, I_NFINAL };

struct P0Item { const float* W; const float* gain; void* dst; int N, K, c0, k0, f8; };
__device__ __forceinline__ void p0_load(const P0Item& p, int lane, float (&v)[32]) {
    const float* s = p.W + (size_t)(p.k0 + (lane >> 5)) * p.N + p.c0 + (lane & 31);
#pragma unroll
    for (int i = 0; i < 32; ++i) v[i] = s[(size_t)(2 * i) * p.N];
}
__device__ __forceinline__ void p0_finish(const P0Item& p, const float (&v)[32], LAS float* scr, int lane) {
#pragma unroll
    for (int i = 0; i < 32; ++i) scr[(2 * i + (lane >> 5)) * 33 + (lane & 31)] = v[i];
    if (!p.f8) {
        const int c = lane & 7;
        f32x4 g0 = (f32x4){1.f, 1.f, 1.f, 1.f}, g1 = g0;
        if (p.gain) { g0 = *(const f32x4*)(p.gain + p.k0 + 8 * c); g1 = *(const f32x4*)(p.gain + p.k0 + 8 * c + 4); }
        asm volatile("s_waitcnt lgkmcnt(0)" ::: "memory");
        const WtBuf bd = wt_buf(p.dst);
#pragma unroll
        for (int j = 0; j < 4; ++j) { const int rho = (lane >> 3) + 8 * j; const LAS float* s = scr + (8 * c) * 33 + pg8::perm32(rho);
            u32x4 o; o.x = cvt_pk_bf16(s[0 * 33] * g0.x, s[1 * 33] * g0.y); o.y = cvt_pk_bf16(s[2 * 33] * g0.z, s[3 * 33] * g0.w); o.z = cvt_pk_bf16(s[4 * 33] * g1.x, s[5 * 33] * g1.y); o.w = cvt_pk_bf16(s[6 * 33] * g1.z, s[7 * 33] * g1.w);
            wt_store16(bd, p.dst, ((size_t)rho * p.K + p.k0 + 8 * c) * 2, o); }
    } else {
        const int c4 = lane & 3;
        f32x4 g[4];
#pragma unroll
        for (int q = 0; q < 4; ++q) { g[q] = (f32x4){MOE_SW, MOE_SW, MOE_SW, MOE_SW}; if (p.gain) g[q] = *(const f32x4*)(p.gain + p.k0 + 16 * c4 + 4 * q) * MOE_SW; }
        asm volatile("s_waitcnt lgkmcnt(0)" ::: "memory");
#pragma unroll
        for (int j = 0; j < 2; ++j) { const int rho = (lane >> 2) + 16 * j; const LAS float* s = scr + (16 * c4) * 33 + pg8::perm32(rho);
            u32x4 o;
            o.x = pk_fp8x4(s[0 * 33] * g[0].x, s[1 * 33] * g[0].y, s[2 * 33] * g[0].z, s[3 * 33] * g[0].w);
            o.y = pk_fp8x4(s[4 * 33] * g[1].x, s[5 * 33] * g[1].y, s[6 * 33] * g[1].z, s[7 * 33] * g[1].w);
            o.z = pk_fp8x4(s[8 * 33] * g[2].x, s[9 * 33] * g[2].y, s[10 * 33] * g[2].z, s[11 * 33] * g[2].w);
            o.w = pk_fp8x4(s[12 * 33] * g[3].x, s[13 * 33] * g[3].y, s[14 * 33] * g[3].z, s[15 * 33] * g[3].w);
            *(u32x4*)((unsigned char*)p.dst + (size_t)rho * p.K + p.k0 + 16 * c4) = o; }
    }
    asm volatile("s_waitcnt lgkmcnt(0)" ::: "memory");
}
constexpr int IT_WIN = 16 * 64, IT_WOUT = 16 * 32, IT_GU = 16 * 176, IT_DN = 44 * 32;
constexpr int P0_NITEMS = 2 * IT_WIN + 2 * IT_WOUT + IT_GU + IT_DN + NE * IT_GU + NE * IT_DN;
__device__ __forceinline__ bool p0_decode(const Args& args, int it, P0Item& p) {
    if (it >= P0_NITEMS) return false;
    unsigned char* ws = args.ws; int r = it;
    if (r < 2 * IT_WIN) { const int l = r / IT_WIN; r -= l * IT_WIN; const int kb = r / 64, g32 = r % 64, Lb = 32 * g32;
        p.c0 = Lb < 1024 ? ((Lb >> 7) & 1) * 512 + (Lb >> 8) * 128 + (Lb & 127) : Lb;
        p.W = args.in[I_WIN] + (size_t)l * D * DIN; p.N = DIN; p.K = D; p.gain = args.in[I_NMIX] + l * D; p.dst = (bf16_t*)(ws + WS_WIN) + ((size_t)l * DIN + Lb) * D; p.k0 = 64 * kb; p.f8 = 0; return true; }
    r -= 2 * IT_WIN;
    if (r < 2 * IT_WOUT) { const int l = r / IT_WOUT; r -= l * IT_WOUT; const int kb = r / 32, g32 = r % 32, Lb = 32 * g32;
        p.c0 = Lb; p.W = args.in[I_WOUT] + (size_t)l * D * D; p.N = D; p.K = D; p.gain = nullptr; p.dst = (bf16_t*)(ws + WS_WOUT) + ((size_t)l * D + Lb) * D; p.k0 = 64 * kb; p.f8 = 0; return true; }
    r -= 2 * IT_WOUT;
    if (r < IT_GU) { const int kb = r / 176, g32 = r % 176, Lb = 32 * g32; const int kind = (Lb >> 7) & 1;
        p.c0 = (Lb >> 8) * 128 + (Lb & 127); p.W = args.in[kind ? I_FWU : I_FWG]; p.N = FF; p.K = D; p.gain = args.in[I_NFFN]; p.dst = (bf16_t*)(ws + WS_FGU) + (size_t)Lb * D; p.k0 = 64 * kb; p.f8 = 0; return true; }
    r -= IT_GU;
    if (r < IT_DN) { const int kb = r / 32, g32 = r % 32, Lb = 32 * g32;
        p.c0 = Lb; p.W = args.in[I_FWD]; p.N = D; p.K = FF; p.gain = nullptr; p.dst = (bf16_t*)(ws + WS_FD) + (size_t)Lb * FF; p.k0 = 64 * kb; p.f8 = 0; return true; }
    r -= IT_DN;
    if (r < NE * IT_GU) { const int e = r / IT_GU; r -= e * IT_GU; const int kb = r / 176, g32 = r % 176, Lb = 32 * g32; const int kind = (Lb >> 7) & 1;
        p.c0 = (Lb >> 8) * 128 + (Lb & 127); p.W = args.in[kind ? I_MWU : I_MWG] + (size_t)e * D * FF; p.N = FF; p.K = D; p.gain = args.in[I_NFFN] + D; p.dst = (unsigned char*)(ws + WS_MGU) + ((size_t)e * NFF2 + Lb) * D; p.k0 = 64 * kb; p.f8 = 1; return true; }
    r -= NE * IT_GU;
    { const int e = r / IT_DN; r -= e * IT_DN; const int kb = r / 32, g32 = r % 32, Lb = 32 * g32;
        p.c0 = Lb; p.W = args.in[I_MWD] + (size_t)e * FF * D; p.N = D; p.K = FF; p.gain = nullptr; p.dst = (unsigned char*)(ws + WS_MD) + ((size_t)e * D + Lb) * FF; p.k0 = 64 * kb; p.f8 = 1; return true; }
}
__device__ __forceinline__ void prologue_phase(const Args& args, LAS unsigned char* lds, int gw, int NGW, int lane) {
    unsigned char* ws = args.ws;
    LAS float* scr = (LAS float*)(lds + (threadIdx.x >> 6) * 16384);
    {
        P0Item pa, pb; float va[32], vb[32]; int it = gw;
        bool ha = p0_decode(args, it, pa); if (ha) p0_load(pa, lane, va);
        while (ha) {
            it += NGW; const bool hb = p0_decode(args, it, pb); if (hb) p0_load(pb, lane, vb);
            p0_finish(pa, va, scr, lane);
            if (!hb) break;
            it += NGW; ha = p0_decode(args, it, pa); if (ha) p0_load(pa, lane, va);
            p0_finish(pb, vb, scr, lane);
        }
    }
    { const float* x = args.in[I_X]; bf16_t* XB = (bf16_t*)(ws + WS_XB); float* rss = (float*)(ws + WS_RSS);
      for (int m = gw; m < T; m += NGW) {
          const f32x4* xr = (const f32x4*)(x + (size_t)m * D) + lane; f32x4 v[4]; float s = 0.f;
#pragma unroll
          for (int j = 0; j < 4; ++j) { v[j] = xr[64 * j]; s += (v[j].x * v[j].x + v[j].y * v[j].y) + (v[j].z * v[j].z + v[j].w * v[j].w); }
          s = wave_sum(s);
          u32x2* o8 = (u32x2*)(XB + (size_t)m * D) + lane;
#pragma unroll
          for (int j = 0; j < 4; ++j) { u32x2 w; w.x = cvt_pk_bf16(v[j].x, v[j].y); w.y = cvt_pk_bf16(v[j].z, v[j].w); o8[64 * j] = w; }
          if (lane < 4) rss[(size_t)m * 4 + lane] = lane == 0 ? s : 0.f; } }
    { float* RT = (float*)(ws + WS_RT); const float* rt = args.in[I_ROUTER]; const float* g = args.in[I_NFFN] + D;
      for (int i = gw * 64 + lane; i < NE * D; i += NGW * 64) { const int e = i / D, k = i % D; RT[i] = rt[k * NE + e] * g[k]; } }
    { bf16_t* SW = (bf16_t*)(ws + WS_SGUW); const float* sw = args.in[I_SGUW];
      for (int i = gw * 64 + lane; i < 2 * 4 * 128 * 128 / 2; i += NGW * 64) { const int e0 = 2 * i, tt = (e0 >> 7) & 127, s0 = e0 & 127;
          const float a = s0 <= tt ? sw[e0] : 0.f, b = (s0 + 1) <= tt ? sw[e0 + 1] : 0.f; ((unsigned*)SW)[i] = cvt_pk_bf16(a, b); } }
}

__device__ __forceinline__ void mid_phase(const Args& args, LAS unsigned char* lds, int l, int gw, int NGW, int lane, int wave) {
    unsigned char* ws = args.ws;
    const bf16_t* CG = (const bf16_t*)(ws + WS_CG); const bf16_t* UA = (const bf16_t*)(ws + WS_UA); const bf16_t* VA = (const bf16_t*)(ws + WS_VA); bf16_t* Y = (bf16_t*)(ws + WS_Y);
    const int fr = lane & 15, fq = lane >> 4;
    {
        constexpr int VST = 264;
        const bf16_t* Wb = (const bf16_t*)(ws + WS_SGUW) + (size_t)l * 4 * 128 * 128;
        const float* ng = args.in[I_SGUNG] + l * CC; const float* nb = args.in[I_SGUNB] + l * CC; const float* sb = args.in[I_SGUB] + l * 4 * 128;
        for (int unit = blockIdx.x; unit < NB * 16 * 4; unit += gridDim.x) {
            const int b = unit >> 6, n = (unit >> 2) & 15, h = unit & 3; const int R0 = b * SEQ + n * 128;
            const f32x2 gg = *(const f32x2*)(ng + h * 128 + 2 * lane), bb = *(const f32x2*)(nb + h * 128 + 2 * lane);
            unsigned pv[16];
#pragma unroll
            for (int rr = 0; rr < 16; ++rr) pv[rr] = *(const unsigned*)(VA + (size_t)(R0 + wave * 16 + rr) * CC + h * 128 + 2 * lane);
            const int nks = ((16 * wave + 15) >> 5) + 1;
            bf16x8 bfrag[4];
#pragma unroll
            for (int ks = 0; ks < 4; ++ks) if (ks < nks) bfrag[ks] = *(const bf16x8*)(Wb + (size_t)h * 16384 + (16 * wave + fr) * 128 + 32 * ks + 8 * fq);
            float s1[16], s2[16];
#pragma unroll
            for (int rr = 0; rr < 16; ++rr) { const float v0 = bf_lo(pv[rr]), v1 = bf_hi(pv[rr]); s1[rr] = v0 + v1; s2[rr] = v0 * v0 + v1 * v1; }
#pragma unroll
            for (int rr = 0; rr < 16; ++rr) { s1[rr] = row16_allsum(s1[rr]); s2[rr] = row16_allsum(s2[rr]); }
#pragma unroll
            for (int rr = 0; rr < 16; ++rr) { s1[rr] += __shfl_xor(s1[rr], 16); s2[rr] += __shfl_xor(s2[rr], 16); }
#pragma unroll
            for (int rr = 0; rr < 16; ++rr) { s1[rr] += __shfl_xor(s1[rr], 32); s2[rr] += __shfl_xor(s2[rr], 32); }
#pragma unroll
            for (int rp = 0; rp < 8; ++rp) {
                float y[2][2];
#pragma unroll
                for (int q = 0; q < 2; ++q) { const int rr = 2 * rp + q; const float mean = s1[rr] * (1.0f / 128.0f); const float var = fmaxf(s2[rr] * (1.0f / 128.0f) - mean * mean, 0.f);
                    const float rstd = 1.0f / sqrtf(var + EPS); y[q][0] = (bf_lo(pv[rr]) - mean) * rstd * gg.x + bb.x; y[q][1] = (bf_hi(pv[rr]) - mean) * rstd * gg.y + bb.y; }
                const int s = wave * 16 + 2 * rp;
                *(LAS unsigned*)(lds + (2 * lane) * VST + s * 2) = cvt_pk_bf16(y[0][0], y[1][0]);
                *(LAS unsigned*)(lds + (2 * lane + 1) * VST + s * 2) = cvt_pk_bf16(y[0][1], y[1][1]);
            }
            const int t = 16 * wave + fr; const size_t row = (size_t)(R0 + t);
            u32x2 uu[8];
#pragma unroll
            for (int db = 0; db < 8; ++db) uu[db] = *(const u32x2*)(UA + row * CC + h * 128 + 16 * db + 4 * fq);
            const float bias = sb[h * 128 + t];
            __syncthreads();
            f32x4 acc[8];
#pragma unroll
            for (int db = 0; db < 8; ++db) acc[db] = (f32x4){0.f, 0.f, 0.f, 0.f};
#pragma unroll
            for (int ks = 0; ks < 4; ++ks) if (ks < nks) {
#pragma unroll
                for (int db = 0; db < 8; ++db) {
                    const LAS unsigned char* ap = lds + (16 * db + fr) * VST + (32 * ks + 8 * fq) * 2;
                    union { bf16x8 v; u32x2 h[2]; } af; af.h[0] = *(const LAS u32x2*)ap; af.h[1] = *(const LAS u32x2*)(ap + 8);
                    acc[db] = __builtin_amdgcn_mfma_f32_16x16x32_bf16(af.v, bfrag[ks], acc[db], 0, 0, 0);
                }
            }
#pragma unroll
            for (int db = 0; db < 8; ++db) { const int d = 16 * db + 4 * fq;
                const float o0 = bf_lo(uu[db].x) * (acc[db][0] + bias), o1 = bf_hi(uu[db].x) * (acc[db][1] + bias), o2 = bf_lo(uu[db].y) * (acc[db][2] + bias), o3 = bf_hi(uu[db].y) * (acc[db][3] + bias);
                u32x2 w; w.x = cvt_pk_bf16(o0, o1); w.y = cvt_pk_bf16(o2, o3);
                *(u32x2*)(Y + row * D + CC + h * 128 + d) = w; }
            __syncthreads();
        }
    }
    {
        const int cg = gw & 3, ch = cg * 128 + 2 * lane;
        const float* cwp = args.in[I_CONVW] + (size_t)l * CW * CC + ch;
        const f32x2 cb = *(const f32x2*)(args.in[I_CONVB] + l * CC + ch), ng = *(const f32x2*)(args.in[I_CONVNG] + l * CC + ch), nb = *(const f32x2*)(args.in[I_CONVNB] + l * CC + ch);
        for (int item = gw >> 2; item < NB * (SEQ / 16); item += NGW >> 2) {
            const int b = item >> 7, t0 = (item & 127) * 16; const size_t rowb = (size_t)b * SEQ;
            unsigned in[46];
#pragma unroll
            for (int i = 0; i < 46; ++i) { const int t = t0 - 30 + i; in[i] = t >= 0 ? *(const unsigned*)(CG + (rowb + t) * CC + ch) : 0u; }
            float a0[16], a1[16];
#pragma unroll
            for (int tt = 0; tt < 16; ++tt) { a0[tt] = cb.x; a1[tt] = cb.y; }
#pragma unroll
            for (int j = 0; j < CW; ++j) {
                const f32x2 w = *(const f32x2*)(cwp + j * CC);
#pragma unroll
                for (int tt = 0; tt < 16; ++tt) { a0[tt] += w.x * bf_lo(in[tt + j]); a1[tt] += w.y * bf_hi(in[tt + j]); }
            }
            float s1[16], s2[16];
#pragma unroll
            for (int tt = 0; tt < 16; ++tt) { s1[tt] = row16_allsum(a0[tt] + a1[tt]); s2[tt] = row16_allsum(a0[tt] * a0[tt] + a1[tt] * a1[tt]); }
#pragma unroll
            for (int tt = 0; tt < 16; ++tt) { s1[tt] += __shfl_xor(s1[tt], 16); s2[tt] += __shfl_xor(s2[tt], 16); }
#pragma unroll
            for (int tt = 0; tt < 16; ++tt) {
                const float mean = s1[tt] * (1.0f / 64.0f); const float var = fmaxf(s2[tt] * (1.0f / 64.0f) - mean * mean, 0.f);
                const float rstd = 1.0f / sqrtf(var + EPS);
                const float y0 = (a0[tt] - mean) * rstd * ng.x + nb.x, y1 = (a1[tt] - mean) * rstd * ng.y + nb.y;
                *(unsigned*)(Y + (rowb + t0 + tt) * D + ch) = cvt_pk_bf16(y0 * fast_sigmoid(y0), y1 * fast_sigmoid(y1));
            }
        }
    }
}

__device__ __forceinline__ void router_phase(const Args& args, LAS unsigned char* lds, int lane, int wave) {
    unsigned char* ws = args.ws;
    const bf16_t* XB = (const bf16_t*)(ws + WS_XB); const float* RT = (const float*)(ws + WS_RT); const float* rss = (const float*)(ws + WS_RSS) + (size_t)3 * T * 4;
    int* toklist = (int*)(ws + WS_TOKLIST); u32x4* tokinfo = (u32x4*)(ws + WS_TOKINFO); unsigned* cntw = (unsigned*)(ws + WS_CTL) + CW_CNT;
    LAS int* wcnt = (LAS int*)lds;
    LAS int* wbase = (LAS int*)(lds + 256);
    f32x4 rw[NE][2][2];
#pragma unroll
    for (int e = 0; e < NE; ++e)
#pragma unroll
        for (int i = 0; i < 2; ++i) { rw[e][i][0] = *(const f32x4*)(RT + e * D + 512 * i + 8 * lane); rw[e][i][1] = *(const f32x4*)(RT + e * D + 512 * i + 8 * lane + 4); }
    for (int blk = blockIdx.x; blk < T / 64; blk += gridDim.x) {
        int my_e0 = 0, my_e1 = 0; float my_g0 = 0.f, my_g1 = 0.f;
        const int tbase = blk * 64 + wave * 8;
        for (int j = 0; j < 8; ++j) {
            const int t = tbase + j;
            float a[NE];
#pragma unroll
            for (int e = 0; e < NE; ++e) a[e] = 0.f;
#pragma unroll
            for (int i = 0; i < 2; ++i) {
                const u32x4 xv = *(const u32x4*)(XB + (size_t)t * D + 512 * i + 8 * lane);
                const float x0 = bf_lo(xv.x), x1 = bf_hi(xv.x), x2 = bf_lo(xv.y), x3 = bf_hi(xv.y), x4 = bf_lo(xv.z), x5 = bf_hi(xv.z), x6 = bf_lo(xv.w), x7 = bf_hi(xv.w);
#pragma unroll
                for (int e = 0; e < NE; ++e) { const f32x4 wa = rw[e][i][0], wb = rw[e][i][1];
                    a[e] += (x0 * wa.x + x1 * wa.y) + (x2 * wa.z + x3 * wa.w) + (x4 * wb.x + x5 * wb.y) + (x6 * wb.z + x7 * wb.w); }
            }
            float p = lane < 4 ? rss[(size_t)t * 4 + lane] : 0.f;
            p = wave_sum(p);
            const float rstd = 1.0f / sqrtf(p * (1.0f / D) + EPS);
#pragma unroll
            for (int e = 0; e < NE; ++e) a[e] = wave_sum(a[e]) * rstd;
            int e0 = 0; float l0 = a[0];
#pragma unroll
            for (int e = 1; e < NE; ++e) if (a[e] > l0) { l0 = a[e]; e0 = e; }
            int e1 = -1; float l1 = -3.0e38f;
#pragma unroll
            for (int e = 0; e < NE; ++e) if (e != e0 && a[e] > l1) { l1 = a[e]; e1 = e; }
            const float g0 = 1.0f / (1.0f + __expf(l1 - l0)), g1 = 1.0f - g0;
            if (lane == j) { my_e0 = e0; my_e1 = e1; my_g0 = g0; my_g1 = g1; }
        }
        const bool act = lane < 8;
        unsigned long long m0[NE], m1[NE];
#pragma unroll
        for (int e = 0; e < NE; ++e) { m0[e] = __ballot(act && my_e0 == e); m1[e] = __ballot(act && my_e1 == e); }
        if (lane < NE) { int c = 0;
#pragma unroll
            for (int e = 0; e < NE; ++e) if (lane == e) c = __popcll(m0[e]) + __popcll(m1[e]);
            wcnt[wave * 8 + lane] = c; }
        __syncthreads();
        if (threadIdx.x < NE) { const int e = threadIdx.x; int tot = 0; int pre[8];
#pragma unroll
            for (int w = 0; w < 8; ++w) { pre[w] = tot; tot += wcnt[w * 8 + e]; }
            const int base = (int)__hip_atomic_fetch_add(cntw + 64 * e, (unsigned)tot, RLX_AGENT);
#pragma unroll
            for (int w = 0; w < 8; ++w) wbase[w * 8 + e] = base + pre[w]; }
        __syncthreads();
        if (act) {
            const unsigned long long lt = (1ull << lane) - 1ull;
            int pos0 = 0, pos1 = 0;
#pragma unroll
            for (int e = 0; e < NE; ++e) { const int wb = wbase[wave * 8 + e];
                if (my_e0 == e) pos0 = wb + __popcll(m0[e] & lt);
                if (my_e1 == e) pos1 = wb + __popcll(m0[e]) + __popcll(m1[e] & lt); }
            const int t = tbase + lane;
            toklist[my_e0 * T + pos0] = t; toklist[my_e1 * T + pos1] = t;
            u32x4 inf; inf.x = ((unsigned)my_e0 << 16) | (unsigned)pos0; inf.y = ((unsigned)my_e1 << 16) | (unsigned)pos1; inf.z = __float_as_uint(my_g0); inf.w = __float_as_uint(my_g1);
            tokinfo[t] = inf;
        }
        __syncthreads();
    }
}
__device__ __forceinline__ void moe_tab_build(const unsigned char* ws, LAS int* tab) {
    if (threadIdx.x == 0) {
        unsigned* cntw = (unsigned*)(ws + WS_CTL) + CW_CNT; int b = 0, p = 0;
        for (int e = 0; e < NE; ++e) { const int c = (int)__hip_atomic_load(cntw + 64 * e, RLX_AGENT); tab[e] = c; tab[8 + e] = b; tab[16 + e] = p; b += c; p += (c + 255) >> 8; }
        tab[24] = p;
    }
    __syncthreads();
}

__device__ __forceinline__ void final_phase(const Args& args, const LAS int* tab, int gw, int NGW, int lane) {
    unsigned char* ws = args.ws; float* out = args.out; const bf16_t* YS = (const bf16_t*)(ws + WS_YS); const u32x4* tokinfo = (const u32x4*)(ws + WS_TOKINFO);
    f32x4 gn[4];
#pragma unroll
    for (int j = 0; j < 4; ++j) gn[j] = *((const f32x4*)args.in[I_NFINAL] + lane + 64 * j);
    for (int t = gw; t < T; t += NGW) {
        const u32x4 inf = tokinfo[t];
        const int e0 = __builtin_amdgcn_readfirstlane((int)(inf.x >> 16)), p0 = __builtin_amdgcn_readfirstlane((int)(inf.x & 0xffffu)), e1 = __builtin_amdgcn_readfirstlane((int)(inf.y >> 16)), p1 = __builtin_amdgcn_readfirstlane((int)(inf.y & 0xffffu));
        const float g0 = __uint_as_float(inf.z), g1 = __uint_as_float(inf.w);
        const int b0 = __builtin_amdgcn_readfirstlane(tab[8 + e0]), b1 = __builtin_amdgcn_readfirstlane(tab[8 + e1]);
        const size_t s0 = (size_t)(b0 + p0), s1 = (size_t)(b1 + p1);
        f32x4* xr = (f32x4*)(out + (size_t)t * D) + lane; const u32x2* y0 = (const u32x2*)(YS + s0 * D) + lane; const u32x2* y1 = (const u32x2*)(YS + s1 * D) + lane;
        f32x4 v[4]; float ss = 0.f;
#pragma unroll
        for (int j = 0; j < 4; ++j) { const f32x4 x = xr[64 * j]; const u32x2 a = y0[64 * j], b = y1[64 * j];
            v[j].x = x.x + g0 * bf_lo(a.x) + g1 * bf_lo(b.x); v[j].y = x.y + g0 * bf_hi(a.x) + g1 * bf_hi(b.x); v[j].z = x.z + g0 * bf_lo(a.y) + g1 * bf_lo(b.y); v[j].w = x.w + g0 * bf_hi(a.y) + g1 * bf_hi(b.y);
            ss += (v[j].x * v[j].x + v[j].y * v[j].y) + (v[j].z * v[j].z + v[j].w * v[j].w); }
        const float rstd = 1.0f / sqrtf(wave_sum(ss) * (1.0f / D) + EPS);
#pragma unroll
        for (int j = 0; j < 4; ++j) xr[64 * j] = v[j] * rstd * gn[j];
    }
}

__global__ void __launch_bounds__(NWAVES * 64, 2) mega_fwd(Args args) {
    extern __shared__ __attribute__((aligned(16))) unsigned char lds_raw[];
    LAS unsigned char* lds = (LAS unsigned char*)lds_raw;
    const int tid = threadIdx.x, lane = tid & 63, wave = __builtin_amdgcn_readfirstlane(tid >> 6);
    const int G = gridDim.x, bx = blockIdx.x;
    const int vcu = (G % 8 == 0) ? (bx % 8) * (G / 8) + bx / 8 : bx;
    const int gw = vcu * NWAVES + wave, NGW = G * NWAVES;
    unsigned char* ws = args.ws;
    unsigned* ctl = (unsigned*)(ws + WS_CTL);
    for (int u = tid; u < 512 / 4; u += NWAVES * 64) ((LAS unsigned*)(lds + LDSCTL_OFF))[u] = 0u;
    __syncthreads();
    XcdBarrier bar; bar.bar = ctl + CW_BAR; bar.x = 0; bar.st = nullptr;
    if (MK_N_LAUNCHES == 1) bar = xcd_barrier_post(ctl + CW_BAR, (volatile LAS unsigned*)(lds + LDSCTL_OFF) + 8);
    const int lo = args.ph_lo, hi = args.ph_hi;
#ifndef PHMASK
#define PHMASK 0xFFFF
#endif
#define IN(k) ((((PHMASK) >> (k)) & 1) && lo <= (k) && (k) < hi)
#ifndef DUP_PHASE
#define DUP_PHASE -1
#endif
#define REP(k) for (int rep_ = 0; rep_ < ((DUP_PHASE) == (k) ? 2 : 1); ++rep_)
#define SEAM(k) do { if (MK_N_LAUNCHES == 1 && IN((k) + 1)) xcd_barrier(bar); } while (0)
    float* rss = (float*)(ws + WS_RSS);
    bf16_t* XB = (bf16_t*)(ws + WS_XB);

    if (IN(0)) { REP(0) prologue_phase(args, lds, gw, NGW, lane); SEAM(0); }

#ifndef MOE_FP8
#define MOE_FP8 1
#endif
    constexpr bool MF8 = (MOE_FP8 != 0); constexpr int MES = MF8 ? 1 : 2;
#define LAYER_MIX(l, pb) \
    if (IN(pb)) {       \
        pg8::DenseSched S; S.A = (const char*)XB; S.Bt = (const char*)(ws + WS_WIN) + (size_t)(l) * DIN * D * 2; S.KB = D * 2; S.so.init(T / 256, DIN / 256, G, bx); \
        pg8::EpiMix E{(bf16_t*)(ws + WS_CG), (bf16_t*)(ws + WS_UA), (bf16_t*)(ws + WS_VA), rss + (size_t)(2 * (l)) * T * 4}; \
        REP(pb) pg8::gemm_phase<pg8::EpiMix, pg8::DenseSched, true, false>(lds, D * 2, S, E); \
        SEAM(pb); \
    } \
    if (IN((pb) + 1)) { REP((pb) + 1) mid_phase(args, lds, (l), gw, NGW, lane, wave); SEAM((pb) + 1); } \
    if (IN((pb) + 2)) {       \
        pg8::DenseSched S; S.A = (const char*)(ws + WS_Y); S.Bt = (const char*)(ws + WS_WOUT) + (size_t)(l) * D * D * 2; S.KB = D * 2; S.so.init(T / 256, D / 256, G, bx); \
        pg8::EpiRes E{(l) == 0 ? args.in[I_X] : args.out, args.out, XB, rss + (size_t)(2 * (l) + 1) * T * 4, ((l) == 1 && MF8) ? (unsigned char*)(ws + WS_XB8) : nullptr}; \
        REP((pb) + 2) for (int r_ = 0; r_ * G < S.so.nwg; ++r_) { S.so.i0 = r_; S.so.nmax = 1; pg8::gemm_phase<pg8::EpiRes, pg8::DenseSched, false, false>(lds, D * 2, S, E); } \
        SEAM((pb) + 2); \
    }
    LAYER_MIX(0, 1)
    if (IN(4)) {
        pg8::DenseSched S; S.A = (const char*)XB; S.Bt = (const char*)(ws + WS_FGU); S.KB = D * 2; S.so.init(T / 256, NFF2 / 256, G, bx);
        pg8::EpiSwiglu<false, false> E{(void*)(ws + WS_ACT), rss + (size_t)1 * T * 4, nullptr, 1.0f, 1.0f};
        REP(4) pg8::gemm_phase<pg8::EpiSwiglu<false, false>, pg8::DenseSched, true, false>(lds, D * 2, S, E);
        SEAM(4);
    }
    if (IN(5)) {
        pg8::DenseSched S; S.A = (const char*)(ws + WS_ACT); S.Bt = (const char*)(ws + WS_FD); S.KB = FF * 2; S.so.init(T / 256, D / 256, G, bx);
        pg8::EpiRes E{args.out, args.out, XB, rss + (size_t)2 * T * 4, nullptr};
        for (int r_ = 0; r_ * G < S.so.nwg; ++r_) { S.so.i0 = r_; S.so.nmax = 1; pg8::gemm_phase<pg8::EpiRes, pg8::DenseSched, false, false>(lds, FF * 2, S, E); }
        SEAM(5);
    }
    LAYER_MIX(1, 6)
    LAS int* mtab = (LAS int*)(lds + LDSCTL_OFF + 64);
    if (IN(9)) { router_phase(args, lds, lane, wave); SEAM(9); }
    if (IN(10)) {
        moe_tab_build(ws, mtab);
        pg8::MoeUpSched<MES> S; S.tab = mtab;
        S.XA = MF8 ? (const char*)(ws + WS_XB8) : (const char*)XB; S.W = (const char*)(ws + WS_MGU); S.toktab = (const LAS int*)(lds + TOKTAB_OFF); S.so.init(__builtin_amdgcn_readfirstlane(mtab[24]), NFF2 / 256, G, bx);
        { const int* toklist = (const int*)(ws + WS_TOKLIST); LAS int* tt = (LAS int*)(lds + TOKTAB_OFF); pg8::Unit u;
          for (int i = 0; i < 12 && S.next(i, u); ++i) if (tid < 256) tt[i * 256 + tid] = tid < u.valid ? toklist[u.e * T + u.pm * 256 + tid] : 0;
          __syncthreads(); }
        pg8::EpiSwiglu<true, MF8> E{(void*)(ws + WS_ACT), rss + (size_t)3 * T * 4, (const LAS int*)(lds + TOKTAB_OFF), MF8 ? 1.0f / MOE_SW : 1.0f, MF8 ? MOE_SA : 1.0f};
#if PROBE_NULL == 10
        { pg8::EpiNull EN{(float*)(ws + WS_TOKINFO)}; pg8::gemm_phase<pg8::EpiNull, pg8::MoeUpSched<MES>, true, MF8>(lds, D * MES, S, EN); }
#endif
        REP(10) pg8::gemm_phase<pg8::EpiSwiglu<true, MF8>, pg8::MoeUpSched<MES>, true, MF8>(lds, D * MES, S, E);
        SEAM(10);
    }
    if (IN(11)) {
        moe_tab_build(ws, mtab);
        pg8::MoeDownSched<MES> S; S.tab = mtab;
        S.ACT = (const char*)(ws + WS_ACT); S.W = (const char*)(ws + WS_MD); S.so.init(__builtin_amdgcn_readfirstlane(mtab[24]), D / 256, G, bx);
        pg8::EpiSlot E{(bf16_t*)(ws + WS_YS), MF8 ? 1.0f / (MOE_SW * MOE_SA) : 1.0f};
#if PROBE_NULL == 11
        { pg8::EpiNull EN{(float*)(ws + WS_TOKINFO)}; pg8::gemm_phase<pg8::EpiNull, pg8::MoeDownSched<MES>, true, MF8>(lds, FF * MES, S, EN); }
#endif
        REP(11) pg8::gemm_phase<pg8::EpiSlot, pg8::MoeDownSched<MES>, true, MF8>(lds, FF * MES, S, E);
        SEAM(11);
    }
    if (IN(12)) { moe_tab_build(ws, mtab); final_phase(args, mtab, gw, NGW, lane); }
#undef IN
#undef SEAM
}

extern "C" void kernel_launch(void* const* d_in, const int* in_sizes, int n_in, void* d_out, int out_size, void* d_ws, size_t ws_size, hipStream_t stream) {
    static int grid = 0;
    if (grid == 0) {
        if (n_in != 21 || in_sizes[0] != T * D || out_size != T * D || ws_size < WS_END) { fprintf(stderr, "kernel_launch: unexpected shapes (n_in %d, in0 %d, out %d, ws %zu < %zu); nothing launched\n", n_in, n_in > 0 ? in_sizes[0] : -1, out_size, ws_size, (size_t)WS_END); grid = -1; return; }
        int dev = 0, cus = 0, per_cu = 0;
        if (hipGetDevice(&dev) != hipSuccess || hipDeviceGetAttribute(&cus, hipDeviceAttributeMultiprocessorCount, dev) != hipSuccess) { grid = -1; return; }
        if (hipFuncSetAttribute((const void*)mega_fwd, hipFuncAttributeMaxDynamicSharedMemorySize, LDS_BYTES) != hipSuccess) { fprintf(stderr, "kernel_launch: hipFuncSetAttribute failed\n"); grid = -1; return; }
        if (hipOccupancyMaxActiveBlocksPerMultiprocessor(&per_cu, (const void*)mega_fwd, NWAVES * 64, LDS_BYTES) != hipSuccess || per_cu < 1) { fprintf(stderr, "kernel_launch: occupancy query reports %d\n", per_cu); }
        (void)hipGetLastError();
        grid = cus;
    }
    if (grid < 0) return;
    if (hipMemsetAsync((char*)d_ws + WS_CTL, 0, CTL_ZERO_BYTES, stream) != hipSuccess) return;
    Args a{};
    for (int i = 0; i < 21; ++i) a.in[i] = (const float*)d_in[i];
    a.out = (float*)d_out; a.ws = (unsigned char*)d_ws;
    if (MK_N_LAUNCHES == 1) { a.ph_lo = 0; a.ph_hi = N_PHASES; hipLaunchKernelGGL(mega_fwd, dim3(grid), dim3(NWAVES * 64), LDS_BYTES, stream, a); }
    else for (int p = 0; p < N_PHASES; ++p) { a.ph_lo = p; a.ph_hi = p + 1; hipLaunchKernelGGL(mega_fwd, dim3(grid), dim3(NWAVES * 64), LDS_BYTES, stream, a); }
}
```

```cpp
#include <hip/hip_runtime.h>
#include <cstdio>
#include <cstdint>

#ifndef PROBE_NULL
#define PROBE_NULL -1
#endif
#ifndef DENSE_FP8
#define DENSE_FP8 0
#endif
#ifndef MK_N_LAUNCHES
#define MK_N_LAUNCHES 1
#endif
constexpr int N_PHASES = 13;

#define GAS __attribute__((address_space(1)))
#define LAS __attribute__((address_space(3)))
typedef unsigned short bf16_t;
typedef short bf16x8 __attribute__((ext_vector_type(8)));
typedef float f32x4 __attribute__((ext_vector_type(4)));
typedef float f32x2 __attribute__((ext_vector_type(2)));
typedef unsigned u32x4 __attribute__((ext_vector_type(4)));
typedef unsigned u32x2 __attribute__((ext_vector_type(2)));

constexpr int NB = 8, SEQ = 2048, T = NB * SEQ, D = 1024, DIN = 2048, CC = 512, FF = 2816, NE = 8, CW = 31, NFF2 = 2 * FF;
constexpr float EPS = 1e-6f;
constexpr int NWAVES = 8;

constexpr size_t KiB = 1024, MiB = 1024 * 1024;
constexpr size_t WS_CTL = 0, CTL_ZERO_BYTES = 64 * KiB;
constexpr int CW_BAR = 1024;
constexpr int CW_CNT = 8192;
constexpr size_t WS_TOKLIST = 64 * KiB;
constexpr size_t WS_TOKINFO = 576 * KiB;
constexpr size_t WS_RT = 832 * KiB;
constexpr size_t WS_SGUW = 1 * MiB;
constexpr size_t WS_RSS = 2 * MiB;
constexpr size_t WS_WIN = 6 * MiB;
constexpr size_t WS_WOUT = 14 * MiB;
constexpr size_t WS_FGU = 18 * MiB;
constexpr size_t WS_FD = 29 * MiB;
constexpr size_t WS_MGU = 35 * MiB;
constexpr size_t WS_MD = 79 * MiB;
constexpr size_t WS_XB = 101 * MiB;
constexpr size_t WS_XB8 = 133 * MiB;
constexpr size_t WS_ACT = 149 * MiB;
constexpr size_t WS_CG = WS_ACT, WS_UA = WS_ACT + 16 * MiB, WS_VA = WS_ACT + 32 * MiB, WS_Y = WS_ACT + 48 * MiB;
constexpr size_t WS_YS = 238 * MiB;
constexpr size_t WS_END = WS_YS + (size_t)2 * T * D * 2;
constexpr float MOE_SW = 32.0f, MOE_SA = 8.0f;
static_assert(WS_END <= 380 * MiB, "workspace map");
static_assert(WS_MGU + (size_t)NE * NFF2 * D <= WS_MD && WS_MD + (size_t)NE * D * FF <= WS_XB && WS_FD + (size_t)D * FF * 2 <= WS_MGU && WS_ACT + (size_t)T * FF * 2 <= WS_YS && WS_ACT + (size_t)(2 * T + 256) * FF <= WS_YS, "workspace map 2");

constexpr int RING_BYTES = 131072;
constexpr int LDSCTL_OFF = RING_BYTES;
constexpr int MAXU = 12;
constexpr int TOKTAB_OFF = RING_BYTES + 512;
constexpr int RSTAB_OFF = TOKTAB_OFF + MAXU * 256 * 4;
constexpr int LDS_BYTES = RSTAB_OFF + MAXU * 256 * 4;
static_assert(LDS_BYTES <= 160 * 1024 && LDS_BYTES > 80 * 1024, "LDS map");

#define RLX_AGENT __ATOMIC_RELAXED, __HIP_MEMORY_SCOPE_AGENT
__device__ __forceinline__ unsigned cvt_pk_bf16(float lo, float hi) { unsigned r; asm volatile("v_cvt_pk_bf16_f32 %0, %1, %2" : "=v"(r) : "v"(lo), "v"(hi)); return r; }
__device__ __forceinline__ float clamp448(float v) { return __builtin_amdgcn_fmed3f(v, -448.0f, 448.0f); }
__device__ __forceinline__ unsigned pk_fp8x4(float a, float b, float c, float d) {
    int p = __builtin_amdgcn_cvt_pk_fp8_f32(clamp448(a), clamp448(b), 0, false); p = __builtin_amdgcn_cvt_pk_fp8_f32(clamp448(c), clamp448(d), p, true); return (unsigned)p; }
__device__ __forceinline__ float bf_lo(unsigned x) { return __uint_as_float(x << 16); }
__device__ __forceinline__ float bf_hi(unsigned x) { return __uint_as_float(x & 0xffff0000u); }
__device__ __forceinline__ float fast_sigmoid(float g) { return __builtin_amdgcn_rcpf(1.0f + __builtin_amdgcn_exp2f(-1.4426950408889634f * g)); }
__device__ __forceinline__ float wave_sum(float v) {
#pragma unroll
    for (int o = 1; o < 64; o <<= 1) v += __shfl_xor(v, o);
    return v;
}
__device__ __forceinline__ float dpp_add(float v, const int ctrl_sel) {
    int r;
    if (ctrl_sel == 0) r = __builtin_amdgcn_update_dpp(0, __float_as_int(v), 0xB1, 0xF, 0xF, false);
    else if (ctrl_sel == 1) r = __builtin_amdgcn_update_dpp(0, __float_as_int(v), 0x4E, 0xF, 0xF, false);
    else if (ctrl_sel == 2) r = __builtin_amdgcn_update_dpp(0, __float_as_int(v), 0x141, 0xF, 0xF, false);
    else r = __builtin_amdgcn_update_dpp(0, __float_as_int(v), 0x140, 0xF, 0xF, false);
    return v + __int_as_float(r);
}
__device__ __forceinline__ float row16_allsum(float v) { v = dpp_add(v, 0); v = dpp_add(v, 1); v = dpp_add(v, 2); v = dpp_add(v, 3); return v; }
__device__ __forceinline__ f32x2 gelu_pk(f32x2 v) {
    const f32x2 av = __builtin_elementwise_abs(v), d = av * 0.2316418882f + 1.0f;
    f32x2 t; t.x = __builtin_amdgcn_rcpf(d.x); t.y = __builtin_amdgcn_rcpf(d.y);
    f32x2 q = t * 0.5307027145f + (-0.7265760135f); q = q * t + 0.7107068705f; q = q * t + (-0.142248368f); q = q * t + 0.127414796f; q = q * t;
    const f32x2 s = (v * v) * (-0.72134752044f);
    f32x2 e; e.x = __builtin_amdgcn_exp2f(s.x); e.y = __builtin_amdgcn_exp2f(s.y);
    const f32x2 m = v * (q * e), r = v - m;
    f32x2 o; o.x = v.x < 0.f ? m.x : r.x; o.y = v.y < 0.f ? m.y : r.y; return o;
}

#ifndef WT_STORES
#define WT_STORES 0
#endif
struct WtBuf { __amdgpu_buffer_rsrc_t r; };
__device__ __forceinline__ WtBuf wt_buf(const void* base) { WtBuf b; b.r = __builtin_amdgcn_make_buffer_rsrc((void*)base, 0, 0xFFFFFFFFu, 0x00020000); return b; }
__device__ __forceinline__ void wt_store16(const WtBuf& b, const void* base, size_t byte_off, u32x4 v) {
#if WT_STORES
    __builtin_amdgcn_raw_buffer_store_b128(v, b.r, (int)(unsigned)byte_off, 0, 16);
#else
    *(u32x4*)((char*)base + byte_off) = v;
#endif
}
__device__ __forceinline__ void wt_store16f(const WtBuf& b, const void* base, size_t byte_off, f32x4 v) { wt_store16(b, base, byte_off, __builtin_bit_cast(u32x4, v)); }

#define XB_TMO      128
#define XB_XCNT(j)  (256  + 64 * (j))
#define XB_XSUB(j)  (1280 + 64 * (j))
#define XB_XGEN(j)  (2304 + 64 * (j))
#define XB_TOP      3328
#define XB_TOPGEN   3392
#define XCD_BAR_WORDS 3456
#define XB_SPIN_CAP (1u << 18)
__device__ __forceinline__ unsigned xb_ld(unsigned* p)              { return __hip_atomic_load(p, __ATOMIC_RELAXED, __HIP_MEMORY_SCOPE_AGENT); }
__device__ __forceinline__ unsigned xb_add(unsigned* p, unsigned v) { return __hip_atomic_fetch_add(p, v, __ATOMIC_RELAXED, __HIP_MEMORY_SCOPE_AGENT); }
__device__ __forceinline__ unsigned xb_xcc_id() { return (unsigned)__builtin_amdgcn_s_getreg((3 << 11) | 20) & 0xFu; }
#define XB_SPIN(cond, bar) do { unsigned _sp = 0; while (cond) { __builtin_amdgcn_s_sleep(1); \
    if ((++_sp & 255u) == 0u) { if (xb_ld(&(bar)[XB_TMO])) break; if (_sp > XB_SPIN_CAP) { atomicAdd(&(bar)[XB_TMO], 1u); break; } } } } while (0)
struct XcdBarrier { unsigned* bar; unsigned x; volatile LAS unsigned* st; };
__device__ __forceinline__ XcdBarrier xcd_barrier_post(unsigned* bar, volatile LAS unsigned* st) {
    XcdBarrier b; b.bar = bar; b.x = xb_xcc_id(); b.st = st;
    if (threadIdx.x == 0) (void)xb_add(&bar[XB_XCNT(b.x)], 1u);
    return b;
}
__device__ __forceinline__ void xcd_barrier_complete(unsigned* bar, unsigned x, unsigned& nloc, unsigned& nx) {
    const unsigned G = gridDim.x * gridDim.y * gridDim.z;
    unsigned sum, cnt, mine, sp = 0u;
    for (;;) {
        sum = 0u; cnt = 0u; mine = 0u;
#pragma unroll
        for (unsigned j = 0; j < 16; ++j) { const unsigned c = xb_ld(&bar[XB_XCNT(j)]); sum += c; cnt += (c > 0u) ? 1u : 0u; mine = (j == x) ? c : mine; }
        if (sum == G) break;
        __builtin_amdgcn_s_sleep(1);
        if ((++sp & 255u) == 0u) { if (xb_ld(&bar[XB_TMO])) break; if (sp > XB_SPIN_CAP) { atomicAdd(&bar[XB_TMO], 1u); break; } }
    }
    nloc = mine > 0u ? mine : 1u; nx = cnt > 0u ? cnt : 1u;
}
__device__ __forceinline__ void xcd_barrier(const XcdBarrier& b) {
    asm volatile("s_waitcnt vmcnt(0)" ::: "memory");
    __syncthreads();
    if (threadIdx.x == 0) {
        unsigned* bar = b.bar;
        __builtin_amdgcn_s_waitcnt(0);
        unsigned nloc = b.st[0], nx = b.st[1];
        if (nloc == 0u) { xcd_barrier_complete(bar, b.x, nloc, nx); b.st[0] = nloc; b.st[1] = nx; }
        const unsigned old = xb_add(&bar[XB_XSUB(b.x)], 1u);
        const unsigned gen = old / nloc;
        if (old + 1u == (gen + 1u) * nloc) {
            __builtin_amdgcn_fence(__ATOMIC_RELEASE, "agent");
            asm volatile("s_waitcnt vmcnt(0)" ::: "memory");
            const unsigned og = xb_add(&bar[XB_TOP], 1u);
            const unsigned tg = og / nx;
            if (og + 1u == (tg + 1u) * nx) xb_add(&bar[XB_TOPGEN], 1u);
            else XB_SPIN(xb_ld(&bar[XB_TOPGEN]) == tg, bar);
            __builtin_amdgcn_fence(__ATOMIC_ACQUIRE, "agent");
            xb_add(&bar[XB_XGEN(b.x)], 1u);
            asm volatile("s_waitcnt vmcnt(0)" ::: "memory");
        } else {
            XB_SPIN(xb_ld(&bar[XB_XGEN(b.x)]) == gen, bar);
            __builtin_amdgcn_fence(__ATOMIC_ACQUIRE, "agent");
            asm volatile("s_waitcnt vmcnt(0)" ::: "memory");
        }
    }
    __syncthreads();
}

namespace pg8 {
constexpr int BM = 256, BK = 64, HALF = 128, HTB = HALF * BK * 2, STAGE_BYTES = 8 * HTB, NXCD = 8, WGM = 8;
__host__ __device__ __forceinline__ int lds_byte(int r, int c) { const int st = (r >> 4) * 2 + (c >> 5), rr = r & 15, cc = c & 31, ob = rr * 64 + cc * 2; return st * 1024 + (ob ^ (((ob >> 9) & 1) << 5)); }
__host__ __device__ __forceinline__ void stage_rc(int b, int& R, int& C) { const int st = b / 1024, sb = b % 1024, swz = sb ^ (((sb >> 9) & 1) << 5); R = (st >> 1) * 16 + swz / 64; C = (st & 1) * 32 + (swz % 64) / 2; }
__host__ __device__ __forceinline__ int perm32(int rho) { const int n = rho >> 4, i = rho & 15; return 8 * (i >> 2) + 4 * n + (i & 3); }

struct Unit { int pm, pn, e, valid, rb, ui; };

struct StaticOrder {
    int nM, nN, nwg, G, c, i0, nmax;
    __device__ __forceinline__ void init(int nM_, int nN_, int G_, int c_) { nM = nM_; nN = nN_; nwg = nM * nN; G = G_; c = c_; i0 = 0; nmax = 1 << 30; }
    __device__ __forceinline__ bool map(int i, int& pm, int& pn) const {
        if (i >= nmax) return false;
        const long L = (long)(i + i0) * G + c; if (L >= nwg) return false;
        int wgid = (int)L; { const int q = nwg / NXCD, r = nwg % NXCD, xcd = wgid % NXCD, off = wgid / NXCD; wgid = (xcd < r ? xcd * (q + 1) : r * (q + 1) + (xcd - r) * q) + off; }
        const int nig = WGM * nN, gid = wgid / nig, fm = gid * WGM, gsz = (nM - fm) < WGM ? (nM - fm) : WGM;
        pm = fm + ((wgid % nig) % gsz); pn = (wgid % nig) / gsz; return true;
    }
};

typedef int v4i32 __attribute__((ext_vector_type(4)));
typedef int v8i32 __attribute__((ext_vector_type(8)));
template <class Epi, class Sched, bool ALIGN_EPI, bool FP8>
__device__ __forceinline__ void gemm_phase(LAS unsigned char* lds, const int KB, const Sched& S, const Epi& E) {
    const int tid = threadIdx.x, wid = __builtin_amdgcn_readfirstlane(tid >> 6), lane = tid & 63, wr = wid >> 2, wc = wid & 3, fr = lane & 15, fq = lane >> 4;
    const int nt = KB / 128;
    int Rs[2], Cs[2]; unsigned voffB[2];
#pragma unroll
    for (int i = 0; i < 2; ++i) { stage_rc(tid * 16 + i * 8192, Rs[i], Cs[i]); voffB[i] = (unsigned)(Rs[i] * KB + Cs[i] * 2); }
    const size_t kstep = (size_t)(BK * 2);
    const size_t hstep = (size_t)HALF * KB;
    const unsigned ldsw = (unsigned)wid * 1024u;
    const int aoff = lds_byte(wr * 64 + fr, fq * 8), boff = lds_byte(wc * 32 + fr, fq * 8);
#define PG8_SA(b, h) (((b) * 2 + (h)) * HTB)
#define PG8_SB(b, h) ((4 + (b) * 2 + (h)) * HTB)
#define PG8_STAGE(bufoff, gbase, voff) do { _Pragma("unroll") for (int _i = 0; _i < 2; ++_i) \
        __builtin_amdgcn_global_load_lds((const unsigned*)((const char*)(gbase) + (voff)[_i]), (LAS unsigned*)(lds + (bufoff) + ldsw + _i * 8192), 16, 0, 0); } while (0)
#define PG8_LDA(dst, b, h) do { _Pragma("unroll") for (int m = 0; m < 4; ++m) dst[m] = __builtin_shufflevector(*(const LAS v4i32*)(lds + PG8_SA(b, h) + aoff + m * 2048), *(const LAS v4i32*)(lds + PG8_SA(b, h) + aoff + m * 2048 + 1024), 0, 1, 2, 3, 4, 5, 6, 7); } while (0)
#define PG8_LDB(dst, b, h) do { _Pragma("unroll") for (int n = 0; n < 2; ++n) dst[n] = __builtin_shufflevector(*(const LAS v4i32*)(lds + PG8_SB(b, h) + boff + n * 2048), *(const LAS v4i32*)(lds + PG8_SB(b, h) + boff + n * 2048 + 1024), 0, 1, 2, 3, 4, 5, 6, 7); } while (0)
#define PG8_MMA(ai, bj, At, Bt) do { __builtin_amdgcn_s_setprio(1); _Pragma("unroll") for (int m = 0; m < 4; ++m) _Pragma("unroll") for (int n = 0; n < 2; ++n) { \
        if constexpr (FP8) asm volatile("v_mfma_f32_16x16x128_f8f6f4 %0, %1, %2, %0" : "+v"(acc[ai][bj][m][n]) : "v"(Bt[n]), "v"(At[m]));   \
        else { acc[ai][bj][m][n] = __builtin_amdgcn_mfma_f32_16x16x32_bf16(__builtin_bit_cast(bf16x8, __builtin_shufflevector(Bt[n], Bt[n], 0, 1, 2, 3)), __builtin_bit_cast(bf16x8, __builtin_shufflevector(At[m], At[m], 0, 1, 2, 3)), acc[ai][bj][m][n], 0, 0, 0); \
               acc[ai][bj][m][n] = __builtin_amdgcn_mfma_f32_16x16x32_bf16(__builtin_bit_cast(bf16x8, __builtin_shufflevector(Bt[n], Bt[n], 4, 5, 6, 7)), __builtin_bit_cast(bf16x8, __builtin_shufflevector(At[m], At[m], 4, 5, 6, 7)), acc[ai][bj][m][n], 0, 0, 0); } } \
        __builtin_amdgcn_s_setprio(0); } while (0)
#define PG8_WAIT_V(n) asm volatile("s_waitcnt vmcnt(" #n ")" ::: "memory")
#define PG8_WAIT_L(n) asm volatile("s_waitcnt lgkmcnt(" #n ")" ::: "memory")
#define PG8_BAR __builtin_amdgcn_s_barrier()
#define PG8_SCHED __builtin_amdgcn_sched_barrier(0)
    Unit cur, nxt; int ui = 0;
    if (!S.next(0, cur)) return;
    f32x4 acc[2][2][4][2];
    E.init_acc(acc, cur, wr, wc, fr, fq);
    v8i32 At[4], B0[2], B1[2];
    const char* cA = S.a_ptr(cur); const char* cB = S.b_ptr(cur);
    unsigned offC[2][2], offN[2][2];
    S.a_offs(cur, Rs, Cs, offC);
    PG8_STAGE(PG8_SB(0, 0), cB, voffB); PG8_STAGE(PG8_SB(0, 1), cB + hstep, voffB); PG8_STAGE(PG8_SA(0, 0), cA, offC[0]); PG8_STAGE(PG8_SA(0, 1), cA, offC[1]);
    if (wr == 1) PG8_BAR;
    PG8_WAIT_V(2); PG8_BAR;
    PG8_STAGE(PG8_SB(1, 0), cB + kstep, voffB); PG8_STAGE(PG8_SA(1, 0), cA + kstep, offC[0]); PG8_STAGE(PG8_SB(1, 1), cB + hstep + kstep, voffB);
    PG8_WAIT_V(6); PG8_BAR;
    bool has_next = false; const char* nA = cA; const char* nB = cB;
    constexpr bool NEXT_IN_LOOP = FP8;
#define PG8_NEXT() do { has_next = S.next(ui + 1, nxt); nA = has_next ? S.a_ptr(nxt) : cA; nB = has_next ? S.b_ptr(nxt) : cB; \
        if (has_next) S.a_offs(nxt, Rs, Cs, offN); else { _Pragma("unroll") for (int h = 0; h < 2; ++h) _Pragma("unroll") for (int i = 0; i < 2; ++i) offN[h][i] = offC[h][i]; } } while (0)
    for (;;) {
        if constexpr (!NEXT_IN_LOOP) PG8_NEXT();
        for (int t = 0; t < nt; t += 2) {
            const bool last = (t == nt - 2);
            const char* a1 = cA + (size_t)(t + 1) * kstep;
            const char* a2 = last ? nA : cA + (size_t)(t + 2) * kstep; const char* b2 = last ? nB : cB + (size_t)(t + 2) * kstep;
            const char* a3 = a2 + kstep; const char* b3 = b2 + kstep;
            unsigned o2[2][2];
#pragma unroll
            for (int h = 0; h < 2; ++h)
#pragma unroll
                for (int i = 0; i < 2; ++i) o2[h][i] = last ? offN[h][i] : offC[h][i];
            PG8_LDB(B0, 0, 0); PG8_LDB(B1, 0, 1); PG8_SCHED; PG8_LDA(At, 0, 0); PG8_STAGE(PG8_SA(1, 1), a1, offC[1]);
            PG8_WAIT_V(8); PG8_WAIT_L(0); PG8_BAR; PG8_MMA(0, 0, At, B0); PG8_MMA(0, 1, At, B1);
            if constexpr (NEXT_IN_LOOP) { if (t == 0) PG8_NEXT(); }
            PG8_BAR; PG8_SCHED;
            PG8_LDA(At, 0, 1); PG8_STAGE(PG8_SB(0, 0), b2, voffB); PG8_STAGE(PG8_SB(0, 1), b2 + hstep, voffB); PG8_STAGE(PG8_SA(0, 0), a2, o2[0]);
            PG8_WAIT_V(8); PG8_WAIT_L(0); PG8_BAR; PG8_MMA(1, 0, At, B0); PG8_MMA(1, 1, At, B1); PG8_BAR; PG8_SCHED;
            PG8_LDB(B0, 1, 0); PG8_LDB(B1, 1, 1); PG8_SCHED; PG8_LDA(At, 1, 0); PG8_STAGE(PG8_SA(0, 1), a2, o2[1]);
            PG8_WAIT_V(8); PG8_WAIT_L(0); PG8_BAR; PG8_MMA(0, 0, At, B0); PG8_MMA(0, 1, At, B1); PG8_BAR; PG8_SCHED;
            PG8_LDA(At, 1, 1); PG8_STAGE(PG8_SB(1, 0), b3, voffB); PG8_STAGE(PG8_SB(1, 1), b3 + hstep, voffB); PG8_STAGE(PG8_SA(1, 0), a3, o2[0]);
            PG8_WAIT_V(8); PG8_WAIT_L(0); PG8_BAR; PG8_MMA(1, 0, At, B0); PG8_MMA(1, 1, At, B1); PG8_BAR; PG8_SCHED;
        }
        if constexpr (ALIGN_EPI) { if (wr == 0) PG8_BAR; }
        if constexpr (FP8) asm volatile("s_nop 15\n\ts_nop 15" ::: "memory");
        if constexpr (!Epi::AFTER_DRAIN) E(acc, cur, wr, wc, fr, fq);
        if (!has_next) break;
        E.init_acc(acc, nxt, wr, wc, fr, fq);
        cur = nxt; cA = nA; cB = nB; ++ui;
#pragma unroll
        for (int h = 0; h < 2; ++h)
#pragma unroll
            for (int i = 0; i < 2; ++i) offC[h][i] = offN[h][i];
        if constexpr (ALIGN_EPI) { if (wr == 1) PG8_BAR; }
    }
    PG8_WAIT_V(0);
    if constexpr (!ALIGN_EPI) { if (wr == 0) PG8_BAR; }
    PG8_BAR;
    if constexpr (Epi::AFTER_DRAIN) E.fused(acc, cur, wr, wc, fr, fq, lds);
#undef PG8_NEXT
#undef PG8_SA
#undef PG8_SB
#undef PG8_STAGE
#undef PG8_LDA
#undef PG8_LDB
#undef PG8_MMA
#undef PG8_WAIT_V
#undef PG8_WAIT_L
#undef PG8_BAR
#undef PG8_SCHED
}

struct DenseSched {
    const char* A; const char* Bt; int KB; StaticOrder so;
    __device__ __forceinline__ bool next(int i, Unit& u) const { int pm, pn; if (!so.map(i, pm, pn)) return false; u.pm = pm; u.pn = pn; u.e = 0; u.valid = 256; u.rb = pm * 256; u.ui = i; return true; }
    __device__ __forceinline__ const char* a_ptr(const Unit& u) const { return A + (size_t)u.pm * 256 * KB; }
    __device__ __forceinline__ const char* b_ptr(const Unit& u) const { return Bt + (size_t)u.pn * 256 * KB; }
    __device__ __forceinline__ void a_offs(const Unit&, const int (&R)[2], const int (&C)[2], unsigned (&off)[2][2]) const {
#pragma unroll
        for (int h = 0; h < 2; ++h)
#pragma unroll
            for (int i = 0; i < 2; ++i) off[h][i] = (unsigned)((h * 128 + R[i]) * KB + C[i] * 2); }
};
__device__ __forceinline__ void moe_lookup(const LAS int* tab, int vt, Unit& u) {
    int e = 0;
#pragma unroll
    for (int k = 1; k < 8; ++k) e += (vt >= tab[16 + k]) ? 1 : 0;
    e = __builtin_amdgcn_readfirstlane(e);
    const int tpe = __builtin_amdgcn_readfirstlane(tab[16 + e]), ce = __builtin_amdgcn_readfirstlane(tab[e]), be = __builtin_amdgcn_readfirstlane(tab[8 + e]);
    const int li = vt - tpe; u.pm = li; u.e = e; const int rem = ce - 256 * li; u.valid = rem < 256 ? rem : 256; u.rb = be + 256 * li;
}
template <int ES> struct MoeUpSched {
    const char* XA; const char* W; const LAS int* toktab; const LAS int* tab; StaticOrder so;
    __device__ __forceinline__ bool next(int i, Unit& u) const { int vt, pn; if (!so.map(i, vt, pn)) return false; moe_lookup(tab, vt, u); u.pn = pn; u.ui = i; return true; }
    __device__ __forceinline__ const char* a_ptr(const Unit&) const { return XA; }
    __device__ __forceinline__ const char* b_ptr(const Unit& u) const { return W + ((size_t)u.e * NFF2 + (size_t)u.pn * 256) * D * ES; }
    __device__ __forceinline__ void a_offs(const Unit& u, const int (&R)[2], const int (&C)[2], unsigned (&off)[2][2]) const {
#pragma unroll
        for (int h = 0; h < 2; ++h)
#pragma unroll
            for (int i = 0; i < 2; ++i) off[h][i] = (unsigned)toktab[u.ui * 256 + h * 128 + R[i]] * (unsigned)(D * ES) + (unsigned)C[i] * 2u; }
};
template <int ES> struct MoeDownSched {
    const char* ACT; const char* W; const LAS int* tab; StaticOrder so;
    __device__ __forceinline__ bool next(int i, Unit& u) const { int vt, pn; if (!so.map(i, vt, pn)) return false; moe_lookup(tab, vt, u); u.pn = pn; u.ui = i; return true; }
    __device__ __forceinline__ const char* a_ptr(const Unit& u) const { return ACT + (size_t)u.rb * FF * ES; }
    __device__ __forceinline__ const char* b_ptr(const Unit& u) const { return W + ((size_t)u.e * D + (size_t)u.pn * 256) * FF * ES; }
    __device__ __forceinline__ void a_offs(const Unit&, const int (&R)[2], const int (&C)[2], unsigned (&off)[2][2]) const {
#pragma unroll
        for (int h = 0; h < 2; ++h)
#pragma unroll
            for (int i = 0; i < 2; ++i) off[h][i] = (unsigned)((h * 128 + R[i]) * FF * ES + C[i] * 2); }
};

__device__ __forceinline__ void zero_acc(f32x4 (&acc)[2][2][4][2]) {
#pragma unroll
    for (int a = 0; a < 2; ++a)
#pragma unroll
        for (int b = 0; b < 2; ++b)
#pragma unroll
            for (int m = 0; m < 4; ++m)
#pragma unroll
                for (int n = 0; n < 2; ++n) acc[a][b][m][n] = (f32x4){0.f, 0.f, 0.f, 0.f};
}
__device__ __forceinline__ float rstd_of(float p) { p += __shfl_xor(p, 16); p += __shfl_xor(p, 32); return 1.0f / sqrtf(p * (1.0f / D) + EPS); }
struct EpiMix {
    static constexpr bool AFTER_DRAIN = false;
    bf16_t* CG; bf16_t* UA; bf16_t* VA; const LAS float* rstab;
    __device__ __forceinline__ void init_acc(f32x4 (&acc)[2][2][4][2], const Unit&, int, int, int, int) const { zero_acc(acc); }
    __device__ __forceinline__ void operator()(const f32x4 (&acc)[2][2][4][2], const Unit& u, int wr, int wc, int fr, int fq) const {
        const int row0 = u.rb + wr * 64 + fr;
        const WtBuf bcg = wt_buf(CG), bdst = wt_buf(u.pn < 6 ? UA : VA);
        float rsv[2][4];
#pragma unroll
        for (int ai = 0; ai < 2; ++ai)
#pragma unroll
            for (int m = 0; m < 4; ++m) rsv[ai][m] = rstab[u.ui * 256 + ai * HALF + wr * 64 + m * 16 + fr];
#pragma unroll
        for (int ai = 0; ai < 2; ++ai)
#pragma unroll
            for (int m = 0; m < 4; ++m) {
                const int row = row0 + ai * HALF + m * 16; const float rs = rsv[ai][m];
                if (u.pn < 4) {
                    float o[8];
#pragma unroll
                    for (int n = 0; n < 2; ++n)
#pragma unroll
                        for (int j = 0; j < 4; ++j) { const float a = acc[ai][0][m][n][j] * rs, g = acc[ai][1][m][n][j] * rs; o[4 * n + j] = a * fast_sigmoid(g); }
                    u32x4 w; w.x = cvt_pk_bf16(o[0], o[1]); w.y = cvt_pk_bf16(o[2], o[3]); w.z = cvt_pk_bf16(o[4], o[5]); w.w = cvt_pk_bf16(o[6], o[7]);
                    wt_store16(bcg, CG, ((size_t)row * CC + u.pn * 128 + wc * 32 + 8 * fq) * 2, w);
                } else {
                    bf16_t* dbase = (u.pn < 6 ? UA : VA); const size_t doff = ((size_t)row * CC + (u.pn & 1) * 256 + wc * 32 + 8 * fq) * 2;
#pragma unroll
                    for (int bj = 0; bj < 2; ++bj) {
                        const f32x4 v0 = acc[ai][bj][m][0] * rs, v1 = acc[ai][bj][m][1] * rs;
                        const f32x2 a = gelu_pk((f32x2){v0[0], v0[1]}), b = gelu_pk((f32x2){v0[2], v0[3]}), c = gelu_pk((f32x2){v1[0], v1[1]}), d = gelu_pk((f32x2){v1[2], v1[3]});
                        u32x4 w; w.x = cvt_pk_bf16(a.x, a.y); w.y = cvt_pk_bf16(b.x, b.y); w.z = cvt_pk_bf16(c.x, c.y); w.w = cvt_pk_bf16(d.x, d.y);
                        wt_store16(bdst, dbase, doff + bj * HALF * 2, w); }
                }
            }
    }
};
struct EpiRes {
    static constexpr bool AFTER_DRAIN = true;
    const float* XIN; float* XOUT; bf16_t* XB; float* rss_out; unsigned char* XB8; float sc_in, sc_out;
    __device__ __forceinline__ void init_acc(f32x4 (&acc)[2][2][4][2], const Unit& u, int wr, int wc, int fr, int fq) const {
        const int row0 = u.rb + wr * 64 + fr, col0 = u.pn * 256 + wc * 32 + 8 * fq;
#pragma unroll
        for (int ai = 0; ai < 2; ++ai)
#pragma unroll
            for (int m = 0; m < 4; ++m)
#pragma unroll
                for (int bj = 0; bj < 2; ++bj) { const size_t off = (size_t)(row0 + ai * HALF + m * 16) * D + col0 + bj * HALF;
                    acc[ai][bj][m][0] = *(const f32x4*)(XIN + off) * sc_in; acc[ai][bj][m][1] = *(const f32x4*)(XIN + off + 4) * sc_in; }
    }
    __device__ __forceinline__ void fused(const f32x4 (&acc)[2][2][4][2], const Unit& u, int wr, int wc, int fr, int fq, LAS unsigned char* lds) const {
        const int row0 = u.rb + wr * 64 + fr, col0 = u.pn * 256 + wc * 32 + 8 * fq;
        LAS float* P = (LAS float*)lds;
        const WtBuf bxo = wt_buf(XOUT), bxb = wt_buf(XB);
#pragma unroll
        for (int ai = 0; ai < 2; ++ai)
#pragma unroll
            for (int m = 0; m < 4; ++m) {
                const int lr = ai * HALF + wr * 64 + m * 16 + fr, row = u.rb + lr; float ss = 0.f;
#pragma unroll
                for (int bj = 0; bj < 2; ++bj) {
                    const size_t off = (size_t)row * D + col0 + bj * HALF;
                    const f32x4 x0 = acc[ai][bj][m][0] * sc_out, x1 = acc[ai][bj][m][1] * sc_out;
                    wt_store16f(bxo, XOUT, off * 4, x0); wt_store16f(bxo, XOUT, off * 4 + 16, x1);
                    u32x4 w; w.x = cvt_pk_bf16(x0[0], x0[1]); w.y = cvt_pk_bf16(x0[2], x0[3]); w.z = cvt_pk_bf16(x1[0], x1[1]); w.w = cvt_pk_bf16(x1[2], x1[3]);
                    wt_store16(bxb, XB, off * 2, w);
                    if (XB8) { u32x2 q; q.x = pk_fp8x4(x0[0], x0[1], x0[2], x0[3]); q.y = pk_fp8x4(x1[0], x1[1], x1[2], x1[3]); *(u32x2*)(XB8 + off) = q; }
                    ss += (x0[0] * x0[0] + x0[1] * x0[1]) + (x0[2] * x0[2] + x0[3] * x0[3]) + (x1[0] * x1[0] + x1[1] * x1[1]) + (x1[2] * x1[2] + x1[3] * x1[3]); }
                ss += __shfl_xor(ss, 16); ss += __shfl_xor(ss, 32);
                if (fq == 0) P[lr * 4 + wc] = ss;
            }
        (void)row0;
        __syncthreads();
        if (threadIdx.x < 256) { const f32x4 p = *(const LAS f32x4*)(P + threadIdx.x * 4); rss_out[(size_t)(u.rb + threadIdx.x) * 4 + u.pn] = (p.x + p.y) + (p.z + p.w); }
        __syncthreads();
    }
};
template <bool MOE, bool F8> struct EpiSwiglu {
    static constexpr bool AFTER_DRAIN = false;
    void* ACT; const LAS float* rstab; float post;
    __device__ __forceinline__ void init_acc(f32x4 (&acc)[2][2][4][2], const Unit&, int, int, int, int) const { zero_acc(acc); }
    __device__ __forceinline__ void operator()(const f32x4 (&acc)[2][2][4][2], const Unit& u, int wr, int wc, int fr, int fq) const {
        const int col = u.pn * 128 + wc * 32 + 8 * fq;
        const WtBuf bact = wt_buf(ACT);
        float rsv[2][4];
#pragma unroll
        for (int ai = 0; ai < 2; ++ai)
#pragma unroll
            for (int m = 0; m < 4; ++m) rsv[ai][m] = rstab[u.ui * 256 + ai * HALF + wr * 64 + m * 16 + fr];
#pragma unroll
        for (int ai = 0; ai < 2; ++ai)
#pragma unroll
            for (int m = 0; m < 4; ++m) {
                const int lr = ai * HALF + wr * 64 + m * 16 + fr;
                const float rs = rsv[ai][m];
                float o[8];
#pragma unroll
                for (int n = 0; n < 2; ++n)
#pragma unroll
                    for (int j = 0; j < 4; ++j) { const float g = acc[ai][0][m][n][j] * rs, up = acc[ai][1][m][n][j] * rs; o[4 * n + j] = g * fast_sigmoid(g) * up; }
                if constexpr (F8) {
                    u32x2 q; q.x = pk_fp8x4(o[0] * post, o[1] * post, o[2] * post, o[3] * post); q.y = pk_fp8x4(o[4] * post, o[5] * post, o[6] * post, o[7] * post);
                    if (!MOE || lr < u.valid) *(u32x2*)((unsigned char*)ACT + (size_t)(u.rb + lr) * FF + col) = q;
                } else {
                    u32x4 w; w.x = cvt_pk_bf16(o[0], o[1]); w.y = cvt_pk_bf16(o[2], o[3]); w.z = cvt_pk_bf16(o[4], o[5]); w.w = cvt_pk_bf16(o[6], o[7]);
                    if (!MOE || lr < u.valid) wt_store16(bact, ACT, ((size_t)(u.rb + lr) * FF + col) * 2, w);
                }
            }
    }
};
struct EpiSlot {
    static constexpr bool AFTER_DRAIN = false;
    bf16_t* YS; float sc;
    __device__ __forceinline__ void init_acc(f32x4 (&acc)[2][2][4][2], const Unit&, int, int, int, int) const { zero_acc(acc); }
    __device__ __forceinline__ void operator()(const f32x4 (&acc)[2][2][4][2], const Unit& u, int wr, int wc, int fr, int fq) const {
        const int col0 = u.pn * 256 + wc * 32 + 8 * fq;
        const WtBuf bys = wt_buf(YS);
#pragma unroll
        for (int ai = 0; ai < 2; ++ai)
#pragma unroll
            for (int m = 0; m < 4; ++m) {
                const int lr = ai * HALF + wr * 64 + m * 16 + fr;
                if (lr < u.valid) {
#pragma unroll
                    for (int bj = 0; bj < 2; ++bj) {
                        const f32x4 x0 = acc[ai][bj][m][0] * sc, x1 = acc[ai][bj][m][1] * sc;
                        u32x4 w; w.x = cvt_pk_bf16(x0[0], x0[1]); w.y = cvt_pk_bf16(x0[2], x0[3]); w.z = cvt_pk_bf16(x1[0], x1[1]); w.w = cvt_pk_bf16(x1[2], x1[3]);
                        wt_store16(bys, YS, ((size_t)(u.rb + lr) * D + col0 + bj * HALF) * 2, w); }
                }
            }
    }
};
struct EpiNull {
    static constexpr bool AFTER_DRAIN = false;
    float* sink;
    __device__ __forceinline__ void init_acc(f32x4 (&acc)[2][2][4][2], const Unit&, int, int, int, int) const { zero_acc(acc); }
    __device__ __forceinline__ void operator()(const f32x4 (&acc)[2][2][4][2], const Unit& u, int wr, int wc, int fr, int fq) const {
        f32x4 s = (f32x4){0.f, 0.f, 0.f, 0.f};
#pragma unroll
        for (int a = 0; a < 2; ++a)
#pragma unroll
            for (int b = 0; b < 2; ++b)
#pragma unroll
                for (int m = 0; m < 4; ++m)
#pragma unroll
                    for (int n = 0; n < 2; ++n) s += acc[a][b][m][n];
        const float t = (s.x + s.y) + (s.z + s.w);
        if (t == 1.2345678e30f) sink[threadIdx.x] = t;
    }
};
}

struct Args { const float* in[21]; float* out; unsigned char* ws; int ph_lo, ph_hi; };
enum { I_X = 0, I_NMIX, I_WIN, I_CONVW, I_CONVB, I_CONVNG, I_CONVNB, I_SGUNG, I_SGUNB, I_SGUW, I_SGUB, I_WOUT, I_NFFN, I_FWG, I_FWU, I_FWD, I_ROUTER, I_MWG, I_MWU, I_MWD, I_NFINAL };

struct P0Item { const float* W; const float* gain; void* dst; int N, K, c0, k0, f8; };
__device__ __forceinline__ void p0_load(const P0Item& p, int lane, float (&v)[32]) {
    const float* s = p.W + (size_t)(p.k0 + (lane >> 5)) * p.N + p.c0 + (lane & 31);
#pragma unroll
    for (int i = 0; i < 32; ++i) v[i] = s[(size_t)(2 * i) * p.N];
}
__device__ __forceinline__ void p0_finish(const P0Item& p, const float (&v)[32], LAS float* scr, int lane) {
#pragma unroll
    for (int i = 0; i < 32; ++i) scr[(2 * i + (lane >> 5)) * 33 + (lane & 31)] = v[i];
    if (!p.f8) {
        const int c = lane & 7;
        f32x4 g0 = (f32x4){1.f, 1.f, 1.f, 1.f}, g1 = g0;
        if (p.gain) { g0 = *(const f32x4*)(p.gain + p.k0 + 8 * c); g1 = *(const f32x4*)(p.gain + p.k0 + 8 * c + 4); }
        asm volatile("s_waitcnt lgkmcnt(0)" ::: "memory");
        const WtBuf bd = wt_buf(p.dst);
#pragma unroll
        for (int j = 0; j < 4; ++j) { const int rho = (lane >> 3) + 8 * j; const LAS float* s = scr + (8 * c) * 33 + pg8::perm32(rho);
            u32x4 o; o.x = cvt_pk_bf16(s[0 * 33] * g0.x, s[1 * 33] * g0.y); o.y = cvt_pk_bf16(s[2 * 33] * g0.z, s[3 * 33] * g0.w); o.z = cvt_pk_bf16(s[4 * 33] * g1.x, s[5 * 33] * g1.y); o.w = cvt_pk_bf16(s[6 * 33] * g1.z, s[7 * 33] * g1.w);
            wt_store16(bd, p.dst, ((size_t)rho * p.K + p.k0 + 8 * c) * 2, o); }
    } else {
        const int c4 = lane & 3;
        f32x4 g[4];
#pragma unroll
        for (int q = 0; q < 4; ++q) { g[q] = (f32x4){MOE_SW, MOE_SW, MOE_SW, MOE_SW}; if (p.gain) g[q] = *(const f32x4*)(p.gain + p.k0 + 16 * c4 + 4 * q) * MOE_SW; }
        asm volatile("s_waitcnt lgkmcnt(0)" ::: "memory");
#pragma unroll
        for (int j = 0; j < 2; ++j) { const int rho = (lane >> 2) + 16 * j; const LAS float* s = scr + (16 * c4) * 33 + pg8::perm32(rho);
            u32x4 o;
            o.x = pk_fp8x4(s[0 * 33] * g[0].x, s[1 * 33] * g[0].y, s[2 * 33] * g[0].z, s[3 * 33] * g[0].w);
            o.y = pk_fp8x4(s[4 * 33] * g[1].x, s[5 * 33] * g[1].y, s[6 * 33] * g[1].z, s[7 * 33] * g[1].w);
            o.z = pk_fp8x4(s[8 * 33] * g[2].x, s[9 * 33] * g[2].y, s[10 * 33] * g[2].z, s[11 * 33] * g[2].w);
            o.w = pk_fp8x4(s[12 * 33] * g[3].x, s[13 * 33] * g[3].y, s[14 * 33] * g[3].z, s[15 * 33] * g[3].w);
            *(u32x4*)((unsigned char*)p.dst + (size_t)rho * p.K + p.k0 + 16 * c4) = o; }
    }
    asm volatile("s_waitcnt lgkmcnt(0)" ::: "memory");
}
constexpr int IT_WIN = 16 * 64, IT_WOUT = 16 * 32, IT_GU = 16 * 176, IT_DN = 44 * 32;
constexpr int P0_NITEMS = 2 * IT_WIN + 2 * IT_WOUT + IT_GU + IT_DN + NE * IT_GU + NE * IT_DN;
__device__ __forceinline__ bool p0_decode(const Args& args, int it, P0Item& p) {
    if (it >= P0_NITEMS) return false;
    unsigned char* ws = args.ws; int r = it;
    if (r < 2 * IT_WIN) { const int l = r / IT_WIN; r -= l * IT_WIN; const int kb = r / 64, g32 = r % 64, Lb = 32 * g32;
        p.c0 = Lb < 1024 ? ((Lb >> 7) & 1) * 512 + (Lb >> 8) * 128 + (Lb & 127) : Lb;
        p.W = args.in[I_WIN] + (size_t)l * D * DIN; p.N = DIN; p.K = D; p.gain = args.in[I_NMIX] + l * D; p.dst = (bf16_t*)(ws + WS_WIN) + ((size_t)l * DIN + Lb) * D; p.k0 = 64 * kb; p.f8 = 0; return true; }
    r -= 2 * IT_WIN;
    if (r < 2 * IT_WOUT) { const int l = r / IT_WOUT; r -= l * IT_WOUT; const int kb = r / 32, g32 = r % 32, Lb = 32 * g32;
        p.c0 = Lb; p.W = args.in[I_WOUT] + (size_t)l * D * D; p.N = D; p.K = D; p.gain = nullptr; p.dst = (bf16_t*)(ws + WS_WOUT) + ((size_t)l * D + Lb) * D; p.k0 = 64 * kb; p.f8 = 0; return true; }
    r -= 2 * IT_WOUT;
    if (r < IT_GU) { const int kb = r / 176, g32 = r % 176, Lb = 32 * g32; const int kind = (Lb >> 7) & 1;
        p.c0 = (Lb >> 8) * 128 + (Lb & 127); p.W = args.in[kind ? I_FWU : I_FWG]; p.N = FF; p.K = D; p.gain = args.in[I_NFFN]; p.dst = (unsigned char*)(ws + WS_FGU) + (size_t)Lb * D * (DENSE_FP8 ? 1 : 2); p.k0 = 64 * kb; p.f8 = DENSE_FP8; return true; }
    r -= IT_GU;
    if (r < IT_DN) { const int kb = r / 32, g32 = r % 32, Lb = 32 * g32;
        p.c0 = Lb; p.W = args.in[I_FWD]; p.N = D; p.K = FF; p.gain = nullptr; p.dst = (unsigned char*)(ws + WS_FD) + (size_t)Lb * FF * (DENSE_FP8 ? 1 : 2); p.k0 = 64 * kb; p.f8 = DENSE_FP8; return true; }
    r -= IT_DN;
    if (r < NE * IT_GU) { const int e = r / IT_GU; r -= e * IT_GU; const int kb = r / 176, g32 = r % 176, Lb = 32 * g32; const int kind = (Lb >> 7) & 1;
        p.c0 = (Lb >> 8) * 128 + (Lb & 127); p.W = args.in[kind ? I_MWU : I_MWG] + (size_t)e * D * FF; p.N = FF; p.K = D; p.gain = args.in[I_NFFN] + D; p.dst = (unsigned char*)(ws + WS_MGU) + ((size_t)e * NFF2 + Lb) * D; p.k0 = 64 * kb; p.f8 = 1; return true; }
    r -= NE * IT_GU;
    { const int e = r / IT_DN; r -= e * IT_DN; const int kb = r / 32, g32 = r % 32, Lb = 32 * g32;
        p.c0 = Lb; p.W = args.in[I_MWD] + (size_t)e * FF * D; p.N = D; p.K = FF; p.gain = nullptr; p.dst = (unsigned char*)(ws + WS_MD) + ((size_t)e * D + Lb) * FF; p.k0 = 64 * kb; p.f8 = 1; return true; }
}
__device__ __forceinline__ void prologue_phase(const Args& args, LAS unsigned char* lds, int gw, int NGW, int lane) {
    unsigned char* ws = args.ws;
    LAS float* scr = (LAS float*)(lds + (threadIdx.x >> 6) * 16384);
    {
        P0Item pa, pb; float va[32], vb[32]; int it = gw;
        bool ha = p0_decode(args, it, pa); if (ha) p0_load(pa, lane, va);
        while (ha) {
            it += NGW; const bool hb = p0_decode(args, it, pb); if (hb) p0_load(pb, lane, vb);
            p0_finish(pa, va, scr, lane);
            if (!hb) break;
            it += NGW; ha = p0_decode(args, it, pa); if (ha) p0_load(pa, lane, va);
            p0_finish(pb, vb, scr, lane);
        }
    }
    { const float* x = args.in[I_X]; bf16_t* XB = (bf16_t*)(ws + WS_XB); float* rss = (float*)(ws + WS_RSS);
      for (int m = gw; m < T; m += NGW) {
          const f32x4* xr = (const f32x4*)(x + (size_t)m * D) + lane; f32x4 v[4]; float s = 0.f;
#pragma unroll
          for (int j = 0; j < 4; ++j) { v[j] = xr[64 * j]; s += (v[j].x * v[j].x + v[j].y * v[j].y) + (v[j].z * v[j].z + v[j].w * v[j].w); }
          s = wave_sum(s);
          u32x2* o8 = (u32x2*)(XB + (size_t)m * D) + lane;
#pragma unroll
          for (int j = 0; j < 4; ++j) { u32x2 w; w.x = cvt_pk_bf16(v[j].x, v[j].y); w.y = cvt_pk_bf16(v[j].z, v[j].w); o8[64 * j] = w; }
          if (lane < 4) rss[(size_t)m * 4 + lane] = lane == 0 ? s : 0.f; } }
    { float* RT = (float*)(ws + WS_RT); const float* rt = args.in[I_ROUTER]; const float* g = args.in[I_NFFN] + D;
      for (int i = gw * 64 + lane; i < NE * D; i += NGW * 64) { const int e = i / D, k = i % D; RT[i] = rt[k * NE + e] * g[k]; } }
    { bf16_t* SW = (bf16_t*)(ws + WS_SGUW); const float* sw = args.in[I_SGUW];
      for (int i = gw * 64 + lane; i < 2 * 4 * 128 * 128 / 2; i += NGW * 64) { const int e0 = 2 * i, tt = (e0 >> 7) & 127, s0 = e0 & 127;
          const float a = s0 <= tt ? sw[e0] : 0.f, b = (s0 + 1) <= tt ? sw[e0 + 1] : 0.f; ((unsigned*)SW)[i] = cvt_pk_bf16(a, b); } }
}

__device__ __forceinline__ void mid_phase(const Args& args, LAS unsigned char* lds, int l, int gw, int NGW, int lane, int wave) {
    unsigned char* ws = args.ws;
    const bf16_t* CG = (const bf16_t*)(ws + WS_CG); const bf16_t* UA = (const bf16_t*)(ws + WS_UA); const bf16_t* VA = (const bf16_t*)(ws + WS_VA); bf16_t* Y = (bf16_t*)(ws + WS_Y);
    const int fr = lane & 15, fq = lane >> 4;
    {
        constexpr int VST = 264;
        const bf16_t* Wb = (const bf16_t*)(ws + WS_SGUW) + (size_t)l * 4 * 128 * 128;
        const float* ng = args.in[I_SGUNG] + l * CC; const float* nb = args.in[I_SGUNB] + l * CC; const float* sb = args.in[I_SGUB] + l * 4 * 128;
        for (int unit = blockIdx.x; unit < NB * 16 * 4; unit += gridDim.x) {
            const int b = unit >> 6, n = (unit >> 2) & 15, h = unit & 3; const int R0 = b * SEQ + n * 128;
            const f32x2 gg = *(const f32x2*)(ng + h * 128 + 2 * lane), bb = *(const f32x2*)(nb + h * 128 + 2 * lane);
            unsigned pv[16];
#pragma unroll
            for (int rr = 0; rr < 16; ++rr) pv[rr] = *(const unsigned*)(VA + (size_t)(R0 + wave * 16 + rr) * CC + h * 128 + 2 * lane);
            const int nks = ((16 * wave + 15) >> 5) + 1;
            bf16x8 bfrag[4];
#pragma unroll
            for (int ks = 0; ks < 4; ++ks) if (ks < nks) bfrag[ks] = *(const bf16x8*)(Wb + (size_t)h * 16384 + (16 * wave + fr) * 128 + 32 * ks + 8 * fq);
            float s1[16], s2[16];
#pragma unroll
            for (int rr = 0; rr < 16; ++rr) { const float v0 = bf_lo(pv[rr]), v1 = bf_hi(pv[rr]); s1[rr] = v0 + v1; s2[rr] = v0 * v0 + v1 * v1; }
#pragma unroll
            for (int rr = 0; rr < 16; ++rr) { s1[rr] = row16_allsum(s1[rr]); s2[rr] = row16_allsum(s2[rr]); }
#pragma unroll
            for (int rr = 0; rr < 16; ++rr) { s1[rr] += __shfl_xor(s1[rr], 16); s2[rr] += __shfl_xor(s2[rr], 16); }
#pragma unroll
            for (int rr = 0; rr < 16; ++rr) { s1[rr] += __shfl_xor(s1[rr], 32); s2[rr] += __shfl_xor(s2[rr], 32); }
#pragma unroll
            for (int rp = 0; rp < 8; ++rp) {
                float y[2][2];
#pragma unroll
                for (int q = 0; q < 2; ++q) { const int rr = 2 * rp + q; const float mean = s1[rr] * (1.0f / 128.0f); const float var = fmaxf(s2[rr] * (1.0f / 128.0f) - mean * mean, 0.f);
                    const float rstd = 1.0f / sqrtf(var + EPS); y[q][0] = (bf_lo(pv[rr]) - mean) * rstd * gg.x + bb.x; y[q][1] = (bf_hi(pv[rr]) - mean) * rstd * gg.y + bb.y; }
                const int s = wave * 16 + 2 * rp;
                *(LAS unsigned*)(lds + (2 * lane) * VST + s * 2) = cvt_pk_bf16(y[0][0], y[1][0]);
                *(LAS unsigned*)(lds + (2 * lane + 1) * VST + s * 2) = cvt_pk_bf16(y[0][1], y[1][1]);
            }
            const int t = 16 * wave + fr; const size_t row = (size_t)(R0 + t);
            u32x2 uu[8];
#pragma unroll
            for (int db = 0; db < 8; ++db) uu[db] = *(const u32x2*)(UA + row * CC + h * 128 + 16 * db + 4 * fq);
            const float bias = sb[h * 128 + t];
            __syncthreads();
            f32x4 acc[8];
#pragma unroll
            for (int db = 0; db < 8; ++db) acc[db] = (f32x4){0.f, 0.f, 0.f, 0.f};
#pragma unroll
            for (int ks = 0; ks < 4; ++ks) if (ks < nks) {
#pragma unroll
                for (int db = 0; db < 8; ++db) {
                    const LAS unsigned char* ap = lds + (16 * db + fr) * VST + (32 * ks + 8 * fq) * 2;
                    union { bf16x8 v; u32x2 h[2]; } af; af.h[0] = *(const LAS u32x2*)ap; af.h[1] = *(const LAS u32x2*)(ap + 8);
                    acc[db] = __builtin_amdgcn_mfma_f32_16x16x32_bf16(af.v, bfrag[ks], acc[db], 0, 0, 0);
                }
            }
#pragma unroll
            for (int db = 0; db < 8; ++db) { const int d = 16 * db + 4 * fq;
                const float o0 = bf_lo(uu[db].x) * (acc[db][0] + bias), o1 = bf_hi(uu[db].x) * (acc[db][1] + bias), o2 = bf_lo(uu[db].y) * (acc[db][2] + bias), o3 = bf_hi(uu[db].y) * (acc[db][3] + bias);
                u32x2 w; w.x = cvt_pk_bf16(o0, o1); w.y = cvt_pk_bf16(o2, o3);
                *(u32x2*)(Y + row * D + CC + h * 128 + d) = w; }
            __syncthreads();
        }
    }
    {
        const int cg = gw & 3, ch = cg * 128 + 2 * lane;
        const float* cwp = args.in[I_CONVW] + (size_t)l * CW * CC + ch;
        const f32x2 cb = *(const f32x2*)(args.in[I_CONVB] + l * CC + ch), ng = *(const f32x2*)(args.in[I_CONVNG] + l * CC + ch), nb = *(const f32x2*)(args.in[I_CONVNB] + l * CC + ch);
        for (int item = gw >> 2; item < NB * (SEQ / 16); item += NGW >> 2) {
            const int b = item >> 7, t0 = (item & 127) * 16; const size_t rowb = (size_t)b * SEQ;
            unsigned in[46];
#pragma unroll
            for (int i = 0; i < 46; ++i) { const int t = t0 - 30 + i; in[i] = t >= 0 ? *(const unsigned*)(CG + (rowb + t) * CC + ch) : 0u; }
            float a0[16], a1[16];
#pragma unroll
            for (int tt = 0; tt < 16; ++tt) { a0[tt] = cb.x; a1[tt] = cb.y; }
#pragma unroll
            for (int j = 0; j < CW; ++j) {
                const f32x2 w = *(const f32x2*)(cwp + j * CC);
#pragma unroll
                for (int tt = 0; tt < 16; ++tt) { a0[tt] += w.x * bf_lo(in[tt + j]); a1[tt] += w.y * bf_hi(in[tt + j]); }
            }
            float s1[16], s2[16];
#pragma unroll
            for (int tt = 0; tt < 16; ++tt) { s1[tt] = row16_allsum(a0[tt] + a1[tt]); s2[tt] = row16_allsum(a0[tt] * a0[tt] + a1[tt] * a1[tt]); }
#pragma unroll
            for (int tt = 0; tt < 16; ++tt) { s1[tt] += __shfl_xor(s1[tt], 16); s2[tt] += __shfl_xor(s2[tt], 16); }
#pragma unroll
            for (int tt = 0; tt < 16; ++tt) {
                const float mean = s1[tt] * (1.0f / 64.0f); const float var = fmaxf(s2[tt] * (1.0f / 64.0f) - mean * mean, 0.f);
                const float rstd = 1.0f / sqrtf(var + EPS);
                const float y0 = (a0[tt] - mean) * rstd * ng.x + nb.x, y1 = (a1[tt] - mean) * rstd * ng.y + nb.y;
                *(unsigned*)(Y + (rowb + t0 + tt) * D + ch) = cvt_pk_bf16(y0 * fast_sigmoid(y0), y1 * fast_sigmoid(y1));
            }
        }
    }
}

__device__ __forceinline__ void router_phase(const Args& args, LAS unsigned char* lds, int lane, int wave) {
    unsigned char* ws = args.ws;
    const bf16_t* XB = (const bf16_t*)(ws + WS_XB); const float* RT = (const float*)(ws + WS_RT); const float* rss = (const float*)(ws + WS_RSS) + (size_t)3 * T * 4;
    int* toklist = (int*)(ws + WS_TOKLIST); u32x4* tokinfo = (u32x4*)(ws + WS_TOKINFO); unsigned* cntw = (unsigned*)(ws + WS_CTL) + CW_CNT;
    LAS int* wcnt = (LAS int*)lds;
    LAS int* wbase = (LAS int*)(lds + 256);
    f32x4 rw[NE][2][2];
#pragma unroll
    for (int e = 0; e < NE; ++e)
#pragma unroll
        for (int i = 0; i < 2; ++i) { rw[e][i][0] = *(const f32x4*)(RT + e * D + 512 * i + 8 * lane); rw[e][i][1] = *(const f32x4*)(RT + e * D + 512 * i + 8 * lane + 4); }
    for (int blk = blockIdx.x; blk < T / 64; blk += gridDim.x) {
        int my_e0 = 0, my_e1 = 0; float my_g0 = 0.f, my_g1 = 0.f;
        const int tbase = blk * 64 + wave * 8;
        for (int j = 0; j < 8; ++j) {
            const int t = tbase + j;
            float a[NE];
#pragma unroll
            for (int e = 0; e < NE; ++e) a[e] = 0.f;
#pragma unroll
            for (int i = 0; i < 2; ++i) {
                const u32x4 xv = *(const u32x4*)(XB + (size_t)t * D + 512 * i + 8 * lane);
                const float x0 = bf_lo(xv.x), x1 = bf_hi(xv.x), x2 = bf_lo(xv.y), x3 = bf_hi(xv.y), x4 = bf_lo(xv.z), x5 = bf_hi(xv.z), x6 = bf_lo(xv.w), x7 = bf_hi(xv.w);
#pragma unroll
                for (int e = 0; e < NE; ++e) { const f32x4 wa = rw[e][i][0], wb = rw[e][i][1];
                    a[e] += (x0 * wa.x + x1 * wa.y) + (x2 * wa.z + x3 * wa.w) + (x4 * wb.x + x5 * wb.y) + (x6 * wb.z + x7 * wb.w); }
            }
            float p = lane < 4 ? rss[(size_t)t * 4 + lane] : 0.f;
            p = wave_sum(p);
            const float rstd = 1.0f / sqrtf(p * (1.0f / D) + EPS);
#pragma unroll
            for (int e = 0; e < NE; ++e) a[e] = wave_sum(a[e]) * rstd;
            int e0 = 0; float l0 = a[0];
#pragma unroll
            for (int e = 1; e < NE; ++e) if (a[e] > l0) { l0 = a[e]; e0 = e; }
            int e1 = -1; float l1 = -3.0e38f;
#pragma unroll
            for (int e = 0; e < NE; ++e) if (e != e0 && a[e] > l1) { l1 = a[e]; e1 = e; }
            const float g0 = 1.0f / (1.0f + __expf(l1 - l0)), g1 = 1.0f - g0;
            if (lane == j) { my_e0 = e0; my_e1 = e1; my_g0 = g0; my_g1 = g1; }
        }
        const bool act = lane < 8;
        unsigned long long m0[NE], m1[NE];
#pragma unroll
        for (int e = 0; e < NE; ++e) { m0[e] = __ballot(act && my_e0 == e); m1[e] = __ballot(act && my_e1 == e); }
        if (lane < NE) { int c = 0;
#pragma unroll
            for (int e = 0; e < NE; ++e) if (lane == e) c = __popcll(m0[e]) + __popcll(m1[e]);
            wcnt[wave * 8 + lane] = c; }
        __syncthreads();
        if (threadIdx.x < NE) { const int e = threadIdx.x; int tot = 0; int pre[8];
#pragma unroll
            for (int w = 0; w < 8; ++w) { pre[w] = tot; tot += wcnt[w * 8 + e]; }
            const int base = (int)__hip_atomic_fetch_add(cntw + 64 * e, (unsigned)tot, RLX_AGENT);
#pragma unroll
            for (int w = 0; w < 8; ++w) wbase[w * 8 + e] = base + pre[w]; }
        __syncthreads();
        if (act) {
            const unsigned long long lt = (1ull << lane) - 1ull;
            int pos0 = 0, pos1 = 0;
#pragma unroll
            for (int e = 0; e < NE; ++e) { const int wb = wbase[wave * 8 + e];
                if (my_e0 == e) pos0 = wb + __popcll(m0[e] & lt);
                if (my_e1 == e) pos1 = wb + __popcll(m0[e]) + __popcll(m1[e] & lt); }
            const int t = tbase + lane;
            toklist[my_e0 * T + pos0] = t; toklist[my_e1 * T + pos1] = t;
            u32x4 inf; inf.x = ((unsigned)my_e0 << 16) | (unsigned)pos0; inf.y = ((unsigned)my_e1 << 16) | (unsigned)pos1; inf.z = __float_as_uint(my_g0); inf.w = __float_as_uint(my_g1);
            tokinfo[t] = inf;
        }
        __syncthreads();
    }
}
__device__ __forceinline__ void moe_tab_build(const unsigned char* ws, LAS int* tab) {
    if (threadIdx.x == 0) {
        unsigned* cntw = (unsigned*)(ws + WS_CTL) + CW_CNT; int b = 0, p = 0;
        for (int e = 0; e < NE; ++e) { const int c = (int)__hip_atomic_load(cntw + 64 * e, RLX_AGENT); tab[e] = c; tab[8 + e] = b; tab[16 + e] = p; b += c; p += (c + 255) >> 8; }
        tab[24] = p;
    }
    __syncthreads();
}

__device__ __forceinline__ void final_phase(const Args& args, const LAS int* tab, int gw, int NGW, int lane) {
    unsigned char* ws = args.ws; float* out = args.out; const bf16_t* YS = (const bf16_t*)(ws + WS_YS); const u32x4* tokinfo = (const u32x4*)(ws + WS_TOKINFO);
    f32x4 gn[4];
#pragma unroll
    for (int j = 0; j < 4; ++j) gn[j] = *((const f32x4*)args.in[I_NFINAL] + lane + 64 * j);
    for (int t = gw; t < T; t += NGW) {
        const u32x4 inf = tokinfo[t];
        const int e0 = __builtin_amdgcn_readfirstlane((int)(inf.x >> 16)), p0 = __builtin_amdgcn_readfirstlane((int)(inf.x & 0xffffu)), e1 = __builtin_amdgcn_readfirstlane((int)(inf.y >> 16)), p1 = __builtin_amdgcn_readfirstlane((int)(inf.y & 0xffffu));
        const float g0 = __uint_as_float(inf.z), g1 = __uint_as_float(inf.w);
        const int b0 = __builtin_amdgcn_readfirstlane(tab[8 + e0]), b1 = __builtin_amdgcn_readfirstlane(tab[8 + e1]);
        const size_t s0 = (size_t)(b0 + p0), s1 = (size_t)(b1 + p1);
        f32x4* xr = (f32x4*)(out + (size_t)t * D) + lane; const u32x2* y0 = (const u32x2*)(YS + s0 * D) + lane; const u32x2* y1 = (const u32x2*)(YS + s1 * D) + lane;
        f32x4 v[4]; float ss = 0.f;
#pragma unroll
        for (int j = 0; j < 4; ++j) { const f32x4 x = xr[64 * j]; const u32x2 a = y0[64 * j], b = y1[64 * j];
            v[j].x = x.x + g0 * bf_lo(a.x) + g1 * bf_lo(b.x); v[j].y = x.y + g0 * bf_hi(a.x) + g1 * bf_hi(b.x); v[j].z = x.z + g0 * bf_lo(a.y) + g1 * bf_lo(b.y); v[j].w = x.w + g0 * bf_hi(a.y) + g1 * bf_hi(b.y);
            ss += (v[j].x * v[j].x + v[j].y * v[j].y) + (v[j].z * v[j].z + v[j].w * v[j].w); }
        const float rstd = 1.0f / sqrtf(wave_sum(ss) * (1.0f / D) + EPS);
#pragma unroll
        for (int j = 0; j < 4; ++j) xr[64 * j] = v[j] * rstd * gn[j];
    }
}

template <bool MOE, class Sched>
__device__ __forceinline__ void fill_unit_tables(const Sched& S, const float* rss, const int* toklist, float pre, LAS unsigned char* lds) {
    LAS int* tt = (LAS int*)(lds + TOKTAB_OFF); LAS float* rt = (LAS float*)(lds + RSTAB_OFF);
    const int lr = threadIdx.x & 255, par = threadIdx.x >> 8;
    int srow[MAXU / 2]; bool have[MAXU / 2];
#pragma unroll
    for (int k = 0; k < MAXU / 2; ++k) { pg8::Unit u; have[k] = S.next(2 * k + par, u); srow[k] = 0;
        if (have[k]) { if (MOE) { if (lr < u.valid) srow[k] = toklist[u.e * T + u.pm * 256 + lr]; } else srow[k] = u.rb + lr; } }
    f32x4 p[MAXU / 2];
#pragma unroll
    for (int k = 0; k < MAXU / 2; ++k) p[k] = have[k] ? *(const f32x4*)(rss + (size_t)srow[k] * 4) : (f32x4){0.f, 0.f, 0.f, 0.f};
#pragma unroll
    for (int k = 0; k < MAXU / 2; ++k) if (have[k]) { const int i = 2 * k + par; if (MOE) tt[i * 256 + lr] = srow[k];
        rt[i * 256 + lr] = pre / sqrtf(((p[k].x + p[k].y) + (p[k].z + p[k].w)) * (1.0f / D) + EPS); }
    __syncthreads();
}

__global__ void __launch_bounds__(NWAVES * 64, 2) mega_fwd(Args args) {
    extern __shared__ __attribute__((aligned(16))) unsigned char lds_raw[];
    LAS unsigned char* lds = (LAS unsigned char*)lds_raw;
    const int tid = threadIdx.x, lane = tid & 63, wave = __builtin_amdgcn_readfirstlane(tid >> 6);
    const int G = gridDim.x, bx = blockIdx.x;
    const int vcu = (G % 8 == 0) ? (bx % 8) * (G / 8) + bx / 8 : bx;
    const int gw = vcu * NWAVES + wave, NGW = G * NWAVES;
    unsigned char* ws = args.ws;
    unsigned* ctl = (unsigned*)(ws + WS_CTL);
    for (int u = tid; u < 512 / 4; u += NWAVES * 64) ((LAS unsigned*)(lds + LDSCTL_OFF))[u] = 0u;
    __syncthreads();
    XcdBarrier bar; bar.bar = ctl + CW_BAR; bar.x = 0; bar.st = nullptr;
    if (MK_N_LAUNCHES == 1) bar = xcd_barrier_post(ctl + CW_BAR, (volatile LAS unsigned*)(lds + LDSCTL_OFF) + 8);
    const int lo = args.ph_lo, hi = args.ph_hi;
#ifndef PHMASK
#define PHMASK 0xFFFF
#endif
#define IN(k) ((((PHMASK) >> (k)) & 1) && lo <= (k) && (k) < hi)
#ifndef DUP_PHASE
#define DUP_PHASE -1
#endif
#define REP(k) for (int rep_ = 0; rep_ < ((DUP_PHASE) == (k) ? 2 : 1); ++rep_)
#define SEAM(k) do { if (MK_N_LAUNCHES == 1 && IN((k) + 1)) xcd_barrier(bar); } while (0)
    float* rss = (float*)(ws + WS_RSS);
    bf16_t* XB = (bf16_t*)(ws + WS_XB);

    if (IN(0)) { REP(0) prologue_phase(args, lds, gw, NGW, lane); SEAM(0); }

#ifndef MOE_FP8
#define MOE_FP8 1
#endif
    constexpr bool MF8 = (MOE_FP8 != 0); constexpr int MES = MF8 ? 1 : 2; constexpr bool DF8 = (DENSE_FP8 != 0); constexpr int DES = DF8 ? 1 : 2;
#define LAYER_MIX(l, pb) \
    if (IN(pb)) {       \
        pg8::DenseSched S; S.A = (const char*)XB; S.Bt = (const char*)(ws + WS_WIN) + (size_t)(l) * DIN * D * 2; S.KB = D * 2; S.so.init(T / 256, DIN / 256, G, bx); \
        fill_unit_tables<false>(S, rss + (size_t)(2 * (l)) * T * 4, nullptr, 1.0f, lds); \
        pg8::EpiMix E{(bf16_t*)(ws + WS_CG), (bf16_t*)(ws + WS_UA), (bf16_t*)(ws + WS_VA), (const LAS float*)(lds + RSTAB_OFF)}; \
        REP(pb) pg8::gemm_phase<pg8::EpiMix, pg8::DenseSched, true, false>(lds, D * 2, S, E); \
        SEAM(pb); \
    } \
    if (IN((pb) + 1)) { REP((pb) + 1) mid_phase(args, lds, (l), gw, NGW, lane, wave); SEAM((pb) + 1); } \
    if (IN((pb) + 2)) {       \
        pg8::DenseSched S; S.A = (const char*)(ws + WS_Y); S.Bt = (const char*)(ws + WS_WOUT) + (size_t)(l) * D * D * 2; S.KB = D * 2; S.so.init(T / 256, D / 256, G, bx); \
        pg8::EpiRes E{(l) == 0 ? args.in[I_X] : args.out, args.out, XB, rss + (size_t)(2 * (l) + 1) * T * 4, (((l) == 1 && MF8) || ((l) == 0 && DF8)) ? (unsigned char*)(ws + WS_XB8) : nullptr, 1.0f, 1.0f}; \
        REP((pb) + 2) for (int r_ = 0; r_ * G < S.so.nwg; ++r_) { S.so.i0 = r_; S.so.nmax = 1; pg8::gemm_phase<pg8::EpiRes, pg8::DenseSched, false, false>(lds, D * 2, S, E); } \
        SEAM((pb) + 2); \
    }
    LAYER_MIX(0, 1)
    if (IN(4)) {
        pg8::DenseSched S; S.A = DF8 ? (const char*)(ws + WS_XB8) : (const char*)XB; S.Bt = (const char*)(ws + WS_FGU); S.KB = D * DES; S.so.init(T / 256, NFF2 / 256, G, bx);
        fill_unit_tables<false>(S, rss + (size_t)1 * T * 4, nullptr, DF8 ? 1.0f / MOE_SW : 1.0f, lds);
        pg8::EpiSwiglu<false, DF8> E{(void*)(ws + WS_ACT), (const LAS float*)(lds + RSTAB_OFF), DF8 ? MOE_SA : 1.0f};
        REP(4) pg8::gemm_phase<pg8::EpiSwiglu<false, DF8>, pg8::DenseSched, true, DF8>(lds, D * DES, S, E);
        SEAM(4);
    }
    if (IN(5)) {
        pg8::DenseSched S; S.A = (const char*)(ws + WS_ACT); S.Bt = (const char*)(ws + WS_FD); S.KB = FF * DES; S.so.init(T / 256, D / 256, G, bx);
        pg8::EpiRes E{args.out, args.out, XB, rss + (size_t)2 * T * 4, nullptr, DF8 ? MOE_SW * MOE_SA : 1.0f, DF8 ? 1.0f / (MOE_SW * MOE_SA) : 1.0f};
        for (int r_ = 0; r_ * G < S.so.nwg; ++r_) { S.so.i0 = r_; S.so.nmax = 1; pg8::gemm_phase<pg8::EpiRes, pg8::DenseSched, false, DF8>(lds, FF * DES, S, E); }
        SEAM(5);
    }
    LAYER_MIX(1, 6)
    LAS int* mtab = (LAS int*)(lds + LDSCTL_OFF + 64);
    if (IN(9)) { router_phase(args, lds, lane, wave); SEAM(9); }
    if (IN(10)) {
        moe_tab_build(ws, mtab);
        pg8::MoeUpSched<MES> S; S.tab = mtab;
        S.XA = MF8 ? (const char*)(ws + WS_XB8) : (const char*)XB; S.W = (const char*)(ws + WS_MGU); S.toktab = (const LAS int*)(lds + TOKTAB_OFF); S.so.init(__builtin_amdgcn_readfirstlane(mtab[24]), NFF2 / 256, G, bx);
        fill_unit_tables<true>(S, rss + (size_t)3 * T * 4, (const int*)(ws + WS_TOKLIST), MF8 ? 1.0f / MOE_SW : 1.0f, lds);
        pg8::EpiSwiglu<true, MF8> E{(void*)(ws + WS_ACT), (const LAS float*)(lds + RSTAB_OFF), MF8 ? MOE_SA : 1.0f};
#if PROBE_NULL == 10
        { pg8::EpiNull EN{(float*)(ws + WS_TOKINFO)}; pg8::gemm_phase<pg8::EpiNull, pg8::MoeUpSched<MES>, true, MF8>(lds, D * MES, S, EN); }
#endif
        REP(10) pg8::gemm_phase<pg8::EpiSwiglu<true, MF8>, pg8::MoeUpSched<MES>, true, MF8>(lds, D * MES, S, E);
        SEAM(10);
    }
    if (IN(11)) {
        moe_tab_build(ws, mtab);
        pg8::MoeDownSched<MES> S; S.tab = mtab;
        S.ACT = (const char*)(ws + WS_ACT); S.W = (const char*)(ws + WS_MD); S.so.init(__builtin_amdgcn_readfirstlane(mtab[24]), D / 256, G, bx);
        pg8::EpiSlot E{(bf16_t*)(ws + WS_YS), MF8 ? 1.0f / (MOE_SW * MOE_SA) : 1.0f};
#if PROBE_NULL == 11
        { pg8::EpiNull EN{(float*)(ws + WS_TOKINFO)}; pg8::gemm_phase<pg8::EpiNull, pg8::MoeDownSched<MES>, true, MF8>(lds, FF * MES, S, EN); }
#endif
        REP(11) pg8::gemm_phase<pg8::EpiSlot, pg8::MoeDownSched<MES>, true, MF8>(lds, FF * MES, S, E);
        SEAM(11);
    }
    if (IN(12)) { moe_tab_build(ws, mtab); final_phase(args, mtab, gw, NGW, lane); }
#undef IN
#undef SEAM
}

extern "C" void kernel_launch(void* const* d_in, const int* in_sizes, int n_in, void* d_out, int out_size, void* d_ws, size_t ws_size, hipStream_t stream) {
    static int grid = 0;
    if (grid == 0) {
        if (n_in != 21 || in_sizes[0] != T * D || out_size != T * D || ws_size < WS_END) { fprintf(stderr, "kernel_launch: unexpected shapes (n_in %d, in0 %d, out %d, ws %zu < %zu); nothing launched\n", n_in, n_in > 0 ? in_sizes[0] : -1, out_size, ws_size, (size_t)WS_END); grid = -1; return; }
        int dev = 0, cus = 0, per_cu = 0;
        if (hipGetDevice(&dev) != hipSuccess || hipDeviceGetAttribute(&cus, hipDeviceAttributeMultiprocessorCount, dev) != hipSuccess) { grid = -1; return; }
        if (hipFuncSetAttribute((const void*)mega_fwd, hipFuncAttributeMaxDynamicSharedMemorySize, LDS_BYTES) != hipSuccess) { fprintf(stderr, "kernel_launch: hipFuncSetAttribute failed\n"); grid = -1; return; }
        if (hipOccupancyMaxActiveBlocksPerMultiprocessor(&per_cu, (const void*)mega_fwd, NWAVES * 64, LDS_BYTES) != hipSuccess || per_cu < 1) { fprintf(stderr, "kernel_launch: occupancy query reports %d\n", per_cu); }
        (void)hipGetLastError();
        grid = cus;
    }
    if (grid < 0) return;
    if (hipMemsetAsync((char*)d_ws + WS_CTL, 0, CTL_ZERO_BYTES, stream) != hipSuccess) return;
    Args a{};
    for (int i = 0; i < 21; ++i) a.in[i] = (const float*)d_in[i];
    a.out = (float*)d_out; a.ws = (unsigned char*)d_ws;
    if (MK_N_LAUNCHES == 1) { a.ph_lo = 0; a.ph_hi = N_PHASES; hipLaunchKernelGGL(mega_fwd, dim3(grid), dim3(NWAVES * 64), LDS_BYTES, stream, a); }
    else for (int p = 0; p < N_PHASES; ++p) { a.ph_lo = p; a.ph_hi = p + 1; hipLaunchKernelGGL(mega_fwd, dim3(grid), dim3(NWAVES * 64), LDS_BYTES, stream, a); }
}
```

```cpp
#include <hip/hip_runtime.h>
#include <cstdio>
#include <cstdint>

#ifndef PROBE_TIME
#define PROBE_TIME -1
#endif
#ifndef PROBE_P0
#define PROBE_P0 0
#endif
#ifndef PROBE_MID
#define PROBE_MID 0
#endif
#ifndef PROBE_NULL
#define PROBE_NULL -1
#endif
#ifndef DENSE_FP8
#define DENSE_FP8 0
#endif
#ifndef MK_N_LAUNCHES
#define MK_N_LAUNCHES 1
#endif
constexpr int N_PHASES = 13;

#define GAS __attribute__((address_space(1)))
#define LAS __attribute__((address_space(3)))
typedef unsigned short bf16_t;
typedef short bf16x8 __attribute__((ext_vector_type(8)));
typedef float f32x4 __attribute__((ext_vector_type(4)));
typedef float f32x2 __attribute__((ext_vector_type(2)));
typedef unsigned u32x4 __attribute__((ext_vector_type(4)));
typedef unsigned u32x2 __attribute__((ext_vector_type(2)));

constexpr int NB = 8, SEQ = 2048, T = NB * SEQ, D = 1024, DIN = 2048, CC = 512, FF = 2816, NE = 8, CW = 31, NFF2 = 2 * FF;
constexpr float EPS = 1e-6f;
constexpr int NWAVES = 8;

constexpr size_t KiB = 1024, MiB = 1024 * 1024;
constexpr size_t WS_CTL = 0, CTL_ZERO_BYTES = 64 * KiB;
constexpr int CW_BAR = 1024;
constexpr int CW_CNT = 8192;
constexpr size_t WS_TOKLIST = 64 * KiB;
constexpr size_t WS_TOKINFO = 576 * KiB;
constexpr size_t WS_RT = 832 * KiB;
constexpr size_t WS_SGUW = 1 * MiB;
constexpr size_t WS_RSS = 2 * MiB;
constexpr size_t WS_WIN = 6 * MiB;
constexpr size_t WS_WOUT = 14 * MiB;
constexpr size_t WS_FGU = 18 * MiB;
constexpr size_t WS_FD = 29 * MiB;
constexpr size_t WS_MGU = 35 * MiB;
constexpr size_t WS_MD = 79 * MiB;
constexpr size_t WS_XB = 101 * MiB;
constexpr size_t WS_XB8 = 133 * MiB;
constexpr size_t WS_ACT = 149 * MiB;
constexpr size_t WS_CG = WS_ACT, WS_UA = WS_ACT + 16 * MiB, WS_VA = WS_ACT + 32 * MiB, WS_Y = WS_ACT + 48 * MiB;
constexpr size_t WS_YS = 238 * MiB;
constexpr size_t WS_END = WS_YS + (size_t)2 * T * D * 2;
constexpr float MOE_SW = 32.0f, MOE_SA = 8.0f;
static_assert(WS_END <= 380 * MiB, "workspace map");
static_assert(WS_MGU + (size_t)NE * NFF2 * D <= WS_MD && WS_MD + (size_t)NE * D * FF <= WS_XB && WS_FD + (size_t)D * FF * 2 <= WS_MGU && WS_ACT + (size_t)T * FF * 2 <= WS_YS && WS_ACT + (size_t)(2 * T + 256) * FF <= WS_YS, "workspace map 2");

constexpr int RING_BYTES = 131072;
constexpr int LDSCTL_OFF = RING_BYTES;
constexpr int MAXU = 12;
constexpr int TOKTAB_OFF = RING_BYTES + 512;
constexpr int RSTAB_OFF = TOKTAB_OFF + MAXU * 256 * 4;
constexpr int LDS_BYTES = RSTAB_OFF + MAXU * 256 * 4;
static_assert(LDS_BYTES <= 160 * 1024 && LDS_BYTES > 80 * 1024, "LDS map");

#define RLX_AGENT __ATOMIC_RELAXED, __HIP_MEMORY_SCOPE_AGENT
__device__ __forceinline__ unsigned cvt_pk_bf16(float lo, float hi) { unsigned r; asm volatile("v_cvt_pk_bf16_f32 %0, %1, %2" : "=v"(r) : "v"(lo), "v"(hi)); return r; }
__device__ __forceinline__ float clamp448(float v) { return __builtin_amdgcn_fmed3f(v, -448.0f, 448.0f); }
__device__ __forceinline__ unsigned pk_fp8x4(float a, float b, float c, float d) {
    int p = __builtin_amdgcn_cvt_pk_fp8_f32(clamp448(a), clamp448(b), 0, false); p = __builtin_amdgcn_cvt_pk_fp8_f32(clamp448(c), clamp448(d), p, true); return (unsigned)p; }
__device__ __forceinline__ float bf_lo(unsigned x) { return __uint_as_float(x << 16); }
__device__ __forceinline__ float bf_hi(unsigned x) { return __uint_as_float(x & 0xffff0000u); }
__device__ __forceinline__ float fast_sigmoid(float g) { return __builtin_amdgcn_rcpf(1.0f + __builtin_amdgcn_exp2f(-1.4426950408889634f * g)); }
__device__ __forceinline__ float wave_sum(float v) {
#pragma unroll
    for (int o = 1; o < 64; o <<= 1) v += __shfl_xor(v, o);
    return v;
}
__device__ __forceinline__ float dpp_add(float v, const int ctrl_sel) {
    int r;
    if (ctrl_sel == 0) r = __builtin_amdgcn_update_dpp(0, __float_as_int(v), 0xB1, 0xF, 0xF, false);
    else if (ctrl_sel == 1) r = __builtin_amdgcn_update_dpp(0, __float_as_int(v), 0x4E, 0xF, 0xF, false);
    else if (ctrl_sel == 2) r = __builtin_amdgcn_update_dpp(0, __float_as_int(v), 0x141, 0xF, 0xF, false);
    else r = __builtin_amdgcn_update_dpp(0, __float_as_int(v), 0x140, 0xF, 0xF, false);
    return v + __int_as_float(r);
}
__device__ __forceinline__ float row16_allsum(float v) { v = dpp_add(v, 0); v = dpp_add(v, 1); v = dpp_add(v, 2); v = dpp_add(v, 3); return v; }
__device__ __forceinline__ f32x2 gelu_pk(f32x2 v) {
    const f32x2 av = __builtin_elementwise_abs(v), d = av * 0.2316418882f + 1.0f;
    f32x2 t; t.x = __builtin_amdgcn_rcpf(d.x); t.y = __builtin_amdgcn_rcpf(d.y);
    f32x2 q = t * 0.5307027145f + (-0.7265760135f); q = q * t + 0.7107068705f; q = q * t + (-0.142248368f); q = q * t + 0.127414796f; q = q * t;
    const f32x2 s = (v * v) * (-0.72134752044f);
    f32x2 e; e.x = __builtin_amdgcn_exp2f(s.x); e.y = __builtin_amdgcn_exp2f(s.y);
    const f32x2 m = v * (q * e), r = v - m;
    f32x2 o; o.x = v.x < 0.f ? m.x : r.x; o.y = v.y < 0.f ? m.y : r.y; return o;
}

#ifndef WT_STORES
#define WT_STORES 0
#endif
struct WtBuf { __amdgpu_buffer_rsrc_t r; };
__device__ __forceinline__ WtBuf wt_buf(const void* base) { WtBuf b; b.r = __builtin_amdgcn_make_buffer_rsrc((void*)base, 0, 0xFFFFFFFFu, 0x00020000); return b; }
__device__ __forceinline__ void wt_store16(const WtBuf& b, const void* base, size_t byte_off, u32x4 v) {
#if WT_STORES
    __builtin_amdgcn_raw_buffer_store_b128(v, b.r, (int)(unsigned)byte_off, 0, 16);
#else
    *(u32x4*)((char*)base + byte_off) = v;
#endif
}
__device__ __forceinline__ void wt_store16f(const WtBuf& b, const void* base, size_t byte_off, f32x4 v) { wt_store16(b, base, byte_off, __builtin_bit_cast(u32x4, v)); }

#define XB_TMO      128
#define XB_XCNT(j)  (256  + 64 * (j))
#define XB_XSUB(j)  (1280 + 64 * (j))
#define XB_XGEN(j)  (2304 + 64 * (j))
#define XB_TOP      3328
#define XB_TOPGEN   3392
#define XCD_BAR_WORDS 3456
#define XB_SPIN_CAP (1u << 18)
__device__ __forceinline__ unsigned xb_ld(unsigned* p)              { return __hip_atomic_load(p, __ATOMIC_RELAXED, __HIP_MEMORY_SCOPE_AGENT); }
__device__ __forceinline__ unsigned xb_add(unsigned* p, unsigned v) { return __hip_atomic_fetch_add(p, v, __ATOMIC_RELAXED, __HIP_MEMORY_SCOPE_AGENT); }
__device__ __forceinline__ unsigned xb_xcc_id() { return (unsigned)__builtin_amdgcn_s_getreg((3 << 11) | 20) & 0xFu; }
#define XB_SPIN(cond, bar) do { unsigned _sp = 0; while (cond) { __builtin_amdgcn_s_sleep(1); \
    if ((++_sp & 255u) == 0u) { if (xb_ld(&(bar)[XB_TMO])) break; if (_sp > XB_SPIN_CAP) { atomicAdd(&(bar)[XB_TMO], 1u); break; } } } } while (0)
struct XcdBarrier { unsigned* bar; unsigned x; volatile LAS unsigned* st; };
__device__ __forceinline__ XcdBarrier xcd_barrier_post(unsigned* bar, volatile LAS unsigned* st) {
    XcdBarrier b; b.bar = bar; b.x = xb_xcc_id(); b.st = st;
    if (threadIdx.x == 0) (void)xb_add(&bar[XB_XCNT(b.x)], 1u);
    return b;
}
__device__ __forceinline__ void xcd_barrier_complete(unsigned* bar, unsigned x, unsigned& nloc, unsigned& nx) {
    const unsigned G = gridDim.x * gridDim.y * gridDim.z;
    unsigned sum, cnt, mine, sp = 0u;
    for (;;) {
        sum = 0u; cnt = 0u; mine = 0u;
#pragma unroll
        for (unsigned j = 0; j < 16; ++j) { const unsigned c = xb_ld(&bar[XB_XCNT(j)]); sum += c; cnt += (c > 0u) ? 1u : 0u; mine = (j == x) ? c : mine; }
        if (sum == G) break;
        __builtin_amdgcn_s_sleep(1);
        if ((++sp & 255u) == 0u) { if (xb_ld(&bar[XB_TMO])) break; if (sp > XB_SPIN_CAP) { atomicAdd(&bar[XB_TMO], 1u); break; } }
    }
    nloc = mine > 0u ? mine : 1u; nx = cnt > 0u ? cnt : 1u;
}
__device__ __forceinline__ void xcd_barrier(const XcdBarrier& b) {
    asm volatile("s_waitcnt vmcnt(0)" ::: "memory");
    __syncthreads();
    if (threadIdx.x == 0) {
        unsigned* bar = b.bar;
        __builtin_amdgcn_s_waitcnt(0);
        unsigned nloc = b.st[0], nx = b.st[1];
        if (nloc == 0u) { xcd_barrier_complete(bar, b.x, nloc, nx); b.st[0] = nloc; b.st[1] = nx; }
        const unsigned old = xb_add(&bar[XB_XSUB(b.x)], 1u);
        const unsigned gen = old / nloc;
        if (old + 1u == (gen + 1u) * nloc) {
            __builtin_amdgcn_fence(__ATOMIC_RELEASE, "agent");
            asm volatile("s_waitcnt vmcnt(0)" ::: "memory");
            const unsigned og = xb_add(&bar[XB_TOP], 1u);
            const unsigned tg = og / nx;
            if (og + 1u == (tg + 1u) * nx) xb_add(&bar[XB_TOPGEN], 1u);
            else XB_SPIN(xb_ld(&bar[XB_TOPGEN]) == tg, bar);
            __builtin_amdgcn_fence(__ATOMIC_ACQUIRE, "agent");
            xb_add(&bar[XB_XGEN(b.x)], 1u);
            asm volatile("s_waitcnt vmcnt(0)" ::: "memory");
        } else {
            XB_SPIN(xb_ld(&bar[XB_XGEN(b.x)]) == gen, bar);
            __builtin_amdgcn_fence(__ATOMIC_ACQUIRE, "agent");
            asm volatile("s_waitcnt vmcnt(0)" ::: "memory");
        }
    }
    __syncthreads();
}

namespace pg8 {
constexpr int BM = 256, BK = 64, HALF = 128, HTB = HALF * BK * 2, STAGE_BYTES = 8 * HTB, NXCD = 8, WGM = 8;
__host__ __device__ __forceinline__ int lds_byte(int r, int c) { const int st = (r >> 4) * 2 + (c >> 5), rr = r & 15, cc = c & 31, ob = rr * 64 + cc * 2; return st * 1024 + (ob ^ (((ob >> 9) & 1) << 5)); }
__host__ __device__ __forceinline__ void stage_rc(int b, int& R, int& C) { const int st = b / 1024, sb = b % 1024, swz = sb ^ (((sb >> 9) & 1) << 5); R = (st >> 1) * 16 + swz / 64; C = (st & 1) * 32 + (swz % 64) / 2; }
__host__ __device__ __forceinline__ int perm32(int rho) { const int n = rho >> 4, i = rho & 15; return 8 * (i >> 2) + 4 * n + (i & 3); }

struct Unit { int pm, pn, e, valid, rb, ui; };

struct StaticOrder {
    int nM, nN, nwg, G, c, i0, nmax;
    __device__ __forceinline__ void init(int nM_, int nN_, int G_, int c_) { nM = nM_; nN = nN_; nwg = nM * nN; G = G_; c = c_; i0 = 0; nmax = 1 << 30; }
    __device__ __forceinline__ bool map(int i, int& pm, int& pn) const {
        if (i >= nmax) return false;
        const long L = (long)(i + i0) * G + c; if (L >= nwg) return false;
        int wgid = (int)L; { const int q = nwg / NXCD, r = nwg % NXCD, xcd = wgid % NXCD, off = wgid / NXCD; wgid = (xcd < r ? xcd * (q + 1) : r * (q + 1) + (xcd - r) * q) + off; }
        const int nig = WGM * nN, gid = wgid / nig, fm = gid * WGM, gsz = (nM - fm) < WGM ? (nM - fm) : WGM;
        pm = fm + ((wgid % nig) % gsz); pn = (wgid % nig) / gsz; return true;
    }
};

typedef int v4i32 __attribute__((ext_vector_type(4)));
typedef int v8i32 __attribute__((ext_vector_type(8)));
template <class Epi, class Sched, bool ALIGN_EPI, bool FP8>
__device__ __forceinline__ void gemm_phase(LAS unsigned char* lds, const int KB, const Sched& S, const Epi& E) {
    const int tid = threadIdx.x, wid = __builtin_amdgcn_readfirstlane(tid >> 6), lane = tid & 63, wr = wid >> 2, wc = wid & 3, fr = lane & 15, fq = lane >> 4;
    const int nt = KB / 128;
    int Rs[2], Cs[2]; unsigned voffB[2];
#pragma unroll
    for (int i = 0; i < 2; ++i) { stage_rc(tid * 16 + i * 8192, Rs[i], Cs[i]); voffB[i] = (unsigned)(Rs[i] * KB + Cs[i] * 2); }
    const size_t kstep = (size_t)(BK * 2);
    const size_t hstep = (size_t)HALF * KB;
    const unsigned ldsw = (unsigned)wid * 1024u;
    const int aoff = lds_byte(wr * 64 + fr, fq * 8), boff = lds_byte(wc * 32 + fr, fq * 8);
#define PG8_SA(b, h) (((b) * 2 + (h)) * HTB)
#define PG8_SB(b, h) ((4 + (b) * 2 + (h)) * HTB)
#define PG8_STAGE(bufoff, gbase, voff) do { _Pragma("unroll") for (int _i = 0; _i < 2; ++_i) \
        __builtin_amdgcn_global_load_lds((const unsigned*)((const char*)(gbase) + (voff)[_i]), (LAS unsigned*)(lds + (bufoff) + ldsw + _i * 8192), 16, 0, 0); } while (0)
#define PG8_LDA(dst, b, h) do { _Pragma("unroll") for (int m = 0; m < 4; ++m) dst[m] = __builtin_shufflevector(*(const LAS v4i32*)(lds + PG8_SA(b, h) + aoff + m * 2048), *(const LAS v4i32*)(lds + PG8_SA(b, h) + aoff + m * 2048 + 1024), 0, 1, 2, 3, 4, 5, 6, 7); } while (0)
#define PG8_LDB(dst, b, h) do { _Pragma("unroll") for (int n = 0; n < 2; ++n) dst[n] = __builtin_shufflevector(*(const LAS v4i32*)(lds + PG8_SB(b, h) + boff + n * 2048), *(const LAS v4i32*)(lds + PG8_SB(b, h) + boff + n * 2048 + 1024), 0, 1, 2, 3, 4, 5, 6, 7); } while (0)
#define PG8_MMA(ai, bj, At, Bt) do { __builtin_amdgcn_s_setprio(1); _Pragma("unroll") for (int m = 0; m < 4; ++m) _Pragma("unroll") for (int n = 0; n < 2; ++n) { \
        if constexpr (FP8) asm volatile("v_mfma_f32_16x16x128_f8f6f4 %0, %1, %2, %0" : "+v"(acc[ai][bj][m][n]) : "v"(Bt[n]), "v"(At[m]));   \
        else { acc[ai][bj][m][n] = __builtin_amdgcn_mfma_f32_16x16x32_bf16(__builtin_bit_cast(bf16x8, __builtin_shufflevector(Bt[n], Bt[n], 0, 1, 2, 3)), __builtin_bit_cast(bf16x8, __builtin_shufflevector(At[m], At[m], 0, 1, 2, 3)), acc[ai][bj][m][n], 0, 0, 0); \
               acc[ai][bj][m][n] = __builtin_amdgcn_mfma_f32_16x16x32_bf16(__builtin_bit_cast(bf16x8, __builtin_shufflevector(Bt[n], Bt[n], 4, 5, 6, 7)), __builtin_bit_cast(bf16x8, __builtin_shufflevector(At[m], At[m], 4, 5, 6, 7)), acc[ai][bj][m][n], 0, 0, 0); } } \
        __builtin_amdgcn_s_setprio(0); } while (0)
#define PG8_WAIT_V(n) asm volatile("s_waitcnt vmcnt(" #n ")" ::: "memory")
#define PG8_WAIT_L(n) asm volatile("s_waitcnt lgkmcnt(" #n ")" ::: "memory")
#define PG8_BAR __builtin_amdgcn_s_barrier()
#define PG8_SCHED __builtin_amdgcn_sched_barrier(0)
    Unit cur, nxt; int ui = 0;
    if (!S.next(0, cur)) return;
    f32x4 acc[2][2][4][2];
    E.init_acc(acc, cur, wr, wc, fr, fq);
    v8i32 At[4], B0[2], B1[2];
    const char* cA = S.a_ptr(cur); const char* cB = S.b_ptr(cur);
    unsigned offC[2][2], offN[2][2];
    S.a_offs(cur, Rs, Cs, offC);
    PG8_STAGE(PG8_SB(0, 0), cB, voffB); PG8_STAGE(PG8_SB(0, 1), cB + hstep, voffB); PG8_STAGE(PG8_SA(0, 0), cA, offC[0]); PG8_STAGE(PG8_SA(0, 1), cA, offC[1]);
    if (wr == 1) PG8_BAR;
    PG8_WAIT_V(2); PG8_BAR;
    PG8_STAGE(PG8_SB(1, 0), cB + kstep, voffB); PG8_STAGE(PG8_SA(1, 0), cA + kstep, offC[0]); PG8_STAGE(PG8_SB(1, 1), cB + hstep + kstep, voffB);
    PG8_WAIT_V(6); PG8_BAR;
    bool has_next = false; const char* nA = cA; const char* nB = cB;
    constexpr bool NEXT_IN_LOOP = FP8;
#define PG8_NEXT() do { has_next = S.next(ui + 1, nxt); nA = has_next ? S.a_ptr(nxt) : cA; nB = has_next ? S.b_ptr(nxt) : cB; \
        if (has_next) S.a_offs(nxt, Rs, Cs, offN); else { _Pragma("unroll") for (int h = 0; h < 2; ++h) _Pragma("unroll") for (int i = 0; i < 2; ++i) offN[h][i] = offC[h][i]; } } while (0)
    for (;;) {
        if constexpr (!NEXT_IN_LOOP) PG8_NEXT();
        for (int t = 0; t < nt; t += 2) {
            const bool last = (t == nt - 2);
            const char* a1 = cA + (size_t)(t + 1) * kstep;
            const char* a2 = last ? nA : cA + (size_t)(t + 2) * kstep; const char* b2 = last ? nB : cB + (size_t)(t + 2) * kstep;
            const char* a3 = a2 + kstep; const char* b3 = b2 + kstep;
            unsigned o2[2][2];
#pragma unroll
            for (int h = 0; h < 2; ++h)
#pragma unroll
                for (int i = 0; i < 2; ++i) o2[h][i] = last ? offN[h][i] : offC[h][i];
            PG8_LDB(B0, 0, 0); PG8_LDB(B1, 0, 1); PG8_SCHED; PG8_LDA(At, 0, 0); PG8_STAGE(PG8_SA(1, 1), a1, offC[1]);
            PG8_WAIT_V(8); PG8_WAIT_L(0); PG8_BAR; PG8_MMA(0, 0, At, B0); PG8_MMA(0, 1, At, B1);
            if constexpr (NEXT_IN_LOOP) { if (t == 0) PG8_NEXT(); }
            PG8_BAR; PG8_SCHED;
            PG8_LDA(At, 0, 1); PG8_STAGE(PG8_SB(0, 0), b2, voffB); PG8_STAGE(PG8_SB(0, 1), b2 + hstep, voffB); PG8_STAGE(PG8_SA(0, 0), a2, o2[0]);
            PG8_WAIT_V(8); PG8_WAIT_L(0); PG8_BAR; PG8_MMA(1, 0, At, B0); PG8_MMA(1, 1, At, B1); PG8_BAR; PG8_SCHED;
            PG8_LDB(B0, 1, 0); PG8_LDB(B1, 1, 1); PG8_SCHED; PG8_LDA(At, 1, 0); PG8_STAGE(PG8_SA(0, 1), a2, o2[1]);
            PG8_WAIT_V(8); PG8_WAIT_L(0); PG8_BAR; PG8_MMA(0, 0, At, B0); PG8_MMA(0, 1, At, B1); PG8_BAR; PG8_SCHED;
            PG8_LDA(At, 1, 1); PG8_STAGE(PG8_SB(1, 0), b3, voffB); PG8_STAGE(PG8_SB(1, 1), b3 + hstep, voffB); PG8_STAGE(PG8_SA(1, 0), a3, o2[0]);
            PG8_WAIT_V(8); PG8_WAIT_L(0); PG8_BAR; PG8_MMA(1, 0, At, B0); PG8_MMA(1, 1, At, B1); PG8_BAR; PG8_SCHED;
        }
        if constexpr (ALIGN_EPI) { if (wr == 0) PG8_BAR; }
        if constexpr (FP8) asm volatile("s_nop 15\n\ts_nop 15" ::: "memory");
        if constexpr (!Epi::AFTER_DRAIN) E(acc, cur, wr, wc, fr, fq);
        if (!has_next) break;
        E.init_acc(acc, nxt, wr, wc, fr, fq);
        cur = nxt; cA = nA; cB = nB; ++ui;
#pragma unroll
        for (int h = 0; h < 2; ++h)
#pragma unroll
            for (int i = 0; i < 2; ++i) offC[h][i] = offN[h][i];
        if constexpr (ALIGN_EPI) { if (wr == 1) PG8_BAR; }
    }
    PG8_WAIT_V(0);
    if constexpr (!ALIGN_EPI) { if (wr == 0) PG8_BAR; }
    PG8_BAR;
    if constexpr (Epi::AFTER_DRAIN) E.fused(acc, cur, wr, wc, fr, fq, lds);
#undef PG8_NEXT
#undef PG8_SA
#undef PG8_SB
#undef PG8_STAGE
#undef PG8_LDA
#undef PG8_LDB
#undef PG8_MMA
#undef PG8_WAIT_V
#undef PG8_WAIT_L
#undef PG8_BAR
#undef PG8_SCHED
}

struct DenseSched {
    const char* A; const char* Bt; int KB; StaticOrder so;
    __device__ __forceinline__ bool next(int i, Unit& u) const { int pm, pn; if (!so.map(i, pm, pn)) return false; u.pm = pm; u.pn = pn; u.e = 0; u.valid = 256; u.rb = pm * 256; u.ui = i; return true; }
    __device__ __forceinline__ const char* a_ptr(const Unit& u) const { return A + (size_t)u.pm * 256 * KB; }
    __device__ __forceinline__ const char* b_ptr(const Unit& u) const { return Bt + (size_t)u.pn * 256 * KB; }
    __device__ __forceinline__ void a_offs(const Unit&, const int (&R)[2], const int (&C)[2], unsigned (&off)[2][2]) const {
#pragma unroll
        for (int h = 0; h < 2; ++h)
#pragma unroll
            for (int i = 0; i < 2; ++i) off[h][i] = (unsigned)((h * 128 + R[i]) * KB + C[i] * 2); }
};
__device__ __forceinline__ void moe_lookup(const LAS int* tab, int vt, Unit& u) {
    int e = 0;
#pragma unroll
    for (int k = 1; k < 8; ++k) e += (vt >= tab[16 + k]) ? 1 : 0;
    e = __builtin_amdgcn_readfirstlane(e);
    const int tpe = __builtin_amdgcn_readfirstlane(tab[16 + e]), ce = __builtin_amdgcn_readfirstlane(tab[e]), be = __builtin_amdgcn_readfirstlane(tab[8 + e]);
    const int li = vt - tpe; u.pm = li; u.e = e; const int rem = ce - 256 * li; u.valid = rem < 256 ? rem : 256; u.rb = be + 256 * li;
}
template <int ES> struct MoeUpSched {
    const char* XA; const char* W; const LAS int* toktab; const LAS int* tab; StaticOrder so;
    __device__ __forceinline__ bool next(int i, Unit& u) const { int vt, pn; if (!so.map(i, vt, pn)) return false; moe_lookup(tab, vt, u); u.pn = pn; u.ui = i; return true; }
    __device__ __forceinline__ const char* a_ptr(const Unit&) const { return XA; }
    __device__ __forceinline__ const char* b_ptr(const Unit& u) const { return W + ((size_t)u.e * NFF2 + (size_t)u.pn * 256) * D * ES; }
    __device__ __forceinline__ void a_offs(const Unit& u, const int (&R)[2], const int (&C)[2], unsigned (&off)[2][2]) const {
#pragma unroll
        for (int h = 0; h < 2; ++h)
#pragma unroll
            for (int i = 0; i < 2; ++i) off[h][i] = (unsigned)toktab[u.ui * 256 + h * 128 + R[i]] * (unsigned)(D * ES) + (unsigned)C[i] * 2u; }
};
template <int ES> struct MoeDownSched {
    const char* ACT; const char* W; const LAS int* tab; StaticOrder so;
    __device__ __forceinline__ bool next(int i, Unit& u) const { int vt, pn; if (!so.map(i, vt, pn)) return false; moe_lookup(tab, vt, u); u.pn = pn; u.ui = i; return true; }
    __device__ __forceinline__ const char* a_ptr(const Unit& u) const { return ACT + (size_t)u.rb * FF * ES; }
    __device__ __forceinline__ const char* b_ptr(const Unit& u) const { return W + ((size_t)u.e * D + (size_t)u.pn * 256) * FF * ES; }
    __device__ __forceinline__ void a_offs(const Unit&, const int (&R)[2], const int (&C)[2], unsigned (&off)[2][2]) const {
#pragma unroll
        for (int h = 0; h < 2; ++h)
#pragma unroll
            for (int i = 0; i < 2; ++i) off[h][i] = (unsigned)((h * 128 + R[i]) * FF * ES + C[i] * 2); }
};

__device__ __forceinline__ void zero_acc(f32x4 (&acc)[2][2][4][2]) {
#pragma unroll
    for (int a = 0; a < 2; ++a)
#pragma unroll
        for (int b = 0; b < 2; ++b)
#pragma unroll
            for (int m = 0; m < 4; ++m)
#pragma unroll
                for (int n = 0; n < 2; ++n) acc[a][b][m][n] = (f32x4){0.f, 0.f, 0.f, 0.f};
}
__device__ __forceinline__ float rstd_of(float p) { p += __shfl_xor(p, 16); p += __shfl_xor(p, 32); return 1.0f / sqrtf(p * (1.0f / D) + EPS); }
struct EpiMix {
    static constexpr bool AFTER_DRAIN = false;
    bf16_t* CG; bf16_t* UA; bf16_t* VA; const LAS float* rstab;
    __device__ __forceinline__ void init_acc(f32x4 (&acc)[2][2][4][2], const Unit&, int, int, int, int) const { zero_acc(acc); }
    __device__ __forceinline__ void operator()(const f32x4 (&acc)[2][2][4][2], const Unit& u, int wr, int wc, int fr, int fq) const {
        const int row0 = u.rb + wr * 64 + fr;
        const WtBuf bcg = wt_buf(CG), bdst = wt_buf(u.pn < 6 ? UA : VA);
        float rsv[2][4];
#pragma unroll
        for (int ai = 0; ai < 2; ++ai)
#pragma unroll
            for (int m = 0; m < 4; ++m) rsv[ai][m] = rstab[u.ui * 256 + ai * HALF + wr * 64 + m * 16 + fr];
#pragma unroll
        for (int ai = 0; ai < 2; ++ai)
#pragma unroll
            for (int m = 0; m < 4; ++m) {
                const int row = row0 + ai * HALF + m * 16; const float rs = rsv[ai][m];
                if (u.pn < 4) {
                    float o[8];
#pragma unroll
                    for (int n = 0; n < 2; ++n)
#pragma unroll
                        for (int j = 0; j < 4; ++j) { const float a = acc[ai][0][m][n][j] * rs, g = acc[ai][1][m][n][j] * rs; o[4 * n + j] = a * fast_sigmoid(g); }
                    u32x4 w; w.x = cvt_pk_bf16(o[0], o[1]); w.y = cvt_pk_bf16(o[2], o[3]); w.z = cvt_pk_bf16(o[4], o[5]); w.w = cvt_pk_bf16(o[6], o[7]);
                    wt_store16(bcg, CG, ((size_t)row * CC + u.pn * 128 + wc * 32 + 8 * fq) * 2, w);
                } else {
                    bf16_t* dbase = (u.pn < 6 ? UA : VA); const size_t doff = ((size_t)row * CC + (u.pn & 1) * 256 + wc * 32 + 8 * fq) * 2;
#pragma unroll
                    for (int bj = 0; bj < 2; ++bj) {
                        const f32x4 v0 = acc[ai][bj][m][0] * rs, v1 = acc[ai][bj][m][1] * rs;
                        const f32x2 a = gelu_pk((f32x2){v0[0], v0[1]}), b = gelu_pk((f32x2){v0[2], v0[3]}), c = gelu_pk((f32x2){v1[0], v1[1]}), d = gelu_pk((f32x2){v1[2], v1[3]});
                        u32x4 w; w.x = cvt_pk_bf16(a.x, a.y); w.y = cvt_pk_bf16(b.x, b.y); w.z = cvt_pk_bf16(c.x, c.y); w.w = cvt_pk_bf16(d.x, d.y);
                        wt_store16(bdst, dbase, doff + bj * HALF * 2, w); }
                }
            }
    }
};
struct EpiRes {
    static constexpr bool AFTER_DRAIN = true;
    const float* XIN; float* XOUT; bf16_t* XB; float* rss_out; unsigned char* XB8; float sc_in, sc_out;
    __device__ __forceinline__ void init_acc(f32x4 (&acc)[2][2][4][2], const Unit& u, int wr, int wc, int fr, int fq) const {
        const int row0 = u.rb + wr * 64 + fr, col0 = u.pn * 256 + wc * 32 + 8 * fq;
#pragma unroll
        for (int ai = 0; ai < 2; ++ai)
#pragma unroll
            for (int m = 0; m < 4; ++m)
#pragma unroll
                for (int bj = 0; bj < 2; ++bj) { const size_t off = (size_t)(row0 + ai * HALF + m * 16) * D + col0 + bj * HALF;
                    acc[ai][bj][m][0] = *(const f32x4*)(XIN + off) * sc_in; acc[ai][bj][m][1] = *(const f32x4*)(XIN + off + 4) * sc_in; }
    }
    __device__ __forceinline__ void fused(const f32x4 (&acc)[2][2][4][2], const Unit& u, int wr, int wc, int fr, int fq, LAS unsigned char* lds) const {
        const int row0 = u.rb + wr * 64 + fr, col0 = u.pn * 256 + wc * 32 + 8 * fq;
        LAS float* P = (LAS float*)lds;
        const WtBuf bxo = wt_buf(XOUT), bxb = wt_buf(XB);
#pragma unroll
        for (int ai = 0; ai < 2; ++ai)
#pragma unroll
            for (int m = 0; m < 4; ++m) {
                const int lr = ai * HALF + wr * 64 + m * 16 + fr, row = u.rb + lr; float ss = 0.f;
#pragma unroll
                for (int bj = 0; bj < 2; ++bj) {
                    const size_t off = (size_t)row * D + col0 + bj * HALF;
                    const f32x4 x0 = acc[ai][bj][m][0] * sc_out, x1 = acc[ai][bj][m][1] * sc_out;
                    wt_store16f(bxo, XOUT, off * 4, x0); wt_store16f(bxo, XOUT, off * 4 + 16, x1);
                    u32x4 w; w.x = cvt_pk_bf16(x0[0], x0[1]); w.y = cvt_pk_bf16(x0[2], x0[3]); w.z = cvt_pk_bf16(x1[0], x1[1]); w.w = cvt_pk_bf16(x1[2], x1[3]);
                    wt_store16(bxb, XB, off * 2, w);
                    if (XB8) { u32x2 q; q.x = pk_fp8x4(x0[0], x0[1], x0[2], x0[3]); q.y = pk_fp8x4(x1[0], x1[1], x1[2], x1[3]); *(u32x2*)(XB8 + off) = q; }
                    ss += (x0[0] * x0[0] + x0[1] * x0[1]) + (x0[2] * x0[2] + x0[3] * x0[3]) + (x1[0] * x1[0] + x1[1] * x1[1]) + (x1[2] * x1[2] + x1[3] * x1[3]); }
                ss += __shfl_xor(ss, 16); ss += __shfl_xor(ss, 32);
                if (fq == 0) P[lr * 4 + wc] = ss;
            }
        (void)row0;
        __syncthreads();
        if (threadIdx.x < 256) { const f32x4 p = *(const LAS f32x4*)(P + threadIdx.x * 4); rss_out[(size_t)(u.rb + threadIdx.x) * 4 + u.pn] = (p.x + p.y) + (p.z + p.w); }
        __syncthreads();
    }
};
template <bool MOE, bool F8> struct EpiSwiglu {
    static constexpr bool AFTER_DRAIN = false;
    void* ACT; const LAS float* rstab; float post;
    __device__ __forceinline__ void init_acc(f32x4 (&acc)[2][2][4][2], const Unit&, int, int, int, int) const { zero_acc(acc); }
    __device__ __forceinline__ void operator()(const f32x4 (&acc)[2][2][4][2], const Unit& u, int wr, int wc, int fr, int fq) const {
        const int col = u.pn * 128 + wc * 32 + 8 * fq;
        const WtBuf bact = wt_buf(ACT);
        float rsv[2][4];
#pragma unroll
        for (int ai = 0; ai < 2; ++ai)
#pragma unroll
            for (int m = 0; m < 4; ++m) rsv[ai][m] = rstab[u.ui * 256 + ai * HALF + wr * 64 + m * 16 + fr];
#pragma unroll
        for (int ai = 0; ai < 2; ++ai)
#pragma unroll
            for (int m = 0; m < 4; ++m) {
                const int lr = ai * HALF + wr * 64 + m * 16 + fr;
                const float rs = rsv[ai][m];
                const float k1 = -1.4426950408889634f * rs, k2 = rs * rs * post;
                float o[8];
#pragma unroll
                for (int n = 0; n < 2; ++n) {
                    const f32x4 ag = acc[ai][0][m][n], au = acc[ai][1][m][n]; const f32x4 tt = ag * k1; f32x4 ee;
#pragma unroll
                    for (int j = 0; j < 4; ++j) ee[j] = __builtin_amdgcn_exp2f(tt[j]);
                    ee = ee + 1.0f; f32x4 rr;
#pragma unroll
                    for (int j = 0; j < 4; ++j) rr[j] = __builtin_amdgcn_rcpf(ee[j]);
                    const f32x4 oo = (ag * au) * (rr * k2);
#pragma unroll
                    for (int j = 0; j < 4; ++j) o[4 * n + j] = oo[j]; }
                if constexpr (F8) {
                    u32x2 q; q.x = pk_fp8x4(o[0], o[1], o[2], o[3]); q.y = pk_fp8x4(o[4], o[5], o[6], o[7]);
                    if (!MOE || lr < u.valid) *(u32x2*)((unsigned char*)ACT + (size_t)(u.rb + lr) * FF + col) = q;
                } else {
                    u32x4 w; w.x = cvt_pk_bf16(o[0], o[1]); w.y = cvt_pk_bf16(o[2], o[3]); w.z = cvt_pk_bf16(o[4], o[5]); w.w = cvt_pk_bf16(o[6], o[7]);
                    if (!MOE || lr < u.valid) wt_store16(bact, ACT, ((size_t)(u.rb + lr) * FF + col) * 2, w);
                }
            }
    }
};
struct EpiSlot {
    static constexpr bool AFTER_DRAIN = false;
    bf16_t* YS; float sc;
    __device__ __forceinline__ void init_acc(f32x4 (&acc)[2][2][4][2], const Unit&, int, int, int, int) const { zero_acc(acc); }
    __device__ __forceinline__ void operator()(const f32x4 (&acc)[2][2][4][2], const Unit& u, int wr, int wc, int fr, int fq) const {
        const int col0 = u.pn * 256 + wc * 32 + 8 * fq;
        const WtBuf bys = wt_buf(YS);
#pragma unroll
        for (int ai = 0; ai < 2; ++ai)
#pragma unroll
            for (int m = 0; m < 4; ++m) {
                const int lr = ai * HALF + wr * 64 + m * 16 + fr;
                if (lr < u.valid) {
#pragma unroll
                    for (int bj = 0; bj < 2; ++bj) {
                        const f32x4 x0 = acc[ai][bj][m][0] * sc, x1 = acc[ai][bj][m][1] * sc;
                        u32x4 w; w.x = cvt_pk_bf16(x0[0], x0[1]); w.y = cvt_pk_bf16(x0[2], x0[3]); w.z = cvt_pk_bf16(x1[0], x1[1]); w.w = cvt_pk_bf16(x1[2], x1[3]);
                        wt_store16(bys, YS, ((size_t)(u.rb + lr) * D + col0 + bj * HALF) * 2, w); }
                }
            }
    }
};
struct EpiNull {
    static constexpr bool AFTER_DRAIN = false;
    float* sink;
    __device__ __forceinline__ void init_acc(f32x4 (&acc)[2][2][4][2], const Unit&, int, int, int, int) const { zero_acc(acc); }
    __device__ __forceinline__ void operator()(const f32x4 (&acc)[2][2][4][2], const Unit& u, int wr, int wc, int fr, int fq) const {
        f32x4 s = (f32x4){0.f, 0.f, 0.f, 0.f};
#pragma unroll
        for (int a = 0; a < 2; ++a)
#pragma unroll
            for (int b = 0; b < 2; ++b)
#pragma unroll
                for (int m = 0; m < 4; ++m)
#pragma unroll
                    for (int n = 0; n < 2; ++n) s += acc[a][b][m][n];
        const float t = (s.x + s.y) + (s.z + s.w);
        if (t == 1.2345678e30f) sink[threadIdx.x] = t;
    }
};
}

struct Args { const float* in[21]; float* out; unsigned char* ws; int ph_lo, ph_hi; };
enum { I_X = 0, I_NMIX, I_WIN, I_CONVW, I_CONVB, I_CONVNG, I_CONVNB, I_SGUNG, I_SGUNB, I_SGUW, I_SGUB, I_WOUT, I_NFFN, I_FWG, I_FWU, I_FWD, I_ROUTER, I_MWG, I_MWU, I_MWD, I_NFINAL };

struct P0Item { const float* W; const float* gain; void* dst; int N, K, c0, k0, f8; };
struct P0Buf { float v[32]; f32x4 g0, g1, g2, g3; };
__device__ __forceinline__ void p0_load(const P0Item& p, int lane, P0Buf& b) {
    const float* s = p.W + (size_t)(p.k0 + (lane >> 5)) * p.N + p.c0 + (lane & 31);
#pragma unroll
    for (int i = 0; i < 32; ++i) b.v[i] = s[(size_t)(2 * i) * p.N];
    const f32x4 one = (f32x4){1.f, 1.f, 1.f, 1.f};
    b.g0 = one; b.g1 = one; b.g2 = one; b.g3 = one;
    if (p.gain) {
        if (p.f8) { const float* gp = p.gain + p.k0 + 16 * (lane & 3); b.g0 = *(const f32x4*)gp; b.g1 = *(const f32x4*)(gp + 4); b.g2 = *(const f32x4*)(gp + 8); b.g3 = *(const f32x4*)(gp + 12); }
        else { const float* gp = p.gain + p.k0 + 8 * (lane & 7); b.g0 = *(const f32x4*)gp; b.g1 = *(const f32x4*)(gp + 4); }
    }
}
__device__ __forceinline__ void p0_finish(const P0Item& p, const P0Buf& b, LAS float* scr, int lane, const int mode = 0) {
    if (mode == 1) { float s = 0.f;
#pragma unroll
        for (int i = 0; i < 32; ++i) s += b.v[i];
        if (s == 1.2345678e30f) *(float*)p.dst = s; return; }
#pragma unroll
    for (int i = 0; i < 32; ++i) scr[(2 * i + (lane >> 5)) * 33 + (lane & 31)] = b.v[i];
    if (!p.f8) {
        const int c = lane & 7;
        const f32x4 g0 = b.g0, g1 = b.g1;
        asm volatile("s_waitcnt lgkmcnt(0)" ::: "memory");
        const WtBuf bd = wt_buf(p.dst);
#pragma unroll
        for (int j = 0; j < 4; ++j) { const int rho = (lane >> 3) + 8 * j; const LAS float* s = scr + (8 * c) * 33 + pg8::perm32(rho);
            u32x4 o; o.x = cvt_pk_bf16(s[0 * 33] * g0.x, s[1 * 33] * g0.y); o.y = cvt_pk_bf16(s[2 * 33] * g0.z, s[3 * 33] * g0.w); o.z = cvt_pk_bf16(s[4 * 33] * g1.x, s[5 * 33] * g1.y); o.w = cvt_pk_bf16(s[6 * 33] * g1.z, s[7 * 33] * g1.w);
            if (mode == 0 || o.x == 0x12345678u) wt_store16(bd, p.dst, ((size_t)rho * p.K + p.k0 + 8 * c) * 2, o); }
    } else {
        const int c4 = lane & 3;
        const f32x4 g[4] = {b.g0 * MOE_SW, b.g1 * MOE_SW, b.g2 * MOE_SW, b.g3 * MOE_SW};
        asm volatile("s_waitcnt lgkmcnt(0)" ::: "memory");
#pragma unroll
        for (int j = 0; j < 2; ++j) { const int rho = (lane >> 2) + 16 * j; const LAS float* s = scr + (16 * c4) * 33 + pg8::perm32(rho);
            u32x4 o;
            o.x = pk_fp8x4(s[0 * 33] * g[0].x, s[1 * 33] * g[0].y, s[2 * 33] * g[0].z, s[3 * 33] * g[0].w);
            o.y = pk_fp8x4(s[4 * 33] * g[1].x, s[5 * 33] * g[1].y, s[6 * 33] * g[1].z, s[7 * 33] * g[1].w);
            o.z = pk_fp8x4(s[8 * 33] * g[2].x, s[9 * 33] * g[2].y, s[10 * 33] * g[2].z, s[11 * 33] * g[2].w);
            o.w = pk_fp8x4(s[12 * 33] * g[3].x, s[13 * 33] * g[3].y, s[14 * 33] * g[3].z, s[15 * 33] * g[3].w);
            if (mode == 0 || o.x == 0x12345678u) *(u32x4*)((unsigned char*)p.dst + (size_t)rho * p.K + p.k0 + 16 * c4) = o; }
    }
    asm volatile("s_waitcnt lgkmcnt(0)" ::: "memory");
}
constexpr int IT_WIN = 16 * 64, IT_WOUT = 16 * 32, IT_GU = 16 * 176, IT_DN = 44 * 32;
constexpr int P0_NITEMS = 2 * IT_WIN + 2 * IT_WOUT + IT_GU + IT_DN;
constexpr int IT_GU8 = 8 * 176, IT_DN8 = 22 * 32, P0_NITEMS8 = NE * (IT_GU8 + IT_DN8);
__device__ __forceinline__ bool p0_decode(const Args& args, int it, P0Item& p) {
    if (it >= P0_NITEMS) return false;
    unsigned char* ws = args.ws; int r = it;
    if (r < 2 * IT_WIN) { const int l = r / IT_WIN; r -= l * IT_WIN; const int kb = r / 64, g32 = r % 64, Lb = 32 * g32;
        p.c0 = Lb < 1024 ? ((Lb >> 7) & 1) * 512 + (Lb >> 8) * 128 + (Lb & 127) : Lb;
        p.W = args.in[I_WIN] + (size_t)l * D * DIN; p.N = DIN; p.K = D; p.gain = args.in[I_NMIX] + l * D; p.dst = (bf16_t*)(ws + WS_WIN) + ((size_t)l * DIN + Lb) * D; p.k0 = 64 * kb; p.f8 = 0; return true; }
    r -= 2 * IT_WIN;
    if (r < 2 * IT_WOUT) { const int l = r / IT_WOUT; r -= l * IT_WOUT; const int kb = r / 32, g32 = r % 32, Lb = 32 * g32;
        p.c0 = Lb; p.W = args.in[I_WOUT] + (size_t)l * D * D; p.N = D; p.K = D; p.gain = nullptr; p.dst = (bf16_t*)(ws + WS_WOUT) + ((size_t)l * D + Lb) * D; p.k0 = 64 * kb; p.f8 = 0; return true; }
    r -= 2 * IT_WOUT;
    if (r < IT_GU) { const int kb = r / 176, g32 = r % 176, Lb = 32 * g32; const int kind = (Lb >> 7) & 1;
        p.c0 = (Lb >> 8) * 128 + (Lb & 127); p.W = args.in[kind ? I_FWU : I_FWG]; p.N = FF; p.K = D; p.gain = args.in[I_NFFN]; p.dst = (unsigned char*)(ws + WS_FGU) + (size_t)Lb * D * (DENSE_FP8 ? 1 : 2); p.k0 = 64 * kb; p.f8 = DENSE_FP8; return true; }
    r -= IT_GU;
    if (r < IT_DN) { const int kb = r / 32, g32 = r % 32, Lb = 32 * g32;
        p.c0 = Lb; p.W = args.in[I_FWD]; p.N = D; p.K = FF; p.gain = nullptr; p.dst = (unsigned char*)(ws + WS_FD) + (size_t)Lb * FF * (DENSE_FP8 ? 1 : 2); p.k0 = 64 * kb; p.f8 = DENSE_FP8; return true; }
    return false;
}
struct P8Buf { float v[64]; };
__device__ __forceinline__ bool p8_decode(const Args& args, int it, P0Item& p) {
    if (it >= P0_NITEMS8) return false;
    unsigned char* ws = args.ws; int r = it; p.f8 = 1;
    if (r < NE * IT_GU8) { const int e = r / IT_GU8; r -= e * IT_GU8; const int kb = r / 176, g32 = r % 176, Lb = 32 * g32; const int kind = (Lb >> 7) & 1;
        p.c0 = (Lb >> 8) * 128 + (Lb & 127); p.W = args.in[kind ? I_MWU : I_MWG] + (size_t)e * D * FF; p.N = FF; p.K = D; p.gain = args.in[I_NFFN] + D; p.dst = (unsigned char*)(ws + WS_MGU) + ((size_t)e * NFF2 + Lb) * D; p.k0 = 128 * kb; return true; }
    r -= NE * IT_GU8;
    { const int e = r / IT_DN8; r -= e * IT_DN8; const int kb = r / 32, g32 = r % 32, Lb = 32 * g32;
        p.c0 = Lb; p.W = args.in[I_MWD] + (size_t)e * FF * D; p.N = D; p.K = FF; p.gain = nullptr; p.dst = (unsigned char*)(ws + WS_MD) + ((size_t)e * D + Lb) * FF; p.k0 = 128 * kb; return true; }
}
__device__ __forceinline__ void p8_load(const P0Item& p, int lane, P8Buf& b) {
    const float* s = p.W + (size_t)(p.k0 + (lane >> 5)) * p.N + p.c0 + (lane & 31);
#pragma unroll
    for (int i = 0; i < 64; ++i) b.v[i] = s[(size_t)(2 * i) * p.N];
}
__device__ __forceinline__ void p8_finish(const P0Item& p, const P8Buf& b, LAS float* scr, int lane) {
    const int c8 = lane & 7;
    const f32x4 sw = (f32x4){MOE_SW, MOE_SW, MOE_SW, MOE_SW};
    f32x4 g[4] = {sw, sw, sw, sw};
    if (p.gain) { const float* gp = p.gain + p.k0 + 16 * c8; g[0] = *(const f32x4*)gp * MOE_SW; g[1] = *(const f32x4*)(gp + 4) * MOE_SW; g[2] = *(const f32x4*)(gp + 8) * MOE_SW; g[3] = *(const f32x4*)(gp + 12) * MOE_SW; }
#pragma unroll
    for (int i = 0; i < 64; ++i) scr[(2 * i + (lane >> 5)) * 33 + (lane & 31)] = b.v[i];
    asm volatile("s_waitcnt lgkmcnt(0)" ::: "memory");
#pragma unroll
    for (int j = 0; j < 4; ++j) { const int rho = (lane >> 3) + 8 * j; const LAS float* s = scr + (16 * c8) * 33 + pg8::perm32(rho);
        u32x4 o;
        o.x = pk_fp8x4(s[0 * 33] * g[0].x, s[1 * 33] * g[0].y, s[2 * 33] * g[0].z, s[3 * 33] * g[0].w);
        o.y = pk_fp8x4(s[4 * 33] * g[1].x, s[5 * 33] * g[1].y, s[6 * 33] * g[1].z, s[7 * 33] * g[1].w);
        o.z = pk_fp8x4(s[8 * 33] * g[2].x, s[9 * 33] * g[2].y, s[10 * 33] * g[2].z, s[11 * 33] * g[2].w);
        o.w = pk_fp8x4(s[12 * 33] * g[3].x, s[13 * 33] * g[3].y, s[14 * 33] * g[3].z, s[15 * 33] * g[3].w);
        *(u32x4*)((unsigned char*)p.dst + (size_t)rho * p.K + p.k0 + 16 * c8) = o; }
    asm volatile("s_waitcnt lgkmcnt(0)" ::: "memory");
}
struct PXBuf { f32x4 v[4][4]; };
__device__ __forceinline__ void px_load(const Args& args, int it, int lane, PXBuf& b) {
#pragma unroll
    for (int k = 0; k < 4; ++k) { const f32x4* xr = (const f32x4*)(args.in[I_X] + (size_t)(4 * it + k) * D) + lane;
#pragma unroll
        for (int j = 0; j < 4; ++j) b.v[k][j] = xr[64 * j]; }
}
__device__ __forceinline__ void px_finish(const Args& args, int it, int lane, const PXBuf& b) {
    bf16_t* XB = (bf16_t*)(args.ws + WS_XB); float* rss = (float*)(args.ws + WS_RSS);
#pragma unroll
    for (int k = 0; k < 4; ++k) { const int m = 4 * it + k; float s = 0.f;
#pragma unroll
        for (int j = 0; j < 4; ++j) s += (b.v[k][j].x * b.v[k][j].x + b.v[k][j].y * b.v[k][j].y) + (b.v[k][j].z * b.v[k][j].z + b.v[k][j].w * b.v[k][j].w);
        s = row16_allsum(s); s += __shfl_xor(s, 16); s += __shfl_xor(s, 32);
        u32x2* o8 = (u32x2*)(XB + (size_t)m * D) + lane;
#pragma unroll
        for (int j = 0; j < 4; ++j) { u32x2 w; w.x = cvt_pk_bf16(b.v[k][j].x, b.v[k][j].y); w.y = cvt_pk_bf16(b.v[k][j].z, b.v[k][j].w); o8[64 * j] = w; }
        if (lane < 4) rss[(size_t)m * 4 + lane] = lane == 0 ? s : 0.f; }
}
constexpr int CW_Q = 9216;
static_assert(P0_NITEMS % 8 == 0 && P0_NITEMS8 % 8 == 0 && T % 32 == 0 && (CW_Q + 3 * 64) * 4 <= (int)CTL_ZERO_BYTES, "prologue tasks");
#define P0_DYN(NTASKS, CTR, BUFT, LOADSTMT, FINSTMT) do { \
        BUFT ba, bb; LAS int* slot = (LAS int*)(lds + LDSCTL_OFF + 192); \
        if (threadIdx.x == 0) { slot[0] = (int)__hip_atomic_fetch_add((CTR), 1u, RLX_AGENT); slot[1] = (int)__hip_atomic_fetch_add((CTR), 1u, RLX_AGENT); } \
        __syncthreads(); int t0 = slot[0], t1 = slot[1]; __syncthreads(); \
        if (t0 < (NTASKS)) { const int it = t0 * 8 + wave; BUFT& b = ba; LOADSTMT; } \
        while (t0 < (NTASKS)) { \
            unsigned tk = 0; if (threadIdx.x == 0) tk = __hip_atomic_fetch_add((CTR), 1u, RLX_AGENT); \
            if (t1 < (NTASKS)) { const int it = t1 * 8 + wave; BUFT& b = bb; LOADSTMT; } \
            { const int it = t0 * 8 + wave; BUFT& b = ba; FINSTMT; } \
            if (threadIdx.x == 0) slot[0] = (int)tk; __syncthreads(); const int t2 = slot[0]; \
            if (t1 >= (NTASKS)) break; \
            if (threadIdx.x == 0) tk = __hip_atomic_fetch_add((CTR), 1u, RLX_AGENT); \
            if (t2 < (NTASKS)) { const int it = t2 * 8 + wave; BUFT& b = ba; LOADSTMT; } \
            { const int it = t1 * 8 + wave; BUFT& b = bb; FINSTMT; } \
            if (threadIdx.x == 0) slot[1] = (int)tk; __syncthreads(); const int t3 = slot[1]; \
            t0 = t2; t1 = t3; } \
        __syncthreads(); } while (0)
__device__ __forceinline__ void prologue_phase(const Args& args, LAS unsigned char* lds, int gw, int NGW, int lane, int wave) {
    unsigned char* ws = args.ws; unsigned* ctl = (unsigned*)(ws + WS_CTL);
    LAS float* scr = (LAS float*)(lds + (wave < 7 ? wave * 16896 : TOKTAB_OFF));
    static_assert(7 * 16896 <= LDSCTL_OFF && TOKTAB_OFF + 16896 <= LDS_BYTES, "prologue scratch");
    P0_DYN(P0_NITEMS8 / 8, ctl + CW_Q, P8Buf, { P0Item p; p8_decode(args, it, p); p8_load(p, lane, b); }, { P0Item p; p8_decode(args, it, p); p8_finish(p, b, scr, lane); });
    P0_DYN(P0_NITEMS / 8, ctl + CW_Q + 64, P0Buf, { P0Item p; p0_decode(args, it, p); p0_load(p, lane, b); }, { P0Item p; p0_decode(args, it, p); p0_finish(p, b, scr, lane); });
    P0_DYN(T / 32, ctl + CW_Q + 128, PXBuf, { px_load(args, it, lane, b); }, { px_finish(args, it, lane, b); });
    { float* RT = (float*)(ws + WS_RT); const float* rt = args.in[I_ROUTER]; const float* g = args.in[I_NFFN] + D;
      for (int i = gw * 64 + lane; i < NE * D; i += NGW * 64) { const int e = i / D, k = i % D; RT[i] = rt[k * NE + e] * g[k]; } }
    { bf16_t* SW = (bf16_t*)(ws + WS_SGUW); const float* sw = args.in[I_SGUW];
      for (int i = gw * 64 + lane; i < 2 * 4 * 128 * 128 / 2; i += NGW * 64) { const int e0 = 2 * i, tt = (e0 >> 7) & 127, s0 = e0 & 127;
          const float a = s0 <= tt ? sw[e0] : 0.f, b = (s0 + 1) <= tt ? sw[e0 + 1] : 0.f; ((unsigned*)SW)[i] = cvt_pk_bf16(a, b); } }
}

__device__ __forceinline__ void mid_phase(const Args& args, LAS unsigned char* lds, int l, int gw, int NGW, int lane, int wave, const int parts = 3) {
    unsigned char* ws = args.ws;
    const bf16_t* CG = (const bf16_t*)(ws + WS_CG); const bf16_t* UA = (const bf16_t*)(ws + WS_UA); const bf16_t* VA = (const bf16_t*)(ws + WS_VA); bf16_t* Y = (bf16_t*)(ws + WS_Y);
    const int fr = lane & 15, fq = lane >> 4;
    if (parts & 1) {
        constexpr int VST = 264;
        const bf16_t* Wb = (const bf16_t*)(ws + WS_SGUW) + (size_t)l * 4 * 128 * 128;
        const float* ng = args.in[I_SGUNG] + l * CC; const float* nb = args.in[I_SGUNB] + l * CC; const float* sb = args.in[I_SGUB] + l * 4 * 128;
        for (int unit = blockIdx.x; unit < NB * 16 * 4; unit += gridDim.x) {
            const int b = unit >> 6, n = (unit >> 2) & 15, h = unit & 3; const int R0 = b * SEQ + n * 128;
            const f32x2 gg = *(const f32x2*)(ng + h * 128 + 2 * lane), bb = *(const f32x2*)(nb + h * 128 + 2 * lane);
            unsigned pv[16];
#pragma unroll
            for (int rr = 0; rr < 16; ++rr) pv[rr] = *(const unsigned*)(VA + (size_t)(R0 + wave * 16 + rr) * CC + h * 128 + 2 * lane);
            const int nks = ((16 * wave + 15) >> 5) + 1;
            bf16x8 bfrag[4];
#pragma unroll
            for (int ks = 0; ks < 4; ++ks) if (ks < nks) bfrag[ks] = *(const bf16x8*)(Wb + (size_t)h * 16384 + (16 * wave + fr) * 128 + 32 * ks + 8 * fq);
            float s1[16], s2[16];
#pragma unroll
            for (int rr = 0; rr < 16; ++rr) { const float v0 = bf_lo(pv[rr]), v1 = bf_hi(pv[rr]); s1[rr] = v0 + v1; s2[rr] = v0 * v0 + v1 * v1; }
#pragma unroll
            for (int rr = 0; rr < 16; ++rr) { s1[rr] = row16_allsum(s1[rr]); s2[rr] = row16_allsum(s2[rr]); }
#pragma unroll
            for (int rr = 0; rr < 16; ++rr) { s1[rr] += __shfl_xor(s1[rr], 16); s2[rr] += __shfl_xor(s2[rr], 16); }
#pragma unroll
            for (int rr = 0; rr < 16; ++rr) { s1[rr] += __shfl_xor(s1[rr], 32); s2[rr] += __shfl_xor(s2[rr], 32); }
#pragma unroll
            for (int rp = 0; rp < 8; ++rp) {
                float y[2][2];
#pragma unroll
                for (int q = 0; q < 2; ++q) { const int rr = 2 * rp + q; const float mean = s1[rr] * (1.0f / 128.0f); const float var = fmaxf(s2[rr] * (1.0f / 128.0f) - mean * mean, 0.f);
                    const float rstd = 1.0f / sqrtf(var + EPS); y[q][0] = (bf_lo(pv[rr]) - mean) * rstd * gg.x + bb.x; y[q][1] = (bf_hi(pv[rr]) - mean) * rstd * gg.y + bb.y; }
                const int s = wave * 16 + 2 * rp;
                *(LAS unsigned*)(lds + (2 * lane) * VST + s * 2) = cvt_pk_bf16(y[0][0], y[1][0]);
                *(LAS unsigned*)(lds + (2 * lane + 1) * VST + s * 2) = cvt_pk_bf16(y[0][1], y[1][1]);
            }
            const int t = 16 * wave + fr; const size_t row = (size_t)(R0 + t);
            u32x2 uu[8];
#pragma unroll
            for (int db = 0; db < 8; ++db) uu[db] = *(const u32x2*)(UA + row * CC + h * 128 + 16 * db + 4 * fq);
            const float bias = sb[h * 128 + t];
            __syncthreads();
            f32x4 acc[8];
#pragma unroll
            for (int db = 0; db < 8; ++db) acc[db] = (f32x4){0.f, 0.f, 0.f, 0.f};
#pragma unroll
            for (int ks = 0; ks < 4; ++ks) if (ks < nks) {
#pragma unroll
                for (int db = 0; db < 8; ++db) {
                    const LAS unsigned char* ap = lds + (16 * db + fr) * VST + (32 * ks + 8 * fq) * 2;
                    union { bf16x8 v; u32x2 h[2]; } af; af.h[0] = *(const LAS u32x2*)ap; af.h[1] = *(const LAS u32x2*)(ap + 8);
                    acc[db] = __builtin_amdgcn_mfma_f32_16x16x32_bf16(af.v, bfrag[ks], acc[db], 0, 0, 0);
                }
            }
#pragma unroll
            for (int db = 0; db < 8; ++db) { const int d = 16 * db + 4 * fq;
                const float o0 = bf_lo(uu[db].x) * (acc[db][0] + bias), o1 = bf_hi(uu[db].x) * (acc[db][1] + bias), o2 = bf_lo(uu[db].y) * (acc[db][2] + bias), o3 = bf_hi(uu[db].y) * (acc[db][3] + bias);
                u32x2 w; w.x = cvt_pk_bf16(o0, o1); w.y = cvt_pk_bf16(o2, o3);
                *(u32x2*)(Y + row * D + CC + h * 128 + d) = w; }
            __syncthreads();
        }
    }
    if (parts & 2) {
        typedef __bf16 bf2_t __attribute__((ext_vector_type(2)));
        const int cg = gw & 3, ch = cg * 128 + 2 * lane;
        const float* cwp = args.in[I_CONVW] + (size_t)l * CW * CC + ch;
        unsigned Wa0[16], Wa1[16], Wb0[16], Wb1[16];
        {
            f32x2 wf[32];
#pragma unroll
            for (int j = 0; j < CW; ++j) wf[j] = *(const f32x2*)(cwp + j * CC);
            wf[31] = (f32x2){0.f, 0.f};
#pragma unroll
            for (int k = 0; k < 16; ++k) { Wa0[k] = cvt_pk_bf16(wf[2 * k].x, wf[2 * k + 1].x); Wa1[k] = cvt_pk_bf16(wf[2 * k].y, wf[2 * k + 1].y); }
            Wb0[0] = cvt_pk_bf16(0.f, wf[0].x); Wb1[0] = cvt_pk_bf16(0.f, wf[0].y);
#pragma unroll
            for (int k = 0; k < 15; ++k) { Wb0[k + 1] = cvt_pk_bf16(wf[2 * k + 1].x, wf[2 * k + 2].x); Wb1[k + 1] = cvt_pk_bf16(wf[2 * k + 1].y, wf[2 * k + 2].y); }
        }
        const f32x2 cb = *(const f32x2*)(args.in[I_CONVB] + l * CC + ch), ng = *(const f32x2*)(args.in[I_CONVNG] + l * CC + ch), nb = *(const f32x2*)(args.in[I_CONVNB] + l * CC + ch);
        for (int item = gw >> 2; item < NB * (SEQ / 32); item += NGW >> 2) {
            const int b = item >> 6, t0 = (item & 63) * 32; const size_t rowb = (size_t)b * SEQ;
            unsigned P0[31], P1[31];
#pragma unroll
            for (int k = 0; k < 31; ++k) { const int ta = t0 - 30 + 2 * k;
                const unsigned xa = ta >= 0 ? *(const unsigned*)(CG + (rowb + ta) * CC + ch) : 0u, xb = ta >= 0 ? *(const unsigned*)(CG + (rowb + ta + 1) * CC + ch) : 0u;
                P0[k] = __builtin_amdgcn_perm(xb, xa, 0x05040100u); P1[k] = __builtin_amdgcn_perm(xb, xa, 0x07060302u); }
#pragma unroll
            for (int hf = 0; hf < 2; ++hf) {
                float a0[16], a1[16];
#pragma unroll
                for (int tt = 0; tt < 16; ++tt) {
                    const int t = 16 * hf + tt; float s0 = cb.x, s1 = cb.y;
                    if ((t & 1) == 0) {
#pragma unroll
                        for (int k = 0; k < 16; ++k) { s0 = __builtin_amdgcn_fdot2_f32_bf16(__builtin_bit_cast(bf2_t, P0[t / 2 + k]), __builtin_bit_cast(bf2_t, Wa0[k]), s0, false);
                                                       s1 = __builtin_amdgcn_fdot2_f32_bf16(__builtin_bit_cast(bf2_t, P1[t / 2 + k]), __builtin_bit_cast(bf2_t, Wa1[k]), s1, false); }
                    } else {
#pragma unroll
                        for (int k = 0; k < 16; ++k) { s0 = __builtin_amdgcn_fdot2_f32_bf16(__builtin_bit_cast(bf2_t, P0[(t - 1) / 2 + k]), __builtin_bit_cast(bf2_t, Wb0[k]), s0, false);
                                                       s1 = __builtin_amdgcn_fdot2_f32_bf16(__builtin_bit_cast(bf2_t, P1[(t - 1) / 2 + k]), __builtin_bit_cast(bf2_t, Wb1[k]), s1, false); }
                    }
                    a0[tt] = s0; a1[tt] = s1;
                }
                float s1[16], s2[16];
#pragma unroll
                for (int tt = 0; tt < 16; ++tt) { s1[tt] = row16_allsum(a0[tt] + a1[tt]); s2[tt] = row16_allsum(a0[tt] * a0[tt] + a1[tt] * a1[tt]); }
#pragma unroll
                for (int tt = 0; tt < 16; ++tt) { s1[tt] += __shfl_xor(s1[tt], 16); s2[tt] += __shfl_xor(s2[tt], 16); }
#pragma unroll
                for (int tt = 0; tt < 16; ++tt) {
                    const float mean = s1[tt] * (1.0f / 64.0f); const float var = fmaxf(s2[tt] * (1.0f / 64.0f) - mean * mean, 0.f);
                    const float rstd = 1.0f / sqrtf(var + EPS);
                    const float y0 = (a0[tt] - mean) * rstd * ng.x + nb.x, y1 = (a1[tt] - mean) * rstd * ng.y + nb.y;
                    *(unsigned*)(Y + (rowb + t0 + 16 * hf + tt) * D + ch) = cvt_pk_bf16(y0 * fast_sigmoid(y0), y1 * fast_sigmoid(y1));
                }
            }
        }
    }
}

__device__ __forceinline__ void router_phase(const Args& args, LAS unsigned char* lds, int lane, int wave) {
    unsigned char* ws = args.ws;
    const bf16_t* XB = (const bf16_t*)(ws + WS_XB); const float* RT = (const float*)(ws + WS_RT); const float* rss = (const float*)(ws + WS_RSS) + (size_t)3 * T * 4;
    int* toklist = (int*)(ws + WS_TOKLIST); u32x4* tokinfo = (u32x4*)(ws + WS_TOKINFO); unsigned* cntw = (unsigned*)(ws + WS_CTL) + CW_CNT;
    LAS int* wcnt = (LAS int*)lds;
    LAS int* wbase = (LAS int*)(lds + 256);
    LAS float* rwl = (LAS float*)(lds + 1024);
    for (int i = threadIdx.x; i < NE * D / 4; i += NWAVES * 64) *(LAS f32x4*)(rwl + 4 * i) = *(const f32x4*)(RT + 4 * i);
    __syncthreads();
    for (int blk = blockIdx.x; blk < T / 64; blk += gridDim.x) {
        int my_e0 = 0, my_e1 = 0; float my_g0 = 0.f, my_g1 = 0.f;
        const int tbase = blk * 64 + wave * 8;
#pragma unroll 1
        for (int jb = 0; jb < 2; ++jb) {
            u32x4 xv[4][2]; float pr[4];
#pragma unroll
            for (int j = 0; j < 4; ++j) { const int t = tbase + 4 * jb + j;
                xv[j][0] = *(const u32x4*)(XB + (size_t)t * D + 8 * lane); xv[j][1] = *(const u32x4*)(XB + (size_t)t * D + 512 + 8 * lane);
                pr[j] = rss[(size_t)t * 4 + (lane & 3)]; }
            float xf[4][16];
#pragma unroll
            for (int j = 0; j < 4; ++j)
#pragma unroll
                for (int i = 0; i < 2; ++i) { const u32x4 v = xv[j][i];
                    xf[j][8 * i + 0] = bf_lo(v.x); xf[j][8 * i + 1] = bf_hi(v.x); xf[j][8 * i + 2] = bf_lo(v.y); xf[j][8 * i + 3] = bf_hi(v.y); xf[j][8 * i + 4] = bf_lo(v.z); xf[j][8 * i + 5] = bf_hi(v.z); xf[j][8 * i + 6] = bf_lo(v.w); xf[j][8 * i + 7] = bf_hi(v.w); }
            float a[4][NE];
#pragma unroll
            for (int e = 0; e < NE; ++e) {
                f32x4 w[4];
#pragma unroll
                for (int i = 0; i < 2; ++i) { w[2 * i] = *(const LAS f32x4*)(rwl + e * D + 512 * i + 8 * lane); w[2 * i + 1] = *(const LAS f32x4*)(rwl + e * D + 512 * i + 8 * lane + 4); }
#pragma unroll
                for (int j = 0; j < 4; ++j) { float s = 0.f;
#pragma unroll
                    for (int q = 0; q < 4; ++q) s += (xf[j][4 * q] * w[q].x + xf[j][4 * q + 1] * w[q].y) + (xf[j][4 * q + 2] * w[q].z + xf[j][4 * q + 3] * w[q].w);
                    a[j][e] = s; }
                __builtin_amdgcn_sched_barrier(0);
            }
#pragma unroll
            for (int j = 0; j < 4; ++j)
#pragma unroll
                for (int e = 0; e < NE; ++e) a[j][e] = row16_allsum(a[j][e]);
#pragma unroll
            for (int j = 0; j < 4; ++j)
#pragma unroll
                for (int e = 0; e < NE; ++e) a[j][e] += __shfl_xor(a[j][e], 16);
#pragma unroll
            for (int j = 0; j < 4; ++j)
#pragma unroll
                for (int e = 0; e < NE; ++e) a[j][e] += __shfl_xor(a[j][e], 32);
#pragma unroll
            for (int j = 0; j < 4; ++j) {
                float p = pr[j]; p = dpp_add(p, 0); p = dpp_add(p, 1);
                const float rstd = 1.0f / sqrtf(p * (1.0f / D) + EPS);
                int e0 = 0; float l0 = a[j][0] * rstd;
#pragma unroll
                for (int e = 1; e < NE; ++e) { const float le = a[j][e] * rstd; if (le > l0) { l0 = le; e0 = e; } }
                int e1 = -1; float l1 = -3.0e38f;
#pragma unroll
                for (int e = 0; e < NE; ++e) { const float le = a[j][e] * rstd; if (e != e0 && le > l1) { l1 = le; e1 = e; } }
                const float g0 = 1.0f / (1.0f + __expf(l1 - l0)), g1 = 1.0f - g0;
                if (lane == 4 * jb + j) { my_e0 = e0; my_e1 = e1; my_g0 = g0; my_g1 = g1; }
            }
        }
        const bool act = lane < 8;
        unsigned long long m0[NE], m1[NE];
#pragma unroll
        for (int e = 0; e < NE; ++e) { m0[e] = __ballot(act && my_e0 == e); m1[e] = __ballot(act && my_e1 == e); }
        if (lane < NE) { int c = 0;
#pragma unroll
            for (int e = 0; e < NE; ++e) if (lane == e) c = __popcll(m0[e]) + __popcll(m1[e]);
            wcnt[wave * 8 + lane] = c; }
        __syncthreads();
        if (threadIdx.x < NE) { const int e = threadIdx.x; int tot = 0; int pre[8];
#pragma unroll
            for (int w = 0; w < 8; ++w) { pre[w] = tot; tot += wcnt[w * 8 + e]; }
            const int base = (int)__hip_atomic_fetch_add(cntw + 64 * e, (unsigned)tot, RLX_AGENT);
#pragma unroll
            for (int w = 0; w < 8; ++w) wbase[w * 8 + e] = base + pre[w]; }
        __syncthreads();
        if (act) {
            const unsigned long long lt = (1ull << lane) - 1ull;
            int pos0 = 0, pos1 = 0;
#pragma unroll
            for (int e = 0; e < NE; ++e) { const int wb = wbase[wave * 8 + e];
                if (my_e0 == e) pos0 = wb + __popcll(m0[e] & lt);
                if (my_e1 == e) pos1 = wb + __popcll(m0[e]) + __popcll(m1[e] & lt); }
            const int t = tbase + lane;
            toklist[my_e0 * T + pos0] = t; toklist[my_e1 * T + pos1] = t;
            u32x4 inf; inf.x = ((unsigned)my_e0 << 16) | (unsigned)pos0; inf.y = ((unsigned)my_e1 << 16) | (unsigned)pos1; inf.z = __float_as_uint(my_g0); inf.w = __float_as_uint(my_g1);
            tokinfo[t] = inf;
        }
        __syncthreads();
    }
}
__device__ __forceinline__ void moe_tab_build(const unsigned char* ws, LAS int* tab) {
    if (threadIdx.x == 0) {
        unsigned* cntw = (unsigned*)(ws + WS_CTL) + CW_CNT; int b = 0, p = 0;
        for (int e = 0; e < NE; ++e) { const int c = (int)__hip_atomic_load(cntw + 64 * e, RLX_AGENT); tab[e] = c; tab[8 + e] = b; tab[16 + e] = p; b += c; p += (c + 255) >> 8; }
        tab[24] = p;
    }
    __syncthreads();
}

__device__ __forceinline__ void final_phase(const Args& args, const LAS int* tab, int gw, int NGW, int lane) {
    unsigned char* ws = args.ws; float* out = args.out; const bf16_t* YS = (const bf16_t*)(ws + WS_YS); const u32x4* tokinfo = (const u32x4*)(ws + WS_TOKINFO);
    f32x4 gn[4];
#pragma unroll
    for (int j = 0; j < 4; ++j) gn[j] = *((const f32x4*)args.in[I_NFINAL] + lane + 64 * j);
    for (int tb = gw; tb < T; tb += 4 * NGW) {
        f32x4 xv[4][4]; u32x2 ya[4][4], yb[4][4]; float g0[4], g1[4];
#pragma unroll
        for (int k = 0; k < 4; ++k) { const int t = tb + k * NGW; if (t < T) {
            const u32x4 inf = tokinfo[t];
            const int e0 = __builtin_amdgcn_readfirstlane((int)(inf.x >> 16)), p0 = __builtin_amdgcn_readfirstlane((int)(inf.x & 0xffffu)), e1 = __builtin_amdgcn_readfirstlane((int)(inf.y >> 16)), p1 = __builtin_amdgcn_readfirstlane((int)(inf.y & 0xffffu));
            g0[k] = __uint_as_float(inf.z); g1[k] = __uint_as_float(inf.w);
            const int b0 = __builtin_amdgcn_readfirstlane(tab[8 + e0]), b1 = __builtin_amdgcn_readfirstlane(tab[8 + e1]);
            const f32x4* xr = (const f32x4*)(out + (size_t)t * D) + lane; const u32x2* y0 = (const u32x2*)(YS + (size_t)(b0 + p0) * D) + lane; const u32x2* y1 = (const u32x2*)(YS + (size_t)(b1 + p1) * D) + lane;
#pragma unroll
            for (int j = 0; j < 4; ++j) { xv[k][j] = xr[64 * j]; ya[k][j] = y0[64 * j]; yb[k][j] = y1[64 * j]; } } }
#pragma unroll
        for (int k = 0; k < 4; ++k) { const int t = tb + k * NGW; if (t < T) {
            f32x4 v[4]; float ss = 0.f;
#pragma unroll
            for (int j = 0; j < 4; ++j) { const f32x4 x = xv[k][j]; const u32x2 a = ya[k][j], b = yb[k][j];
                v[j].x = x.x + g0[k] * bf_lo(a.x) + g1[k] * bf_lo(b.x); v[j].y = x.y + g0[k] * bf_hi(a.x) + g1[k] * bf_hi(b.x); v[j].z = x.z + g0[k] * bf_lo(a.y) + g1[k] * bf_lo(b.y); v[j].w = x.w + g0[k] * bf_hi(a.y) + g1[k] * bf_hi(b.y);
                ss += (v[j].x * v[j].x + v[j].y * v[j].y) + (v[j].z * v[j].z + v[j].w * v[j].w); }
            ss = row16_allsum(ss); ss += __shfl_xor(ss, 16); ss += __shfl_xor(ss, 32);
            const float rstd = 1.0f / sqrtf(ss * (1.0f / D) + EPS);
            f32x4* xo = (f32x4*)(out + (size_t)t * D) + lane;
#pragma unroll
            for (int j = 0; j < 4; ++j) xo[64 * j] = v[j] * rstd * gn[j]; } }
    }
}

template <bool MOE, class Sched>
__device__ __forceinline__ void fill_unit_tables(const Sched& S, const float* rss, const int* toklist, float pre, LAS unsigned char* lds) {
    LAS int* tt = (LAS int*)(lds + TOKTAB_OFF); LAS float* rt = (LAS float*)(lds + RSTAB_OFF);
    const int lr = threadIdx.x & 255, par = threadIdx.x >> 8;
    int srow[MAXU / 2]; bool have[MAXU / 2];
#pragma unroll
    for (int k = 0; k < MAXU / 2; ++k) { pg8::Unit u; have[k] = S.next(2 * k + par, u); srow[k] = 0;
        if (have[k]) { if (MOE) { if (lr < u.valid) srow[k] = toklist[u.e * T + u.pm * 256 + lr]; } else srow[k] = u.rb + lr; } }
    f32x4 p[MAXU / 2];
#pragma unroll
    for (int k = 0; k < MAXU / 2; ++k) p[k] = have[k] ? *(const f32x4*)(rss + (size_t)srow[k] * 4) : (f32x4){0.f, 0.f, 0.f, 0.f};
#pragma unroll
    for (int k = 0; k < MAXU / 2; ++k) if (have[k]) { const int i = 2 * k + par; if (MOE) tt[i * 256 + lr] = srow[k];
        rt[i * 256 + lr] = pre / sqrtf(((p[k].x + p[k].y) + (p[k].z + p[k].w)) * (1.0f / D) + EPS); }
    __syncthreads();
}

__global__ void __launch_bounds__(NWAVES * 64, 2) mega_fwd(Args args) {
    extern __shared__ __attribute__((aligned(16))) unsigned char lds_raw[];
    LAS unsigned char* lds = (LAS unsigned char*)lds_raw;
    const int tid = threadIdx.x, lane = tid & 63, wave = __builtin_amdgcn_readfirstlane(tid >> 6);
    const int G = gridDim.x, bx = blockIdx.x;
    const int vcu = (G % 8 == 0) ? (bx % 8) * (G / 8) + bx / 8 : bx;
    const int gw = vcu * NWAVES + wave, NGW = G * NWAVES;
    unsigned char* ws = args.ws;
    unsigned* ctl = (unsigned*)(ws + WS_CTL);
    for (int u = tid; u < 512 / 4; u += NWAVES * 64) ((LAS unsigned*)(lds + LDSCTL_OFF))[u] = 0u;
    __syncthreads();
    XcdBarrier bar; bar.bar = ctl + CW_BAR; bar.x = 0; bar.st = nullptr;
    if (MK_N_LAUNCHES == 1) bar = xcd_barrier_post(ctl + CW_BAR, (volatile LAS unsigned*)(lds + LDSCTL_OFF) + 8);
    const int lo = args.ph_lo, hi = args.ph_hi;
#ifndef PHMASK
#define PHMASK 0xFFFF
#endif
#define IN(k) ((((PHMASK) >> (k)) & 1) && lo <= (k) && (k) < hi)
#ifndef DUP_PHASE
#define DUP_PHASE -1
#endif
#define REP(k) for (int rep_ = 0; rep_ < ((DUP_PHASE) == (k) ? 2 : 1); ++rep_)
#define SEAM(k) do { if (MK_N_LAUNCHES == 1 && IN((k) + 1)) xcd_barrier(bar); if (PROBE_TIME == (k)) pt1 = wall_clock64(); } while (0)
    unsigned long long pt0 = 0, pt1 = 0;
#define PT(k) do { if (PROBE_TIME == (k)) pt0 = wall_clock64(); } while (0)
    float* rss = (float*)(ws + WS_RSS);
    bf16_t* XB = (bf16_t*)(ws + WS_XB);

    PT(0); if (IN(0)) { REP(0) prologue_phase(args, lds, gw, NGW, lane, wave); SEAM(0); }

#ifndef MOE_FP8
#define MOE_FP8 1
#endif
    constexpr bool MF8 = (MOE_FP8 != 0); constexpr int MES = MF8 ? 1 : 2; constexpr bool DF8 = (DENSE_FP8 != 0); constexpr int DES = DF8 ? 1 : 2;
#define LAYER_MIX(l, pb) \
    PT(pb); if (IN(pb)) {       \
        pg8::DenseSched S; S.A = (const char*)XB; S.Bt = (const char*)(ws + WS_WIN) + (size_t)(l) * DIN * D * 2; S.KB = D * 2; S.so.init(T / 256, DIN / 256, G, bx); \
        fill_unit_tables<false>(S, rss + (size_t)(2 * (l)) * T * 4, nullptr, 1.0f, lds); \
        pg8::EpiMix E{(bf16_t*)(ws + WS_CG), (bf16_t*)(ws + WS_UA), (bf16_t*)(ws + WS_VA), (const LAS float*)(lds + RSTAB_OFF)}; \
        REP(pb) pg8::gemm_phase<pg8::EpiMix, pg8::DenseSched, true, false>(lds, D * 2, S, E); \
        SEAM(pb); \
    } \
    PT((pb) + 1); if (IN((pb) + 1)) { if (PROBE_MID != 0 && (l) == 0) mid_phase(args, lds, (l), gw, NGW, lane, wave, PROBE_MID); REP((pb) + 1) mid_phase(args, lds, (l), gw, NGW, lane, wave); SEAM((pb) + 1); } \
    PT((pb) + 2); if (IN((pb) + 2)) {       \
        pg8::DenseSched S; S.A = (const char*)(ws + WS_Y); S.Bt = (const char*)(ws + WS_WOUT) + (size_t)(l) * D * D * 2; S.KB = D * 2; S.so.init(T / 256, D / 256, G, bx); \
        pg8::EpiRes E{(l) == 0 ? args.in[I_X] : args.out, args.out, XB, rss + (size_t)(2 * (l) + 1) * T * 4, (((l) == 1 && MF8) || ((l) == 0 && DF8)) ? (unsigned char*)(ws + WS_XB8) : nullptr, 1.0f, 1.0f}; \
        REP((pb) + 2) for (int r_ = 0; r_ * G < S.so.nwg; ++r_) { S.so.i0 = r_; S.so.nmax = 1; pg8::gemm_phase<pg8::EpiRes, pg8::DenseSched, false, false>(lds, D * 2, S, E); } \
        SEAM((pb) + 2); \
    }
    LAYER_MIX(0, 1)
    PT(4); if (IN(4)) {
        pg8::DenseSched S; S.A = DF8 ? (const char*)(ws + WS_XB8) : (const char*)XB; S.Bt = (const char*)(ws + WS_FGU); S.KB = D * DES; S.so.init(T / 256, NFF2 / 256, G, bx);
        fill_unit_tables<false>(S, rss + (size_t)1 * T * 4, nullptr, DF8 ? 1.0f / MOE_SW : 1.0f, lds);
        pg8::EpiSwiglu<false, DF8> E{(void*)(ws + WS_ACT), (const LAS float*)(lds + RSTAB_OFF), DF8 ? MOE_SA : 1.0f};
        REP(4) pg8::gemm_phase<pg8::EpiSwiglu<false, DF8>, pg8::DenseSched, true, DF8>(lds, D * DES, S, E);
        SEAM(4);
    }
    PT(5); if (IN(5)) {
        pg8::DenseSched S; S.A = (const char*)(ws + WS_ACT); S.Bt = (const char*)(ws + WS_FD); S.KB = FF * DES; S.so.init(T / 256, D / 256, G, bx);
        pg8::EpiRes E{args.out, args.out, XB, rss + (size_t)2 * T * 4, nullptr, DF8 ? MOE_SW * MOE_SA : 1.0f, DF8 ? 1.0f / (MOE_SW * MOE_SA) : 1.0f};
        for (int r_ = 0; r_ * G < S.so.nwg; ++r_) { S.so.i0 = r_; S.so.nmax = 1; pg8::gemm_phase<pg8::EpiRes, pg8::DenseSched, false, DF8>(lds, FF * DES, S, E); }
        SEAM(5);
    }
    LAYER_MIX(1, 6)
    LAS int* mtab = (LAS int*)(lds + LDSCTL_OFF + 64);
    PT(9); if (IN(9)) { router_phase(args, lds, lane, wave); SEAM(9); }
    PT(10); if (IN(10)) {
        moe_tab_build(ws, mtab);
        pg8::MoeUpSched<MES> S; S.tab = mtab;
        S.XA = MF8 ? (const char*)(ws + WS_XB8) : (const char*)XB; S.W = (const char*)(ws + WS_MGU); S.toktab = (const LAS int*)(lds + TOKTAB_OFF); S.so.init(__builtin_amdgcn_readfirstlane(mtab[24]), NFF2 / 256, G, bx);
        fill_unit_tables<true>(S, rss + (size_t)3 * T * 4, (const int*)(ws + WS_TOKLIST), MF8 ? 1.0f / MOE_SW : 1.0f, lds);
        pg8::EpiSwiglu<true, MF8> E{(void*)(ws + WS_ACT), (const LAS float*)(lds + RSTAB_OFF), MF8 ? MOE_SA : 1.0f};
#if PROBE_NULL == 10
        { pg8::EpiNull EN{(float*)(ws + WS_TOKINFO)}; pg8::gemm_phase<pg8::EpiNull, pg8::MoeUpSched<MES>, true, MF8>(lds, D * MES, S, EN); }
#endif
        REP(10) pg8::gemm_phase<pg8::EpiSwiglu<true, MF8>, pg8::MoeUpSched<MES>, true, MF8>(lds, D * MES, S, E);
        SEAM(10);
    }
    PT(11); if (IN(11)) {
        moe_tab_build(ws, mtab);
        pg8::MoeDownSched<MES> S; S.tab = mtab;
        S.ACT = (const char*)(ws + WS_ACT); S.W = (const char*)(ws + WS_MD); S.so.init(__builtin_amdgcn_readfirstlane(mtab[24]), D / 256, G, bx);
        pg8::EpiSlot E{(bf16_t*)(ws + WS_YS), MF8 ? 1.0f / (MOE_SW * MOE_SA) : 1.0f};
#if PROBE_NULL == 11
        { pg8::EpiNull EN{(float*)(ws + WS_TOKINFO)}; pg8::gemm_phase<pg8::EpiNull, pg8::MoeDownSched<MES>, true, MF8>(lds, FF * MES, S, EN); }
#endif
        REP(11) pg8::gemm_phase<pg8::EpiSlot, pg8::MoeDownSched<MES>, true, MF8>(lds, FF * MES, S, E);
        SEAM(11);
    }
    PT(12); if (IN(12)) { moe_tab_build(ws, mtab); final_phase(args, mtab, gw, NGW, lane); }
    if (PROBE_TIME == 12) pt1 = wall_clock64();
    if (PROBE_TIME >= 0) { const unsigned long long tgt = wall_clock64() + 4ull * (pt1 - pt0); while (wall_clock64() < tgt) __builtin_amdgcn_s_sleep(8); }
#undef IN
#undef SEAM
}

extern "C" void kernel_launch(void* const* d_in, const int* in_sizes, int n_in, void* d_out, int out_size, void* d_ws, size_t ws_size, hipStream_t stream) {
    static int grid = 0;
    if (grid == 0) {
        if (n_in != 21 || in_sizes[0] != T * D || out_size != T * D || ws_size < WS_END) { fprintf(stderr, "kernel_launch: unexpected shapes (n_in %d, in0 %d, out %d, ws %zu < %zu); nothing launched\n", n_in, n_in > 0 ? in_sizes[0] : -1, out_size, ws_size, (size_t)WS_END); grid = -1; return; }
        int dev = 0, cus = 0, per_cu = 0;
        if (hipGetDevice(&dev) != hipSuccess || hipDeviceGetAttribute(&cus, hipDeviceAttributeMultiprocessorCount, dev) != hipSuccess) { grid = -1; return; }
        if (hipFuncSetAttribute((const void*)mega_fwd, hipFuncAttributeMaxDynamicSharedMemorySize, LDS_BYTES) != hipSuccess) { fprintf(stderr, "kernel_launch: hipFuncSetAttribute failed\n"); grid = -1; return; }
        if (hipOccupancyMaxActiveBlocksPerMultiprocessor(&per_cu, (const void*)mega_fwd, NWAVES * 64, LDS_BYTES) != hipSuccess || per_cu < 1) { fprintf(stderr, "kernel_launch: occupancy query reports %d\n", per_cu); }
        (void)hipGetLastError();
        grid = cus;
    }
    if (grid < 0) return;
    if (hipMemsetAsync((char*)d_ws + WS_CTL, 0, CTL_ZERO_BYTES, stream) != hipSuccess) return;
    Args a{};
    for (int i = 0; i < 21; ++i) a.in[i] = (const float*)d_in[i];
    a.out = (float*)d_out; a.ws = (unsigned char*)d_ws;
    if (MK_N_LAUNCHES == 1) { a.ph_lo = 0; a.ph_hi = N_PHASES; hipLaunchKernelGGL(mega_fwd, dim3(grid), dim3(NWAVES * 64), LDS_BYTES, stream, a); }
    else for (int p = 0; p < N_PHASES; ++p) { a.ph_lo = p; a.ph_hi = p + 1; hipLaunchKernelGGL(mega_fwd, dim3(grid), dim3(NWAVES * 64), LDS_BYTES, stream, a); }
}
```

```cpp
#include <hip/hip_runtime.h>
#include <cstdio>
#include <cstdint>

#ifndef PROBE_TIME
#define PROBE_TIME -1
#endif
#ifndef PROBE_P0
#define PROBE_P0 0
#endif
#ifndef PROBE_MID
#define PROBE_MID 0
#endif
#ifndef PROBE_NULL
#define PROBE_NULL -1
#endif
#ifndef RES_BF16
#define RES_BF16 1
#endif
#ifndef DENSE_FP8
#define DENSE_FP8 0
#endif
#ifndef MK_N_LAUNCHES
#define MK_N_LAUNCHES 1
#endif
constexpr int N_PHASES = 13;

#define GAS __attribute__((address_space(1)))
#define LAS __attribute__((address_space(3)))
typedef unsigned short bf16_t;
typedef short bf16x8 __attribute__((ext_vector_type(8)));
typedef float f32x4 __attribute__((ext_vector_type(4)));
typedef float f32x2 __attribute__((ext_vector_type(2)));
typedef unsigned u32x4 __attribute__((ext_vector_type(4)));
typedef unsigned u32x2 __attribute__((ext_vector_type(2)));

constexpr int NB = 8, SEQ = 2048, T = NB * SEQ, D = 1024, DIN = 2048, CC = 512, FF = 2816, NE = 8, CW = 31, NFF2 = 2 * FF;
constexpr float EPS = 1e-6f;
constexpr int NWAVES = 8;

constexpr size_t KiB = 1024, MiB = 1024 * 1024;
constexpr size_t WS_CTL = 0, CTL_ZERO_BYTES = 64 * KiB;
constexpr int CW_BAR = 1024;
constexpr int CW_CNT = 8192;
constexpr size_t WS_TOKLIST = 64 * KiB;
constexpr size_t WS_TOKINFO = 576 * KiB;
constexpr size_t WS_RT = 832 * KiB;
constexpr size_t WS_SGUW = 1 * MiB;
constexpr size_t WS_RSS = 2 * MiB;
constexpr size_t WS_WIN = 6 * MiB;
constexpr size_t WS_WOUT = 14 * MiB;
constexpr size_t WS_FGU = 18 * MiB;
constexpr size_t WS_FD = 29 * MiB;
constexpr size_t WS_MGU = 35 * MiB;
constexpr size_t WS_MD = 79 * MiB;
constexpr size_t WS_XB = 101 * MiB;
constexpr size_t WS_XB8 = 133 * MiB;
constexpr size_t WS_ACT = 149 * MiB;
constexpr size_t WS_CG = WS_ACT, WS_UA = WS_ACT + 16 * MiB, WS_VA = WS_ACT + 32 * MiB, WS_Y = WS_ACT + 48 * MiB;
constexpr size_t WS_YS = 238 * MiB;
constexpr size_t WS_YP = 302 * MiB;
constexpr size_t WS_END = WS_YP + (size_t)8 * 4 * 256 * D * 4;
static_assert(WS_YS + (size_t)2 * T * D * 2 <= WS_YP, "workspace map 3");
constexpr float MOE_SW = 32.0f, MOE_SA = 8.0f;
static_assert(WS_END <= 380 * MiB, "workspace map");
static_assert(WS_MGU + (size_t)NE * NFF2 * D <= WS_MD && WS_MD + (size_t)NE * D * FF <= WS_XB && WS_FD + (size_t)D * FF * 2 <= WS_MGU && WS_ACT + (size_t)T * FF * 2 <= WS_YS && WS_ACT + (size_t)(2 * T + 256) * FF <= WS_YS, "workspace map 2");

constexpr int RING_BYTES = 131072;
constexpr int LDSCTL_OFF = RING_BYTES;
constexpr int MAXU = 12;
constexpr int TOKTAB_OFF = RING_BYTES + 512;
constexpr int RSTAB_OFF = TOKTAB_OFF + MAXU * 256 * 4;
constexpr int LDS_BYTES = RSTAB_OFF + MAXU * 256 * 4;
static_assert(LDS_BYTES <= 160 * 1024 && LDS_BYTES > 80 * 1024, "LDS map");

#define RLX_AGENT __ATOMIC_RELAXED, __HIP_MEMORY_SCOPE_AGENT
__device__ __forceinline__ unsigned cvt_pk_bf16(float lo, float hi) { unsigned r; asm volatile("v_cvt_pk_bf16_f32 %0, %1, %2" : "=v"(r) : "v"(lo), "v"(hi)); return r; }
__device__ __forceinline__ float clamp448(float v) { return __builtin_amdgcn_fmed3f(v, -448.0f, 448.0f); }
__device__ __forceinline__ unsigned pk_fp8x4(float a, float b, float c, float d) {
    int p = __builtin_amdgcn_cvt_pk_fp8_f32(clamp448(a), clamp448(b), 0, false); p = __builtin_amdgcn_cvt_pk_fp8_f32(clamp448(c), clamp448(d), p, true); return (unsigned)p; }
__device__ __forceinline__ float bf_lo(unsigned x) { return __uint_as_float(x << 16); }
__device__ __forceinline__ float bf_hi(unsigned x) { return __uint_as_float(x & 0xffff0000u); }
__device__ __forceinline__ float fast_sigmoid(float g) { return __builtin_amdgcn_rcpf(1.0f + __builtin_amdgcn_exp2f(-1.4426950408889634f * g)); }
__device__ __forceinline__ float wave_sum(float v) {
#pragma unroll
    for (int o = 1; o < 64; o <<= 1) v += __shfl_xor(v, o);
    return v;
}
__device__ __forceinline__ float dpp_add(float v, const int ctrl_sel) {
    int r;
    if (ctrl_sel == 0) r = __builtin_amdgcn_update_dpp(0, __float_as_int(v), 0xB1, 0xF, 0xF, false);
    else if (ctrl_sel == 1) r = __builtin_amdgcn_update_dpp(0, __float_as_int(v), 0x4E, 0xF, 0xF, false);
    else if (ctrl_sel == 2) r = __builtin_amdgcn_update_dpp(0, __float_as_int(v), 0x141, 0xF, 0xF, false);
    else r = __builtin_amdgcn_update_dpp(0, __float_as_int(v), 0x140, 0xF, 0xF, false);
    return v + __int_as_float(r);
}
__device__ __forceinline__ float row16_allsum(float v) { v = dpp_add(v, 0); v = dpp_add(v, 1); v = dpp_add(v, 2); v = dpp_add(v, 3); return v; }
__device__ __forceinline__ f32x2 gelu_pk(f32x2 v) {
    const f32x2 av = __builtin_elementwise_abs(v), d = av * 0.2316418882f + 1.0f;
    f32x2 t; t.x = __builtin_amdgcn_rcpf(d.x); t.y = __builtin_amdgcn_rcpf(d.y);
    f32x2 q = t * 0.5307027145f + (-0.7265760135f); q = q * t + 0.7107068705f; q = q * t + (-0.142248368f); q = q * t + 0.127414796f; q = q * t;
    const f32x2 s = (v * v) * (-0.72134752044f);
    f32x2 e; e.x = __builtin_amdgcn_exp2f(s.x); e.y = __builtin_amdgcn_exp2f(s.y);
    const f32x2 m = v * (q * e), r = v - m;
    f32x2 o; o.x = v.x < 0.f ? m.x : r.x; o.y = v.y < 0.f ? m.y : r.y; return o;
}

#ifndef WT_STORES
#define WT_STORES 0
#endif
struct WtBuf { __amdgpu_buffer_rsrc_t r; };
__device__ __forceinline__ WtBuf wt_buf(const void* base) { WtBuf b; b.r = __builtin_amdgcn_make_buffer_rsrc((void*)base, 0, 0xFFFFFFFFu, 0x00020000); return b; }
__device__ __forceinline__ void wt_store16(const WtBuf& b, const void* base, size_t byte_off, u32x4 v) {
#if WT_STORES
    __builtin_amdgcn_raw_buffer_store_b128(v, b.r, (int)(unsigned)byte_off, 0, 16);
#else
    *(u32x4*)((char*)base + byte_off) = v;
#endif
}
__device__ __forceinline__ void wt_store16f(const WtBuf& b, const void* base, size_t byte_off, f32x4 v) { wt_store16(b, base, byte_off, __builtin_bit_cast(u32x4, v)); }

#define XB_TMO      128
#define XB_XCNT(j)  (256  + 64 * (j))
#define XB_XSUB(j)  (1280 + 64 * (j))
#define XB_XGEN(j)  (2304 + 64 * (j))
#define XB_TOP      3328
#define XB_TOPGEN   3392
#define XCD_BAR_WORDS 3456
#define XB_SPIN_CAP (1u << 18)
__device__ __forceinline__ unsigned xb_ld(unsigned* p)              { return __hip_atomic_load(p, __ATOMIC_RELAXED, __HIP_MEMORY_SCOPE_AGENT); }
__device__ __forceinline__ unsigned xb_add(unsigned* p, unsigned v) { return __hip_atomic_fetch_add(p, v, __ATOMIC_RELAXED, __HIP_MEMORY_SCOPE_AGENT); }
__device__ __forceinline__ unsigned xb_xcc_id() { return (unsigned)__builtin_amdgcn_s_getreg((3 << 11) | 20) & 0xFu; }
#define XB_SPIN(cond, bar) do { unsigned _sp = 0; while (cond) { __builtin_amdgcn_s_sleep(1); \
    if ((++_sp & 255u) == 0u) { if (xb_ld(&(bar)[XB_TMO])) break; if (_sp > XB_SPIN_CAP) { atomicAdd(&(bar)[XB_TMO], 1u); break; } } } } while (0)
struct XcdBarrier { unsigned* bar; unsigned x; volatile LAS unsigned* st; };
__device__ __forceinline__ XcdBarrier xcd_barrier_post(unsigned* bar, volatile LAS unsigned* st) {
    XcdBarrier b; b.bar = bar; b.x = xb_xcc_id(); b.st = st;
    if (threadIdx.x == 0) (void)xb_add(&bar[XB_XCNT(b.x)], 1u);
    return b;
}
__device__ __forceinline__ void xcd_barrier_complete(unsigned* bar, unsigned x, unsigned& nloc, unsigned& nx) {
    const unsigned G = gridDim.x * gridDim.y * gridDim.z;
    unsigned sum, cnt, mine, sp = 0u;
    for (;;) {
        sum = 0u; cnt = 0u; mine = 0u;
#pragma unroll
        for (unsigned j = 0; j < 16; ++j) { const unsigned c = xb_ld(&bar[XB_XCNT(j)]); sum += c; cnt += (c > 0u) ? 1u : 0u; mine = (j == x) ? c : mine; }
        if (sum == G) break;
        __builtin_amdgcn_s_sleep(1);
        if ((++sp & 255u) == 0u) { if (xb_ld(&bar[XB_TMO])) break; if (sp > XB_SPIN_CAP) { atomicAdd(&bar[XB_TMO], 1u); break; } }
    }
    nloc = mine > 0u ? mine : 1u; nx = cnt > 0u ? cnt : 1u;
}
__device__ __forceinline__ void xcd_barrier(const XcdBarrier& b) {
    asm volatile("s_waitcnt vmcnt(0)" ::: "memory");
    __syncthreads();
    if (threadIdx.x == 0) {
        unsigned* bar = b.bar;
        __builtin_amdgcn_s_waitcnt(0);
        unsigned nloc = b.st[0], nx = b.st[1];
        if (nloc == 0u) { xcd_barrier_complete(bar, b.x, nloc, nx); b.st[0] = nloc; b.st[1] = nx; }
        const unsigned old = xb_add(&bar[XB_XSUB(b.x)], 1u);
        const unsigned gen = old / nloc;
        if (old + 1u == (gen + 1u) * nloc) {
            __builtin_amdgcn_fence(__ATOMIC_RELEASE, "agent");
            asm volatile("s_waitcnt vmcnt(0)" ::: "memory");
            const unsigned og = xb_add(&bar[XB_TOP], 1u);
            const unsigned tg = og / nx;
            if (og + 1u == (tg + 1u) * nx) xb_add(&bar[XB_TOPGEN], 1u);
            else XB_SPIN(xb_ld(&bar[XB_TOPGEN]) == tg, bar);
            __builtin_amdgcn_fence(__ATOMIC_ACQUIRE, "agent");
            xb_add(&bar[XB_XGEN(b.x)], 1u);
            asm volatile("s_waitcnt vmcnt(0)" ::: "memory");
        } else {
            XB_SPIN(xb_ld(&bar[XB_XGEN(b.x)]) == gen, bar);
            __builtin_amdgcn_fence(__ATOMIC_ACQUIRE, "agent");
            asm volatile("s_waitcnt vmcnt(0)" ::: "memory");
        }
    }
    __syncthreads();
}

namespace pg8 {
constexpr int BM = 256, BK = 64, HALF = 128, HTB = HALF * BK * 2, STAGE_BYTES = 8 * HTB, NXCD = 8, WGM = 8;
__host__ __device__ __forceinline__ int lds_byte(int r, int c) { const int st = (r >> 4) * 2 + (c >> 5), rr = r & 15, cc = c & 31, ob = rr * 64 + cc * 2; return st * 1024 + (ob ^ (((ob >> 9) & 1) << 5)); }
__host__ __device__ __forceinline__ void stage_rc(int b, int& R, int& C) { const int st = b / 1024, sb = b % 1024, swz = sb ^ (((sb >> 9) & 1) << 5); R = (st >> 1) * 16 + swz / 64; C = (st & 1) * 32 + (swz % 64) / 2; }
__host__ __device__ __forceinline__ int perm32(int rho) { const int n = rho >> 4, i = rho & 15; return 8 * (i >> 2) + 4 * n + (i & 3); }

struct Unit { int pm, pn, e, valid, rb, ui, nt, k0, part, pi; };

struct StaticOrder {
    int nM, nN, nwg, G, c, i0, nmax;
    __device__ __forceinline__ void init(int nM_, int nN_, int G_, int c_) { nM = nM_; nN = nN_; nwg = nM * nN; G = G_; c = c_; i0 = 0; nmax = 1 << 30; }
    __device__ __forceinline__ bool map(int i, int& pm, int& pn) const {
        if (i >= nmax) return false;
        const long L = (long)(i + i0) * G + c; if (L >= nwg) return false;
        int wgid = (int)L; { const int q = nwg / NXCD, r = nwg % NXCD, xcd = wgid % NXCD, off = wgid / NXCD; wgid = (xcd < r ? xcd * (q + 1) : r * (q + 1) + (xcd - r) * q) + off; }
        const int nig = WGM * nN, gid = wgid / nig, fm = gid * WGM, gsz = (nM - fm) < WGM ? (nM - fm) : WGM;
        pm = fm + ((wgid % nig) % gsz); pn = (wgid % nig) / gsz; return true;
    }
};

typedef int v4i32 __attribute__((ext_vector_type(4)));
typedef int v8i32 __attribute__((ext_vector_type(8)));
template <class Epi, class Sched, bool ALIGN_EPI, bool FP8>
__device__ __forceinline__ void gemm_phase(LAS unsigned char* lds, const int KB, const Sched& S, const Epi& E) {
    const int tid = threadIdx.x, wid = __builtin_amdgcn_readfirstlane(tid >> 6), lane = tid & 63, wr = wid >> 2, wc = wid & 3, fr = lane & 15, fq = lane >> 4;
    int Rs[2], Cs[2]; unsigned voffB[2];
#pragma unroll
    for (int i = 0; i < 2; ++i) { stage_rc(tid * 16 + i * 8192, Rs[i], Cs[i]); voffB[i] = (unsigned)(Rs[i] * KB + Cs[i] * 2); }
    const size_t kstep = (size_t)(BK * 2);
    const size_t hstep = (size_t)HALF * KB;
    const unsigned ldsw = (unsigned)wid * 1024u;
    const int aoff = lds_byte(wr * 64 + fr, fq * 8), boff = lds_byte(wc * 32 + fr, fq * 8);
#define PG8_SA(b, h) (((b) * 2 + (h)) * HTB)
#define PG8_SB(b, h) ((4 + (b) * 2 + (h)) * HTB)
#define PG8_STAGE(bufoff, gbase, voff) do { _Pragma("unroll") for (int _i = 0; _i < 2; ++_i) \
        __builtin_amdgcn_global_load_lds((const unsigned*)((const char*)(gbase) + (voff)[_i]), (LAS unsigned*)(lds + (bufoff) + ldsw + _i * 8192), 16, 0, 0); } while (0)
#define PG8_LDA(dst, b, h) do { _Pragma("unroll") for (int m = 0; m < 4; ++m) dst[m] = __builtin_shufflevector(*(const LAS v4i32*)(lds + PG8_SA(b, h) + aoff + m * 2048), *(const LAS v4i32*)(lds + PG8_SA(b, h) + aoff + m * 2048 + 1024), 0, 1, 2, 3, 4, 5, 6, 7); } while (0)
#define PG8_LDB(dst, b, h) do { _Pragma("unroll") for (int n = 0; n < 2; ++n) dst[n] = __builtin_shufflevector(*(const LAS v4i32*)(lds + PG8_SB(b, h) + boff + n * 2048), *(const LAS v4i32*)(lds + PG8_SB(b, h) + boff + n * 2048 + 1024), 0, 1, 2, 3, 4, 5, 6, 7); } while (0)
#define PG8_MMA(ai, bj, At, Bt) do { __builtin_amdgcn_s_setprio(1); _Pragma("unroll") for (int m = 0; m < 4; ++m) _Pragma("unroll") for (int n = 0; n < 2; ++n) { \
        if constexpr (FP8) asm volatile("v_mfma_f32_16x16x128_f8f6f4 %0, %1, %2, %0" : "+v"(acc[ai][bj][m][n]) : "v"(Bt[n]), "v"(At[m]));   \
        else { acc[ai][bj][m][n] = __builtin_amdgcn_mfma_f32_16x16x32_bf16(__builtin_bit_cast(bf16x8, __builtin_shufflevector(Bt[n], Bt[n], 0, 1, 2, 3)), __builtin_bit_cast(bf16x8, __builtin_shufflevector(At[m], At[m], 0, 1, 2, 3)), acc[ai][bj][m][n], 0, 0, 0); \
               acc[ai][bj][m][n] = __builtin_amdgcn_mfma_f32_16x16x32_bf16(__builtin_bit_cast(bf16x8, __builtin_shufflevector(Bt[n], Bt[n], 4, 5, 6, 7)), __builtin_bit_cast(bf16x8, __builtin_shufflevector(At[m], At[m], 4, 5, 6, 7)), acc[ai][bj][m][n], 0, 0, 0); } } \
        __builtin_amdgcn_s_setprio(0); } while (0)
#define PG8_WAIT_V(n) asm volatile("s_waitcnt vmcnt(" #n ")" ::: "memory")
#define PG8_WAIT_L(n) asm volatile("s_waitcnt lgkmcnt(" #n ")" ::: "memory")
#define PG8_BAR __builtin_amdgcn_s_barrier()
#define PG8_SCHED __builtin_amdgcn_sched_barrier(0)
    Unit cur, nxt; int ui = 0;
    if (!S.next(0, cur)) return;
    f32x4 acc[2][2][4][2];
    E.init_acc(acc, cur, wr, wc, fr, fq);
    v8i32 At[4], B0[2], B1[2];
    const char* cA = S.a_ptr(cur); const char* cB = S.b_ptr(cur);
    unsigned offC[2][2], offN[2][2];
    S.a_offs(cur, Rs, Cs, offC);
    PG8_STAGE(PG8_SB(0, 0), cB, voffB); PG8_STAGE(PG8_SB(0, 1), cB + hstep, voffB); PG8_STAGE(PG8_SA(0, 0), cA, offC[0]); PG8_STAGE(PG8_SA(0, 1), cA, offC[1]);
    if (wr == 1) PG8_BAR;
    PG8_WAIT_V(2); PG8_BAR;
    PG8_STAGE(PG8_SB(1, 0), cB + kstep, voffB); PG8_STAGE(PG8_SA(1, 0), cA + kstep, offC[0]); PG8_STAGE(PG8_SB(1, 1), cB + hstep + kstep, voffB);
    PG8_WAIT_V(6); PG8_BAR;
    bool has_next = false; const char* nA = cA; const char* nB = cB;
    constexpr bool NEXT_IN_LOOP = FP8;
#define PG8_NEXT() do { has_next = S.next(ui + 1, nxt); nA = has_next ? S.a_ptr(nxt) : cA; nB = has_next ? S.b_ptr(nxt) : cB; \
        if (has_next) S.a_offs(nxt, Rs, Cs, offN); else { _Pragma("unroll") for (int h = 0; h < 2; ++h) _Pragma("unroll") for (int i = 0; i < 2; ++i) offN[h][i] = offC[h][i]; } } while (0)
    for (;;) {
        if constexpr (!NEXT_IN_LOOP) PG8_NEXT();
        const int nt = cur.nt;
        for (int t = 0; t < nt; t += 2) {
            const bool last = (t == nt - 2);
            const char* a1 = cA + (size_t)(t + 1) * kstep;
            const char* a2 = last ? nA : cA + (size_t)(t + 2) * kstep; const char* b2 = last ? nB : cB + (size_t)(t + 2) * kstep;
            const char* a3 = a2 + kstep; const char* b3 = b2 + kstep;
            unsigned o2[2][2];
#pragma unroll
            for (int h = 0; h < 2; ++h)
#pragma unroll
                for (int i = 0; i < 2; ++i) o2[h][i] = last ? offN[h][i] : offC[h][i];
            PG8_LDB(B0, 0, 0); PG8_LDB(B1, 0, 1); PG8_SCHED; PG8_LDA(At, 0, 0); PG8_STAGE(PG8_SA(1, 1), a1, offC[1]);
            PG8_WAIT_V(8); PG8_WAIT_L(0); PG8_BAR; PG8_MMA(0, 0, At, B0); PG8_MMA(0, 1, At, B1);
            if constexpr (NEXT_IN_LOOP) { if (t == 0) PG8_NEXT(); }
            PG8_BAR; PG8_SCHED;
            PG8_LDA(At, 0, 1); PG8_STAGE(PG8_SB(0, 0), b2, voffB); PG8_STAGE(PG8_SB(0, 1), b2 + hstep, voffB); PG8_STAGE(PG8_SA(0, 0), a2, o2[0]);
            PG8_WAIT_V(8); PG8_WAIT_L(0); PG8_BAR; PG8_MMA(1, 0, At, B0); PG8_MMA(1, 1, At, B1); PG8_BAR; PG8_SCHED;
            PG8_LDB(B0, 1, 0); PG8_LDB(B1, 1, 1); PG8_SCHED; PG8_LDA(At, 1, 0); PG8_STAGE(PG8_SA(0, 1), a2, o2[1]);
            PG8_WAIT_V(8); PG8_WAIT_L(0); PG8_BAR; PG8_MMA(0, 0, At, B0); PG8_MMA(0, 1, At, B1); PG8_BAR; PG8_SCHED;
            PG8_LDA(At, 1, 1); PG8_STAGE(PG8_SB(1, 0), b3, voffB); PG8_STAGE(PG8_SB(1, 1), b3 + hstep, voffB); PG8_STAGE(PG8_SA(1, 0), a3, o2[0]);
            PG8_WAIT_V(8); PG8_WAIT_L(0); PG8_BAR; PG8_MMA(1, 0, At, B0); PG8_MMA(1, 1, At, B1); PG8_BAR; PG8_SCHED;
        }
        if constexpr (ALIGN_EPI) { if (wr == 0) PG8_BAR; }
        if constexpr (FP8) asm volatile("s_nop 15\n\ts_nop 15" ::: "memory");
        if constexpr (!Epi::AFTER_DRAIN) E(acc, cur, wr, wc, fr, fq);
        if (!has_next) break;
        E.init_acc(acc, nxt, wr, wc, fr, fq);
        cur = nxt; cA = nA; cB = nB; ++ui;
#pragma unroll
        for (int h = 0; h < 2; ++h)
#pragma unroll
            for (int i = 0; i < 2; ++i) offC[h][i] = offN[h][i];
        if constexpr (ALIGN_EPI) { if (wr == 1) PG8_BAR; }
    }
    PG8_WAIT_V(0);
    if constexpr (!ALIGN_EPI) { if (wr == 0) PG8_BAR; }
    PG8_BAR;
    if constexpr (Epi::AFTER_DRAIN) E.fused(acc, cur, wr, wc, fr, fq, lds);
#undef PG8_NEXT
#undef PG8_SA
#undef PG8_SB
#undef PG8_STAGE
#undef PG8_LDA
#undef PG8_LDB
#undef PG8_MMA
#undef PG8_WAIT_V
#undef PG8_WAIT_L
#undef PG8_BAR
#undef PG8_SCHED
}

struct DenseSched {
    const char* A; const char* Bt; int KB; StaticOrder so; int g1;
    __device__ __forceinline__ bool next(int i, Unit& u) const { int pm, pn;
        if (g1) { const int L = i * so.G + so.c; if (L >= 512) return false; pm = (L & 255) >> 2; pn = (L & 3) + 4 * (L >> 8); }
        else if (!so.map(i, pm, pn)) return false; u.pm = pm; u.pn = pn; u.e = 0; u.valid = 256; u.rb = pm * 256; u.ui = i; u.nt = KB / 128; u.k0 = 0; u.part = 0; u.pi = 0; return true; }
    __device__ __forceinline__ const char* a_ptr(const Unit& u) const { return A + (size_t)u.pm * 256 * KB; }
    __device__ __forceinline__ const char* b_ptr(const Unit& u) const { return Bt + (size_t)u.pn * 256 * KB; }
    __device__ __forceinline__ void a_offs(const Unit&, const int (&R)[2], const int (&C)[2], unsigned (&off)[2][2]) const {
#pragma unroll
        for (int h = 0; h < 2; ++h)
#pragma unroll
            for (int i = 0; i < 2; ++i) off[h][i] = (unsigned)((h * 128 + R[i]) * KB + C[i] * 2); }
};
__device__ __forceinline__ void moe_lookup(const LAS int* tab, int vt, Unit& u) {
    int e = 0;
#pragma unroll
    for (int k = 1; k < 8; ++k) e += (vt >= tab[16 + k]) ? 1 : 0;
    e = __builtin_amdgcn_readfirstlane(e);
    const int tpe = __builtin_amdgcn_readfirstlane(tab[16 + e]), ce = __builtin_amdgcn_readfirstlane(tab[e]), be = __builtin_amdgcn_readfirstlane(tab[8 + e]);
    const int li = vt - tpe; u.pm = li; u.e = e; const int rem = ce - 256 * li; u.valid = rem < 256 ? rem : 256; u.rb = be + 256 * li;
}
template <int ES> struct MoeUpSched {
    const char* XA; const char* W; const LAS int* toktab; const LAS int* tab; StaticOrder so;
    __device__ __forceinline__ bool next(int i, Unit& u) const { int vt, pn; if (!so.map(i, vt, pn)) return false; moe_lookup(tab, vt, u); u.pn = pn; u.ui = i; u.nt = D * ES / 128; u.k0 = 0; u.part = 0; u.pi = 0; return true; }
    __device__ __forceinline__ const char* a_ptr(const Unit&) const { return XA; }
    __device__ __forceinline__ const char* b_ptr(const Unit& u) const { return W + ((size_t)u.e * NFF2 + (size_t)u.pn * 256) * D * ES; }
    __device__ __forceinline__ void a_offs(const Unit& u, const int (&R)[2], const int (&C)[2], unsigned (&off)[2][2]) const {
#pragma unroll
        for (int h = 0; h < 2; ++h)
#pragma unroll
            for (int i = 0; i < 2; ++i) off[h][i] = (unsigned)toktab[u.ui * 256 + h * 128 + R[i]] * (unsigned)(D * ES) + (unsigned)C[i] * 2u; }
};
template <int ES> struct MoeDownSched {
    const char* ACT; const char* W; const LAS int* tab; StaticOrder so;
    __device__ __forceinline__ bool next(int i, Unit& u) const {
        const int L = i * so.G + so.c, nf4 = so.nwg, np = __builtin_amdgcn_readfirstlane(tab[34]);
        if (L >= nf4 + 16 * np) return false;
        u.ui = i;
        if (L < nf4) {
            int f, pn; so.map(i, f, pn);
            int e = 0;
#pragma unroll
            for (int k = 1; k < 8; ++k) e += (f >= tab[25 + k]) ? 1 : 0;
            e = __builtin_amdgcn_readfirstlane(e);
            const int li = f - __builtin_amdgcn_readfirstlane(tab[25 + e]);
            u.pm = li; u.pn = pn; u.e = e; u.valid = 256; u.rb = __builtin_amdgcn_readfirstlane(tab[8 + e]) + 256 * li; u.nt = FF * ES / 128; u.k0 = 0; u.part = 0; u.pi = 0;
        } else {
            const int s = L - nf4, p = s >> 4, r = s & 15, kp = r & 3;
            const int e = __builtin_amdgcn_readfirstlane(tab[35 + p]), ce = __builtin_amdgcn_readfirstlane(tab[e]);
            u.pm = ce >> 8; u.pn = r >> 2; u.e = e; u.valid = ce & 255; u.rb = __builtin_amdgcn_readfirstlane(tab[8 + e]) + (ce & ~255);
            constexpr int NTK = FF * ES / 128, Q = ((NTK / 4) + 1) & ~1;
            static_assert(NTK - 3 * Q >= 4 && ((NTK - 3 * Q) & 1) == 0, "K split");
            u.k0 = kp * Q; u.nt = kp < 3 ? Q : NTK - 3 * Q; u.part = 1; u.pi = p * 4 + kp;
        }
        return true;
    }
    __device__ __forceinline__ const char* a_ptr(const Unit& u) const { return ACT + (size_t)u.rb * FF * ES + (size_t)u.k0 * 128; }
    __device__ __forceinline__ const char* b_ptr(const Unit& u) const { return W + ((size_t)u.e * D + (size_t)u.pn * 256) * FF * ES + (size_t)u.k0 * 128; }
    __device__ __forceinline__ void a_offs(const Unit&, const int (&R)[2], const int (&C)[2], unsigned (&off)[2][2]) const {
#pragma unroll
        for (int h = 0; h < 2; ++h)
#pragma unroll
            for (int i = 0; i < 2; ++i) off[h][i] = (unsigned)((h * 128 + R[i]) * FF * ES + C[i] * 2); }
};

__device__ __forceinline__ void zero_acc(f32x4 (&acc)[2][2][4][2]) {
#pragma unroll
    for (int a = 0; a < 2; ++a)
#pragma unroll
        for (int b = 0; b < 2; ++b)
#pragma unroll
            for (int m = 0; m < 4; ++m)
#pragma unroll
                for (int n = 0; n < 2; ++n) acc[a][b][m][n] = (f32x4){0.f, 0.f, 0.f, 0.f};
}
__device__ __forceinline__ float rstd_of(float p) { p += __shfl_xor(p, 16); p += __shfl_xor(p, 32); return 1.0f / sqrtf(p * (1.0f / D) + EPS); }
struct EpiMix {
    static constexpr bool AFTER_DRAIN = false;
    bf16_t* CG; bf16_t* UA; bf16_t* VA; const LAS float* rstab;
    __device__ __forceinline__ void init_acc(f32x4 (&acc)[2][2][4][2], const Unit&, int, int, int, int) const { zero_acc(acc); }
    __device__ __forceinline__ void operator()(const f32x4 (&acc)[2][2][4][2], const Unit& u, int wr, int wc, int fr, int fq) const {
        const int row0 = u.rb + wr * 64 + fr;
        const WtBuf bcg = wt_buf(CG), bdst = wt_buf(u.pn < 6 ? UA : VA);
        float rsv[2][4];
#pragma unroll
        for (int ai = 0; ai < 2; ++ai)
#pragma unroll
            for (int m = 0; m < 4; ++m) rsv[ai][m] = rstab[u.ui * 256 + ai * HALF + wr * 64 + m * 16 + fr];
#pragma unroll
        for (int ai = 0; ai < 2; ++ai)
#pragma unroll
            for (int m = 0; m < 4; ++m) {
                const int row = row0 + ai * HALF + m * 16; const float rs = rsv[ai][m];
                if (u.pn < 4) {
                    float o[8];
#pragma unroll
                    for (int n = 0; n < 2; ++n)
#pragma unroll
                        for (int j = 0; j < 4; ++j) { const float a = acc[ai][0][m][n][j] * rs, g = acc[ai][1][m][n][j] * rs; o[4 * n + j] = a * fast_sigmoid(g); }
                    u32x4 w; w.x = cvt_pk_bf16(o[0], o[1]); w.y = cvt_pk_bf16(o[2], o[3]); w.z = cvt_pk_bf16(o[4], o[5]); w.w = cvt_pk_bf16(o[6], o[7]);
                    wt_store16(bcg, CG, ((size_t)row * CC + u.pn * 128 + wc * 32 + 8 * fq) * 2, w);
                } else {
                    bf16_t* dbase = (u.pn < 6 ? UA : VA); const size_t doff = ((size_t)row * CC + (u.pn & 1) * 256 + wc * 32 + 8 * fq) * 2;
#pragma unroll
                    for (int bj = 0; bj < 2; ++bj) {
                        const f32x4 v0 = acc[ai][bj][m][0] * rs, v1 = acc[ai][bj][m][1] * rs;
                        const f32x2 a = gelu_pk((f32x2){v0[0], v0[1]}), b = gelu_pk((f32x2){v0[2], v0[3]}), c = gelu_pk((f32x2){v1[0], v1[1]}), d = gelu_pk((f32x2){v1[2], v1[3]});
                        u32x4 w; w.x = cvt_pk_bf16(a.x, a.y); w.y = cvt_pk_bf16(b.x, b.y); w.z = cvt_pk_bf16(c.x, c.y); w.w = cvt_pk_bf16(d.x, d.y);
                        wt_store16(bdst, dbase, doff + bj * HALF * 2, w); }
                }
            }
    }
};
struct EpiRes {
    static constexpr bool AFTER_DRAIN = true;
    const float* XIN; float* XOUT; bf16_t* XB; float* rss_out; unsigned char* XB8; float sc_in, sc_out;
    __device__ __forceinline__ void init_acc(f32x4 (&acc)[2][2][4][2], const Unit& u, int wr, int wc, int fr, int fq) const {
        const int row0 = u.rb + wr * 64 + fr, col0 = u.pn * 256 + wc * 32 + 8 * fq;
#pragma unroll
        for (int ai = 0; ai < 2; ++ai)
#pragma unroll
            for (int m = 0; m < 4; ++m)
#pragma unroll
                for (int bj = 0; bj < 2; ++bj) { const size_t off = (size_t)(row0 + ai * HALF + m * 16) * D + col0 + bj * HALF;
                    if (RES_BF16) { const u32x4 w = *(const u32x4*)(XB + off);
                        acc[ai][bj][m][0] = (f32x4){bf_lo(w.x), bf_hi(w.x), bf_lo(w.y), bf_hi(w.y)} * sc_in; acc[ai][bj][m][1] = (f32x4){bf_lo(w.z), bf_hi(w.z), bf_lo(w.w), bf_hi(w.w)} * sc_in; }
                    else { acc[ai][bj][m][0] = *(const f32x4*)(XIN + off) * sc_in; acc[ai][bj][m][1] = *(const f32x4*)(XIN + off + 4) * sc_in; } }
    }
    __device__ __forceinline__ void fused(const f32x4 (&acc)[2][2][4][2], const Unit& u, int wr, int wc, int fr, int fq, LAS unsigned char* lds) const {
        const int row0 = u.rb + wr * 64 + fr, col0 = u.pn * 256 + wc * 32 + 8 * fq;
        LAS float* P = (LAS float*)lds;
        const WtBuf bxo = wt_buf(XOUT), bxb = wt_buf(XB);
#pragma unroll
        for (int ai = 0; ai < 2; ++ai)
#pragma unroll
            for (int m = 0; m < 4; ++m) {
                const int lr = ai * HALF + wr * 64 + m * 16 + fr, row = u.rb + lr; float ss = 0.f;
#pragma unroll
                for (int bj = 0; bj < 2; ++bj) {
                    const size_t off = (size_t)row * D + col0 + bj * HALF;
                    const f32x4 x0 = acc[ai][bj][m][0] * sc_out, x1 = acc[ai][bj][m][1] * sc_out;
                    if (!RES_BF16) { wt_store16f(bxo, XOUT, off * 4, x0); wt_store16f(bxo, XOUT, off * 4 + 16, x1); }
                    u32x4 w; w.x = cvt_pk_bf16(x0[0], x0[1]); w.y = cvt_pk_bf16(x0[2], x0[3]); w.z = cvt_pk_bf16(x1[0], x1[1]); w.w = cvt_pk_bf16(x1[2], x1[3]);
                    wt_store16(bxb, XB, off * 2, w);
                    if (XB8) { u32x2 q; q.x = pk_fp8x4(x0[0], x0[1], x0[2], x0[3]); q.y = pk_fp8x4(x1[0], x1[1], x1[2], x1[3]); *(u32x2*)(XB8 + off) = q; }
                    ss += (x0[0] * x0[0] + x0[1] * x0[1]) + (x0[2] * x0[2] + x0[3] * x0[3]) + (x1[0] * x1[0] + x1[1] * x1[1]) + (x1[2] * x1[2] + x1[3] * x1[3]); }
                ss += __shfl_xor(ss, 16); ss += __shfl_xor(ss, 32);
                if (fq == 0) P[lr * 4 + wc] = ss;
            }
        (void)row0;
        __syncthreads();
        if (threadIdx.x < 256) { const f32x4 p = *(const LAS f32x4*)(P + threadIdx.x * 4); rss_out[(size_t)(u.rb + threadIdx.x) * 4 + u.pn] = (p.x + p.y) + (p.z + p.w); }
        __syncthreads();
    }
};
template <bool MOE, bool F8> struct EpiSwiglu {
    static constexpr bool AFTER_DRAIN = false;
    void* ACT; const LAS float* rstab; float post;
    __device__ __forceinline__ void init_acc(f32x4 (&acc)[2][2][4][2], const Unit&, int, int, int, int) const { zero_acc(acc); }
    __device__ __forceinline__ void operator()(const f32x4 (&acc)[2][2][4][2], const Unit& u, int wr, int wc, int fr, int fq) const {
        const int col = u.pn * 128 + wc * 32 + 8 * fq;
        const WtBuf bact = wt_buf(ACT);
        float rsv[2][4];
#pragma unroll
        for (int ai = 0; ai < 2; ++ai)
#pragma unroll
            for (int m = 0; m < 4; ++m) rsv[ai][m] = rstab[u.ui * 256 + ai * HALF + wr * 64 + m * 16 + fr];
#pragma unroll
        for (int ai = 0; ai < 2; ++ai)
#pragma unroll
            for (int m = 0; m < 4; ++m) {
                const int lr = ai * HALF + wr * 64 + m * 16 + fr;
                const float rs = rsv[ai][m];
                const float k1 = -1.4426950408889634f * rs, k2 = rs * rs * post;
                float o[8];
#pragma unroll
                for (int n = 0; n < 2; ++n) {
                    const f32x4 ag = acc[ai][0][m][n], au = acc[ai][1][m][n]; const f32x4 tt = ag * k1; f32x4 ee;
#pragma unroll
                    for (int j = 0; j < 4; ++j) ee[j] = __builtin_amdgcn_exp2f(tt[j]);
                    ee = ee + 1.0f; f32x4 rr;
#pragma unroll
                    for (int j = 0; j < 4; ++j) rr[j] = __builtin_amdgcn_rcpf(ee[j]);
                    const f32x4 oo = (ag * au) * (rr * k2);
#pragma unroll
                    for (int j = 0; j < 4; ++j) o[4 * n + j] = oo[j]; }
                if constexpr (F8) {
                    u32x2 q; q.x = pk_fp8x4(o[0], o[1], o[2], o[3]); q.y = pk_fp8x4(o[4], o[5], o[6], o[7]);
                    if (!MOE || lr < u.valid) *(u32x2*)((unsigned char*)ACT + (size_t)(u.rb + lr) * FF + col) = q;
                } else {
                    u32x4 w; w.x = cvt_pk_bf16(o[0], o[1]); w.y = cvt_pk_bf16(o[2], o[3]); w.z = cvt_pk_bf16(o[4], o[5]); w.w = cvt_pk_bf16(o[6], o[7]);
                    if (!MOE || lr < u.valid) wt_store16(bact, ACT, ((size_t)(u.rb + lr) * FF + col) * 2, w);
                }
            }
    }
};
struct EpiSlot {
    static constexpr bool AFTER_DRAIN = false;
    bf16_t* YS; float* YP; float sc;
    __device__ __forceinline__ void init_acc(f32x4 (&acc)[2][2][4][2], const Unit&, int, int, int, int) const { zero_acc(acc); }
    __device__ __forceinline__ void operator()(const f32x4 (&acc)[2][2][4][2], const Unit& u, int wr, int wc, int fr, int fq) const {
        const int col0 = u.pn * 256 + wc * 32 + 8 * fq;
        const WtBuf bys = wt_buf(YS);
#pragma unroll
        for (int ai = 0; ai < 2; ++ai)
#pragma unroll
            for (int m = 0; m < 4; ++m) {
                const int lr = ai * HALF + wr * 64 + m * 16 + fr;
                if (lr < u.valid) {
#pragma unroll
                    for (int bj = 0; bj < 2; ++bj) {
                        const f32x4 x0 = acc[ai][bj][m][0] * sc, x1 = acc[ai][bj][m][1] * sc;
                        if (u.part) { float* yp = YP + ((size_t)u.pi * 256 + lr) * D + col0 + bj * HALF; *(f32x4*)yp = x0; *(f32x4*)(yp + 4) = x1; continue; }
                        u32x4 w; w.x = cvt_pk_bf16(x0[0], x0[1]); w.y = cvt_pk_bf16(x0[2], x0[3]); w.z = cvt_pk_bf16(x1[0], x1[1]); w.w = cvt_pk_bf16(x1[2], x1[3]);
                        wt_store16(bys, YS, ((size_t)(u.rb + lr) * D + col0 + bj * HALF) * 2, w); }
                }
            }
    }
};
struct EpiNull {
    static constexpr bool AFTER_DRAIN = false;
    float* sink;
    __device__ __forceinline__ void init_acc(f32x4 (&acc)[2][2][4][2], const Unit&, int, int, int, int) const { zero_acc(acc); }
    __device__ __forceinline__ void operator()(const f32x4 (&acc)[2][2][4][2], const Unit& u, int wr, int wc, int fr, int fq) const {
        f32x4 s = (f32x4){0.f, 0.f, 0.f, 0.f};
#pragma unroll
        for (int a = 0; a < 2; ++a)
#pragma unroll
            for (int b = 0; b < 2; ++b)
#pragma unroll
                for (int m = 0; m < 4; ++m)
#pragma unroll
                    for (int n = 0; n < 2; ++n) s += acc[a][b][m][n];
        const float t = (s.x + s.y) + (s.z + s.w);
        if (t == 1.2345678e30f) sink[threadIdx.x] = t;
    }
};
}

struct Args { const float* in[21]; float* out; unsigned char* ws; int ph_lo, ph_hi; };
enum { I_X = 0, I_NMIX, I_WIN, I_CONVW, I_CONVB, I_CONVNG, I_CONVNB, I_SGUNG, I_SGUNB, I_SGUW, I_SGUB, I_WOUT, I_NFFN, I_FWG, I_FWU, I_FWD, I_ROUTER, I_MWG, I_MWU, I_MWD, I_NFINAL };

struct P0Item { const float* W; const float* gain; void* dst; int N, K, c0, k0, f8; };
struct P0Buf { float v[32]; f32x4 g0, g1, g2, g3; };
__device__ __forceinline__ void p0_load(const P0Item& p, int lane, P0Buf& b) {
    const float* s = p.W + (size_t)(p.k0 + (lane >> 5)) * p.N + p.c0 + (lane & 31);
#pragma unroll
    for (int i = 0; i < 32; ++i) b.v[i] = s[(size_t)(2 * i) * p.N];
    const f32x4 one = (f32x4){1.f, 1.f, 1.f, 1.f};
    b.g0 = one; b.g1 = one; b.g2 = one; b.g3 = one;
    if (p.gain) {
        if (p.f8) { const float* gp = p.gain + p.k0 + 16 * (lane & 3); b.g0 = *(const f32x4*)gp; b.g1 = *(const f32x4*)(gp + 4); b.g2 = *(const f32x4*)(gp + 8); b.g3 = *(const f32x4*)(gp + 12); }
        else { const float* gp = p.gain + p.k0 + 8 * (lane & 7); b.g0 = *(const f32x4*)gp; b.g1 = *(const f32x4*)(gp + 4); }
    }
}
__device__ __forceinline__ void p0_finish(const P0Item& p, const P0Buf& b, LAS float* scr, int lane, const int mode = 0) {
    if (mode == 1) { float s = 0.f;
#pragma unroll
        for (int i = 0; i < 32; ++i) s += b.v[i];
        if (s == 1.2345678e30f) *(float*)p.dst = s; return; }
#pragma unroll
    for (int i = 0; i < 32; ++i) scr[(2 * i + (lane >> 5)) * 33 + (lane & 31)] = b.v[i];
    if (!p.f8) {
        const int c = lane & 7;
        const f32x4 g0 = b.g0, g1 = b.g1;
        asm volatile("s_waitcnt lgkmcnt(0)" ::: "memory");
        const WtBuf bd = wt_buf(p.dst);
#pragma unroll
        for (int j = 0; j < 4; ++j) { const int rho = (lane >> 3) + 8 * j; const LAS float* s = scr + (8 * c) * 33 + pg8::perm32(rho);
            u32x4 o; o.x = cvt_pk_bf16(s[0 * 33] * g0.x, s[1 * 33] * g0.y); o.y = cvt_pk_bf16(s[2 * 33] * g0.z, s[3 * 33] * g0.w); o.z = cvt_pk_bf16(s[4 * 33] * g1.x, s[5 * 33] * g1.y); o.w = cvt_pk_bf16(s[6 * 33] * g1.z, s[7 * 33] * g1.w);
            if (mode == 0 || o.x == 0x12345678u) wt_store16(bd, p.dst, ((size_t)rho * p.K + p.k0 + 8 * c) * 2, o); }
    } else {
        const int c4 = lane & 3;
        const f32x4 g[4] = {b.g0 * MOE_SW, b.g1 * MOE_SW, b.g2 * MOE_SW, b.g3 * MOE_SW};
        asm volatile("s_waitcnt lgkmcnt(0)" ::: "memory");
#pragma unroll
        for (int j = 0; j < 2; ++j) { const int rho = (lane >> 2) + 16 * j; const LAS float* s = scr + (16 * c4) * 33 + pg8::perm32(rho);
            u32x4 o;
            o.x = pk_fp8x4(s[0 * 33] * g[0].x, s[1 * 33] * g[0].y, s[2 * 33] * g[0].z, s[3 * 33] * g[0].w);
            o.y = pk_fp8x4(s[4 * 33] * g[1].x, s[5 * 33] * g[1].y, s[6 * 33] * g[1].z, s[7 * 33] * g[1].w);
            o.z = pk_fp8x4(s[8 * 33] * g[2].x, s[9 * 33] * g[2].y, s[10 * 33] * g[2].z, s[11 * 33] * g[2].w);
            o.w = pk_fp8x4(s[12 * 33] * g[3].x, s[13 * 33] * g[3].y, s[14 * 33] * g[3].z, s[15 * 33] * g[3].w);
            if (mode == 0 || o.x == 0x12345678u) *(u32x4*)((unsigned char*)p.dst + (size_t)rho * p.K + p.k0 + 16 * c4) = o; }
    }
    asm volatile("s_waitcnt lgkmcnt(0)" ::: "memory");
}
constexpr int IT_WIN = 16 * 64, IT_WOUT = 16 * 32, IT_GU = 16 * 176, IT_DN = 44 * 32;
constexpr int P0_NITEMS = 2 * IT_WIN + 2 * IT_WOUT + IT_GU + IT_DN;
constexpr int IT_GU8 = 8 * 176, IT_DN8 = 22 * 32, P0_NITEMS8 = NE * (IT_GU8 + IT_DN8);
__device__ __forceinline__ bool p0_decode(const Args& args, int it, P0Item& p) {
    if (it >= P0_NITEMS) return false;
    unsigned char* ws = args.ws; int r = it;
    if (r < 2 * IT_WIN) { const int l = r / IT_WIN; r -= l * IT_WIN; const int kb = r / 64, g32 = r % 64, Lb = 32 * g32;
        p.c0 = Lb < 1024 ? ((Lb >> 7) & 1) * 512 + (Lb >> 8) * 128 + (Lb & 127) : Lb;
        p.W = args.in[I_WIN] + (size_t)l * D * DIN; p.N = DIN; p.K = D; p.gain = args.in[I_NMIX] + l * D; p.dst = (bf16_t*)(ws + WS_WIN) + ((size_t)l * DIN + Lb) * D; p.k0 = 64 * kb; p.f8 = 0; return true; }
    r -= 2 * IT_WIN;
    if (r < 2 * IT_WOUT) { const int l = r / IT_WOUT; r -= l * IT_WOUT; const int kb = r / 32, g32 = r % 32, Lb = 32 * g32;
        p.c0 = Lb; p.W = args.in[I_WOUT] + (size_t)l * D * D; p.N = D; p.K = D; p.gain = nullptr; p.dst = (bf16_t*)(ws + WS_WOUT) + ((size_t)l * D + Lb) * D; p.k0 = 64 * kb; p.f8 = 0; return true; }
    r -= 2 * IT_WOUT;
    if (r < IT_GU) { const int kb = r / 176, g32 = r % 176, Lb = 32 * g32; const int kind = (Lb >> 7) & 1;
        p.c0 = (Lb >> 8) * 128 + (Lb & 127); p.W = args.in[kind ? I_FWU : I_FWG]; p.N = FF; p.K = D; p.gain = args.in[I_NFFN]; p.dst = (unsigned char*)(ws + WS_FGU) + (size_t)Lb * D * (DENSE_FP8 ? 1 : 2); p.k0 = 64 * kb; p.f8 = DENSE_FP8; return true; }
    r -= IT_GU;
    if (r < IT_DN) { const int kb = r / 32, g32 = r % 32, Lb = 32 * g32;
        p.c0 = Lb; p.W = args.in[I_FWD]; p.N = D; p.K = FF; p.gain = nullptr; p.dst = (unsigned char*)(ws + WS_FD) + (size_t)Lb * FF * (DENSE_FP8 ? 1 : 2); p.k0 = 64 * kb; p.f8 = DENSE_FP8; return true; }
    return false;
}
struct P8Buf { float v[64]; };
__device__ __forceinline__ bool p8_decode(const Args& args, int it, P0Item& p) {
    if (it >= P0_NITEMS8) return false;
    unsigned char* ws = args.ws; int r = it; p.f8 = 1;
    if (r < NE * IT_GU8) { const int e = r / IT_GU8; r -= e * IT_GU8; const int kb = r / 176, g32 = r % 176, Lb = 32 * g32; const int kind = (Lb >> 7) & 1;
        p.c0 = (Lb >> 8) * 128 + (Lb & 127); p.W = args.in[kind ? I_MWU : I_MWG] + (size_t)e * D * FF; p.N = FF; p.K = D; p.gain = args.in[I_NFFN] + D; p.dst = (unsigned char*)(ws + WS_MGU) + ((size_t)e * NFF2 + Lb) * D; p.k0 = 128 * kb; return true; }
    r -= NE * IT_GU8;
    { const int e = r / IT_DN8; r -= e * IT_DN8; const int kb = r / 32, g32 = r % 32, Lb = 32 * g32;
        p.c0 = Lb; p.W = args.in[I_MWD] + (size_t)e * FF * D; p.N = D; p.K = FF; p.gain = nullptr; p.dst = (unsigned char*)(ws + WS_MD) + ((size_t)e * D + Lb) * FF; p.k0 = 128 * kb; return true; }
}
__device__ __forceinline__ void p8_load(const P0Item& p, int lane, P8Buf& b) {
    const float* s = p.W + (size_t)(p.k0 + (lane >> 5)) * p.N + p.c0 + (lane & 31);
#pragma unroll
    for (int i = 0; i < 64; ++i) b.v[i] = s[(size_t)(2 * i) * p.N];
}
__device__ __forceinline__ void p8_finish(const P0Item& p, const P8Buf& b, LAS float* scr, int lane) {
    const int c8 = lane & 7;
    const f32x4 sw = (f32x4){MOE_SW, MOE_SW, MOE_SW, MOE_SW};
    f32x4 g[4] = {sw, sw, sw, sw};
    if (p.gain) { const float* gp = p.gain + p.k0 + 16 * c8; g[0] = *(const f32x4*)gp * MOE_SW; g[1] = *(const f32x4*)(gp + 4) * MOE_SW; g[2] = *(const f32x4*)(gp + 8) * MOE_SW; g[3] = *(const f32x4*)(gp + 12) * MOE_SW; }
#pragma unroll
    for (int i = 0; i < 64; ++i) scr[(2 * i + (lane >> 5)) * 33 + (lane & 31)] = b.v[i];
    asm volatile("s_waitcnt lgkmcnt(0)" ::: "memory");
#pragma unroll
    for (int j = 0; j < 4; ++j) { const int rho = (lane >> 3) + 8 * j; const LAS float* s = scr + (16 * c8) * 33 + pg8::perm32(rho);
        u32x4 o;
        o.x = pk_fp8x4(s[0 * 33] * g[0].x, s[1 * 33] * g[0].y, s[2 * 33] * g[0].z, s[3 * 33] * g[0].w);
        o.y = pk_fp8x4(s[4 * 33] * g[1].x, s[5 * 33] * g[1].y, s[6 * 33] * g[1].z, s[7 * 33] * g[1].w);
        o.z = pk_fp8x4(s[8 * 33] * g[2].x, s[9 * 33] * g[2].y, s[10 * 33] * g[2].z, s[11 * 33] * g[2].w);
        o.w = pk_fp8x4(s[12 * 33] * g[3].x, s[13 * 33] * g[3].y, s[14 * 33] * g[3].z, s[15 * 33] * g[3].w);
        *(u32x4*)((unsigned char*)p.dst + (size_t)rho * p.K + p.k0 + 16 * c8) = o; }
    asm volatile("s_waitcnt lgkmcnt(0)" ::: "memory");
}
struct PXBuf { f32x4 v[4][4]; };
__device__ __forceinline__ void px_load(const Args& args, int it, int lane, PXBuf& b) {
#pragma unroll
    for (int k = 0; k < 4; ++k) { const f32x4* xr = (const f32x4*)(args.in[I_X] + (size_t)(4 * it + k) * D) + lane;
#pragma unroll
        for (int j = 0; j < 4; ++j) b.v[k][j] = xr[64 * j]; }
}
__device__ __forceinline__ void px_finish(const Args& args, int it, int lane, const PXBuf& b) {
    bf16_t* XB = (bf16_t*)(args.ws + WS_XB); float* rss = (float*)(args.ws + WS_RSS);
#pragma unroll
    for (int k = 0; k < 4; ++k) { const int m = 4 * it + k; float s = 0.f;
#pragma unroll
        for (int j = 0; j < 4; ++j) s += (b.v[k][j].x * b.v[k][j].x + b.v[k][j].y * b.v[k][j].y) + (b.v[k][j].z * b.v[k][j].z + b.v[k][j].w * b.v[k][j].w);
        s = row16_allsum(s); s += __shfl_xor(s, 16); s += __shfl_xor(s, 32);
        u32x2* o8 = (u32x2*)(XB + (size_t)m * D) + lane;
#pragma unroll
        for (int j = 0; j < 4; ++j) { u32x2 w; w.x = cvt_pk_bf16(b.v[k][j].x, b.v[k][j].y); w.y = cvt_pk_bf16(b.v[k][j].z, b.v[k][j].w); o8[64 * j] = w; }
        if (lane < 4) rss[(size_t)m * 4 + lane] = lane == 0 ? s : 0.f; }
}
constexpr int CW_Q = 9216;
static_assert(P0_NITEMS % 8 == 0 && P0_NITEMS8 % 8 == 0 && T % 32 == 0 && (CW_Q + 3 * 64) * 4 <= (int)CTL_ZERO_BYTES, "prologue tasks");
#define P0_DYN(NTASKS, CTR, BUFT, LOADSTMT, FINSTMT) do { \
        BUFT ba, bb; LAS int* slot = (LAS int*)(lds + LDSCTL_OFF + 448); \
        if (threadIdx.x == 0) { slot[0] = (int)__hip_atomic_fetch_add((CTR), 1u, RLX_AGENT); slot[1] = (int)__hip_atomic_fetch_add((CTR), 1u, RLX_AGENT); } \
        __syncthreads(); int t0 = slot[0], t1 = slot[1]; __syncthreads(); \
        if (t0 < (NTASKS)) { const int it = t0 * 8 + wave; BUFT& b = ba; LOADSTMT; } \
        while (t0 < (NTASKS)) { \
            unsigned tk = 0; if (threadIdx.x == 0) tk = __hip_atomic_fetch_add((CTR), 1u, RLX_AGENT); \
            if (t1 < (NTASKS)) { const int it = t1 * 8 + wave; BUFT& b = bb; LOADSTMT; } \
            { const int it = t0 * 8 + wave; BUFT& b = ba; FINSTMT; } \
            if (threadIdx.x == 0) slot[0] = (int)tk; __syncthreads(); const int t2 = slot[0]; \
            if (t1 >= (NTASKS)) break; \
            if (threadIdx.x == 0) tk = __hip_atomic_fetch_add((CTR), 1u, RLX_AGENT); \
            if (t2 < (NTASKS)) { const int it = t2 * 8 + wave; BUFT& b = ba; LOADSTMT; } \
            { const int it = t1 * 8 + wave; BUFT& b = bb; FINSTMT; } \
            if (threadIdx.x == 0) slot[1] = (int)tk; __syncthreads(); const int t3 = slot[1]; \
            t0 = t2; t1 = t3; } \
        __syncthreads(); } while (0)
__device__ __forceinline__ void prologue_phase(const Args& args, LAS unsigned char* lds, int gw, int NGW, int lane, int wave) {
    unsigned char* ws = args.ws; unsigned* ctl = (unsigned*)(ws + WS_CTL);
    LAS float* scr = (LAS float*)(lds + (wave < 7 ? wave * 16896 : TOKTAB_OFF));
    static_assert(7 * 16896 <= LDSCTL_OFF && TOKTAB_OFF + 16896 <= LDS_BYTES, "prologue scratch");
    P0_DYN(P0_NITEMS8 / 8, ctl + CW_Q, P8Buf, { P0Item p; p8_decode(args, it, p); p8_load(p, lane, b); }, { P0Item p; p8_decode(args, it, p); p8_finish(p, b, scr, lane); });
    P0_DYN(P0_NITEMS / 8, ctl + CW_Q + 64, P0Buf, { P0Item p; p0_decode(args, it, p); p0_load(p, lane, b); }, { P0Item p; p0_decode(args, it, p); p0_finish(p, b, scr, lane); });
    P0_DYN(T / 32, ctl + CW_Q + 128, PXBuf, { px_load(args, it, lane, b); }, { px_finish(args, it, lane, b); });
    { float* RT = (float*)(ws + WS_RT); const float* rt = args.in[I_ROUTER]; const float* g = args.in[I_NFFN] + D;
      for (int i = gw * 64 + lane; i < NE * D; i += NGW * 64) { const int e = i / D, k = i % D; RT[i] = rt[k * NE + e] * g[k]; } }
    { bf16_t* SW = (bf16_t*)(ws + WS_SGUW); const float* sw = args.in[I_SGUW];
      for (int i = gw * 64 + lane; i < 2 * 4 * 128 * 128 / 2; i += NGW * 64) { const int e0 = 2 * i, tt = (e0 >> 7) & 127, s0 = e0 & 127;
          const float a = s0 <= tt ? sw[e0] : 0.f, b = (s0 + 1) <= tt ? sw[e0 + 1] : 0.f; ((unsigned*)SW)[i] = cvt_pk_bf16(a, b); } }
}

__device__ __forceinline__ void mid_phase(const Args& args, LAS unsigned char* lds, int l, int gw, int NGW, int lane, int wave, const int parts = 3) {
    unsigned char* ws = args.ws;
    const bf16_t* CG = (const bf16_t*)(ws + WS_CG); const bf16_t* UA = (const bf16_t*)(ws + WS_UA); const bf16_t* VA = (const bf16_t*)(ws + WS_VA); bf16_t* Y = (bf16_t*)(ws + WS_Y);
    const int fr = lane & 15, fq = lane >> 4;
    const int cv_cg = gw & 3, cv_ch = cv_cg * 128 + 2 * lane, cv_step = NGW >> 2, cv_first = gw >> 2;
    unsigned cv_raw[62];
    if (parts & 2) {
        if (cv_first < NB * (SEQ / 32)) { const int b = cv_first >> 6, t0 = (cv_first & 63) * 32; const size_t rowb = (size_t)b * SEQ;
#pragma unroll
            for (int i = 0; i < 62; ++i) { const int ta = t0 - 30 + i; cv_raw[i] = ta >= 0 ? *(const unsigned*)(CG + (rowb + ta) * CC + cv_ch) : 0u; } }
    }
    if (parts & 1) {
        constexpr int VST = 264;
        const bf16_t* Wb = (const bf16_t*)(ws + WS_SGUW) + (size_t)l * 4 * 128 * 128;
        const float* ng = args.in[I_SGUNG] + l * CC; const float* nb = args.in[I_SGUNB] + l * CC; const float* sb = args.in[I_SGUB] + l * 4 * 128;
        for (int unit = blockIdx.x; unit < NB * 16 * 4; unit += gridDim.x) {
            const int b = unit >> 6, n = (unit >> 2) & 15, h = unit & 3; const int R0 = b * SEQ + n * 128;
            const f32x2 gg = *(const f32x2*)(ng + h * 128 + 2 * lane), bb = *(const f32x2*)(nb + h * 128 + 2 * lane);
            unsigned pv[16];
#pragma unroll
            for (int rr = 0; rr < 16; ++rr) pv[rr] = *(const unsigned*)(VA + (size_t)(R0 + wave * 16 + rr) * CC + h * 128 + 2 * lane);
            const int nks = ((16 * wave + 15) >> 5) + 1;
            bf16x8 bfrag[4];
#pragma unroll
            for (int ks = 0; ks < 4; ++ks) if (ks < nks) bfrag[ks] = *(const bf16x8*)(Wb + (size_t)h * 16384 + (16 * wave + fr) * 128 + 32 * ks + 8 * fq);
            float s1[16], s2[16];
#pragma unroll
            for (int rr = 0; rr < 16; ++rr) { const float v0 = bf_lo(pv[rr]), v1 = bf_hi(pv[rr]); s1[rr] = v0 + v1; s2[rr] = v0 * v0 + v1 * v1; }
#pragma unroll
            for (int rr = 0; rr < 16; ++rr) { s1[rr] = row16_allsum(s1[rr]); s2[rr] = row16_allsum(s2[rr]); }
#pragma unroll
            for (int rr = 0; rr < 16; ++rr) { s1[rr] += __shfl_xor(s1[rr], 16); s2[rr] += __shfl_xor(s2[rr], 16); }
#pragma unroll
            for (int rr = 0; rr < 16; ++rr) { s1[rr] += __shfl_xor(s1[rr], 32); s2[rr] += __shfl_xor(s2[rr], 32); }
#pragma unroll
            for (int rp = 0; rp < 8; ++rp) {
                float y[2][2];
#pragma unroll
                for (int q = 0; q < 2; ++q) { const int rr = 2 * rp + q; const float mean = s1[rr] * (1.0f / 128.0f); const float var = fmaxf(s2[rr] * (1.0f / 128.0f) - mean * mean, 0.f);
                    const float rstd = 1.0f / sqrtf(var + EPS); y[q][0] = (bf_lo(pv[rr]) - mean) * rstd * gg.x + bb.x; y[q][1] = (bf_hi(pv[rr]) - mean) * rstd * gg.y + bb.y; }
                const int s = wave * 16 + 2 * rp;
                *(LAS unsigned*)(lds + (2 * lane) * VST + s * 2) = cvt_pk_bf16(y[0][0], y[1][0]);
                *(LAS unsigned*)(lds + (2 * lane + 1) * VST + s * 2) = cvt_pk_bf16(y[0][1], y[1][1]);
            }
            const int t = 16 * wave + fr; const size_t row = (size_t)(R0 + t);
            u32x2 uu[8];
#pragma unroll
            for (int db = 0; db < 8; ++db) uu[db] = *(const u32x2*)(UA + row * CC + h * 128 + 16 * db + 4 * fq);
            const float bias = sb[h * 128 + t];
            __syncthreads();
            f32x4 acc[8];
#pragma unroll
            for (int db = 0; db < 8; ++db) acc[db] = (f32x4){0.f, 0.f, 0.f, 0.f};
#pragma unroll
            for (int ks = 0; ks < 4; ++ks) if (ks < nks) {
#pragma unroll
                for (int db = 0; db < 8; ++db) {
                    const LAS unsigned char* ap = lds + (16 * db + fr) * VST + (32 * ks + 8 * fq) * 2;
                    union { bf16x8 v; u32x2 h[2]; } af; af.h[0] = *(const LAS u32x2*)ap; af.h[1] = *(const LAS u32x2*)(ap + 8);
                    acc[db] = __builtin_amdgcn_mfma_f32_16x16x32_bf16(af.v, bfrag[ks], acc[db], 0, 0, 0);
                }
            }
#pragma unroll
            for (int db = 0; db < 8; ++db) { const int d = 16 * db + 4 * fq;
                const float o0 = bf_lo(uu[db].x) * (acc[db][0] + bias), o1 = bf_hi(uu[db].x) * (acc[db][1] + bias), o2 = bf_lo(uu[db].y) * (acc[db][2] + bias), o3 = bf_hi(uu[db].y) * (acc[db][3] + bias);
                u32x2 w; w.x = cvt_pk_bf16(o0, o1); w.y = cvt_pk_bf16(o2, o3);
                *(u32x2*)(Y + row * D + CC + h * 128 + d) = w; }
            __syncthreads();
        }
    }
    if (parts & 2) {
        typedef __bf16 bf2_t __attribute__((ext_vector_type(2)));
        const int ch = cv_ch;
        for (int item = cv_first; item < NB * (SEQ / 32); item += cv_step) {
            const int b = item >> 6, t0 = (item & 63) * 32; const size_t rowb = (size_t)b * SEQ;
            if (item != cv_first) {
#pragma unroll
                for (int i = 0; i < 62; ++i) { const int ta = t0 - 30 + i; cv_raw[i] = ta >= 0 ? *(const unsigned*)(CG + (rowb + ta) * CC + ch) : 0u; } }
            unsigned P0[31], P1[31];
#pragma unroll
            for (int k = 0; k < 31; ++k) { P0[k] = __builtin_amdgcn_perm(cv_raw[2 * k + 1], cv_raw[2 * k], 0x05040100u); P1[k] = __builtin_amdgcn_perm(cv_raw[2 * k + 1], cv_raw[2 * k], 0x07060302u); }
            asm volatile("" ::: "memory");
            unsigned Wa0[16], Wa1[16], Wb0[16], Wb1[16];
            { f32x2 cv_wf[32]; const float* cwp = args.in[I_CONVW] + (size_t)l * CW * CC + cv_ch;
#pragma unroll
              for (int j = 0; j < CW; ++j) cv_wf[j] = *(const f32x2*)(cwp + j * CC);
              cv_wf[31] = (f32x2){0.f, 0.f};
#pragma unroll
              for (int k = 0; k < 16; ++k) { Wa0[k] = cvt_pk_bf16(cv_wf[2 * k].x, cv_wf[2 * k + 1].x); Wa1[k] = cvt_pk_bf16(cv_wf[2 * k].y, cv_wf[2 * k + 1].y); }
              Wb0[0] = cvt_pk_bf16(0.f, cv_wf[0].x); Wb1[0] = cvt_pk_bf16(0.f, cv_wf[0].y);
#pragma unroll
              for (int k = 0; k < 15; ++k) { Wb0[k + 1] = cvt_pk_bf16(cv_wf[2 * k + 1].x, cv_wf[2 * k + 2].x); Wb1[k + 1] = cvt_pk_bf16(cv_wf[2 * k + 1].y, cv_wf[2 * k + 2].y); } }
            const f32x2 cb = *(const f32x2*)(args.in[I_CONVB] + l * CC + ch), ng = *(const f32x2*)(args.in[I_CONVNG] + l * CC + ch), nb = *(const f32x2*)(args.in[I_CONVNB] + l * CC + ch);
#pragma unroll
            for (int hf = 0; hf < 2; ++hf) {
                float a0[16], a1[16];
#pragma unroll
                for (int tt = 0; tt < 16; ++tt) {
                    const int t = 16 * hf + tt; float s0 = cb.x, s1 = cb.y;
                    if ((t & 1) == 0) {
#pragma unroll
                        for (int k = 0; k < 16; ++k) { s0 = __builtin_amdgcn_fdot2_f32_bf16(__builtin_bit_cast(bf2_t, P0[t / 2 + k]), __builtin_bit_cast(bf2_t, Wa0[k]), s0, false);
                                                       s1 = __builtin_amdgcn_fdot2_f32_bf16(__builtin_bit_cast(bf2_t, P1[t / 2 + k]), __builtin_bit_cast(bf2_t, Wa1[k]), s1, false); }
                    } else {
#pragma unroll
                        for (int k = 0; k < 16; ++k) { s0 = __builtin_amdgcn_fdot2_f32_bf16(__builtin_bit_cast(bf2_t, P0[(t - 1) / 2 + k]), __builtin_bit_cast(bf2_t, Wb0[k]), s0, false);
                                                       s1 = __builtin_amdgcn_fdot2_f32_bf16(__builtin_bit_cast(bf2_t, P1[(t - 1) / 2 + k]), __builtin_bit_cast(bf2_t, Wb1[k]), s1, false); }
                    }
                    a0[tt] = s0; a1[tt] = s1;
                }
                float s1[16], s2[16];
#pragma unroll
                for (int tt = 0; tt < 16; ++tt) { s1[tt] = row16_allsum(a0[tt] + a1[tt]); s2[tt] = row16_allsum(a0[tt] * a0[tt] + a1[tt] * a1[tt]); }
#pragma unroll
                for (int tt = 0; tt < 16; ++tt) { s1[tt] += __shfl_xor(s1[tt], 16); s2[tt] += __shfl_xor(s2[tt], 16); }
#pragma unroll
                for (int tt = 0; tt < 16; ++tt) {
                    const float mean = s1[tt] * (1.0f / 64.0f); const float var = fmaxf(s2[tt] * (1.0f / 64.0f) - mean * mean, 0.f);
                    const float rstd = 1.0f / sqrtf(var + EPS);
                    const float y0 = (a0[tt] - mean) * rstd * ng.x + nb.x, y1 = (a1[tt] - mean) * rstd * ng.y + nb.y;
                    *(unsigned*)(Y + (rowb + t0 + 16 * hf + tt) * D + ch) = cvt_pk_bf16(y0 * fast_sigmoid(y0), y1 * fast_sigmoid(y1));
                }
            }
        }
    }
}

__device__ __forceinline__ void router_phase(const Args& args, LAS unsigned char* lds, int lane, int wave) {
    unsigned char* ws = args.ws;
    const bf16_t* XB = (const bf16_t*)(ws + WS_XB); const float* RT = (const float*)(ws + WS_RT); const float* rss = (const float*)(ws + WS_RSS) + (size_t)3 * T * 4;
    int* toklist = (int*)(ws + WS_TOKLIST); u32x4* tokinfo = (u32x4*)(ws + WS_TOKINFO); unsigned* cntw = (unsigned*)(ws + WS_CTL) + CW_CNT;
    LAS int* wcnt = (LAS int*)lds;
    LAS int* wbase = (LAS int*)(lds + 256);
    LAS float* rwl = (LAS float*)(lds + 1024);
    for (int i = threadIdx.x; i < NE * D / 4; i += NWAVES * 64) *(LAS f32x4*)(rwl + 4 * i) = *(const f32x4*)(RT + 4 * i);
    __syncthreads();
    for (int blk = blockIdx.x; blk < T / 64; blk += gridDim.x) {
        int my_e0 = 0, my_e1 = 0; float my_g0 = 0.f, my_g1 = 0.f;
        const int tbase = blk * 64 + wave * 8;
#pragma unroll 1
        for (int jb = 0; jb < 2; ++jb) {
            u32x4 xv[4][2]; float pr[4];
#pragma unroll
            for (int j = 0; j < 4; ++j) { const int t = tbase + 4 * jb + j;
                xv[j][0] = *(const u32x4*)(XB + (size_t)t * D + 8 * lane); xv[j][1] = *(const u32x4*)(XB + (size_t)t * D + 512 + 8 * lane);
                pr[j] = rss[(size_t)t * 4 + (lane & 3)]; }
            float xf[4][16];
#pragma unroll
            for (int j = 0; j < 4; ++j)
#pragma unroll
                for (int i = 0; i < 2; ++i) { const u32x4 v = xv[j][i];
                    xf[j][8 * i + 0] = bf_lo(v.x); xf[j][8 * i + 1] = bf_hi(v.x); xf[j][8 * i + 2] = bf_lo(v.y); xf[j][8 * i + 3] = bf_hi(v.y); xf[j][8 * i + 4] = bf_lo(v.z); xf[j][8 * i + 5] = bf_hi(v.z); xf[j][8 * i + 6] = bf_lo(v.w); xf[j][8 * i + 7] = bf_hi(v.w); }
            float a[4][NE];
#pragma unroll
            for (int e = 0; e < NE; ++e) {
                f32x4 w[4];
#pragma unroll
                for (int i = 0; i < 2; ++i) { w[2 * i] = *(const LAS f32x4*)(rwl + e * D + 512 * i + 8 * lane); w[2 * i + 1] = *(const LAS f32x4*)(rwl + e * D + 512 * i + 8 * lane + 4); }
#pragma unroll
                for (int j = 0; j < 4; ++j) { float s = 0.f;
#pragma unroll
                    for (int q = 0; q < 4; ++q) s += (xf[j][4 * q] * w[q].x + xf[j][4 * q + 1] * w[q].y) + (xf[j][4 * q + 2] * w[q].z + xf[j][4 * q + 3] * w[q].w);
                    a[j][e] = s; }
                __builtin_amdgcn_sched_barrier(0);
            }
#pragma unroll
            for (int j = 0; j < 4; ++j)
#pragma unroll
                for (int e = 0; e < NE; ++e) a[j][e] = row16_allsum(a[j][e]);
#pragma unroll
            for (int j = 0; j < 4; ++j)
#pragma unroll
                for (int e = 0; e < NE; ++e) a[j][e] += __shfl_xor(a[j][e], 16);
#pragma unroll
            for (int j = 0; j < 4; ++j)
#pragma unroll
                for (int e = 0; e < NE; ++e) a[j][e] += __shfl_xor(a[j][e], 32);
#pragma unroll
            for (int j = 0; j < 4; ++j) {
                float p = pr[j]; p = dpp_add(p, 0); p = dpp_add(p, 1);
                const float rstd = 1.0f / sqrtf(p * (1.0f / D) + EPS);
                int e0 = 0; float l0 = a[j][0] * rstd;
#pragma unroll
                for (int e = 1; e < NE; ++e) { const float le = a[j][e] * rstd; if (le > l0) { l0 = le; e0 = e; } }
                int e1 = -1; float l1 = -3.0e38f;
#pragma unroll
                for (int e = 0; e < NE; ++e) { const float le = a[j][e] * rstd; if (e != e0 && le > l1) { l1 = le; e1 = e; } }
                const float g0 = 1.0f / (1.0f + __expf(l1 - l0)), g1 = 1.0f - g0;
                if (lane == 4 * jb + j) { my_e0 = e0; my_e1 = e1; my_g0 = g0; my_g1 = g1; }
            }
        }
        const bool act = lane < 8;
        unsigned long long m0[NE], m1[NE];
#pragma unroll
        for (int e = 0; e < NE; ++e) { m0[e] = __ballot(act && my_e0 == e); m1[e] = __ballot(act && my_e1 == e); }
        if (lane < NE) { int c = 0;
#pragma unroll
            for (int e = 0; e < NE; ++e) if (lane == e) c = __popcll(m0[e]) + __popcll(m1[e]);
            wcnt[wave * 8 + lane] = c; }
        __syncthreads();
        if (threadIdx.x < NE) { const int e = threadIdx.x; int tot = 0; int pre[8];
#pragma unroll
            for (int w = 0; w < 8; ++w) { pre[w] = tot; tot += wcnt[w * 8 + e]; }
            const int base = (int)__hip_atomic_fetch_add(cntw + 64 * e, (unsigned)tot, RLX_AGENT);
#pragma unroll
            for (int w = 0; w < 8; ++w) wbase[w * 8 + e] = base + pre[w]; }
        __syncthreads();
        if (act) {
            const unsigned long long lt = (1ull << lane) - 1ull;
            int pos0 = 0, pos1 = 0;
#pragma unroll
            for (int e = 0; e < NE; ++e) { const int wb = wbase[wave * 8 + e];
                if (my_e0 == e) pos0 = wb + __popcll(m0[e] & lt);
                if (my_e1 == e) pos1 = wb + __popcll(m0[e]) + __popcll(m1[e] & lt); }
            const int t = tbase + lane;
            toklist[my_e0 * T + pos0] = t; toklist[my_e1 * T + pos1] = t;
            u32x4 inf; inf.x = ((unsigned)my_e0 << 16) | (unsigned)pos0; inf.y = ((unsigned)my_e1 << 16) | (unsigned)pos1; inf.z = __float_as_uint(my_g0); inf.w = __float_as_uint(my_g1);
            tokinfo[t] = inf;
        }
        __syncthreads();
    }
}
__device__ __forceinline__ void moe_tab_build(const unsigned char* ws, LAS int* tab) {
    if (threadIdx.x == 0) {
        unsigned* cntw = (unsigned*)(ws + WS_CTL) + CW_CNT; int b = 0, p = 0, f = 0, np = 0;
        for (int e = 0; e < NE; ++e) { const int c = (int)__hip_atomic_load(cntw + 64 * e, RLX_AGENT); tab[e] = c; tab[8 + e] = b; tab[16 + e] = p; tab[25 + e] = f; b += c; p += (c + 255) >> 8; f += c >> 8;
            tab[43 + e] = -1; if (c & 255) { tab[35 + np] = e; tab[43 + e] = np; ++np; } }
        tab[24] = p; tab[33] = f; tab[34] = np;
    }
    __syncthreads();
}

__device__ __forceinline__ void final_phase(const Args& args, const LAS int* tab, int gw, int NGW, int lane) {
    unsigned char* ws = args.ws; float* out = args.out; const bf16_t* YS = (const bf16_t*)(ws + WS_YS); const u32x4* tokinfo = (const u32x4*)(ws + WS_TOKINFO); const float* YP = (const float*)(ws + WS_YP);
    f32x4 gn[4];
#pragma unroll
    for (int j = 0; j < 4; ++j) gn[j] = *((const f32x4*)args.in[I_NFINAL] + lane + 64 * j);
    for (int tb = gw; tb < T; tb += 4 * NGW) {
        f32x4 xv[4][4]; u32x2 ya[4][4], yb[4][4]; float g0[4], g1[4]; u32x4 inf[4];
#pragma unroll
        for (int k = 0; k < 4; ++k) { const int t = tb + k * NGW; inf[k] = tokinfo[t < T ? t : 0]; }
#pragma unroll
        for (int k = 0; k < 4; ++k) { const int t = tb + k * NGW; if (t < T) {
            const int e0 = __builtin_amdgcn_readfirstlane((int)(inf[k].x >> 16)), p0 = __builtin_amdgcn_readfirstlane((int)(inf[k].x & 0xffffu)), e1 = __builtin_amdgcn_readfirstlane((int)(inf[k].y >> 16)), p1 = __builtin_amdgcn_readfirstlane((int)(inf[k].y & 0xffffu));
            g0[k] = __uint_as_float(inf[k].z); g1[k] = __uint_as_float(inf[k].w);
            const int b0 = __builtin_amdgcn_readfirstlane(tab[8 + e0]), b1 = __builtin_amdgcn_readfirstlane(tab[8 + e1]);
            const int c0 = __builtin_amdgcn_readfirstlane(tab[e0]), c1 = __builtin_amdgcn_readfirstlane(tab[e1]);
            if (RES_BF16) { const u32x2* xr = (const u32x2*)((const bf16_t*)(ws + WS_XB) + (size_t)t * D) + lane;
#pragma unroll
                for (int j = 0; j < 4; ++j) { const u32x2 w = xr[64 * j]; xv[k][j] = (f32x4){bf_lo(w.x), bf_hi(w.x), bf_lo(w.y), bf_hi(w.y)}; } }
            else { const f32x4* xr = (const f32x4*)(out + (size_t)t * D) + lane;
#pragma unroll
                for (int j = 0; j < 4; ++j) xv[k][j] = xr[64 * j]; }
            if (p0 >= (c0 & ~255)) { const float* yp = YP + ((size_t)__builtin_amdgcn_readfirstlane(tab[43 + e0]) * 4 * 256 + (p0 & 255)) * D;
#pragma unroll
                for (int j = 0; j < 4; ++j) { f32x4 s = *((const f32x4*)yp + lane + 64 * j);
#pragma unroll
                    for (int q = 1; q < 4; ++q) s += *((const f32x4*)(yp + (size_t)q * 256 * D) + lane + 64 * j);
                    ya[k][j].x = cvt_pk_bf16(s.x, s.y); ya[k][j].y = cvt_pk_bf16(s.z, s.w); } }
            else { const u32x2* y0 = (const u32x2*)(YS + (size_t)(b0 + p0) * D) + lane;
#pragma unroll
                for (int j = 0; j < 4; ++j) ya[k][j] = y0[64 * j]; }
            if (p1 >= (c1 & ~255)) { const float* yp = YP + ((size_t)__builtin_amdgcn_readfirstlane(tab[43 + e1]) * 4 * 256 + (p1 & 255)) * D;
#pragma unroll
                for (int j = 0; j < 4; ++j) { f32x4 s = *((const f32x4*)yp + lane + 64 * j);
#pragma unroll
                    for (int q = 1; q < 4; ++q) s += *((const f32x4*)(yp + (size_t)q * 256 * D) + lane + 64 * j);
                    yb[k][j].x = cvt_pk_bf16(s.x, s.y); yb[k][j].y = cvt_pk_bf16(s.z, s.w); } }
            else { const u32x2* y1 = (const u32x2*)(YS + (size_t)(b1 + p1) * D) + lane;
#pragma unroll
                for (int j = 0; j < 4; ++j) yb[k][j] = y1[64 * j]; }
        } }
#pragma unroll
        for (int k = 0; k < 4; ++k) { const int t = tb + k * NGW; if (t < T) {
            f32x4 v[4]; float ss = 0.f;
#pragma unroll
            for (int j = 0; j < 4; ++j) { const f32x4 x = xv[k][j]; const u32x2 a = ya[k][j], b = yb[k][j];
                v[j].x = x.x + g0[k] * bf_lo(a.x) + g1[k] * bf_lo(b.x); v[j].y = x.y + g0[k] * bf_hi(a.x) + g1[k] * bf_hi(b.x); v[j].z = x.z + g0[k] * bf_lo(a.y) + g1[k] * bf_lo(b.y); v[j].w = x.w + g0[k] * bf_hi(a.y) + g1[k] * bf_hi(b.y);
                ss += (v[j].x * v[j].x + v[j].y * v[j].y) + (v[j].z * v[j].z + v[j].w * v[j].w); }
            ss = row16_allsum(ss); ss += __shfl_xor(ss, 16); ss += __shfl_xor(ss, 32);
            const float rstd = 1.0f / sqrtf(ss * (1.0f / D) + EPS);
            f32x4* xo = (f32x4*)(out + (size_t)t * D) + lane;
#pragma unroll
            for (int j = 0; j < 4; ++j) xo[64 * j] = v[j] * rstd * gn[j]; } }
    }
}

template <bool MOE, class Sched>
__device__ __forceinline__ void fill_unit_tables(const Sched& S, const float* rss, const int* toklist, float pre, LAS unsigned char* lds) {
    LAS int* tt = (LAS int*)(lds + TOKTAB_OFF); LAS float* rt = (LAS float*)(lds + RSTAB_OFF);
    const int lr = threadIdx.x & 255, par = threadIdx.x >> 8;
    int srow[MAXU / 2]; bool have[MAXU / 2];
#pragma unroll
    for (int k = 0; k < MAXU / 2; ++k) { pg8::Unit u; have[k] = S.next(2 * k + par, u); srow[k] = 0;
        if (have[k]) { if (MOE) { if (lr < u.valid) srow[k] = toklist[u.e * T + u.pm * 256 + lr]; } else srow[k] = u.rb + lr; } }
    f32x4 p[MAXU / 2];
#pragma unroll
    for (int k = 0; k < MAXU / 2; ++k) p[k] = have[k] ? *(const f32x4*)(rss + (size_t)srow[k] * 4) : (f32x4){0.f, 0.f, 0.f, 0.f};
#pragma unroll
    for (int k = 0; k < MAXU / 2; ++k) if (have[k]) { const int i = 2 * k + par; if (MOE) tt[i * 256 + lr] = srow[k];
        rt[i * 256 + lr] = pre / sqrtf(((p[k].x + p[k].y) + (p[k].z + p[k].w)) * (1.0f / D) + EPS); }
    __syncthreads();
}

__global__ void __launch_bounds__(NWAVES * 64, 2) mega_fwd(Args args) {
    extern __shared__ __attribute__((aligned(16))) unsigned char lds_raw[];
    LAS unsigned char* lds = (LAS unsigned char*)lds_raw;
    const int tid = threadIdx.x, lane = tid & 63, wave = __builtin_amdgcn_readfirstlane(tid >> 6);
    const int G = gridDim.x, bx = blockIdx.x;
    const int vcu = (G % 8 == 0) ? (bx % 8) * (G / 8) + bx / 8 : bx;
    const int gw = vcu * NWAVES + wave, NGW = G * NWAVES;
    unsigned char* ws = args.ws;
    unsigned* ctl = (unsigned*)(ws + WS_CTL);
    for (int u = tid; u < 512 / 4; u += NWAVES * 64) ((LAS unsigned*)(lds + LDSCTL_OFF))[u] = 0u;
    __syncthreads();
    XcdBarrier bar; bar.bar = ctl + CW_BAR; bar.x = 0; bar.st = nullptr;
    if (MK_N_LAUNCHES == 1) bar = xcd_barrier_post(ctl + CW_BAR, (volatile LAS unsigned*)(lds + LDSCTL_OFF) + 8);
    const int lo = args.ph_lo, hi = args.ph_hi;
#ifndef PHMASK
#define PHMASK 0xFFFF
#endif
#define IN(k) ((((PHMASK) >> (k)) & 1) && lo <= (k) && (k) < hi)
#ifndef DUP_PHASE
#define DUP_PHASE -1
#endif
#define REP(k) for (int rep_ = 0; rep_ < ((DUP_PHASE) == (k) ? 2 : 1); ++rep_)
#define SEAM(k) do { if (MK_N_LAUNCHES == 1 && IN((k) + 1)) xcd_barrier(bar); if (PROBE_TIME == (k)) pt1 = wall_clock64(); } while (0)
    unsigned long long pt0 = 0, pt1 = 0;
#define PT(k) do { if (PROBE_TIME == (k)) pt0 = wall_clock64(); } while (0)
    float* rss = (float*)(ws + WS_RSS);
    bf16_t* XB = (bf16_t*)(ws + WS_XB);

    PT(0); if (IN(0)) { REP(0) prologue_phase(args, lds, gw, NGW, lane, wave); SEAM(0); }

#ifndef MOE_FP8
#define MOE_FP8 1
#endif
    constexpr bool MF8 = (MOE_FP8 != 0); constexpr int MES = MF8 ? 1 : 2; constexpr bool DF8 = (DENSE_FP8 != 0); constexpr int DES = DF8 ? 1 : 2;
#define LAYER_MIX(l, pb) \
    PT(pb); if (IN(pb)) {       \
        pg8::DenseSched S; S.A = (const char*)XB; S.Bt = (const char*)(ws + WS_WIN) + (size_t)(l) * DIN * D * 2; S.KB = D * 2; S.so.init(T / 256, DIN / 256, G, vcu); S.g1 = 1; \
        fill_unit_tables<false>(S, rss + (size_t)(2 * (l)) * T * 4, nullptr, 1.0f, lds); \
        pg8::EpiMix E{(bf16_t*)(ws + WS_CG), (bf16_t*)(ws + WS_UA), (bf16_t*)(ws + WS_VA), (const LAS float*)(lds + RSTAB_OFF)}; \
        REP(pb) pg8::gemm_phase<pg8::EpiMix, pg8::DenseSched, true, false>(lds, D * 2, S, E); \
        SEAM(pb); \
    } \
    PT((pb) + 1); if (IN((pb) + 1)) { if (PROBE_MID != 0 && (l) == 0) mid_phase(args, lds, (l), gw, NGW, lane, wave, PROBE_MID); REP((pb) + 1) mid_phase(args, lds, (l), gw, NGW, lane, wave); SEAM((pb) + 1); } \
    PT((pb) + 2); if (IN((pb) + 2)) {       \
        pg8::DenseSched S; S.A = (const char*)(ws + WS_Y); S.Bt = (const char*)(ws + WS_WOUT) + (size_t)(l) * D * D * 2; S.KB = D * 2; S.so.init(T / 256, D / 256, G, bx); S.g1 = 0; \
        pg8::EpiRes E{(l) == 0 ? args.in[I_X] : args.out, args.out, XB, rss + (size_t)(2 * (l) + 1) * T * 4, (((l) == 1 && MF8) || ((l) == 0 && DF8)) ? (unsigned char*)(ws + WS_XB8) : nullptr, 1.0f, 1.0f}; \
        REP((pb) + 2) for (int r_ = 0; r_ * G < S.so.nwg; ++r_) { S.so.i0 = r_; S.so.nmax = 1; pg8::gemm_phase<pg8::EpiRes, pg8::DenseSched, false, false>(lds, D * 2, S, E); } \
        SEAM((pb) + 2); \
    }
    LAYER_MIX(0, 1)
    PT(4); if (IN(4)) {
        pg8::DenseSched S; S.A = DF8 ? (const char*)(ws + WS_XB8) : (const char*)XB; S.Bt = (const char*)(ws + WS_FGU); S.KB = D * DES; S.so.init(T / 256, NFF2 / 256, G, bx); S.g1 = 0;
        fill_unit_tables<false>(S, rss + (size_t)1 * T * 4, nullptr, DF8 ? 1.0f / MOE_SW : 1.0f, lds);
        pg8::EpiSwiglu<false, DF8> E{(void*)(ws + WS_ACT), (const LAS float*)(lds + RSTAB_OFF), DF8 ? MOE_SA : 1.0f};
        REP(4) pg8::gemm_phase<pg8::EpiSwiglu<false, DF8>, pg8::DenseSched, true, DF8>(lds, D * DES, S, E);
        SEAM(4);
    }
    PT(5); if (IN(5)) {
        pg8::DenseSched S; S.A = (const char*)(ws + WS_ACT); S.Bt = (const char*)(ws + WS_FD); S.KB = FF * DES; S.so.init(T / 256, D / 256, G, bx); S.g1 = 0;
        pg8::EpiRes E{args.out, args.out, XB, rss + (size_t)2 * T * 4, nullptr, DF8 ? MOE_SW * MOE_SA : 1.0f, DF8 ? 1.0f / (MOE_SW * MOE_SA) : 1.0f};
        for (int r_ = 0; r_ * G < S.so.nwg; ++r_) { S.so.i0 = r_; S.so.nmax = 1; pg8::gemm_phase<pg8::EpiRes, pg8::DenseSched, false, DF8>(lds, FF * DES, S, E); }
        SEAM(5);
    }
    LAYER_MIX(1, 6)
    LAS int* mtab = (LAS int*)(lds + LDSCTL_OFF + 64);
    PT(9); if (IN(9)) { router_phase(args, lds, lane, wave); SEAM(9); }
    PT(10); if (IN(10)) {
        moe_tab_build(ws, mtab);
        pg8::MoeUpSched<MES> S; S.tab = mtab;
        S.XA = MF8 ? (const char*)(ws + WS_XB8) : (const char*)XB; S.W = (const char*)(ws + WS_MGU); S.toktab = (const LAS int*)(lds + TOKTAB_OFF); S.so.init(__builtin_amdgcn_readfirstlane(mtab[24]), NFF2 / 256, G, bx);
        fill_unit_tables<true>(S, rss + (size_t)3 * T * 4, (const int*)(ws + WS_TOKLIST), MF8 ? 1.0f / MOE_SW : 1.0f, lds);
        pg8::EpiSwiglu<true, MF8> E{(void*)(ws + WS_ACT), (const LAS float*)(lds + RSTAB_OFF), MF8 ? MOE_SA : 1.0f};
#if PROBE_NULL == 10
        { pg8::EpiNull EN{(float*)(ws + WS_TOKINFO)}; pg8::gemm_phase<pg8::EpiNull, pg8::MoeUpSched<MES>, true, MF8>(lds, D * MES, S, EN); }
#endif
        REP(10) pg8::gemm_phase<pg8::EpiSwiglu<true, MF8>, pg8::MoeUpSched<MES>, true, MF8>(lds, D * MES, S, E);
        SEAM(10);
    }
    PT(11); if (IN(11)) {
        moe_tab_build(ws, mtab);
        pg8::MoeDownSched<MES> S; S.tab = mtab;
        S.ACT = (const char*)(ws + WS_ACT); S.W = (const char*)(ws + WS_MD); S.so.init(__builtin_amdgcn_readfirstlane(mtab[33]), D / 256, G, bx);
        pg8::EpiSlot E{(bf16_t*)(ws + WS_YS), (float*)(ws + WS_YP), MF8 ? 1.0f / (MOE_SW * MOE_SA) : 1.0f};
#if PROBE_NULL == 11
        { pg8::EpiNull EN{(float*)(ws + WS_TOKINFO)}; pg8::gemm_phase<pg8::EpiNull, pg8::MoeDownSched<MES>, true, MF8>(lds, FF * MES, S, EN); }
#endif
        REP(11) pg8::gemm_phase<pg8::EpiSlot, pg8::MoeDownSched<MES>, true, MF8>(lds, FF * MES, S, E);
        SEAM(11);
    }
    PT(12); if (IN(12)) { moe_tab_build(ws, mtab); final_phase(args, mtab, gw, NGW, lane); }
    if (PROBE_TIME == 12) pt1 = wall_clock64();
    if (PROBE_TIME >= 0) { const unsigned long long tgt = wall_clock64() + 4ull * (pt1 - pt0); while (wall_clock64() < tgt) __builtin_amdgcn_s_sleep(8); }
#undef IN
#undef SEAM
}

extern "C" void kernel_launch(void* const* d_in, const int* in_sizes, int n_in, void* d_out, int out_size, void* d_ws, size_t ws_size, hipStream_t stream) {
    static int grid = 0;
    if (grid == 0) {
        if (n_in != 21 || in_sizes[0] != T * D || out_size != T * D || ws_size < WS_END) { fprintf(stderr, "kernel_launch: unexpected shapes (n_in %d, in0 %d, out %d, ws %zu < %zu); nothing launched\n", n_in, n_in > 0 ? in_sizes[0] : -1, out_size, ws_size, (size_t)WS_END); grid = -1; return; }
        int dev = 0, cus = 0, per_cu = 0;
        if (hipGetDevice(&dev) != hipSuccess || hipDeviceGetAttribute(&cus, hipDeviceAttributeMultiprocessorCount, dev) != hipSuccess) { grid = -1; return; }
        if (hipFuncSetAttribute((const void*)mega_fwd, hipFuncAttributeMaxDynamicSharedMemorySize, LDS_BYTES) != hipSuccess) { fprintf(stderr, "kernel_launch: hipFuncSetAttribute failed\n"); grid = -1; return; }
        if (hipOccupancyMaxActiveBlocksPerMultiprocessor(&per_cu, (const void*)mega_fwd, NWAVES * 64, LDS_BYTES) != hipSuccess || per_cu < 1) { fprintf(stderr, "kernel_launch: occupancy query reports %d\n", per_cu); }
        (void)hipGetLastError();
        grid = cus;
    }
    if (grid < 0) return;
    if (hipMemsetAsync((char*)d_ws + WS_CTL, 0, CTL_ZERO_BYTES, stream) != hipSuccess) return;
    Args a{};
    for (int i = 0; i < 21; ++i) a.in[i] = (const float*)d_in[i];
    a.out = (float*)d_out; a.ws = (unsigned char*)d_ws;
    if (MK_N_LAUNCHES == 1) { a.ph_lo = 0; a.ph_hi = N_PHASES; hipLaunchKernelGGL(mega_fwd, dim3(grid), dim3(NWAVES * 64), LDS_BYTES, stream, a); }
    else for (int p = 0; p < N_PHASES; ++p) { a.ph_lo = p; a.ph_hi = p + 1; hipLaunchKernelGGL(mega_fwd, dim3(grid), dim3(NWAVES * 64), LDS_BYTES, stream, a); }
}
```

```cpp
#include <hip/hip_runtime.h>
#include <cstdio>
#include <cstdint>

#ifndef PROBE_TIME
#define PROBE_TIME -1
#endif
#ifndef PROBE_P0
#define PROBE_P0 0
#endif
#ifndef PROBE_MID
#define PROBE_MID 0
#endif
#ifndef PROBE_NULL
#define PROBE_NULL -1
#endif
#ifndef RES_BF16
#define RES_BF16 1
#endif
#ifndef DENSE_FP8
#define DENSE_FP8 0
#endif
#ifndef MK_N_LAUNCHES
#define MK_N_LAUNCHES 1
#endif
constexpr int N_PHASES = 13;

#define GAS __attribute__((address_space(1)))
#define LAS __attribute__((address_space(3)))
typedef unsigned short bf16_t;
typedef short bf16x8 __attribute__((ext_vector_type(8)));
typedef float f32x4 __attribute__((ext_vector_type(4)));
typedef float f32x2 __attribute__((ext_vector_type(2)));
typedef unsigned u32x4 __attribute__((ext_vector_type(4)));
typedef unsigned u32x2 __attribute__((ext_vector_type(2)));

constexpr int NB = 8, SEQ = 2048, T = NB * SEQ, D = 1024, DIN = 2048, CC = 512, FF = 2816, NE = 8, CW = 31, NFF2 = 2 * FF;
constexpr float EPS = 1e-6f;
constexpr int NWAVES = 8;

constexpr size_t KiB = 1024, MiB = 1024 * 1024;
constexpr size_t WS_CTL = 0, CTL_ZERO_BYTES = 64 * KiB;
constexpr int CW_BAR = 1024;
constexpr int CW_CNT = 8192;
constexpr size_t WS_TOKLIST = 64 * KiB;
constexpr size_t WS_TOKINFO = 576 * KiB;
constexpr size_t WS_RT = 832 * KiB;
constexpr size_t WS_SGUW = 1 * MiB;
constexpr size_t WS_RSS = 2 * MiB;
constexpr size_t WS_WIN = 6 * MiB;
constexpr size_t WS_WOUT = 14 * MiB;
constexpr size_t WS_FGU = 18 * MiB;
constexpr size_t WS_FD = 29 * MiB;
constexpr size_t WS_MGU = 35 * MiB;
constexpr size_t WS_MD = 79 * MiB;
constexpr size_t WS_XB = 101 * MiB;
constexpr size_t WS_XB8 = 133 * MiB;
constexpr size_t WS_ACT = 149 * MiB;
constexpr size_t WS_CG = WS_ACT, WS_UA = WS_ACT + 16 * MiB, WS_VA = WS_ACT + 32 * MiB, WS_Y = WS_ACT + 48 * MiB;
constexpr size_t WS_YS = 238 * MiB;
constexpr size_t WS_YP = 302 * MiB;
constexpr size_t WS_END = WS_YP + (size_t)8 * 4 * 256 * D * 4;
static_assert(WS_YS + (size_t)2 * T * D * 2 <= WS_YP, "workspace map 3");
constexpr float MOE_SW = 32.0f, MOE_SA = 8.0f;
static_assert(WS_END <= 380 * MiB, "workspace map");
static_assert(WS_MGU + (size_t)NE * NFF2 * D <= WS_MD && WS_MD + (size_t)NE * D * FF <= WS_XB && WS_FD + (size_t)D * FF * 2 <= WS_MGU && WS_ACT + (size_t)T * FF * 2 <= WS_YS && WS_ACT + (size_t)(2 * T + 256) * FF <= WS_YS, "workspace map 2");

constexpr int RING_BYTES = 131072;
constexpr int LDSCTL_OFF = RING_BYTES;
constexpr int MAXU = 12;
constexpr int TOKTAB_OFF = RING_BYTES + 512;
constexpr int RSTAB_OFF = TOKTAB_OFF + MAXU * 256 * 4;
constexpr int LDS_BYTES = RSTAB_OFF + MAXU * 256 * 4;
static_assert(LDS_BYTES <= 160 * 1024 && LDS_BYTES > 80 * 1024, "LDS map");

#define RLX_AGENT __ATOMIC_RELAXED, __HIP_MEMORY_SCOPE_AGENT
__device__ __forceinline__ unsigned cvt_pk_bf16(float lo, float hi) { unsigned r; asm volatile("v_cvt_pk_bf16_f32 %0, %1, %2" : "=v"(r) : "v"(lo), "v"(hi)); return r; }
__device__ __forceinline__ float clamp448(float v) { return __builtin_amdgcn_fmed3f(v, -448.0f, 448.0f); }
__device__ __forceinline__ unsigned pk_fp8x4(float a, float b, float c, float d) {
    int p = __builtin_amdgcn_cvt_pk_fp8_f32(clamp448(a), clamp448(b), 0, false); p = __builtin_amdgcn_cvt_pk_fp8_f32(clamp448(c), clamp448(d), p, true); return (unsigned)p; }
__device__ __forceinline__ float bf_lo(unsigned x) { return __uint_as_float(x << 16); }
__device__ __forceinline__ float bf_hi(unsigned x) { return __uint_as_float(x & 0xffff0000u); }
__device__ __forceinline__ float fast_sigmoid(float g) { return __builtin_amdgcn_rcpf(1.0f + __builtin_amdgcn_exp2f(-1.4426950408889634f * g)); }
__device__ __forceinline__ float wave_sum(float v) {
#pragma unroll
    for (int o = 1; o < 64; o <<= 1) v += __shfl_xor(v, o);
    return v;
}
__device__ __forceinline__ float dpp_add(float v, const int ctrl_sel) {
    int r;
    if (ctrl_sel == 0) r = __builtin_amdgcn_update_dpp(0, __float_as_int(v), 0xB1, 0xF, 0xF, false);
    else if (ctrl_sel == 1) r = __builtin_amdgcn_update_dpp(0, __float_as_int(v), 0x4E, 0xF, 0xF, false);
    else if (ctrl_sel == 2) r = __builtin_amdgcn_update_dpp(0, __float_as_int(v), 0x141, 0xF, 0xF, false);
    else r = __builtin_amdgcn_update_dpp(0, __float_as_int(v), 0x140, 0xF, 0xF, false);
    return v + __int_as_float(r);
}
__device__ __forceinline__ float row16_allsum(float v) { v = dpp_add(v, 0); v = dpp_add(v, 1); v = dpp_add(v, 2); v = dpp_add(v, 3); return v; }
__device__ __forceinline__ f32x2 gelu_pk(f32x2 v) {
    const f32x2 av = __builtin_elementwise_abs(v), d = av * 0.2316418882f + 1.0f;
    f32x2 t; t.x = __builtin_amdgcn_rcpf(d.x); t.y = __builtin_amdgcn_rcpf(d.y);
    f32x2 q = t * 0.5307027145f + (-0.7265760135f); q = q * t + 0.7107068705f; q = q * t + (-0.142248368f); q = q * t + 0.127414796f; q = q * t;
    const f32x2 s = (v * v) * (-0.72134752044f);
    f32x2 e; e.x = __builtin_amdgcn_exp2f(s.x); e.y = __builtin_amdgcn_exp2f(s.y);
    const f32x2 m = v * (q * e), r = v - m;
    f32x2 o; o.x = v.x < 0.f ? m.x : r.x; o.y = v.y < 0.f ? m.y : r.y; return o;
}

#ifndef WT_STORES
#define WT_STORES 0
#endif
struct WtBuf { __amdgpu_buffer_rsrc_t r; };
__device__ __forceinline__ WtBuf wt_buf(const void* base) { WtBuf b; b.r = __builtin_amdgcn_make_buffer_rsrc((void*)base, 0, 0xFFFFFFFFu, 0x00020000); return b; }
__device__ __forceinline__ void wt_store16(const WtBuf& b, const void* base, size_t byte_off, u32x4 v) {
#if WT_STORES
    __builtin_amdgcn_raw_buffer_store_b128(v, b.r, (int)(unsigned)byte_off, 0, 16);
#else
    *(u32x4*)((char*)base + byte_off) = v;
#endif
}
__device__ __forceinline__ void wt_store16f(const WtBuf& b, const void* base, size_t byte_off, f32x4 v) { wt_store16(b, base, byte_off, __builtin_bit_cast(u32x4, v)); }

#define XB_TMO      128
#define XB_XCNT(j)  (256  + 64 * (j))
#define XB_XSUB(j)  (1280 + 64 * (j))
#define XB_XGEN(j)  (2304 + 64 * (j))
#define XB_TOP      3328
#define XB_TOPGEN   3392
#define XCD_BAR_WORDS 3456
#define XB_SPIN_CAP (1u << 18)
__device__ __forceinline__ unsigned xb_ld(unsigned* p)              { return __hip_atomic_load(p, __ATOMIC_RELAXED, __HIP_MEMORY_SCOPE_AGENT); }
__device__ __forceinline__ unsigned xb_add(unsigned* p, unsigned v) { return __hip_atomic_fetch_add(p, v, __ATOMIC_RELAXED, __HIP_MEMORY_SCOPE_AGENT); }
__device__ __forceinline__ unsigned xb_xcc_id() { return (unsigned)__builtin_amdgcn_s_getreg((3 << 11) | 20) & 0xFu; }
#define XB_SPIN(cond, bar) do { unsigned _sp = 0; while (cond) { __builtin_amdgcn_s_sleep(1); \
    if ((++_sp & 255u) == 0u) { if (xb_ld(&(bar)[XB_TMO])) break; if (_sp > XB_SPIN_CAP) { atomicAdd(&(bar)[XB_TMO], 1u); break; } } } } while (0)
struct XcdBarrier { unsigned* bar; unsigned x; volatile LAS unsigned* st; };
__device__ __forceinline__ XcdBarrier xcd_barrier_post(unsigned* bar, volatile LAS unsigned* st) {
    XcdBarrier b; b.bar = bar; b.x = xb_xcc_id(); b.st = st;
    if (threadIdx.x == 0) (void)xb_add(&bar[XB_XCNT(b.x)], 1u);
    return b;
}
__device__ __forceinline__ void xcd_barrier_complete(unsigned* bar, unsigned x, unsigned& nloc, unsigned& nx) {
    const unsigned G = gridDim.x * gridDim.y * gridDim.z;
    unsigned sum, cnt, mine, sp = 0u;
    for (;;) {
        sum = 0u; cnt = 0u; mine = 0u;
#pragma unroll
        for (unsigned j = 0; j < 16; ++j) { const unsigned c = xb_ld(&bar[XB_XCNT(j)]); sum += c; cnt += (c > 0u) ? 1u : 0u; mine = (j == x) ? c : mine; }
        if (sum == G) break;
        __builtin_amdgcn_s_sleep(1);
        if ((++sp & 255u) == 0u) { if (xb_ld(&bar[XB_TMO])) break; if (sp > XB_SPIN_CAP) { atomicAdd(&bar[XB_TMO], 1u); break; } }
    }
    nloc = mine > 0u ? mine : 1u; nx = cnt > 0u ? cnt : 1u;
}
__device__ __forceinline__ void xcd_barrier(const XcdBarrier& b) {
    asm volatile("s_waitcnt vmcnt(0)" ::: "memory");
    __syncthreads();
    if (threadIdx.x == 0) {
        unsigned* bar = b.bar;
        __builtin_amdgcn_s_waitcnt(0);
        unsigned nloc = b.st[0], nx = b.st[1];
        if (nloc == 0u) { xcd_barrier_complete(bar, b.x, nloc, nx); b.st[0] = nloc; b.st[1] = nx; }
        const unsigned old = xb_add(&bar[XB_XSUB(b.x)], 1u);
        const unsigned gen = old / nloc;
        if (old + 1u == (gen + 1u) * nloc) {
            __builtin_amdgcn_fence(__ATOMIC_RELEASE, "agent");
            asm volatile("s_waitcnt vmcnt(0)" ::: "memory");
            const unsigned og = xb_add(&bar[XB_TOP], 1u);
            const unsigned tg = og / nx;
            if (og + 1u == (tg + 1u) * nx) xb_add(&bar[XB_TOPGEN], 1u);
            else XB_SPIN(xb_ld(&bar[XB_TOPGEN]) == tg, bar);
            __builtin_amdgcn_fence(__ATOMIC_ACQUIRE, "agent");
            xb_add(&bar[XB_XGEN(b.x)], 1u);
            asm volatile("s_waitcnt vmcnt(0)" ::: "memory");
        } else {
            XB_SPIN(xb_ld(&bar[XB_XGEN(b.x)]) == gen, bar);
            __builtin_amdgcn_fence(__ATOMIC_ACQUIRE, "agent");
            asm volatile("s_waitcnt vmcnt(0)" ::: "memory");
        }
    }
    __syncthreads();
}

namespace pg8 {
constexpr int BM = 256, BK = 64, HALF = 128, HTB = HALF * BK * 2, STAGE_BYTES = 8 * HTB, NXCD = 8, WGM = 8;
__host__ __device__ __forceinline__ int lds_byte(int r, int c) { const int st = (r >> 4) * 2 + (c >> 5), rr = r & 15, cc = c & 31, ob = rr * 64 + cc * 2; return st * 1024 + (ob ^ (((ob >> 9) & 1) << 5)); }
__host__ __device__ __forceinline__ void stage_rc(int b, int& R, int& C) { const int st = b / 1024, sb = b % 1024, swz = sb ^ (((sb >> 9) & 1) << 5); R = (st >> 1) * 16 + swz / 64; C = (st & 1) * 32 + (swz % 64) / 2; }
__host__ __device__ __forceinline__ int perm32(int rho) { const int n = rho >> 4, i = rho & 15; return 8 * (i >> 2) + 4 * n + (i & 3); }

struct Unit { int pm, pn, e, valid, rb, ui, nt, k0, part, pi; };

struct StaticOrder {
    int nM, nN, nwg, G, c, i0, nmax;
    __device__ __forceinline__ void init(int nM_, int nN_, int G_, int c_) { nM = nM_; nN = nN_; nwg = nM * nN; G = G_; c = c_; i0 = 0; nmax = 1 << 30; }
    __device__ __forceinline__ bool map(int i, int& pm, int& pn) const {
        if (i >= nmax) return false;
        const long L = (long)(i + i0) * G + c; if (L >= nwg) return false;
        int wgid = (int)L; { const int q = nwg / NXCD, r = nwg % NXCD, xcd = wgid % NXCD, off = wgid / NXCD; wgid = (xcd < r ? xcd * (q + 1) : r * (q + 1) + (xcd - r) * q) + off; }
        const int nig = WGM * nN, gid = wgid / nig, fm = gid * WGM, gsz = (nM - fm) < WGM ? (nM - fm) : WGM;
        pm = fm + ((wgid % nig) % gsz); pn = (wgid % nig) / gsz; return true;
    }
};

typedef int v4i32 __attribute__((ext_vector_type(4)));
typedef int v8i32 __attribute__((ext_vector_type(8)));
template <class Epi, class Sched, bool ALIGN_EPI, bool FP8>
__device__ __forceinline__ void gemm_phase(LAS unsigned char* lds, const int KB, const Sched& S, const Epi& E) {
    const int tid = threadIdx.x, wid = __builtin_amdgcn_readfirstlane(tid >> 6), lane = tid & 63, wr = wid >> 2, wc = wid & 3, fr = lane & 15, fq = lane >> 4;
    int Rs[2], Cs[2]; unsigned voffB[2];
#pragma unroll
    for (int i = 0; i < 2; ++i) { stage_rc(tid * 16 + i * 8192, Rs[i], Cs[i]); voffB[i] = (unsigned)(Rs[i] * KB + Cs[i] * 2); }
    const size_t kstep = (size_t)(BK * 2);
    const size_t hstep = (size_t)HALF * KB;
    const unsigned ldsw = (unsigned)wid * 1024u;
    const int aoff = lds_byte(wr * 64 + fr, fq * 8), boff = lds_byte(wc * 32 + fr, fq * 8);
#define PG8_SA(b, h) (((b) * 2 + (h)) * HTB)
#define PG8_SB(b, h) ((4 + (b) * 2 + (h)) * HTB)
#define PG8_STAGE(bufoff, gbase, voff) do { _Pragma("unroll") for (int _i = 0; _i < 2; ++_i) \
        __builtin_amdgcn_global_load_lds((const unsigned*)((const char*)(gbase) + (voff)[_i]), (LAS unsigned*)(lds + (bufoff) + ldsw + _i * 8192), 16, 0, 0); } while (0)
#define PG8_LDA(dst, b, h) do { _Pragma("unroll") for (int m = 0; m < 4; ++m) dst[m] = __builtin_shufflevector(*(const LAS v4i32*)(lds + PG8_SA(b, h) + aoff + m * 2048), *(const LAS v4i32*)(lds + PG8_SA(b, h) + aoff + m * 2048 + 1024), 0, 1, 2, 3, 4, 5, 6, 7); } while (0)
#define PG8_LDB(dst, b, h) do { _Pragma("unroll") for (int n = 0; n < 2; ++n) dst[n] = __builtin_shufflevector(*(const LAS v4i32*)(lds + PG8_SB(b, h) + boff + n * 2048), *(const LAS v4i32*)(lds + PG8_SB(b, h) + boff + n * 2048 + 1024), 0, 1, 2, 3, 4, 5, 6, 7); } while (0)
#define PG8_MMA(ai, bj, At, Bt) do { __builtin_amdgcn_s_setprio(1); _Pragma("unroll") for (int m = 0; m < 4; ++m) _Pragma("unroll") for (int n = 0; n < 2; ++n) { \
        if constexpr (FP8) asm volatile("v_mfma_f32_16x16x128_f8f6f4 %0, %1, %2, %0" : "+v"(acc[ai][bj][m][n]) : "v"(Bt[n]), "v"(At[m]));   \
        else { acc[ai][bj][m][n] = __builtin_amdgcn_mfma_f32_16x16x32_bf16(__builtin_bit_cast(bf16x8, __builtin_shufflevector(Bt[n], Bt[n], 0, 1, 2, 3)), __builtin_bit_cast(bf16x8, __builtin_shufflevector(At[m], At[m], 0, 1, 2, 3)), acc[ai][bj][m][n], 0, 0, 0); \
               acc[ai][bj][m][n] = __builtin_amdgcn_mfma_f32_16x16x32_bf16(__builtin_bit_cast(bf16x8, __builtin_shufflevector(Bt[n], Bt[n], 4, 5, 6, 7)), __builtin_bit_cast(bf16x8, __builtin_shufflevector(At[m], At[m], 4, 5, 6, 7)), acc[ai][bj][m][n], 0, 0, 0); } } \
        __builtin_amdgcn_s_setprio(0); } while (0)
#define PG8_WAIT_V(n) asm volatile("s_waitcnt vmcnt(" #n ")" ::: "memory")
#define PG8_WAIT_L(n) asm volatile("s_waitcnt lgkmcnt(" #n ")" ::: "memory")
#define PG8_BAR __builtin_amdgcn_s_barrier()
#define PG8_SCHED __builtin_amdgcn_sched_barrier(0)
    Unit cur, nxt; int ui = 0;
    if (!S.next(0, cur)) return;
    f32x4 acc[2][2][4][2];
    E.init_acc(acc, cur, wr, wc, fr, fq);
    v8i32 At[4], B0[2], B1[2];
    const char* cA = S.a_ptr(cur); const char* cB = S.b_ptr(cur);
    unsigned offC[2][2], offN[2][2];
    S.a_offs(cur, Rs, Cs, offC);
    PG8_STAGE(PG8_SB(0, 0), cB, voffB); PG8_STAGE(PG8_SB(0, 1), cB + hstep, voffB); PG8_STAGE(PG8_SA(0, 0), cA, offC[0]); PG8_STAGE(PG8_SA(0, 1), cA, offC[1]);
    if (wr == 1) PG8_BAR;
    PG8_WAIT_V(2); PG8_BAR;
    PG8_STAGE(PG8_SB(1, 0), cB + kstep, voffB); PG8_STAGE(PG8_SA(1, 0), cA + kstep, offC[0]); PG8_STAGE(PG8_SB(1, 1), cB + hstep + kstep, voffB);
    PG8_WAIT_V(6); PG8_BAR;
    bool has_next = false; const char* nA = cA; const char* nB = cB;
    constexpr bool NEXT_IN_LOOP = FP8;
#define PG8_NEXT() do { has_next = S.next(ui + 1, nxt); nA = has_next ? S.a_ptr(nxt) : cA; nB = has_next ? S.b_ptr(nxt) : cB; \
        if (has_next) S.a_offs(nxt, Rs, Cs, offN); else { _Pragma("unroll") for (int h = 0; h < 2; ++h) _Pragma("unroll") for (int i = 0; i < 2; ++i) offN[h][i] = offC[h][i]; } } while (0)
    for (;;) {
        if constexpr (!NEXT_IN_LOOP) PG8_NEXT();
        const int nt = cur.nt;
        for (int t = 0; t < nt; t += 2) {
            const bool last = (t == nt - 2);
            const char* a1 = cA + (size_t)(t + 1) * kstep;
            const char* a2 = last ? nA : cA + (size_t)(t + 2) * kstep; const char* b2 = last ? nB : cB + (size_t)(t + 2) * kstep;
            const char* a3 = a2 + kstep; const char* b3 = b2 + kstep;
            unsigned o2[2][2];
#pragma unroll
            for (int h = 0; h < 2; ++h)
#pragma unroll
                for (int i = 0; i < 2; ++i) o2[h][i] = last ? offN[h][i] : offC[h][i];
            PG8_LDB(B0, 0, 0); PG8_LDB(B1, 0, 1); PG8_SCHED; PG8_LDA(At, 0, 0); PG8_STAGE(PG8_SA(1, 1), a1, offC[1]);
            PG8_WAIT_V(8); PG8_WAIT_L(0); PG8_BAR; PG8_MMA(0, 0, At, B0); PG8_MMA(0, 1, At, B1);
            if constexpr (NEXT_IN_LOOP) { if (t == 0) PG8_NEXT(); }
            PG8_BAR; PG8_SCHED;
            PG8_LDA(At, 0, 1); PG8_STAGE(PG8_SB(0, 0), b2, voffB); PG8_STAGE(PG8_SB(0, 1), b2 + hstep, voffB); PG8_STAGE(PG8_SA(0, 0), a2, o2[0]);
            PG8_WAIT_V(8); PG8_WAIT_L(0); PG8_BAR; PG8_MMA(1, 0, At, B0); PG8_MMA(1, 1, At, B1); PG8_BAR; PG8_SCHED;
            PG8_LDB(B0, 1, 0); PG8_LDB(B1, 1, 1); PG8_SCHED; PG8_LDA(At, 1, 0); PG8_STAGE(PG8_SA(0, 1), a2, o2[1]);
            PG8_WAIT_V(8); PG8_WAIT_L(0); PG8_BAR; PG8_MMA(0, 0, At, B0); PG8_MMA(0, 1, At, B1); PG8_BAR; PG8_SCHED;
            PG8_LDA(At, 1, 1); PG8_STAGE(PG8_SB(1, 0), b3, voffB); PG8_STAGE(PG8_SB(1, 1), b3 + hstep, voffB); PG8_STAGE(PG8_SA(1, 0), a3, o2[0]);
            PG8_WAIT_V(8); PG8_WAIT_L(0); PG8_BAR; PG8_MMA(1, 0, At, B0); PG8_MMA(1, 1, At, B1); PG8_BAR; PG8_SCHED;
        }
        if constexpr (ALIGN_EPI) { if (wr == 0) PG8_BAR; }
        if constexpr (FP8) asm volatile("s_nop 15\n\ts_nop 15" ::: "memory");
        if constexpr (!Epi::AFTER_DRAIN) E(acc, cur, wr, wc, fr, fq);
        if (!has_next) break;
        E.init_acc(acc, nxt, wr, wc, fr, fq);
        cur = nxt; cA = nA; cB = nB; ++ui;
#pragma unroll
        for (int h = 0; h < 2; ++h)
#pragma unroll
            for (int i = 0; i < 2; ++i) offC[h][i] = offN[h][i];
        if constexpr (ALIGN_EPI) { if (wr == 1) PG8_BAR; }
    }
    PG8_WAIT_V(0);
    if constexpr (!ALIGN_EPI) { if (wr == 0) PG8_BAR; }
    PG8_BAR;
    if constexpr (Epi::AFTER_DRAIN) E.fused(acc, cur, wr, wc, fr, fq, lds);
#undef PG8_NEXT
#undef PG8_SA
#undef PG8_SB
#undef PG8_STAGE
#undef PG8_LDA
#undef PG8_LDB
#undef PG8_MMA
#undef PG8_WAIT_V
#undef PG8_WAIT_L
#undef PG8_BAR
#undef PG8_SCHED
}

struct DenseSched {
    const char* A; const char* Bt; int KB; StaticOrder so; int g1;
    __device__ __forceinline__ bool next(int i, Unit& u) const { int pm, pn;
        if (g1) { const int L = i * so.G + so.c; if (L >= 512) return false; pm = (L & 255) >> 2; pn = (L & 3) + 4 * (L >> 8); }
        else if (!so.map(i, pm, pn)) return false; u.pm = pm; u.pn = pn; u.e = 0; u.valid = 256; u.rb = pm * 256; u.ui = i; u.nt = KB / 128; u.k0 = 0; u.part = 0; u.pi = 0; return true; }
    __device__ __forceinline__ const char* a_ptr(const Unit& u) const { return A + (size_t)u.pm * 256 * KB; }
    __device__ __forceinline__ const char* b_ptr(const Unit& u) const { return Bt + (size_t)u.pn * 256 * KB; }
    __device__ __forceinline__ void a_offs(const Unit&, const int (&R)[2], const int (&C)[2], unsigned (&off)[2][2]) const {
#pragma unroll
        for (int h = 0; h < 2; ++h)
#pragma unroll
            for (int i = 0; i < 2; ++i) off[h][i] = (unsigned)((h * 128 + R[i]) * KB + C[i] * 2); }
};
__device__ __forceinline__ void moe_lookup(const LAS int* tab, int vt, Unit& u) {
    int e = 0;
#pragma unroll
    for (int k = 1; k < 8; ++k) e += (vt >= tab[16 + k]) ? 1 : 0;
    e = __builtin_amdgcn_readfirstlane(e);
    const int tpe = __builtin_amdgcn_readfirstlane(tab[16 + e]), ce = __builtin_amdgcn_readfirstlane(tab[e]), be = __builtin_amdgcn_readfirstlane(tab[8 + e]);
    const int li = vt - tpe; u.pm = li; u.e = e; const int rem = ce - 256 * li; u.valid = rem < 256 ? rem : 256; u.rb = be + 256 * li;
}
template <int ES> struct MoeUpSched {
    const char* XA; const char* W; const LAS int* toktab; const LAS int* tab; StaticOrder so;
    __device__ __forceinline__ bool next(int i, Unit& u) const { int vt, pn; if (!so.map(i, vt, pn)) return false; moe_lookup(tab, vt, u); u.pn = pn; u.ui = i; u.nt = D * ES / 128; u.k0 = 0; u.part = 0; u.pi = 0; return true; }
    __device__ __forceinline__ const char* a_ptr(const Unit&) const { return XA; }
    __device__ __forceinline__ const char* b_ptr(const Unit& u) const { return W + ((size_t)u.e * NFF2 + (size_t)u.pn * 256) * D * ES; }
    __device__ __forceinline__ void a_offs(const Unit& u, const int (&R)[2], const int (&C)[2], unsigned (&off)[2][2]) const {
#pragma unroll
        for (int h = 0; h < 2; ++h)
#pragma unroll
            for (int i = 0; i < 2; ++i) off[h][i] = (unsigned)toktab[u.ui * 256 + h * 128 + R[i]] * (unsigned)(D * ES) + (unsigned)C[i] * 2u; }
};
template <int ES> struct MoeDownSched {
    const char* ACT; const char* W; const LAS int* tab; StaticOrder so;
    __device__ __forceinline__ bool next(int i, Unit& u) const {
        const int L = i * so.G + so.c, nf4 = so.nwg, np = __builtin_amdgcn_readfirstlane(tab[34]);
        if (L >= nf4 + 16 * np) return false;
        u.ui = i;
        if (L < nf4) {
            int f, pn; so.map(i, f, pn);
            int e = 0;
#pragma unroll
            for (int k = 1; k < 8; ++k) e += (f >= tab[25 + k]) ? 1 : 0;
            e = __builtin_amdgcn_readfirstlane(e);
            const int li = f - __builtin_amdgcn_readfirstlane(tab[25 + e]);
            u.pm = li; u.pn = pn; u.e = e; u.valid = 256; u.rb = __builtin_amdgcn_readfirstlane(tab[8 + e]) + 256 * li; u.nt = FF * ES / 128; u.k0 = 0; u.part = 0; u.pi = 0;
        } else {
            const int s = L - nf4, p = s >> 4, r = s & 15, kp = r & 3;
            const int e = __builtin_amdgcn_readfirstlane(tab[35 + p]), ce = __builtin_amdgcn_readfirstlane(tab[e]);
            u.pm = ce >> 8; u.pn = r >> 2; u.e = e; u.valid = ce & 255; u.rb = __builtin_amdgcn_readfirstlane(tab[8 + e]) + (ce & ~255);
            constexpr int NTK = FF * ES / 128, Q = ((NTK / 4) + 1) & ~1;
            static_assert(NTK - 3 * Q >= 4 && ((NTK - 3 * Q) & 1) == 0, "K split");
            u.k0 = kp * Q; u.nt = kp < 3 ? Q : NTK - 3 * Q; u.part = 1; u.pi = p * 4 + kp;
        }
        return true;
    }
    __device__ __forceinline__ const char* a_ptr(const Unit& u) const { return ACT + (size_t)u.rb * FF * ES + (size_t)u.k0 * 128; }
    __device__ __forceinline__ const char* b_ptr(const Unit& u) const { return W + ((size_t)u.e * D + (size_t)u.pn * 256) * FF * ES + (size_t)u.k0 * 128; }
    __device__ __forceinline__ void a_offs(const Unit&, const int (&R)[2], const int (&C)[2], unsigned (&off)[2][2]) const {
#pragma unroll
        for (int h = 0; h < 2; ++h)
#pragma unroll
            for (int i = 0; i < 2; ++i) off[h][i] = (unsigned)((h * 128 + R[i]) * FF * ES + C[i] * 2); }
};

__device__ __forceinline__ void zero_acc(f32x4 (&acc)[2][2][4][2]) {
#pragma unroll
    for (int a = 0; a < 2; ++a)
#pragma unroll
        for (int b = 0; b < 2; ++b)
#pragma unroll
            for (int m = 0; m < 4; ++m)
#pragma unroll
                for (int n = 0; n < 2; ++n) acc[a][b][m][n] = (f32x4){0.f, 0.f, 0.f, 0.f};
}
__device__ __forceinline__ float rstd_of(float p) { p += __shfl_xor(p, 16); p += __shfl_xor(p, 32); return 1.0f / sqrtf(p * (1.0f / D) + EPS); }
struct EpiMix {
    static constexpr bool AFTER_DRAIN = false;
    bf16_t* CG; bf16_t* UA; bf16_t* VA; const LAS float* rstab;
    __device__ __forceinline__ void init_acc(f32x4 (&acc)[2][2][4][2], const Unit&, int, int, int, int) const { zero_acc(acc); }
    __device__ __forceinline__ void operator()(const f32x4 (&acc)[2][2][4][2], const Unit& u, int wr, int wc, int fr, int fq) const {
        const int row0 = u.rb + wr * 64 + fr;
        const WtBuf bcg = wt_buf(CG), bdst = wt_buf(u.pn < 6 ? UA : VA);
        float rsv[2][4];
#pragma unroll
        for (int ai = 0; ai < 2; ++ai)
#pragma unroll
            for (int m = 0; m < 4; ++m) rsv[ai][m] = rstab[u.ui * 256 + ai * HALF + wr * 64 + m * 16 + fr];
#pragma unroll
        for (int ai = 0; ai < 2; ++ai)
#pragma unroll
            for (int m = 0; m < 4; ++m) {
                const int row = row0 + ai * HALF + m * 16; const float rs = rsv[ai][m];
                if (u.pn < 4) {
                    float o[8];
#pragma unroll
                    for (int n = 0; n < 2; ++n)
#pragma unroll
                        for (int j = 0; j < 4; ++j) { const float a = acc[ai][0][m][n][j] * rs, g = acc[ai][1][m][n][j] * rs; o[4 * n + j] = a * fast_sigmoid(g); }
                    u32x4 w; w.x = cvt_pk_bf16(o[0], o[1]); w.y = cvt_pk_bf16(o[2], o[3]); w.z = cvt_pk_bf16(o[4], o[5]); w.w = cvt_pk_bf16(o[6], o[7]);
                    wt_store16(bcg, CG, ((size_t)row * CC + u.pn * 128 + wc * 32 + 8 * fq) * 2, w);
                } else {
                    bf16_t* dbase = (u.pn < 6 ? UA : VA); const size_t doff = ((size_t)row * CC + (u.pn & 1) * 256 + wc * 32 + 8 * fq) * 2;
#pragma unroll
                    for (int bj = 0; bj < 2; ++bj) {
                        const f32x4 v0 = acc[ai][bj][m][0] * rs, v1 = acc[ai][bj][m][1] * rs;
                        const f32x2 a = gelu_pk((f32x2){v0[0], v0[1]}), b = gelu_pk((f32x2){v0[2], v0[3]}), c = gelu_pk((f32x2){v1[0], v1[1]}), d = gelu_pk((f32x2){v1[2], v1[3]});
                        u32x4 w; w.x = cvt_pk_bf16(a.x, a.y); w.y = cvt_pk_bf16(b.x, b.y); w.z = cvt_pk_bf16(c.x, c.y); w.w = cvt_pk_bf16(d.x, d.y);
                        wt_store16(bdst, dbase, doff + bj * HALF * 2, w); }
                }
            }
    }
};
struct EpiRes {
    static constexpr bool AFTER_DRAIN = true;
    const float* XIN; float* XOUT; bf16_t* XB; float* rss_out; unsigned char* XB8; float sc_in, sc_out;
    __device__ __forceinline__ void init_acc(f32x4 (&acc)[2][2][4][2], const Unit& u, int wr, int wc, int fr, int fq) const {
        const int row0 = u.rb + wr * 64 + fr, col0 = u.pn * 256 + wc * 32 + 8 * fq;
#pragma unroll
        for (int ai = 0; ai < 2; ++ai)
#pragma unroll
            for (int m = 0; m < 4; ++m)
#pragma unroll
                for (int bj = 0; bj < 2; ++bj) { const size_t off = (size_t)(row0 + ai * HALF + m * 16) * D + col0 + bj * HALF;
                    if (RES_BF16) { const u32x4 w = *(const u32x4*)(XB + off);
                        acc[ai][bj][m][0] = (f32x4){bf_lo(w.x), bf_hi(w.x), bf_lo(w.y), bf_hi(w.y)} * sc_in; acc[ai][bj][m][1] = (f32x4){bf_lo(w.z), bf_hi(w.z), bf_lo(w.w), bf_hi(w.w)} * sc_in; }
                    else { acc[ai][bj][m][0] = *(const f32x4*)(XIN + off) * sc_in; acc[ai][bj][m][1] = *(const f32x4*)(XIN + off + 4) * sc_in; } }
    }
    __device__ __forceinline__ void fused(const f32x4 (&acc)[2][2][4][2], const Unit& u, int wr, int wc, int fr, int fq, LAS unsigned char* lds) const {
        const int row0 = u.rb + wr * 64 + fr, col0 = u.pn * 256 + wc * 32 + 8 * fq;
        LAS float* P = (LAS float*)lds;
        const WtBuf bxo = wt_buf(XOUT), bxb = wt_buf(XB);
#pragma unroll
        for (int ai = 0; ai < 2; ++ai)
#pragma unroll
            for (int m = 0; m < 4; ++m) {
                const int lr = ai * HALF + wr * 64 + m * 16 + fr, row = u.rb + lr; float ss = 0.f;
#pragma unroll
                for (int bj = 0; bj < 2; ++bj) {
                    const size_t off = (size_t)row * D + col0 + bj * HALF;
                    const f32x4 x0 = acc[ai][bj][m][0] * sc_out, x1 = acc[ai][bj][m][1] * sc_out;
                    if (!RES_BF16) { wt_store16f(bxo, XOUT, off * 4, x0); wt_store16f(bxo, XOUT, off * 4 + 16, x1); }
                    u32x4 w; w.x = cvt_pk_bf16(x0[0], x0[1]); w.y = cvt_pk_bf16(x0[2], x0[3]); w.z = cvt_pk_bf16(x1[0], x1[1]); w.w = cvt_pk_bf16(x1[2], x1[3]);
                    wt_store16(bxb, XB, off * 2, w);
                    if (XB8) { u32x2 q; q.x = pk_fp8x4(x0[0], x0[1], x0[2], x0[3]); q.y = pk_fp8x4(x1[0], x1[1], x1[2], x1[3]); *(u32x2*)(XB8 + off) = q; }
                    ss += (x0[0] * x0[0] + x0[1] * x0[1]) + (x0[2] * x0[2] + x0[3] * x0[3]) + (x1[0] * x1[0] + x1[1] * x1[1]) + (x1[2] * x1[2] + x1[3] * x1[3]); }
                ss += __shfl_xor(ss, 16); ss += __shfl_xor(ss, 32);
                if (fq == 0) P[lr * 4 + wc] = ss;
            }
        (void)row0;
        __syncthreads();
        if (threadIdx.x < 256) { const f32x4 p = *(const LAS f32x4*)(P + threadIdx.x * 4); rss_out[(size_t)(u.rb + threadIdx.x) * 4 + u.pn] = (p.x + p.y) + (p.z + p.w); }
        __syncthreads();
    }
};
template <bool MOE, bool F8> struct EpiSwiglu {
    static constexpr bool AFTER_DRAIN = false;
    void* ACT; const LAS float* rstab; float post;
    __device__ __forceinline__ void init_acc(f32x4 (&acc)[2][2][4][2], const Unit&, int, int, int, int) const { zero_acc(acc); }
    __device__ __forceinline__ void operator()(const f32x4 (&acc)[2][2][4][2], const Unit& u, int wr, int wc, int fr, int fq) const {
        const int col = u.pn * 128 + wc * 32 + 8 * fq;
        const WtBuf bact = wt_buf(ACT);
        float rsv[2][4];
#pragma unroll
        for (int ai = 0; ai < 2; ++ai)
#pragma unroll
            for (int m = 0; m < 4; ++m) rsv[ai][m] = rstab[u.ui * 256 + ai * HALF + wr * 64 + m * 16 + fr];
#pragma unroll
        for (int ai = 0; ai < 2; ++ai)
#pragma unroll
            for (int m = 0; m < 4; ++m) {
                const int lr = ai * HALF + wr * 64 + m * 16 + fr;
                const float rs = rsv[ai][m];
                const float k1 = -1.4426950408889634f * rs, k2 = rs * rs * post;
                float o[8];
#pragma unroll
                for (int n = 0; n < 2; ++n) {
                    const f32x4 ag = acc[ai][0][m][n], au = acc[ai][1][m][n]; const f32x4 tt = ag * k1; f32x4 ee;
#pragma unroll
                    for (int j = 0; j < 4; ++j) ee[j] = __builtin_amdgcn_exp2f(tt[j]);
                    ee = ee + 1.0f; f32x4 rr;
#pragma unroll
                    for (int j = 0; j < 4; ++j) rr[j] = __builtin_amdgcn_rcpf(ee[j]);
                    const f32x4 oo = (ag * au) * (rr * k2);
#pragma unroll
                    for (int j = 0; j < 4; ++j) o[4 * n + j] = oo[j]; }
                if constexpr (F8) {
                    u32x2 q; q.x = pk_fp8x4(o[0], o[1], o[2], o[3]); q.y = pk_fp8x4(o[4], o[5], o[6], o[7]);
                    if (!MOE || lr < u.valid) *(u32x2*)((unsigned char*)ACT + (size_t)(u.rb + lr) * FF + col) = q;
                } else {
                    u32x4 w; w.x = cvt_pk_bf16(o[0], o[1]); w.y = cvt_pk_bf16(o[2], o[3]); w.z = cvt_pk_bf16(o[4], o[5]); w.w = cvt_pk_bf16(o[6], o[7]);
                    if (!MOE || lr < u.valid) wt_store16(bact, ACT, ((size_t)(u.rb + lr) * FF + col) * 2, w);
                }
            }
    }
};
struct EpiSlot {
    static constexpr bool AFTER_DRAIN = false;
    bf16_t* YS; float* YP; float sc;
    __device__ __forceinline__ void init_acc(f32x4 (&acc)[2][2][4][2], const Unit&, int, int, int, int) const { zero_acc(acc); }
    __device__ __forceinline__ void operator()(const f32x4 (&acc)[2][2][4][2], const Unit& u, int wr, int wc, int fr, int fq) const {
        const int col0 = u.pn * 256 + wc * 32 + 8 * fq;
        const WtBuf bys = wt_buf(YS);
#pragma unroll
        for (int ai = 0; ai < 2; ++ai)
#pragma unroll
            for (int m = 0; m < 4; ++m) {
                const int lr = ai * HALF + wr * 64 + m * 16 + fr;
                if (lr < u.valid) {
#pragma unroll
                    for (int bj = 0; bj < 2; ++bj) {
                        const f32x4 x0 = acc[ai][bj][m][0] * sc, x1 = acc[ai][bj][m][1] * sc;
                        if (u.part) { const char* ypb = (const char*)(YP + (size_t)u.pi * 256 * D); const unsigned yo = (unsigned)((lr * D + col0 + bj * HALF) * 4);
                            *(f32x4*)(ypb + yo) = x0; *(f32x4*)(ypb + yo + 16) = x1; continue; }
                        u32x4 w; w.x = cvt_pk_bf16(x0[0], x0[1]); w.y = cvt_pk_bf16(x0[2], x0[3]); w.z = cvt_pk_bf16(x1[0], x1[1]); w.w = cvt_pk_bf16(x1[2], x1[3]);
                        wt_store16(bys, YS, ((size_t)(u.rb + lr) * D + col0 + bj * HALF) * 2, w); }
                }
            }
    }
};
struct EpiNull {
    static constexpr bool AFTER_DRAIN = false;
    float* sink;
    __device__ __forceinline__ void init_acc(f32x4 (&acc)[2][2][4][2], const Unit&, int, int, int, int) const { zero_acc(acc); }
    __device__ __forceinline__ void operator()(const f32x4 (&acc)[2][2][4][2], const Unit& u, int wr, int wc, int fr, int fq) const {
        f32x4 s = (f32x4){0.f, 0.f, 0.f, 0.f};
#pragma unroll
        for (int a = 0; a < 2; ++a)
#pragma unroll
            for (int b = 0; b < 2; ++b)
#pragma unroll
                for (int m = 0; m < 4; ++m)
#pragma unroll
                    for (int n = 0; n < 2; ++n) s += acc[a][b][m][n];
        const float t = (s.x + s.y) + (s.z + s.w);
        if (t == 1.2345678e30f) sink[threadIdx.x] = t;
    }
};
}

struct Args { const float* in[21]; float* out; unsigned char* ws; int ph_lo, ph_hi; };
enum { I_X = 0, I_NMIX, I_WIN, I_CONVW, I_CONVB, I_CONVNG, I_CONVNB, I_SGUNG, I_SGUNB, I_SGUW, I_SGUB, I_WOUT, I_NFFN, I_FWG, I_FWU, I_FWD, I_ROUTER, I_MWG, I_MWU, I_MWD, I_NFINAL };

struct P0Item { const float* W; const float* gain; void* dst; int N, K, c0, k0, f8; };
struct P0Buf { float v[32]; f32x4 g0, g1, g2, g3; };
__device__ __forceinline__ void p0_load(const P0Item& p, int lane, P0Buf& b) {
    const float* s = p.W + (size_t)(p.k0 + (lane >> 5)) * p.N + p.c0 + (lane & 31);
#pragma unroll
    for (int i = 0; i < 32; ++i) b.v[i] = s[(size_t)(2 * i) * p.N];
    const f32x4 one = (f32x4){1.f, 1.f, 1.f, 1.f};
    b.g0 = one; b.g1 = one; b.g2 = one; b.g3 = one;
    if (p.gain) {
        if (p.f8) { const float* gp = p.gain + p.k0 + 16 * (lane & 3); b.g0 = *(const f32x4*)gp; b.g1 = *(const f32x4*)(gp + 4); b.g2 = *(const f32x4*)(gp + 8); b.g3 = *(const f32x4*)(gp + 12); }
        else { const float* gp = p.gain + p.k0 + 8 * (lane & 7); b.g0 = *(const f32x4*)gp; b.g1 = *(const f32x4*)(gp + 4); }
    }
}
__device__ __forceinline__ void p0_finish(const P0Item& p, const P0Buf& b, LAS float* scr, int lane, const int mode = 0) {
    if (mode == 1) { float s = 0.f;
#pragma unroll
        for (int i = 0; i < 32; ++i) s += b.v[i];
        if (s == 1.2345678e30f) *(float*)p.dst = s; return; }
#pragma unroll
    for (int i = 0; i < 32; ++i) scr[(2 * i + (lane >> 5)) * 33 + (lane & 31)] = b.v[i];
    if (!p.f8) {
        const int c = lane & 7;
        const f32x4 g0 = b.g0, g1 = b.g1;
        asm volatile("s_waitcnt lgkmcnt(0)" ::: "memory");
        const WtBuf bd = wt_buf(p.dst);
#pragma unroll
        for (int j = 0; j < 4; ++j) { const int rho = (lane >> 3) + 8 * j; const LAS float* s = scr + (8 * c) * 33 + pg8::perm32(rho);
            u32x4 o; o.x = cvt_pk_bf16(s[0 * 33] * g0.x, s[1 * 33] * g0.y); o.y = cvt_pk_bf16(s[2 * 33] * g0.z, s[3 * 33] * g0.w); o.z = cvt_pk_bf16(s[4 * 33] * g1.x, s[5 * 33] * g1.y); o.w = cvt_pk_bf16(s[6 * 33] * g1.z, s[7 * 33] * g1.w);
            if (mode == 0 || o.x == 0x12345678u) wt_store16(bd, p.dst, ((size_t)rho * p.K + p.k0 + 8 * c) * 2, o); }
    } else {
        const int c4 = lane & 3;
        const f32x4 g[4] = {b.g0 * MOE_SW, b.g1 * MOE_SW, b.g2 * MOE_SW, b.g3 * MOE_SW};
        asm volatile("s_waitcnt lgkmcnt(0)" ::: "memory");
#pragma unroll
        for (int j = 0; j < 2; ++j) { const int rho = (lane >> 2) + 16 * j; const LAS float* s = scr + (16 * c4) * 33 + pg8::perm32(rho);
            u32x4 o;
            o.x = pk_fp8x4(s[0 * 33] * g[0].x, s[1 * 33] * g[0].y, s[2 * 33] * g[0].z, s[3 * 33] * g[0].w);
            o.y = pk_fp8x4(s[4 * 33] * g[1].x, s[5 * 33] * g[1].y, s[6 * 33] * g[1].z, s[7 * 33] * g[1].w);
            o.z = pk_fp8x4(s[8 * 33] * g[2].x, s[9 * 33] * g[2].y, s[10 * 33] * g[2].z, s[11 * 33] * g[2].w);
            o.w = pk_fp8x4(s[12 * 33] * g[3].x, s[13 * 33] * g[3].y, s[14 * 33] * g[3].z, s[15 * 33] * g[3].w);
            if (mode == 0 || o.x == 0x12345678u) *(u32x4*)((unsigned char*)p.dst + (size_t)rho * p.K + p.k0 + 16 * c4) = o; }
    }
    asm volatile("s_waitcnt lgkmcnt(0)" ::: "memory");
}
constexpr int IT_WIN = 16 * 64, IT_WOUT = 16 * 32, IT_GU = 16 * 176, IT_DN = 44 * 32;
constexpr int P0_NITEMS = 2 * IT_WIN + 2 * IT_WOUT + IT_GU + IT_DN;
constexpr int IT_GU8 = 8 * 176, IT_DN8 = 22 * 32, P0_NITEMS8 = NE * (IT_GU8 + IT_DN8);
__device__ __forceinline__ bool p0_decode(const Args& args, int it, P0Item& p) {
    if (it >= P0_NITEMS) return false;
    unsigned char* ws = args.ws; int r = it;
    if (r < 2 * IT_WIN) { const int l = r / IT_WIN; r -= l * IT_WIN; const int kb = r / 64, g32 = r % 64, Lb = 32 * g32;
        p.c0 = Lb < 1024 ? ((Lb >> 7) & 1) * 512 + (Lb >> 8) * 128 + (Lb & 127) : Lb;
        p.W = args.in[I_WIN] + (size_t)l * D * DIN; p.N = DIN; p.K = D; p.gain = args.in[I_NMIX] + l * D; p.dst = (bf16_t*)(ws + WS_WIN) + ((size_t)l * DIN + Lb) * D; p.k0 = 64 * kb; p.f8 = 0; return true; }
    r -= 2 * IT_WIN;
    if (r < 2 * IT_WOUT) { const int l = r / IT_WOUT; r -= l * IT_WOUT; const int kb = r / 32, g32 = r % 32, Lb = 32 * g32;
        p.c0 = Lb; p.W = args.in[I_WOUT] + (size_t)l * D * D; p.N = D; p.K = D; p.gain = nullptr; p.dst = (bf16_t*)(ws + WS_WOUT) + ((size_t)l * D + Lb) * D; p.k0 = 64 * kb; p.f8 = 0; return true; }
    r -= 2 * IT_WOUT;
    if (r < IT_GU) { const int kb = r / 176, g32 = r % 176, Lb = 32 * g32; const int kind = (Lb >> 7) & 1;
        p.c0 = (Lb >> 8) * 128 + (Lb & 127); p.W = args.in[kind ? I_FWU : I_FWG]; p.N = FF; p.K = D; p.gain = args.in[I_NFFN]; p.dst = (unsigned char*)(ws + WS_FGU) + (size_t)Lb * D * (DENSE_FP8 ? 1 : 2); p.k0 = 64 * kb; p.f8 = DENSE_FP8; return true; }
    r -= IT_GU;
    if (r < IT_DN) { const int kb = r / 32, g32 = r % 32, Lb = 32 * g32;
        p.c0 = Lb; p.W = args.in[I_FWD]; p.N = D; p.K = FF; p.gain = nullptr; p.dst = (unsigned char*)(ws + WS_FD) + (size_t)Lb * FF * (DENSE_FP8 ? 1 : 2); p.k0 = 64 * kb; p.f8 = DENSE_FP8; return true; }
    return false;
}
struct P8Buf { float v[64]; };
__device__ __forceinline__ bool p8_decode(const Args& args, int it, P0Item& p) {
    if (it >= P0_NITEMS8) return false;
    unsigned char* ws = args.ws; int r = it; p.f8 = 1;
    if (r < NE * IT_GU8) { const int e = r / IT_GU8; r -= e * IT_GU8; const int kb = r / 176, g32 = r % 176, Lb = 32 * g32; const int kind = (Lb >> 7) & 1;
        p.c0 = (Lb >> 8) * 128 + (Lb & 127); p.W = args.in[kind ? I_MWU : I_MWG] + (size_t)e * D * FF; p.N = FF; p.K = D; p.gain = args.in[I_NFFN] + D; p.dst = (unsigned char*)(ws + WS_MGU) + ((size_t)e * NFF2 + Lb) * D; p.k0 = 128 * kb; return true; }
    r -= NE * IT_GU8;
    { const int e = r / IT_DN8; r -= e * IT_DN8; const int kb = r / 32, g32 = r % 32, Lb = 32 * g32;
        p.c0 = Lb; p.W = args.in[I_MWD] + (size_t)e * FF * D; p.N = D; p.K = FF; p.gain = nullptr; p.dst = (unsigned char*)(ws + WS_MD) + ((size_t)e * D + Lb) * FF; p.k0 = 128 * kb; return true; }
}
__device__ __forceinline__ void p8_load(const P0Item& p, int lane, P8Buf& b) {
    const float* s = p.W + (size_t)(p.k0 + (lane >> 5)) * p.N + p.c0 + (lane & 31);
#pragma unroll
    for (int i = 0; i < 64; ++i) b.v[i] = s[(size_t)(2 * i) * p.N];
}
__device__ __forceinline__ void p8_finish(const P0Item& p, const P8Buf& b, LAS float* scr, int lane) {
    const int c8 = lane & 7;
    const f32x4 sw = (f32x4){MOE_SW, MOE_SW, MOE_SW, MOE_SW};
    f32x4 g[4] = {sw, sw, sw, sw};
    if (p.gain) { const float* gp = p.gain + p.k0 + 16 * c8; g[0] = *(const f32x4*)gp * MOE_SW; g[1] = *(const f32x4*)(gp + 4) * MOE_SW; g[2] = *(const f32x4*)(gp + 8) * MOE_SW; g[3] = *(const f32x4*)(gp + 12) * MOE_SW; }
#pragma unroll
    for (int i = 0; i < 64; ++i) scr[(2 * i + (lane >> 5)) * 33 + (lane & 31)] = b.v[i];
    asm volatile("s_waitcnt lgkmcnt(0)" ::: "memory");
#pragma unroll
    for (int j = 0; j < 4; ++j) { const int rho = (lane >> 3) + 8 * j; const LAS float* s = scr + (16 * c8) * 33 + pg8::perm32(rho);
        u32x4 o;
        o.x = pk_fp8x4(s[0 * 33] * g[0].x, s[1 * 33] * g[0].y, s[2 * 33] * g[0].z, s[3 * 33] * g[0].w);
        o.y = pk_fp8x4(s[4 * 33] * g[1].x, s[5 * 33] * g[1].y, s[6 * 33] * g[1].z, s[7 * 33] * g[1].w);
        o.z = pk_fp8x4(s[8 * 33] * g[2].x, s[9 * 33] * g[2].y, s[10 * 33] * g[2].z, s[11 * 33] * g[2].w);
        o.w = pk_fp8x4(s[12 * 33] * g[3].x, s[13 * 33] * g[3].y, s[14 * 33] * g[3].z, s[15 * 33] * g[3].w);
        *(u32x4*)((unsigned char*)p.dst + (size_t)rho * p.K + p.k0 + 16 * c8) = o; }
    asm volatile("s_waitcnt lgkmcnt(0)" ::: "memory");
}
struct PXBuf { f32x4 v[4][4]; };
__device__ __forceinline__ void px_load(const Args& args, int it, int lane, PXBuf& b) {
#pragma unroll
    for (int k = 0; k < 4; ++k) { const f32x4* xr = (const f32x4*)(args.in[I_X] + (size_t)(4 * it + k) * D) + lane;
#pragma unroll
        for (int j = 0; j < 4; ++j) b.v[k][j] = xr[64 * j]; }
}
__device__ __forceinline__ void px_finish(const Args& args, int it, int lane, const PXBuf& b) {
    bf16_t* XB = (bf16_t*)(args.ws + WS_XB); float* rss = (float*)(args.ws + WS_RSS);
#pragma unroll
    for (int k = 0; k < 4; ++k) { const int m = 4 * it + k; float s = 0.f;
#pragma unroll
        for (int j = 0; j < 4; ++j) s += (b.v[k][j].x * b.v[k][j].x + b.v[k][j].y * b.v[k][j].y) + (b.v[k][j].z * b.v[k][j].z + b.v[k][j].w * b.v[k][j].w);
        s = row16_allsum(s); s += __shfl_xor(s, 16); s += __shfl_xor(s, 32);
        u32x2* o8 = (u32x2*)(XB + (size_t)m * D) + lane;
#pragma unroll
        for (int j = 0; j < 4; ++j) { u32x2 w; w.x = cvt_pk_bf16(b.v[k][j].x, b.v[k][j].y); w.y = cvt_pk_bf16(b.v[k][j].z, b.v[k][j].w); o8[64 * j] = w; }
        if (lane < 4) rss[(size_t)m * 4 + lane] = lane == 0 ? s : 0.f; }
}
constexpr int CW_Q = 9216;
static_assert(P0_NITEMS % 8 == 0 && P0_NITEMS8 % 8 == 0 && T % 32 == 0 && (CW_Q + 3 * 64) * 4 <= (int)CTL_ZERO_BYTES, "prologue tasks");
#define P0_TICKET(dst, NS, CTR) do { if (kseq < (NS)) { dst = (int)blockIdx.x + kseq * (int)gridDim.x; } else { \
        if (threadIdx.x == 0) slot[kseq & 1] = (NS) * (int)gridDim.x + (int)__hip_atomic_fetch_add((CTR), 1u, RLX_AGENT); __syncthreads(); dst = slot[kseq & 1]; } ++kseq; } while (0)
#define P0_DYN(NTASKS, CTR, BUFT, LOADSTMT, FINSTMT) do { \
        BUFT ba, bb; LAS int* slot = (LAS int*)(lds + LDSCTL_OFF + 448); int kseq = 0; \
        const int ns_ = (((NTASKS) * 3) / 4) / (int)gridDim.x; \
        int t0, t1; P0_TICKET(t0, ns_, CTR); P0_TICKET(t1, ns_, CTR); \
        if (t0 < (NTASKS)) { const int it = t0 * 8 + wave; BUFT& b = ba; LOADSTMT; } \
        while (t0 < (NTASKS)) { \
            if (t1 < (NTASKS)) { const int it = t1 * 8 + wave; BUFT& b = bb; LOADSTMT; } \
            { const int it = t0 * 8 + wave; BUFT& b = ba; FINSTMT; } \
            if (t1 >= (NTASKS)) break; \
            int t2; P0_TICKET(t2, ns_, CTR); \
            if (t2 < (NTASKS)) { const int it = t2 * 8 + wave; BUFT& b = ba; LOADSTMT; } \
            { const int it = t1 * 8 + wave; BUFT& b = bb; FINSTMT; } \
            if (t2 >= (NTASKS)) break; \
            int t3; P0_TICKET(t3, ns_, CTR); \
            t0 = t2; t1 = t3; } \
        __syncthreads(); } while (0)
__device__ __forceinline__ void prologue_phase(const Args& args, LAS unsigned char* lds, int gw, int NGW, int lane, int wave) {
    unsigned char* ws = args.ws; unsigned* ctl = (unsigned*)(ws + WS_CTL);
#if PROBE_P0 == 3
    { LAS float* scr0 = (LAS float*)(lds + (wave < 7 ? wave * 16896 : TOKTAB_OFF));
      for (int it = gw; it < P0_NITEMS8; it += NGW) { P0Item p; p8_decode(args, it, p); P8Buf b;
#pragma unroll
          for (int i = 0; i < 64; ++i) b.v[i] = (float)(lane + i);
          p.gain = nullptr; p8_finish(p, b, scr0, lane); } }
#endif
    LAS float* scr = (LAS float*)(lds + (wave < 7 ? wave * 16896 : TOKTAB_OFF));
    static_assert(7 * 16896 <= LDSCTL_OFF && TOKTAB_OFF + 16896 <= LDS_BYTES, "prologue scratch");
    P0_DYN(P0_NITEMS8 / 8, ctl + CW_Q, P8Buf, { P0Item p; p8_decode(args, it, p); p8_load(p, lane, b); }, { P0Item p; p8_decode(args, it, p); p8_finish(p, b, scr, lane); });
    P0_DYN(P0_NITEMS / 8, ctl + CW_Q + 64, P0Buf, { P0Item p; p0_decode(args, it, p); p0_load(p, lane, b); }, { P0Item p; p0_decode(args, it, p); p0_finish(p, b, scr, lane); });
    P0_DYN(T / 32, ctl + CW_Q + 128, PXBuf, { px_load(args, it, lane, b); }, { px_finish(args, it, lane, b); });
    { float* RT = (float*)(ws + WS_RT); const float* rt = args.in[I_ROUTER]; const float* g = args.in[I_NFFN] + D;
      for (int i = gw * 64 + lane; i < NE * D; i += NGW * 64) { const int e = i / D, k = i % D; RT[i] = rt[k * NE + e] * g[k]; } }
    { bf16_t* SW = (bf16_t*)(ws + WS_SGUW); const float* sw = args.in[I_SGUW];
      for (int i = gw * 64 + lane; i < 2 * 4 * 128 * 128 / 2; i += NGW * 64) { const int e0 = 2 * i, tt = (e0 >> 7) & 127, s0 = e0 & 127;
          const float a = s0 <= tt ? sw[e0] : 0.f, b = (s0 + 1) <= tt ? sw[e0 + 1] : 0.f; ((unsigned*)SW)[i] = cvt_pk_bf16(a, b); } }
}

__device__ __forceinline__ void mid_phase(const Args& args, LAS unsigned char* lds, int l, int gw, int NGW, int lane, int wave, const int parts = 3) {
    unsigned char* ws = args.ws;
    const bf16_t* CG = (const bf16_t*)(ws + WS_CG); const bf16_t* UA = (const bf16_t*)(ws + WS_UA); const bf16_t* VA = (const bf16_t*)(ws + WS_VA); bf16_t* Y = (bf16_t*)(ws + WS_Y);
    const int fr = lane & 15, fq = lane >> 4;
    const int cv_cg = gw & 3, cv_ch = cv_cg * 128 + 2 * lane, cv_step = NGW >> 2, cv_first = gw >> 2;
    unsigned cv_raw[62];
    if (parts & 2) {
        if (cv_first < NB * (SEQ / 32)) { const int b = cv_first >> 6, t0 = (cv_first & 63) * 32; const size_t rowb = (size_t)b * SEQ;
#pragma unroll
            for (int i = 0; i < 62; ++i) { const int ta = t0 - 30 + i; cv_raw[i] = ta >= 0 ? *(const unsigned*)(CG + (rowb + ta) * CC + cv_ch) : 0u; } }
    }
    if (parts & 1) {
        constexpr int VST = 264;
        const bf16_t* Wb = (const bf16_t*)(ws + WS_SGUW) + (size_t)l * 4 * 128 * 128;
        const float* ng = args.in[I_SGUNG] + l * CC; const float* nb = args.in[I_SGUNB] + l * CC; const float* sb = args.in[I_SGUB] + l * 4 * 128;
        for (int unit = blockIdx.x; unit < NB * 16 * 4; unit += gridDim.x) {
            const int b = unit >> 6, n = (unit >> 2) & 15, h = unit & 3; const int R0 = b * SEQ + n * 128;
            const f32x2 gg = *(const f32x2*)(ng + h * 128 + 2 * lane), bb = *(const f32x2*)(nb + h * 128 + 2 * lane);
            unsigned pv[16];
#pragma unroll
            for (int rr = 0; rr < 16; ++rr) pv[rr] = *(const unsigned*)(VA + (size_t)(R0 + wave * 16 + rr) * CC + h * 128 + 2 * lane);
            const int nks = ((16 * wave + 15) >> 5) + 1;
            bf16x8 bfrag[4];
#pragma unroll
            for (int ks = 0; ks < 4; ++ks) if (ks < nks) bfrag[ks] = *(const bf16x8*)(Wb + (size_t)h * 16384 + (16 * wave + fr) * 128 + 32 * ks + 8 * fq);
            float s1[16], s2[16];
#pragma unroll
            for (int rr = 0; rr < 16; ++rr) { const float v0 = bf_lo(pv[rr]), v1 = bf_hi(pv[rr]); s1[rr] = v0 + v1; s2[rr] = v0 * v0 + v1 * v1; }
#pragma unroll
            for (int rr = 0; rr < 16; ++rr) { s1[rr] = row16_allsum(s1[rr]); s2[rr] = row16_allsum(s2[rr]); }
#pragma unroll
            for (int rr = 0; rr < 16; ++rr) { s1[rr] += __shfl_xor(s1[rr], 16); s2[rr] += __shfl_xor(s2[rr], 16); }
#pragma unroll
            for (int rr = 0; rr < 16; ++rr) { s1[rr] += __shfl_xor(s1[rr], 32); s2[rr] += __shfl_xor(s2[rr], 32); }
#pragma unroll
            for (int rp = 0; rp < 8; ++rp) {
                float y[2][2];
#pragma unroll
                for (int q = 0; q < 2; ++q) { const int rr = 2 * rp + q; const float mean = s1[rr] * (1.0f / 128.0f); const float var = fmaxf(s2[rr] * (1.0f / 128.0f) - mean * mean, 0.f);
                    const float rstd = 1.0f / sqrtf(var + EPS); y[q][0] = (bf_lo(pv[rr]) - mean) * rstd * gg.x + bb.x; y[q][1] = (bf_hi(pv[rr]) - mean) * rstd * gg.y + bb.y; }
                const int s = wave * 16 + 2 * rp;
                *(LAS unsigned*)(lds + (2 * lane) * VST + s * 2) = cvt_pk_bf16(y[0][0], y[1][0]);
                *(LAS unsigned*)(lds + (2 * lane + 1) * VST + s * 2) = cvt_pk_bf16(y[0][1], y[1][1]);
            }
            const int t = 16 * wave + fr; const size_t row = (size_t)(R0 + t);
            u32x2 uu[8];
#pragma unroll
            for (int db = 0; db < 8; ++db) uu[db] = *(const u32x2*)(UA + row * CC + h * 128 + 16 * db + 4 * fq);
            const float bias = sb[h * 128 + t];
            __syncthreads();
            f32x4 acc[8];
#pragma unroll
            for (int db = 0; db < 8; ++db) acc[db] = (f32x4){0.f, 0.f, 0.f, 0.f};
#pragma unroll
            for (int ks = 0; ks < 4; ++ks) if (ks < nks) {
#pragma unroll
                for (int db = 0; db < 8; ++db) {
                    const LAS unsigned char* ap = lds + (16 * db + fr) * VST + (32 * ks + 8 * fq) * 2;
                    union { bf16x8 v; u32x2 h[2]; } af; af.h[0] = *(const LAS u32x2*)ap; af.h[1] = *(const LAS u32x2*)(ap + 8);
                    acc[db] = __builtin_amdgcn_mfma_f32_16x16x32_bf16(af.v, bfrag[ks], acc[db], 0, 0, 0);
                }
            }
#pragma unroll
            for (int db = 0; db < 8; ++db) { const int d = 16 * db + 4 * fq;
                const float o0 = bf_lo(uu[db].x) * (acc[db][0] + bias), o1 = bf_hi(uu[db].x) * (acc[db][1] + bias), o2 = bf_lo(uu[db].y) * (acc[db][2] + bias), o3 = bf_hi(uu[db].y) * (acc[db][3] + bias);
                u32x2 w; w.x = cvt_pk_bf16(o0, o1); w.y = cvt_pk_bf16(o2, o3);
                *(u32x2*)(Y + row * D + CC + h * 128 + d) = w; }
            __syncthreads();
        }
    }
    if (parts & 2) {
        typedef __bf16 bf2_t __attribute__((ext_vector_type(2)));
        const int ch = cv_ch;
        for (int item = cv_first; item < NB * (SEQ / 32); item += cv_step) {
            const int b = item >> 6, t0 = (item & 63) * 32; const size_t rowb = (size_t)b * SEQ;
            if (item != cv_first) {
#pragma unroll
                for (int i = 0; i < 62; ++i) { const int ta = t0 - 30 + i; cv_raw[i] = ta >= 0 ? *(const unsigned*)(CG + (rowb + ta) * CC + ch) : 0u; } }
            unsigned P0[31], P1[31];
#pragma unroll
            for (int k = 0; k < 31; ++k) { P0[k] = __builtin_amdgcn_perm(cv_raw[2 * k + 1], cv_raw[2 * k], 0x05040100u); P1[k] = __builtin_amdgcn_perm(cv_raw[2 * k + 1], cv_raw[2 * k], 0x07060302u); }
            asm volatile("" ::: "memory");
            unsigned Wa0[16], Wa1[16], Wb0[16], Wb1[16];
            { f32x2 cv_wf[32]; const float* cwp = args.in[I_CONVW] + (size_t)l * CW * CC + cv_ch;
#pragma unroll
              for (int j = 0; j < CW; ++j) cv_wf[j] = *(const f32x2*)(cwp + j * CC);
              cv_wf[31] = (f32x2){0.f, 0.f};
#pragma unroll
              for (int k = 0; k < 16; ++k) { Wa0[k] = cvt_pk_bf16(cv_wf[2 * k].x, cv_wf[2 * k + 1].x); Wa1[k] = cvt_pk_bf16(cv_wf[2 * k].y, cv_wf[2 * k + 1].y); }
              Wb0[0] = cvt_pk_bf16(0.f, cv_wf[0].x); Wb1[0] = cvt_pk_bf16(0.f, cv_wf[0].y);
#pragma unroll
              for (int k = 0; k < 15; ++k) { Wb0[k + 1] = cvt_pk_bf16(cv_wf[2 * k + 1].x, cv_wf[2 * k + 2].x); Wb1[k + 1] = cvt_pk_bf16(cv_wf[2 * k + 1].y, cv_wf[2 * k + 2].y); } }
            const f32x2 cb = *(const f32x2*)(args.in[I_CONVB] + l * CC + ch), ng = *(const f32x2*)(args.in[I_CONVNG] + l * CC + ch), nb = *(const f32x2*)(args.in[I_CONVNB] + l * CC + ch);
#pragma unroll
            for (int hf = 0; hf < 4; ++hf) {
                float a0[8], a1[8];
#pragma unroll
                for (int tt = 0; tt < 8; ++tt) {
                    const int t = 8 * hf + tt; float s0 = cb.x, s1 = cb.y;
                    if ((t & 1) == 0) {
#pragma unroll
                        for (int k = 0; k < 16; ++k) { s0 = __builtin_amdgcn_fdot2_f32_bf16(__builtin_bit_cast(bf2_t, P0[t / 2 + k]), __builtin_bit_cast(bf2_t, Wa0[k]), s0, false);
                                                       s1 = __builtin_amdgcn_fdot2_f32_bf16(__builtin_bit_cast(bf2_t, P1[t / 2 + k]), __builtin_bit_cast(bf2_t, Wa1[k]), s1, false); }
                    } else {
#pragma unroll
                        for (int k = 0; k < 16; ++k) { s0 = __builtin_amdgcn_fdot2_f32_bf16(__builtin_bit_cast(bf2_t, P0[(t - 1) / 2 + k]), __builtin_bit_cast(bf2_t, Wb0[k]), s0, false);
                                                       s1 = __builtin_amdgcn_fdot2_f32_bf16(__builtin_bit_cast(bf2_t, P1[(t - 1) / 2 + k]), __builtin_bit_cast(bf2_t, Wb1[k]), s1, false); }
                    }
                    a0[tt] = s0; a1[tt] = s1;
                }
                float s1[8], s2[8];
#pragma unroll
                for (int tt = 0; tt < 8; ++tt) { s1[tt] = row16_allsum(a0[tt] + a1[tt]); s2[tt] = row16_allsum(a0[tt] * a0[tt] + a1[tt] * a1[tt]); }
#pragma unroll
                for (int tt = 0; tt < 8; ++tt) { s1[tt] += __shfl_xor(s1[tt], 16); s2[tt] += __shfl_xor(s2[tt], 16); }
#pragma unroll
                for (int tt = 0; tt < 8; ++tt) {
                    const float mean = s1[tt] * (1.0f / 64.0f); const float var = fmaxf(s2[tt] * (1.0f / 64.0f) - mean * mean, 0.f);
                    const float rstd = 1.0f / sqrtf(var + EPS);
                    const float y0 = (a0[tt] - mean) * rstd * ng.x + nb.x, y1 = (a1[tt] - mean) * rstd * ng.y + nb.y;
                    *(unsigned*)(Y + (rowb + t0 + 8 * hf + tt) * D + ch) = cvt_pk_bf16(y0 * fast_sigmoid(y0), y1 * fast_sigmoid(y1));
                }
            }
        }
    }
}

__device__ __forceinline__ void router_phase(const Args& args, LAS unsigned char* lds, int lane, int wave) {
    unsigned char* ws = args.ws;
    const bf16_t* XB = (const bf16_t*)(ws + WS_XB); const float* RT = (const float*)(ws + WS_RT); const float* rss = (const float*)(ws + WS_RSS) + (size_t)3 * T * 4;
    int* toklist = (int*)(ws + WS_TOKLIST); u32x4* tokinfo = (u32x4*)(ws + WS_TOKINFO); unsigned* cntw = (unsigned*)(ws + WS_CTL) + CW_CNT;
    LAS int* wcnt = (LAS int*)lds;
    LAS int* wbase = (LAS int*)(lds + 256);
    LAS float* rwl = (LAS float*)(lds + 1024);
    for (int i = threadIdx.x; i < NE * D / 4; i += NWAVES * 64) *(LAS f32x4*)(rwl + 4 * i) = *(const f32x4*)(RT + 4 * i);
    __syncthreads();
    for (int blk = blockIdx.x; blk < T / 64; blk += gridDim.x) {
        int my_e0 = 0, my_e1 = 0; float my_g0 = 0.f, my_g1 = 0.f;
        const int tbase = blk * 64 + wave * 8;
#pragma unroll 1
        for (int jb = 0; jb < 2; ++jb) {
            u32x4 xv[4][2]; float pr[4];
#pragma unroll
            for (int j = 0; j < 4; ++j) { const int t = tbase + 4 * jb + j;
                xv[j][0] = *(const u32x4*)(XB + (size_t)t * D + 8 * lane); xv[j][1] = *(const u32x4*)(XB + (size_t)t * D + 512 + 8 * lane);
                pr[j] = rss[(size_t)t * 4 + (lane & 3)]; }
            float xf[4][16];
#pragma unroll
            for (int j = 0; j < 4; ++j)
#pragma unroll
                for (int i = 0; i < 2; ++i) { const u32x4 v = xv[j][i];
                    xf[j][8 * i + 0] = bf_lo(v.x); xf[j][8 * i + 1] = bf_hi(v.x); xf[j][8 * i + 2] = bf_lo(v.y); xf[j][8 * i + 3] = bf_hi(v.y); xf[j][8 * i + 4] = bf_lo(v.z); xf[j][8 * i + 5] = bf_hi(v.z); xf[j][8 * i + 6] = bf_lo(v.w); xf[j][8 * i + 7] = bf_hi(v.w); }
            float a[4][NE];
#pragma unroll
            for (int e = 0; e < NE; ++e) {
                f32x4 w[4];
#pragma unroll
                for (int i = 0; i < 2; ++i) { w[2 * i] = *(const LAS f32x4*)(rwl + e * D + 512 * i + 8 * lane); w[2 * i + 1] = *(const LAS f32x4*)(rwl + e * D + 512 * i + 8 * lane + 4); }
#pragma unroll
                for (int j = 0; j < 4; ++j) { float s = 0.f;
#pragma unroll
                    for (int q = 0; q < 4; ++q) s += (xf[j][4 * q] * w[q].x + xf[j][4 * q + 1] * w[q].y) + (xf[j][4 * q + 2] * w[q].z + xf[j][4 * q + 3] * w[q].w);
                    a[j][e] = s; }
                __builtin_amdgcn_sched_barrier(0);
            }
#pragma unroll
            for (int j = 0; j < 4; ++j)
#pragma unroll
                for (int e = 0; e < NE; ++e) a[j][e] = row16_allsum(a[j][e]);
#pragma unroll
            for (int j = 0; j < 4; ++j)
#pragma unroll
                for (int e = 0; e < NE; ++e) a[j][e] += __shfl_xor(a[j][e], 16);
#pragma unroll
            for (int j = 0; j < 4; ++j)
#pragma unroll
                for (int e = 0; e < NE; ++e) a[j][e] += __shfl_xor(a[j][e], 32);
#pragma unroll
            for (int j = 0; j < 4; ++j) {
                float p = pr[j]; p = dpp_add(p, 0); p = dpp_add(p, 1);
                const float rstd = 1.0f / sqrtf(p * (1.0f / D) + EPS);
                int e0 = 0; float l0 = a[j][0] * rstd;
#pragma unroll
                for (int e = 1; e < NE; ++e) { const float le = a[j][e] * rstd; if (le > l0) { l0 = le; e0 = e; } }
                int e1 = -1; float l1 = -3.0e38f;
#pragma unroll
                for (int e = 0; e < NE; ++e) { const float le = a[j][e] * rstd; if (e != e0 && le > l1) { l1 = le; e1 = e; } }
                const float g0 = 1.0f / (1.0f + __expf(l1 - l0)), g1 = 1.0f - g0;
                if (lane == 4 * jb + j) { my_e0 = e0; my_e1 = e1; my_g0 = g0; my_g1 = g1; }
            }
        }
        const bool act = lane < 8;
        unsigned long long m0[NE], m1[NE];
#pragma unroll
        for (int e = 0; e < NE; ++e) { m0[e] = __ballot(act && my_e0 == e); m1[e] = __ballot(act && my_e1 == e); }
        if (lane < NE) { int c = 0;
#pragma unroll
            for (int e = 0; e < NE; ++e) if (lane == e) c = __popcll(m0[e]) + __popcll(m1[e]);
            wcnt[wave * 8 + lane] = c; }
        __syncthreads();
        if (threadIdx.x < NE) { const int e = threadIdx.x; int tot = 0; int pre[8];
#pragma unroll
            for (int w = 0; w < 8; ++w) { pre[w] = tot; tot += wcnt[w * 8 + e]; }
            const int base = (int)__hip_atomic_fetch_add(cntw + 64 * e, (unsigned)tot, RLX_AGENT);
#pragma unroll
            for (int w = 0; w < 8; ++w) wbase[w * 8 + e] = base + pre[w]; }
        __syncthreads();
        if (act) {
            const unsigned long long lt = (1ull << lane) - 1ull;
            int pos0 = 0, pos1 = 0;
#pragma unroll
            for (int e = 0; e < NE; ++e) { const int wb = wbase[wave * 8 + e];
                if (my_e0 == e) pos0 = wb + __popcll(m0[e] & lt);
                if (my_e1 == e) pos1 = wb + __popcll(m0[e]) + __popcll(m1[e] & lt); }
            const int t = tbase + lane;
            toklist[my_e0 * T + pos0] = t; toklist[my_e1 * T + pos1] = t;
            u32x4 inf; inf.x = ((unsigned)my_e0 << 16) | (unsigned)pos0; inf.y = ((unsigned)my_e1 << 16) | (unsigned)pos1; inf.z = __float_as_uint(my_g0); inf.w = __float_as_uint(my_g1);
            tokinfo[t] = inf;
        }
        __syncthreads();
    }
}
__device__ __forceinline__ void moe_tab_build(const unsigned char* ws, LAS int* tab) {
    if (threadIdx.x < NE) tab[threadIdx.x] = (int)__hip_atomic_load((unsigned*)(ws + WS_CTL) + CW_CNT + 64 * threadIdx.x, RLX_AGENT);
    __syncthreads();
    if (threadIdx.x == 0) {
        int b = 0, p = 0, f = 0, np = 0;
        for (int e = 0; e < NE; ++e) { const int c = tab[e]; tab[8 + e] = b; tab[16 + e] = p; tab[25 + e] = f; b += c; p += (c + 255) >> 8; f += c >> 8;
            tab[43 + e] = -1; if (c & 255) { tab[35 + np] = e; tab[43 + e] = np; ++np; } }
        tab[24] = p; tab[33] = f; tab[34] = np;
    }
    __syncthreads();
}

__device__ __forceinline__ void final_phase(const Args& args, const LAS int* tab, int gw, int NGW, int lane) {
    unsigned char* ws = args.ws; float* out = args.out; const bf16_t* YS = (const bf16_t*)(ws + WS_YS); const u32x4* tokinfo = (const u32x4*)(ws + WS_TOKINFO); const float* YP = (const float*)(ws + WS_YP);
    f32x4 gn[4];
#pragma unroll
    for (int j = 0; j < 4; ++j) gn[j] = *((const f32x4*)args.in[I_NFINAL] + lane + 64 * j);
    for (int tb = gw; tb < T; tb += 4 * NGW) {
        f32x4 xv[4][4]; u32x2 ya[4][4], yb[4][4]; float g0[4], g1[4]; u32x4 inf[4];
#pragma unroll
        for (int k = 0; k < 4; ++k) { const int t = tb + k * NGW; inf[k] = tokinfo[t < T ? t : 0]; }
#pragma unroll
        for (int k = 0; k < 4; ++k) { const int t = tb + k * NGW; if (t < T) {
            const int e0 = __builtin_amdgcn_readfirstlane((int)(inf[k].x >> 16)), p0 = __builtin_amdgcn_readfirstlane((int)(inf[k].x & 0xffffu)), e1 = __builtin_amdgcn_readfirstlane((int)(inf[k].y >> 16)), p1 = __builtin_amdgcn_readfirstlane((int)(inf[k].y & 0xffffu));
            g0[k] = __uint_as_float(inf[k].z); g1[k] = __uint_as_float(inf[k].w);
            const int b0 = __builtin_amdgcn_readfirstlane(tab[8 + e0]), b1 = __builtin_amdgcn_readfirstlane(tab[8 + e1]);
            const int c0 = __builtin_amdgcn_readfirstlane(tab[e0]), c1 = __builtin_amdgcn_readfirstlane(tab[e1]);
            if (RES_BF16) { const u32x2* xr = (const u32x2*)((const bf16_t*)(ws + WS_XB) + (size_t)t * D) + lane;
#pragma unroll
                for (int j = 0; j < 4; ++j) { const u32x2 w = xr[64 * j]; xv[k][j] = (f32x4){bf_lo(w.x), bf_hi(w.x), bf_lo(w.y), bf_hi(w.y)}; } }
            else { const f32x4* xr = (const f32x4*)(out + (size_t)t * D) + lane;
#pragma unroll
                for (int j = 0; j < 4; ++j) xv[k][j] = xr[64 * j]; }
            if (p0 >= (c0 & ~255)) { const float* yp = YP + ((size_t)__builtin_amdgcn_readfirstlane(tab[43 + e0]) * 4 * 256 + (p0 & 255)) * D;
#pragma unroll
                for (int j = 0; j < 4; ++j) { f32x4 s = *((const f32x4*)yp + lane + 64 * j);
#pragma unroll
                    for (int q = 1; q < 4; ++q) s += *((const f32x4*)(yp + (size_t)q * 256 * D) + lane + 64 * j);
                    ya[k][j].x = cvt_pk_bf16(s.x, s.y); ya[k][j].y = cvt_pk_bf16(s.z, s.w); } }
            else { const u32x2* y0 = (const u32x2*)(YS + (size_t)(b0 + p0) * D) + lane;
#pragma unroll
                for (int j = 0; j < 4; ++j) ya[k][j] = y0[64 * j]; }
            if (p1 >= (c1 & ~255)) { const float* yp = YP + ((size_t)__builtin_amdgcn_readfirstlane(tab[43 + e1]) * 4 * 256 + (p1 & 255)) * D;
#pragma unroll
                for (int j = 0; j < 4; ++j) { f32x4 s = *((const f32x4*)yp + lane + 64 * j);
#pragma unroll
                    for (int q = 1; q < 4; ++q) s += *((const f32x4*)(yp + (size_t)q * 256 * D) + lane + 64 * j);
                    yb[k][j].x = cvt_pk_bf16(s.x, s.y); yb[k][j].y = cvt_pk_bf16(s.z, s.w); } }
            else { const u32x2* y1 = (const u32x2*)(YS + (size_t)(b1 + p1) * D) + lane;
#pragma unroll
                for (int j = 0; j < 4; ++j) yb[k][j] = y1[64 * j]; }
        } }
#pragma unroll
        for (int k = 0; k < 4; ++k) { const int t = tb + k * NGW; if (t < T) {
            f32x4 v[4]; float ss = 0.f;
#pragma unroll
            for (int j = 0; j < 4; ++j) { const f32x4 x = xv[k][j]; const u32x2 a = ya[k][j], b = yb[k][j];
                v[j].x = x.x + g0[k] * bf_lo(a.x) + g1[k] * bf_lo(b.x); v[j].y = x.y + g0[k] * bf_hi(a.x) + g1[k] * bf_hi(b.x); v[j].z = x.z + g0[k] * bf_lo(a.y) + g1[k] * bf_lo(b.y); v[j].w = x.w + g0[k] * bf_hi(a.y) + g1[k] * bf_hi(b.y);
                ss += (v[j].x * v[j].x + v[j].y * v[j].y) + (v[j].z * v[j].z + v[j].w * v[j].w); }
            ss = row16_allsum(ss); ss += __shfl_xor(ss, 16); ss += __shfl_xor(ss, 32);
            const float rstd = 1.0f / sqrtf(ss * (1.0f / D) + EPS);
            f32x4* xo = (f32x4*)(out + (size_t)t * D) + lane;
#pragma unroll
            for (int j = 0; j < 4; ++j) xo[64 * j] = v[j] * rstd * gn[j]; } }
    }
}

template <bool MOE, class Sched>
__device__ __forceinline__ void fill_unit_tables(const Sched& S, const float* rss, const int* toklist, float pre, LAS unsigned char* lds) {
    LAS int* tt = (LAS int*)(lds + TOKTAB_OFF); LAS float* rt = (LAS float*)(lds + RSTAB_OFF);
    const int lr = threadIdx.x & 255, par = threadIdx.x >> 8;
    int srow[MAXU / 2]; bool have[MAXU / 2];
#pragma unroll
    for (int k = 0; k < MAXU / 2; ++k) { pg8::Unit u; have[k] = S.next(2 * k + par, u); srow[k] = 0;
        if (have[k]) { if (MOE) { if (lr < u.valid) srow[k] = toklist[u.e * T + u.pm * 256 + lr]; } else srow[k] = u.rb + lr; } }
    f32x4 p[MAXU / 2];
#pragma unroll
    for (int k = 0; k < MAXU / 2; ++k) p[k] = have[k] ? *(const f32x4*)(rss + (size_t)srow[k] * 4) : (f32x4){0.f, 0.f, 0.f, 0.f};
#pragma unroll
    for (int k = 0; k < MAXU / 2; ++k) if (have[k]) { const int i = 2 * k + par; if (MOE) tt[i * 256 + lr] = srow[k];
        rt[i * 256 + lr] = pre / sqrtf(((p[k].x + p[k].y) + (p[k].z + p[k].w)) * (1.0f / D) + EPS); }
    __syncthreads();
}

__global__ void __launch_bounds__(NWAVES * 64, 2) mega_fwd(Args args) {
    extern __shared__ __attribute__((aligned(16))) unsigned char lds_raw[];
    LAS unsigned char* lds = (LAS unsigned char*)lds_raw;
    const int tid = threadIdx.x, lane = tid & 63, wave = __builtin_amdgcn_readfirstlane(tid >> 6);
    const int G = gridDim.x, bx = blockIdx.x;
    const int vcu = (G % 8 == 0) ? (bx % 8) * (G / 8) + bx / 8 : bx;
    const int gw = vcu * NWAVES + wave, NGW = G * NWAVES;
    unsigned char* ws = args.ws;
    unsigned* ctl = (unsigned*)(ws + WS_CTL);
    for (int u = tid; u < 512 / 4; u += NWAVES * 64) ((LAS unsigned*)(lds + LDSCTL_OFF))[u] = 0u;
    __syncthreads();
    XcdBarrier bar; bar.bar = ctl + CW_BAR; bar.x = 0; bar.st = nullptr;
    if (MK_N_LAUNCHES == 1) bar = xcd_barrier_post(ctl + CW_BAR, (volatile LAS unsigned*)(lds + LDSCTL_OFF) + 8);
    const int lo = args.ph_lo, hi = args.ph_hi;
#ifndef PHMASK
#define PHMASK 0xFFFF
#endif
#define IN(k) ((((PHMASK) >> (k)) & 1) && lo <= (k) && (k) < hi)
#ifndef DUP_PHASE
#define DUP_PHASE -1
#endif
#define REP(k) for (int rep_ = 0; rep_ < ((DUP_PHASE) == (k) ? 2 : 1); ++rep_)
#define SEAM(k) do { if (MK_N_LAUNCHES == 1 && IN((k) + 1)) xcd_barrier(bar); if (PROBE_TIME == (k)) pt1 = wall_clock64(); } while (0)
    unsigned long long pt0 = 0, pt1 = 0;
#define PT(k) do { if (PROBE_TIME == (k)) pt0 = wall_clock64(); } while (0)
    float* rss = (float*)(ws + WS_RSS);
    bf16_t* XB = (bf16_t*)(ws + WS_XB);

    PT(0); if (IN(0)) { REP(0) prologue_phase(args, lds, gw, NGW, lane, wave); SEAM(0); }

#ifndef MOE_FP8
#define MOE_FP8 1
#endif
    constexpr bool MF8 = (MOE_FP8 != 0); constexpr int MES = MF8 ? 1 : 2; constexpr bool DF8 = (DENSE_FP8 != 0); constexpr int DES = DF8 ? 1 : 2;
#define LAYER_MIX(l, pb) \
    PT(pb); if (IN(pb)) {       \
        pg8::DenseSched S; S.A = (const char*)XB; S.Bt = (const char*)(ws + WS_WIN) + (size_t)(l) * DIN * D * 2; S.KB = D * 2; S.so.init(T / 256, DIN / 256, G, vcu); S.g1 = 1; \
        fill_unit_tables<false>(S, rss + (size_t)(2 * (l)) * T * 4, nullptr, 1.0f, lds); \
        pg8::EpiMix E{(bf16_t*)(ws + WS_CG), (bf16_t*)(ws + WS_UA), (bf16_t*)(ws + WS_VA), (const LAS float*)(lds + RSTAB_OFF)}; \
        REP(pb) pg8::gemm_phase<pg8::EpiMix, pg8::DenseSched, true, false>(lds, D * 2, S, E); \
        SEAM(pb); \
    } \
    PT((pb) + 1); if (IN((pb) + 1)) { if (PROBE_MID != 0 && (l) == 0) mid_phase(args, lds, (l), gw, NGW, lane, wave, PROBE_MID); REP((pb) + 1) mid_phase(args, lds, (l), gw, NGW, lane, wave); SEAM((pb) + 1); } \
    PT((pb) + 2); if (IN((pb) + 2)) {       \
        pg8::DenseSched S; S.A = (const char*)(ws + WS_Y); S.Bt = (const char*)(ws + WS_WOUT) + (size_t)(l) * D * D * 2; S.KB = D * 2; S.so.init(T / 256, D / 256, G, bx); S.g1 = 0; \
        pg8::EpiRes E{(l) == 0 ? args.in[I_X] : args.out, args.out, XB, rss + (size_t)(2 * (l) + 1) * T * 4, (((l) == 1 && MF8) || ((l) == 0 && DF8)) ? (unsigned char*)(ws + WS_XB8) : nullptr, 1.0f, 1.0f}; \
        REP((pb) + 2) for (int r_ = 0; r_ * G < S.so.nwg; ++r_) { S.so.i0 = r_; S.so.nmax = 1; pg8::gemm_phase<pg8::EpiRes, pg8::DenseSched, false, false>(lds, D * 2, S, E); } \
        SEAM((pb) + 2); \
    }
    LAYER_MIX(0, 1)
    PT(4); if (IN(4)) {
        pg8::DenseSched S; S.A = DF8 ? (const char*)(ws + WS_XB8) : (const char*)XB; S.Bt = (const char*)(ws + WS_FGU); S.KB = D * DES; S.so.init(T / 256, NFF2 / 256, G, bx); S.g1 = 0;
        fill_unit_tables<false>(S, rss + (size_t)1 * T * 4, nullptr, DF8 ? 1.0f / MOE_SW : 1.0f, lds);
        pg8::EpiSwiglu<false, DF8> E{(void*)(ws + WS_ACT), (const LAS float*)(lds + RSTAB_OFF), DF8 ? MOE_SA : 1.0f};
        REP(4) pg8::gemm_phase<pg8::EpiSwiglu<false, DF8>, pg8::DenseSched, true, DF8>(lds, D * DES, S, E);
        SEAM(4);
    }
    PT(5); if (IN(5)) {
        pg8::DenseSched S; S.A = (const char*)(ws + WS_ACT); S.Bt = (const char*)(ws + WS_FD); S.KB = FF * DES; S.so.init(T / 256, D / 256, G, bx); S.g1 = 0;
        pg8::EpiRes E{args.out, args.out, XB, rss + (size_t)2 * T * 4, nullptr, DF8 ? MOE_SW * MOE_SA : 1.0f, DF8 ? 1.0f / (MOE_SW * MOE_SA) : 1.0f};
        for (int r_ = 0; r_ * G < S.so.nwg; ++r_) { S.so.i0 = r_; S.so.nmax = 1; pg8::gemm_phase<pg8::EpiRes, pg8::DenseSched, false, DF8>(lds, FF * DES, S, E); }
        SEAM(5);
    }
    LAYER_MIX(1, 6)
    LAS int* mtab = (LAS int*)(lds + LDSCTL_OFF + 64);
    PT(9); if (IN(9)) { router_phase(args, lds, lane, wave); SEAM(9); }
    PT(10); if (IN(10)) {
        moe_tab_build(ws, mtab);
        pg8::MoeUpSched<MES> S; S.tab = mtab;
        S.XA = MF8 ? (const char*)(ws + WS_XB8) : (const char*)XB; S.W = (const char*)(ws + WS_MGU); S.toktab = (const LAS int*)(lds + TOKTAB_OFF); S.so.init(__builtin_amdgcn_readfirstlane(mtab[24]), NFF2 / 256, G, bx);
        fill_unit_tables<true>(S, rss + (size_t)3 * T * 4, (const int*)(ws + WS_TOKLIST), MF8 ? 1.0f / MOE_SW : 1.0f, lds);
        pg8::EpiSwiglu<true, MF8> E{(void*)(ws + WS_ACT), (const LAS float*)(lds + RSTAB_OFF), MF8 ? MOE_SA : 1.0f};
#if PROBE_NULL == 10
        { pg8::EpiNull EN{(float*)(ws + WS_TOKINFO)}; pg8::gemm_phase<pg8::EpiNull, pg8::MoeUpSched<MES>, true, MF8>(lds, D * MES, S, EN); }
#endif
        REP(10) pg8::gemm_phase<pg8::EpiSwiglu<true, MF8>, pg8::MoeUpSched<MES>, true, MF8>(lds, D * MES, S, E);
        SEAM(10);
    }
    PT(11); if (IN(11)) {
        moe_tab_build(ws, mtab);
        pg8::MoeDownSched<MES> S; S.tab = mtab;
        S.ACT = (const char*)(ws + WS_ACT); S.W = (const char*)(ws + WS_MD); S.so.init(__builtin_amdgcn_readfirstlane(mtab[33]), D / 256, G, bx);
        pg8::EpiSlot E{(bf16_t*)(ws + WS_YS), (float*)(ws + WS_YP), MF8 ? 1.0f / (MOE_SW * MOE_SA) : 1.0f};
#if PROBE_NULL == 11
        { pg8::EpiNull EN{(float*)(ws + WS_TOKINFO)}; pg8::gemm_phase<pg8::EpiNull, pg8::MoeDownSched<MES>, true, MF8>(lds, FF * MES, S, EN); }
#endif
        REP(11) pg8::gemm_phase<pg8::EpiSlot, pg8::MoeDownSched<MES>, true, MF8>(lds, FF * MES, S, E);
        SEAM(11);
    }
    PT(12); if (IN(12)) { moe_tab_build(ws, mtab); final_phase(args, mtab, gw, NGW, lane); }
    if (PROBE_TIME == 12) pt1 = wall_clock64();
    if (PROBE_TIME >= 0) { const unsigned long long tgt = wall_clock64() + 4ull * (pt1 - pt0); while (wall_clock64() < tgt) __builtin_amdgcn_s_sleep(8); }
#undef IN
#undef SEAM
}

extern "C" void kernel_launch(void* const* d_in, const int* in_sizes, int n_in, void* d_out, int out_size, void* d_ws, size_t ws_size, hipStream_t stream) {
    static int grid = 0;
    if (grid == 0) {
        if (n_in != 21 || in_sizes[0] != T * D || out_size != T * D || ws_size < WS_END) { fprintf(stderr, "kernel_launch: unexpected shapes (n_in %d, in0 %d, out %d, ws %zu < %zu); nothing launched\n", n_in, n_in > 0 ? in_sizes[0] : -1, out_size, ws_size, (size_t)WS_END); grid = -1; return; }
        int dev = 0, cus = 0, per_cu = 0;
        if (hipGetDevice(&dev) != hipSuccess || hipDeviceGetAttribute(&cus, hipDeviceAttributeMultiprocessorCount, dev) != hipSuccess) { grid = -1; return; }
        if (hipFuncSetAttribute((const void*)mega_fwd, hipFuncAttributeMaxDynamicSharedMemorySize, LDS_BYTES) != hipSuccess) { fprintf(stderr, "kernel_launch: hipFuncSetAttribute failed\n"); grid = -1; return; }
        if (hipOccupancyMaxActiveBlocksPerMultiprocessor(&per_cu, (const void*)mega_fwd, NWAVES * 64, LDS_BYTES) != hipSuccess || per_cu < 1) { fprintf(stderr, "kernel_launch: occupancy query reports %d\n", per_cu); }
        (void)hipGetLastError();
        grid = cus;
    }
    if (grid < 0) return;
    if (hipMemsetAsync((char*)d_ws + WS_CTL, 0, CTL_ZERO_BYTES, stream) != hipSuccess) return;
    Args a{};
    for (int i = 0; i < 21; ++i) a.in[i] = (const float*)d_in[i];
    a.out = (float*)d_out; a.ws = (unsigned char*)d_ws;
    if (MK_N_LAUNCHES == 1) { a.ph_lo = 0; a.ph_hi = N_PHASES; hipLaunchKernelGGL(mega_fwd, dim3(grid), dim3(NWAVES * 64), LDS_BYTES, stream, a); }
    else for (int p = 0; p < N_PHASES; ++p) { a.ph_lo = p; a.ph_hi = p + 1; hipLaunchKernelGGL(mega_fwd, dim3(grid), dim3(NWAVES * 64), LDS_BYTES, stream, a); }
}
```

```cpp
#include <hip/hip_runtime.h>
#include <cstdio>
#include <cstdint>

#ifndef PROBE_TIME
#define PROBE_TIME -1
#endif
#ifndef PROBE_P0
#define PROBE_P0 0
#endif
#ifndef PROBE_MID
#define PROBE_MID 0
#endif
#ifndef PROBE_NULL
#define PROBE_NULL -1
#endif
#ifndef RES_BF16
#define RES_BF16 1
#endif
#ifndef DENSE_FP8
#define DENSE_FP8 0
#endif
#ifndef MK_N_LAUNCHES
#define MK_N_LAUNCHES 1
#endif
constexpr int N_PHASES = 13;

#define GAS __attribute__((address_space(1)))
#define LAS __attribute__((address_space(3)))
typedef unsigned short bf16_t;
typedef short bf16x8 __attribute__((ext_vector_type(8)));
typedef float f32x4 __attribute__((ext_vector_type(4)));
typedef float f32x2 __attribute__((ext_vector_type(2)));
typedef unsigned u32x4 __attribute__((ext_vector_type(4)));
typedef unsigned u32x2 __attribute__((ext_vector_type(2)));

constexpr int NB = 8, SEQ = 2048, T = NB * SEQ, D = 1024, DIN = 2048, CC = 512, FF = 2816, NE = 8, CW = 31, NFF2 = 2 * FF;
constexpr float EPS = 1e-6f;
constexpr int NWAVES = 8;

constexpr size_t KiB = 1024, MiB = 1024 * 1024;
constexpr size_t WS_CTL = 0, CTL_ZERO_BYTES = 64 * KiB;
constexpr int CW_BAR = 1024;
constexpr int CW_CNT = 8192;
constexpr size_t WS_TOKLIST = 64 * KiB;
constexpr size_t WS_TOKINFO = 576 * KiB;
constexpr size_t WS_RT = 832 * KiB;
constexpr size_t WS_SGUW = 1 * MiB;
constexpr size_t WS_RSS = 2 * MiB;
constexpr size_t WS_WIN = 6 * MiB;
constexpr size_t WS_WOUT = 14 * MiB;
constexpr size_t WS_FGU = 18 * MiB;
constexpr size_t WS_FD = 29 * MiB;
constexpr size_t WS_MGU = 35 * MiB;
constexpr size_t WS_MD = 79 * MiB;
constexpr size_t WS_XB = 101 * MiB;
constexpr size_t WS_XB8 = 133 * MiB;
constexpr size_t WS_ACT = 149 * MiB;
constexpr size_t WS_CG = WS_ACT, WS_UA = WS_ACT + 16 * MiB, WS_VA = WS_ACT + 32 * MiB, WS_Y = WS_ACT + 48 * MiB;
constexpr size_t WS_YS = 238 * MiB;
constexpr size_t WS_YP = 302 * MiB;
constexpr size_t WS_END = WS_YP + (size_t)8 * 4 * 256 * D * 4;
static_assert(WS_YS + (size_t)2 * T * D * 2 <= WS_YP, "workspace map 3");
constexpr float MOE_SW = 32.0f, MOE_SA = 8.0f;
static_assert(WS_END <= 380 * MiB, "workspace map");
static_assert(WS_MGU + (size_t)NE * NFF2 * D <= WS_MD && WS_MD + (size_t)NE * D * FF <= WS_XB && WS_FD + (size_t)D * FF * 2 <= WS_MGU && WS_ACT + (size_t)T * FF * 2 <= WS_YS && WS_ACT + (size_t)(2 * T + 256) * FF <= WS_YS, "workspace map 2");

constexpr int RING_BYTES = 131072;
constexpr int LDSCTL_OFF = RING_BYTES;
constexpr int MAXU = 12;
constexpr int TOKTAB_OFF = RING_BYTES + 512;
constexpr int RSTAB_OFF = TOKTAB_OFF + MAXU * 256 * 4;
constexpr int LDS_BYTES = RSTAB_OFF + MAXU * 256 * 4;
static_assert(LDS_BYTES <= 160 * 1024 && LDS_BYTES > 80 * 1024, "LDS map");

#define RLX_AGENT __ATOMIC_RELAXED, __HIP_MEMORY_SCOPE_AGENT
__device__ __forceinline__ unsigned cvt_pk_bf16(float lo, float hi) { unsigned r; asm volatile("v_cvt_pk_bf16_f32 %0, %1, %2" : "=v"(r) : "v"(lo), "v"(hi)); return r; }
__device__ __forceinline__ float clamp448(float v) { return __builtin_amdgcn_fmed3f(v, -448.0f, 448.0f); }
__device__ __forceinline__ unsigned pk_fp8x4(float a, float b, float c, float d) {
    int p = __builtin_amdgcn_cvt_pk_fp8_f32(clamp448(a), clamp448(b), 0, false); p = __builtin_amdgcn_cvt_pk_fp8_f32(clamp448(c), clamp448(d), p, true); return (unsigned)p; }
__device__ __forceinline__ float bf_lo(unsigned x) { return __uint_as_float(x << 16); }
__device__ __forceinline__ float bf_hi(unsigned x) { return __uint_as_float(x & 0xffff0000u); }
__device__ __forceinline__ float fast_sigmoid(float g) { return __builtin_amdgcn_rcpf(1.0f + __builtin_amdgcn_exp2f(-1.4426950408889634f * g)); }
__device__ __forceinline__ float wave_sum(float v) {
#pragma unroll
    for (int o = 1; o < 64; o <<= 1) v += __shfl_xor(v, o);
    return v;
}
__device__ __forceinline__ float dpp_add(float v, const int ctrl_sel) {
    int r;
    if (ctrl_sel == 0) r = __builtin_amdgcn_update_dpp(0, __float_as_int(v), 0xB1, 0xF, 0xF, false);
    else if (ctrl_sel == 1) r = __builtin_amdgcn_update_dpp(0, __float_as_int(v), 0x4E, 0xF, 0xF, false);
    else if (ctrl_sel == 2) r = __builtin_amdgcn_update_dpp(0, __float_as_int(v), 0x141, 0xF, 0xF, false);
    else r = __builtin_amdgcn_update_dpp(0, __float_as_int(v), 0x140, 0xF, 0xF, false);
    return v + __int_as_float(r);
}
__device__ __forceinline__ float row16_allsum(float v) { v = dpp_add(v, 0); v = dpp_add(v, 1); v = dpp_add(v, 2); v = dpp_add(v, 3); return v; }
__device__ __forceinline__ f32x2 gelu_pk(f32x2 v) {
    const f32x2 av = __builtin_elementwise_abs(v), d = av * 0.2316418882f + 1.0f;
    f32x2 t; t.x = __builtin_amdgcn_rcpf(d.x); t.y = __builtin_amdgcn_rcpf(d.y);
    f32x2 q = t * 0.5307027145f + (-0.7265760135f); q = q * t + 0.7107068705f; q = q * t + (-0.142248368f); q = q * t + 0.127414796f; q = q * t;
    const f32x2 s = (v * v) * (-0.72134752044f);
    f32x2 e; e.x = __builtin_amdgcn_exp2f(s.x); e.y = __builtin_amdgcn_exp2f(s.y);
    const f32x2 m = v * (q * e), r = v - m;
    f32x2 o; o.x = v.x < 0.f ? m.x : r.x; o.y = v.y < 0.f ? m.y : r.y; return o;
}

#ifndef WT_STORES
#define WT_STORES 0
#endif
struct WtBuf { __amdgpu_buffer_rsrc_t r; };
__device__ __forceinline__ WtBuf wt_buf(const void* base) { WtBuf b; b.r = __builtin_amdgcn_make_buffer_rsrc((void*)base, 0, 0xFFFFFFFFu, 0x00020000); return b; }
__device__ __forceinline__ void wt_store16(const WtBuf& b, const void* base, size_t byte_off, u32x4 v) {
#if WT_STORES
    __builtin_amdgcn_raw_buffer_store_b128(v, b.r, (int)(unsigned)byte_off, 0, 16);
#else
    *(u32x4*)((char*)base + byte_off) = v;
#endif
}
__device__ __forceinline__ void wt_store16f(const WtBuf& b, const void* base, size_t byte_off, f32x4 v) { wt_store16(b, base, byte_off, __builtin_bit_cast(u32x4, v)); }

#define XB_TMO      128
#define XB_XCNT(j)  (256  + 64 * (j))
#define XB_XSUB(j)  (1280 + 64 * (j))
#define XB_XGEN(j)  (2304 + 64 * (j))
#define XB_TOP      3328
#define XB_TOPGEN   3392
#define XCD_BAR_WORDS 3456
#define XB_SPIN_CAP (1u << 18)
__device__ __forceinline__ unsigned xb_ld(unsigned* p)              { return __hip_atomic_load(p, __ATOMIC_RELAXED, __HIP_MEMORY_SCOPE_AGENT); }
__device__ __forceinline__ unsigned xb_add(unsigned* p, unsigned v) { return __hip_atomic_fetch_add(p, v, __ATOMIC_RELAXED, __HIP_MEMORY_SCOPE_AGENT); }
__device__ __forceinline__ unsigned xb_xcc_id() { return (unsigned)__builtin_amdgcn_s_getreg((3 << 11) | 20) & 0xFu; }
#define XB_SPIN(cond, bar) do { unsigned _sp = 0; while (cond) { __builtin_amdgcn_s_sleep(1); \
    if ((++_sp & 255u) == 0u) { if (xb_ld(&(bar)[XB_TMO])) break; if (_sp > XB_SPIN_CAP) { atomicAdd(&(bar)[XB_TMO], 1u); break; } } } } while (0)
struct XcdBarrier { unsigned* bar; unsigned x; volatile LAS unsigned* st; };
__device__ __forceinline__ XcdBarrier xcd_barrier_post(unsigned* bar, volatile LAS unsigned* st) {
    XcdBarrier b; b.bar = bar; b.x = xb_xcc_id(); b.st = st;
    if (threadIdx.x == 0) (void)xb_add(&bar[XB_XCNT(b.x)], 1u);
    return b;
}
__device__ __forceinline__ void xcd_barrier_complete(unsigned* bar, unsigned x, unsigned& nloc, unsigned& nx) {
    const unsigned G = gridDim.x * gridDim.y * gridDim.z;
    unsigned sum, cnt, mine, sp = 0u;
    for (;;) {
        sum = 0u; cnt = 0u; mine = 0u;
#pragma unroll
        for (unsigned j = 0; j < 16; ++j) { const unsigned c = xb_ld(&bar[XB_XCNT(j)]); sum += c; cnt += (c > 0u) ? 1u : 0u; mine = (j == x) ? c : mine; }
        if (sum == G) break;
        __builtin_amdgcn_s_sleep(1);
        if ((++sp & 255u) == 0u) { if (xb_ld(&bar[XB_TMO])) break; if (sp > XB_SPIN_CAP) { atomicAdd(&bar[XB_TMO], 1u); break; } }
    }
    nloc = mine > 0u ? mine : 1u; nx = cnt > 0u ? cnt : 1u;
}
__device__ __forceinline__ void xcd_barrier(const XcdBarrier& b) {
    asm volatile("s_waitcnt vmcnt(0)" ::: "memory");
    __syncthreads();
    if (threadIdx.x == 0) {
        unsigned* bar = b.bar;
        __builtin_amdgcn_s_waitcnt(0);
        unsigned nloc = b.st[0], nx = b.st[1];
        if (nloc == 0u) { xcd_barrier_complete(bar, b.x, nloc, nx); b.st[0] = nloc; b.st[1] = nx; }
        const unsigned old = xb_add(&bar[XB_XSUB(b.x)], 1u);
        const unsigned gen = old / nloc;
        if (old + 1u == (gen + 1u) * nloc) {
            __builtin_amdgcn_fence(__ATOMIC_RELEASE, "agent");
            asm volatile("s_waitcnt vmcnt(0)" ::: "memory");
            const unsigned og = xb_add(&bar[XB_TOP], 1u);
            const unsigned tg = og / nx;
            if (og + 1u == (tg + 1u) * nx) xb_add(&bar[XB_TOPGEN], 1u);
            else XB_SPIN(xb_ld(&bar[XB_TOPGEN]) == tg, bar);
            __builtin_amdgcn_fence(__ATOMIC_ACQUIRE, "agent");
            xb_add(&bar[XB_XGEN(b.x)], 1u);
            asm volatile("s_waitcnt vmcnt(0)" ::: "memory");
        } else {
            XB_SPIN(xb_ld(&bar[XB_XGEN(b.x)]) == gen, bar);
            __builtin_amdgcn_fence(__ATOMIC_ACQUIRE, "agent");
            asm volatile("s_waitcnt vmcnt(0)" ::: "memory");
        }
    }
    __syncthreads();
}

namespace pg8 {
constexpr int BM = 256, BK = 64, HALF = 128, HTB = HALF * BK * 2, STAGE_BYTES = 8 * HTB, NXCD = 8, WGM = 4;
__host__ __device__ __forceinline__ int lds_byte(int r, int c) { const int st = (r >> 4) * 2 + (c >> 5), rr = r & 15, cc = c & 31, ob = rr * 64 + cc * 2; return st * 1024 + (ob ^ (((ob >> 9) & 1) << 5)); }
__host__ __device__ __forceinline__ void stage_rc(int b, int& R, int& C) { const int st = b / 1024, sb = b % 1024, swz = sb ^ (((sb >> 9) & 1) << 5); R = (st >> 1) * 16 + swz / 64; C = (st & 1) * 32 + (swz % 64) / 2; }
__host__ __device__ __forceinline__ int perm32(int rho) { const int n = rho >> 4, i = rho & 15; return 8 * (i >> 2) + 4 * n + (i & 3); }

struct Unit { int pm, pn, e, valid, rb, ui, nt, k0, part, pi; };

struct StaticOrder {
    int nM, nN, nwg, G, c, i0, nmax;
    __device__ __forceinline__ void init(int nM_, int nN_, int G_, int c_) { nM = nM_; nN = nN_; nwg = nM * nN; G = G_; c = c_; i0 = 0; nmax = 1 << 30; }
    __device__ __forceinline__ bool map(int i, int& pm, int& pn) const {
        if (i >= nmax) return false;
        const long L = (long)(i + i0) * G + c; if (L >= nwg) return false;
        int wgid = (int)L; { const int q = nwg / NXCD, r = nwg % NXCD, xcd = wgid % NXCD, off = wgid / NXCD; wgid = (xcd < r ? xcd * (q + 1) : r * (q + 1) + (xcd - r) * q) + off; }
        const int nig = WGM * nN, gid = wgid / nig, fm = gid * WGM, gsz = (nM - fm) < WGM ? (nM - fm) : WGM;
        pm = fm + ((wgid % nig) % gsz); pn = (wgid % nig) / gsz; return true;
    }
};

typedef int v4i32 __attribute__((ext_vector_type(4)));
typedef int v8i32 __attribute__((ext_vector_type(8)));
template <class Epi, class Sched, bool ALIGN_EPI, bool FP8>
__device__ __forceinline__ void gemm_phase(LAS unsigned char* lds, const int KB, const Sched& S, const Epi& E) {
    const int tid = threadIdx.x, wid = __builtin_amdgcn_readfirstlane(tid >> 6), lane = tid & 63, wr = wid >> 2, wc = wid & 3, fr = lane & 15, fq = lane >> 4;
    int Rs[2], Cs[2]; unsigned voffB[2];
#pragma unroll
    for (int i = 0; i < 2; ++i) { stage_rc(tid * 16 + i * 8192, Rs[i], Cs[i]); voffB[i] = (unsigned)(Rs[i] * KB + Cs[i] * 2); }
    const size_t kstep = (size_t)(BK * 2);
    const size_t hstep = (size_t)HALF * KB;
    const unsigned ldsw = (unsigned)wid * 1024u;
    const int aoff = lds_byte(wr * 64 + fr, fq * 8), boff = lds_byte(wc * 32 + fr, fq * 8);
#define PG8_SA(b, h) (((b) * 2 + (h)) * HTB)
#define PG8_SB(b, h) ((4 + (b) * 2 + (h)) * HTB)
#define PG8_STAGE(bufoff, gbase, voff) do { _Pragma("unroll") for (int _i = 0; _i < 2; ++_i) \
        __builtin_amdgcn_global_load_lds((const unsigned*)((const char*)(gbase) + (voff)[_i]), (LAS unsigned*)(lds + (bufoff) + ldsw + _i * 8192), 16, 0, 0); } while (0)
#define PG8_LDA(dst, b, h) do { _Pragma("unroll") for (int m = 0; m < 4; ++m) dst[m] = __builtin_shufflevector(*(const LAS v4i32*)(lds + PG8_SA(b, h) + aoff + m * 2048), *(const LAS v4i32*)(lds + PG8_SA(b, h) + aoff + m * 2048 + 1024), 0, 1, 2, 3, 4, 5, 6, 7); } while (0)
#define PG8_LDB(dst, b, h) do { _Pragma("unroll") for (int n = 0; n < 2; ++n) dst[n] = __builtin_shufflevector(*(const LAS v4i32*)(lds + PG8_SB(b, h) + boff + n * 2048), *(const LAS v4i32*)(lds + PG8_SB(b, h) + boff + n * 2048 + 1024), 0, 1, 2, 3, 4, 5, 6, 7); } while (0)
#define PG8_MMA(ai, bj, At, Bt) do { __builtin_amdgcn_s_setprio(1); _Pragma("unroll") for (int m = 0; m < 4; ++m) _Pragma("unroll") for (int n = 0; n < 2; ++n) { \
        if constexpr (FP8) asm volatile("v_mfma_f32_16x16x128_f8f6f4 %0, %1, %2, %0" : "+v"(acc[ai][bj][m][n]) : "v"(Bt[n]), "v"(At[m]));   \
        else { acc[ai][bj][m][n] = __builtin_amdgcn_mfma_f32_16x16x32_bf16(__builtin_bit_cast(bf16x8, __builtin_shufflevector(Bt[n], Bt[n], 0, 1, 2, 3)), __builtin_bit_cast(bf16x8, __builtin_shufflevector(At[m], At[m], 0, 1, 2, 3)), acc[ai][bj][m][n], 0, 0, 0); \
               acc[ai][bj][m][n] = __builtin_amdgcn_mfma_f32_16x16x32_bf16(__builtin_bit_cast(bf16x8, __builtin_shufflevector(Bt[n], Bt[n], 4, 5, 6, 7)), __builtin_bit_cast(bf16x8, __builtin_shufflevector(At[m], At[m], 4, 5, 6, 7)), acc[ai][bj][m][n], 0, 0, 0); } } \
        __builtin_amdgcn_s_setprio(0); } while (0)
#define PG8_WAIT_V(n) asm volatile("s_waitcnt vmcnt(" #n ")" ::: "memory")
#define PG8_WAIT_L(n) asm volatile("s_waitcnt lgkmcnt(" #n ")" ::: "memory")
#define PG8_BAR __builtin_amdgcn_s_barrier()
#define PG8_SCHED __builtin_amdgcn_sched_barrier(0)
    Unit cur, nxt; int ui = 0;
    if (!S.next(0, cur)) return;
    f32x4 acc[2][2][4][2];
    E.init_acc(acc, cur, wr, wc, fr, fq);
    v8i32 At[4], B0[2], B1[2];
    const char* cA = S.a_ptr(cur); const char* cB = S.b_ptr(cur);
    unsigned offC[2][2], offN[2][2];
    S.a_offs(cur, Rs, Cs, offC);
    PG8_STAGE(PG8_SB(0, 0), cB, voffB); PG8_STAGE(PG8_SB(0, 1), cB + hstep, voffB); PG8_STAGE(PG8_SA(0, 0), cA, offC[0]); PG8_STAGE(PG8_SA(0, 1), cA, offC[1]);
    if (wr == 1) PG8_BAR;
    PG8_WAIT_V(2); PG8_BAR;
    PG8_STAGE(PG8_SB(1, 0), cB + kstep, voffB); PG8_STAGE(PG8_SA(1, 0), cA + kstep, offC[0]); PG8_STAGE(PG8_SB(1, 1), cB + hstep + kstep, voffB);
    PG8_WAIT_V(6); PG8_BAR;
    bool has_next = false; const char* nA = cA; const char* nB = cB;
    constexpr bool NEXT_IN_LOOP = FP8;
#define PG8_NEXT() do { has_next = S.next(ui + 1, nxt); nA = has_next ? S.a_ptr(nxt) : cA; nB = has_next ? S.b_ptr(nxt) : cB; \
        if (has_next) S.a_offs(nxt, Rs, Cs, offN); else { _Pragma("unroll") for (int h = 0; h < 2; ++h) _Pragma("unroll") for (int i = 0; i < 2; ++i) offN[h][i] = offC[h][i]; } } while (0)
    for (;;) {
        if constexpr (!NEXT_IN_LOOP) PG8_NEXT();
        const int nt = cur.nt;
        for (int t = 0; t < nt; t += 2) {
            const bool last = (t == nt - 2);
            const char* a1 = cA + (size_t)(t + 1) * kstep;
            const char* a2 = last ? nA : cA + (size_t)(t + 2) * kstep; const char* b2 = last ? nB : cB + (size_t)(t + 2) * kstep;
            const char* a3 = a2 + kstep; const char* b3 = b2 + kstep;
            unsigned o2[2][2];
#pragma unroll
            for (int h = 0; h < 2; ++h)
#pragma unroll
                for (int i = 0; i < 2; ++i) o2[h][i] = last ? offN[h][i] : offC[h][i];
            PG8_LDB(B0, 0, 0); PG8_LDB(B1, 0, 1); PG8_SCHED; PG8_LDA(At, 0, 0); PG8_STAGE(PG8_SA(1, 1), a1, offC[1]);
            PG8_WAIT_V(8); PG8_WAIT_L(0); PG8_BAR; PG8_MMA(0, 0, At, B0); PG8_MMA(0, 1, At, B1);
            if constexpr (NEXT_IN_LOOP) { if (t == 0) PG8_NEXT(); }
            PG8_BAR; PG8_SCHED;
            PG8_LDA(At, 0, 1); PG8_STAGE(PG8_SB(0, 0), b2, voffB); PG8_STAGE(PG8_SB(0, 1), b2 + hstep, voffB); PG8_STAGE(PG8_SA(0, 0), a2, o2[0]);
            PG8_WAIT_V(8); PG8_WAIT_L(0); PG8_BAR; PG8_MMA(1, 0, At, B0); PG8_MMA(1, 1, At, B1); PG8_BAR; PG8_SCHED;
            PG8_LDB(B0, 1, 0); PG8_LDB(B1, 1, 1); PG8_SCHED; PG8_LDA(At, 1, 0); PG8_STAGE(PG8_SA(0, 1), a2, o2[1]);
            PG8_WAIT_V(8); PG8_WAIT_L(0); PG8_BAR; PG8_MMA(0, 0, At, B0); PG8_MMA(0, 1, At, B1); PG8_BAR; PG8_SCHED;
            PG8_LDA(At, 1, 1); PG8_STAGE(PG8_SB(1, 0), b3, voffB); PG8_STAGE(PG8_SB(1, 1), b3 + hstep, voffB); PG8_STAGE(PG8_SA(1, 0), a3, o2[0]);
            PG8_WAIT_V(8); PG8_WAIT_L(0); PG8_BAR; PG8_MMA(1, 0, At, B0); PG8_MMA(1, 1, At, B1); PG8_BAR; PG8_SCHED;
        }
        if constexpr (ALIGN_EPI) { if (wr == 0) PG8_BAR; }
        if constexpr (FP8) asm volatile("s_nop 15\n\ts_nop 15" ::: "memory");
        if constexpr (!Epi::AFTER_DRAIN) E(acc, cur, wr, wc, fr, fq);
        if (!has_next) break;
        E.init_acc(acc, nxt, wr, wc, fr, fq);
        cur = nxt; cA = nA; cB = nB; ++ui;
#pragma unroll
        for (int h = 0; h < 2; ++h)
#pragma unroll
            for (int i = 0; i < 2; ++i) offC[h][i] = offN[h][i];
        if constexpr (ALIGN_EPI) { if (wr == 1) PG8_BAR; }
    }
    PG8_WAIT_V(0);
    if constexpr (!ALIGN_EPI) { if (wr == 0) PG8_BAR; }
    PG8_BAR;
    if constexpr (Epi::AFTER_DRAIN) E.fused(acc, cur, wr, wc, fr, fq, lds);
#undef PG8_NEXT
#undef PG8_SA
#undef PG8_SB
#undef PG8_STAGE
#undef PG8_LDA
#undef PG8_LDB
#undef PG8_MMA
#undef PG8_WAIT_V
#undef PG8_WAIT_L
#undef PG8_BAR
#undef PG8_SCHED
}

struct DenseSched {
    const char* A; const char* Bt; int KB; StaticOrder so; int g1;
    __device__ __forceinline__ bool next(int i, Unit& u) const { int pm, pn;
        if (g1) { const int L = i * so.G + so.c; if (L >= 512) return false; pm = (L & 255) >> 2; pn = (L & 3) + 4 * (L >> 8); }
        else if (!so.map(i, pm, pn)) return false; u.pm = pm; u.pn = pn; u.e = 0; u.valid = 256; u.rb = pm * 256; u.ui = i; u.nt = KB / 128; u.k0 = 0; u.part = 0; u.pi = 0; return true; }
    __device__ __forceinline__ const char* a_ptr(const Unit& u) const { return A + (size_t)u.pm * 256 * KB; }
    __device__ __forceinline__ const char* b_ptr(const Unit& u) const { return Bt + (size_t)u.pn * 256 * KB; }
    __device__ __forceinline__ void a_offs(const Unit&, const int (&R)[2], const int (&C)[2], unsigned (&off)[2][2]) const {
#pragma unroll
        for (int h = 0; h < 2; ++h)
#pragma unroll
            for (int i = 0; i < 2; ++i) off[h][i] = (unsigned)((h * 128 + R[i]) * KB + C[i] * 2); }
};
__device__ __forceinline__ void moe_lookup(const LAS int* tab, int vt, Unit& u) {
    int e = 0;
#pragma unroll
    for (int k = 1; k < 8; ++k) e += (vt >= tab[16 + k]) ? 1 : 0;
    e = __builtin_amdgcn_readfirstlane(e);
    const int tpe = __builtin_amdgcn_readfirstlane(tab[16 + e]), ce = __builtin_amdgcn_readfirstlane(tab[e]), be = __builtin_amdgcn_readfirstlane(tab[8 + e]);
    const int li = vt - tpe; u.pm = li; u.e = e; const int rem = ce - 256 * li; u.valid = rem < 256 ? rem : 256; u.rb = be + 256 * li;
}
template <int ES> struct MoeUpSched {
    const char* XA; const char* W; const LAS int* toktab; const LAS int* tab; StaticOrder so;
    __device__ __forceinline__ bool next(int i, Unit& u) const { int vt, pn; if (!so.map(i, vt, pn)) return false; moe_lookup(tab, vt, u); u.pn = pn; u.ui = i; u.nt = D * ES / 128; u.k0 = 0; u.part = 0; u.pi = 0; return true; }
    __device__ __forceinline__ const char* a_ptr(const Unit&) const { return XA; }
    __device__ __forceinline__ const char* b_ptr(const Unit& u) const { return W + ((size_t)u.e * NFF2 + (size_t)u.pn * 256) * D * ES; }
    __device__ __forceinline__ void a_offs(const Unit& u, const int (&R)[2], const int (&C)[2], unsigned (&off)[2][2]) const {
#pragma unroll
        for (int h = 0; h < 2; ++h)
#pragma unroll
            for (int i = 0; i < 2; ++i) off[h][i] = (unsigned)toktab[u.ui * 256 + h * 128 + R[i]] * (unsigned)(D * ES) + (unsigned)C[i] * 2u; }
};
template <int ES> struct MoeDownSched {
    const char* ACT; const char* W; const LAS int* tab; StaticOrder so;
    __device__ __forceinline__ bool next(int i, Unit& u) const {
        const int L = i * so.G + so.c, nf4 = so.nwg, np = __builtin_amdgcn_readfirstlane(tab[34]);
        if (L >= nf4 + 16 * np) return false;
        u.ui = i;
        if (L < nf4) {
            int f, pn; so.map(i, f, pn);
            int e = 0;
#pragma unroll
            for (int k = 1; k < 8; ++k) e += (f >= tab[25 + k]) ? 1 : 0;
            e = __builtin_amdgcn_readfirstlane(e);
            const int li = f - __builtin_amdgcn_readfirstlane(tab[25 + e]);
            u.pm = li; u.pn = pn; u.e = e; u.valid = 256; u.rb = __builtin_amdgcn_readfirstlane(tab[8 + e]) + 256 * li; u.nt = FF * ES / 128; u.k0 = 0; u.part = 0; u.pi = 0;
        } else {
            const int s = L - nf4, p = s >> 4, r = s & 15, kp = r & 3;
            const int e = __builtin_amdgcn_readfirstlane(tab[35 + p]), ce = __builtin_amdgcn_readfirstlane(tab[e]);
            u.pm = ce >> 8; u.pn = r >> 2; u.e = e; u.valid = ce & 255; u.rb = __builtin_amdgcn_readfirstlane(tab[8 + e]) + (ce & ~255);
            constexpr int NTK = FF * ES / 128, Q = ((NTK / 4) + 1) & ~1;
            static_assert(NTK - 3 * Q >= 4 && ((NTK - 3 * Q) & 1) == 0, "K split");
            u.k0 = kp * Q; u.nt = kp < 3 ? Q : NTK - 3 * Q; u.part = 1; u.pi = p * 4 + kp;
        }
        return true;
    }
    __device__ __forceinline__ const char* a_ptr(const Unit& u) const { return ACT + (size_t)u.rb * FF * ES + (size_t)u.k0 * 128; }
    __device__ __forceinline__ const char* b_ptr(const Unit& u) const { return W + ((size_t)u.e * D + (size_t)u.pn * 256) * FF * ES + (size_t)u.k0 * 128; }
    __device__ __forceinline__ void a_offs(const Unit&, const int (&R)[2], const int (&C)[2], unsigned (&off)[2][2]) const {
#pragma unroll
        for (int h = 0; h < 2; ++h)
#pragma unroll
            for (int i = 0; i < 2; ++i) off[h][i] = (unsigned)((h * 128 + R[i]) * FF * ES + C[i] * 2); }
};

__device__ __forceinline__ void zero_acc(f32x4 (&acc)[2][2][4][2]) {
#pragma unroll
    for (int a = 0; a < 2; ++a)
#pragma unroll
        for (int b = 0; b < 2; ++b)
#pragma unroll
            for (int m = 0; m < 4; ++m)
#pragma unroll
                for (int n = 0; n < 2; ++n) acc[a][b][m][n] = (f32x4){0.f, 0.f, 0.f, 0.f};
}
__device__ __forceinline__ float rstd_of(float p) { p += __shfl_xor(p, 16); p += __shfl_xor(p, 32); return 1.0f / sqrtf(p * (1.0f / D) + EPS); }
struct EpiMix {
    static constexpr bool AFTER_DRAIN = false;
    bf16_t* CG; bf16_t* UA; bf16_t* VA; const LAS float* rstab;
    __device__ __forceinline__ void init_acc(f32x4 (&acc)[2][2][4][2], const Unit&, int, int, int, int) const { zero_acc(acc); }
    __device__ __forceinline__ void operator()(const f32x4 (&acc)[2][2][4][2], const Unit& u, int wr, int wc, int fr, int fq) const {
        const int row0 = u.rb + wr * 64 + fr;
        const WtBuf bcg = wt_buf(CG), bdst = wt_buf(u.pn < 6 ? UA : VA);
        float rsv[2][4];
#pragma unroll
        for (int ai = 0; ai < 2; ++ai)
#pragma unroll
            for (int m = 0; m < 4; ++m) rsv[ai][m] = rstab[u.ui * 256 + ai * HALF + wr * 64 + m * 16 + fr];
#pragma unroll
        for (int ai = 0; ai < 2; ++ai)
#pragma unroll
            for (int m = 0; m < 4; ++m) {
                const int row = row0 + ai * HALF + m * 16; const float rs = rsv[ai][m];
                if (u.pn < 4) {
                    float o[8];
#pragma unroll
                    for (int n = 0; n < 2; ++n)
#pragma unroll
                        for (int j = 0; j < 4; ++j) { const float a = acc[ai][0][m][n][j] * rs, g = acc[ai][1][m][n][j] * rs; o[4 * n + j] = a * fast_sigmoid(g); }
                    u32x4 w; w.x = cvt_pk_bf16(o[0], o[1]); w.y = cvt_pk_bf16(o[2], o[3]); w.z = cvt_pk_bf16(o[4], o[5]); w.w = cvt_pk_bf16(o[6], o[7]);
                    wt_store16(bcg, CG, ((size_t)row * CC + u.pn * 128 + wc * 32 + 8 * fq) * 2, w);
                } else {
                    bf16_t* dbase = (u.pn < 6 ? UA : VA); const size_t doff = ((size_t)row * CC + (u.pn & 1) * 256 + wc * 32 + 8 * fq) * 2;
#pragma unroll
                    for (int bj = 0; bj < 2; ++bj) {
                        const f32x4 v0 = acc[ai][bj][m][0] * rs, v1 = acc[ai][bj][m][1] * rs;
                        const f32x2 a = gelu_pk((f32x2){v0[0], v0[1]}), b = gelu_pk((f32x2){v0[2], v0[3]}), c = gelu_pk((f32x2){v1[0], v1[1]}), d = gelu_pk((f32x2){v1[2], v1[3]});
                        u32x4 w; w.x = cvt_pk_bf16(a.x, a.y); w.y = cvt_pk_bf16(b.x, b.y); w.z = cvt_pk_bf16(c.x, c.y); w.w = cvt_pk_bf16(d.x, d.y);
                        wt_store16(bdst, dbase, doff + bj * HALF * 2, w); }
                }
            }
    }
};
struct EpiRes {
    static constexpr bool AFTER_DRAIN = true;
    const float* XIN; float* XOUT; bf16_t* XB; float* rss_out; unsigned char* XB8; float sc_in, sc_out;
    __device__ __forceinline__ void init_acc(f32x4 (&acc)[2][2][4][2], const Unit& u, int wr, int wc, int fr, int fq) const {
        const int row0 = u.rb + wr * 64 + fr, col0 = u.pn * 256 + wc * 32 + 8 * fq;
#pragma unroll
        for (int ai = 0; ai < 2; ++ai)
#pragma unroll
            for (int m = 0; m < 4; ++m)
#pragma unroll
                for (int bj = 0; bj < 2; ++bj) { const size_t off = (size_t)(row0 + ai * HALF + m * 16) * D + col0 + bj * HALF;
                    if (RES_BF16) { const u32x4 w = *(const u32x4*)(XB + off);
                        acc[ai][bj][m][0] = (f32x4){bf_lo(w.x), bf_hi(w.x), bf_lo(w.y), bf_hi(w.y)} * sc_in; acc[ai][bj][m][1] = (f32x4){bf_lo(w.z), bf_hi(w.z), bf_lo(w.w), bf_hi(w.w)} * sc_in; }
                    else { acc[ai][bj][m][0] = *(const f32x4*)(XIN + off) * sc_in; acc[ai][bj][m][1] = *(const f32x4*)(XIN + off + 4) * sc_in; } }
    }
    __device__ __forceinline__ void fused(const f32x4 (&acc)[2][2][4][2], const Unit& u, int wr, int wc, int fr, int fq, LAS unsigned char* lds) const {
        const int row0 = u.rb + wr * 64 + fr, col0 = u.pn * 256 + wc * 32 + 8 * fq;
        LAS float* P = (LAS float*)lds;
        const WtBuf bxo = wt_buf(XOUT), bxb = wt_buf(XB);
#pragma unroll
        for (int ai = 0; ai < 2; ++ai)
#pragma unroll
            for (int m = 0; m < 4; ++m) {
                const int lr = ai * HALF + wr * 64 + m * 16 + fr, row = u.rb + lr; float ss = 0.f;
#pragma unroll
                for (int bj = 0; bj < 2; ++bj) {
                    const size_t off = (size_t)row * D + col0 + bj * HALF;
                    const f32x4 x0 = acc[ai][bj][m][0] * sc_out, x1 = acc[ai][bj][m][1] * sc_out;
                    if (!RES_BF16) { wt_store16f(bxo, XOUT, off * 4, x0); wt_store16f(bxo, XOUT, off * 4 + 16, x1); }
                    u32x4 w; w.x = cvt_pk_bf16(x0[0], x0[1]); w.y = cvt_pk_bf16(x0[2], x0[3]); w.z = cvt_pk_bf16(x1[0], x1[1]); w.w = cvt_pk_bf16(x1[2], x1[3]);
                    wt_store16(bxb, XB, off * 2, w);
                    if (XB8) { u32x2 q; q.x = pk_fp8x4(x0[0], x0[1], x0[2], x0[3]); q.y = pk_fp8x4(x1[0], x1[1], x1[2], x1[3]); *(u32x2*)(XB8 + off) = q; }
                    ss += (x0[0] * x0[0] + x0[1] * x0[1]) + (x0[2] * x0[2] + x0[3] * x0[3]) + (x1[0] * x1[0] + x1[1] * x1[1]) + (x1[2] * x1[2] + x1[3] * x1[3]); }
                ss += __shfl_xor(ss, 16); ss += __shfl_xor(ss, 32);
                if (fq == 0) P[lr * 4 + wc] = ss;
            }
        (void)row0;
        __syncthreads();
        if (threadIdx.x < 256) { const f32x4 p = *(const LAS f32x4*)(P + threadIdx.x * 4); rss_out[(size_t)(u.rb + threadIdx.x) * 4 + u.pn] = (p.x + p.y) + (p.z + p.w); }
        __syncthreads();
    }
};
template <bool MOE, bool F8> struct EpiSwiglu {
    static constexpr bool AFTER_DRAIN = false;
    void* ACT; const LAS float* rstab; float post;
    __device__ __forceinline__ void init_acc(f32x4 (&acc)[2][2][4][2], const Unit&, int, int, int, int) const { zero_acc(acc); }
    __device__ __forceinline__ void operator()(const f32x4 (&acc)[2][2][4][2], const Unit& u, int wr, int wc, int fr, int fq) const {
        const int col = u.pn * 128 + wc * 32 + 8 * fq;
        const WtBuf bact = wt_buf(ACT);
        float rsv[2][4];
#pragma unroll
        for (int ai = 0; ai < 2; ++ai)
#pragma unroll
            for (int m = 0; m < 4; ++m) rsv[ai][m] = rstab[u.ui * 256 + ai * HALF + wr * 64 + m * 16 + fr];
#pragma unroll
        for (int ai = 0; ai < 2; ++ai)
#pragma unroll
            for (int m = 0; m < 4; ++m) {
                const int lr = ai * HALF + wr * 64 + m * 16 + fr;
                const float rs = rsv[ai][m];
                const float k1 = -1.4426950408889634f * rs, k2 = rs * rs * post;
                float o[8];
#pragma unroll
                for (int n = 0; n < 2; ++n) {
                    const f32x4 ag = acc[ai][0][m][n], au = acc[ai][1][m][n]; const f32x4 tt = ag * k1; f32x4 ee;
#pragma unroll
                    for (int j = 0; j < 4; ++j) ee[j] = __builtin_amdgcn_exp2f(tt[j]);
                    ee = ee + 1.0f; f32x4 rr;
#pragma unroll
                    for (int j = 0; j < 4; ++j) rr[j] = __builtin_amdgcn_rcpf(ee[j]);
                    const f32x4 oo = (ag * au) * (rr * k2);
#pragma unroll
                    for (int j = 0; j < 4; ++j) o[4 * n + j] = oo[j]; }
                if constexpr (F8) {
                    u32x2 q; q.x = pk_fp8x4(o[0], o[1], o[2], o[3]); q.y = pk_fp8x4(o[4], o[5], o[6], o[7]);
                    if (!MOE || lr < u.valid) *(u32x2*)((unsigned char*)ACT + (size_t)(u.rb + lr) * FF + col) = q;
                } else {
                    u32x4 w; w.x = cvt_pk_bf16(o[0], o[1]); w.y = cvt_pk_bf16(o[2], o[3]); w.z = cvt_pk_bf16(o[4], o[5]); w.w = cvt_pk_bf16(o[6], o[7]);
                    if (!MOE || lr < u.valid) wt_store16(bact, ACT, ((size_t)(u.rb + lr) * FF + col) * 2, w);
                }
            }
    }
};
struct EpiSlot {
    static constexpr bool AFTER_DRAIN = false;
    bf16_t* YS; float* YP; float sc;
    __device__ __forceinline__ void init_acc(f32x4 (&acc)[2][2][4][2], const Unit&, int, int, int, int) const { zero_acc(acc); }
    __device__ __forceinline__ void operator()(const f32x4 (&acc)[2][2][4][2], const Unit& u, int wr, int wc, int fr, int fq) const {
        const int col0 = u.pn * 256 + wc * 32 + 8 * fq;
        const WtBuf bys = wt_buf(YS);
#pragma unroll
        for (int ai = 0; ai < 2; ++ai)
#pragma unroll
            for (int m = 0; m < 4; ++m) {
                const int lr = ai * HALF + wr * 64 + m * 16 + fr;
                if (lr < u.valid) {
#pragma unroll
                    for (int bj = 0; bj < 2; ++bj) {
                        const f32x4 x0 = acc[ai][bj][m][0] * sc, x1 = acc[ai][bj][m][1] * sc;
                        if (u.part) { const char* ypb = (const char*)(YP + (size_t)u.pi * 256 * D); const unsigned yo = (unsigned)((lr * D + col0 + bj * HALF) * 4);
                            *(f32x4*)(ypb + yo) = x0; *(f32x4*)(ypb + yo + 16) = x1; continue; }
                        u32x4 w; w.x = cvt_pk_bf16(x0[0], x0[1]); w.y = cvt_pk_bf16(x0[2], x0[3]); w.z = cvt_pk_bf16(x1[0], x1[1]); w.w = cvt_pk_bf16(x1[2], x1[3]);
                        wt_store16(bys, YS, ((size_t)(u.rb + lr) * D + col0 + bj * HALF) * 2, w); }
                }
            }
    }
};
struct EpiNull {
    static constexpr bool AFTER_DRAIN = false;
    float* sink;
    __device__ __forceinline__ void init_acc(f32x4 (&acc)[2][2][4][2], const Unit&, int, int, int, int) const { zero_acc(acc); }
    __device__ __forceinline__ void operator()(const f32x4 (&acc)[2][2][4][2], const Unit& u, int wr, int wc, int fr, int fq) const {
        f32x4 s = (f32x4){0.f, 0.f, 0.f, 0.f};
#pragma unroll
        for (int a = 0; a < 2; ++a)
#pragma unroll
            for (int b = 0; b < 2; ++b)
#pragma unroll
                for (int m = 0; m < 4; ++m)
#pragma unroll
                    for (int n = 0; n < 2; ++n) s += acc[a][b][m][n];
        const float t = (s.x + s.y) + (s.z + s.w);
        if (t == 1.2345678e30f) sink[threadIdx.x] = t;
    }
};
}

struct Args { const float* in[21]; float* out; unsigned char* ws; int ph_lo, ph_hi; };
enum { I_X = 0, I_NMIX, I_WIN, I_CONVW, I_CONVB, I_CONVNG, I_CONVNB, I_SGUNG, I_SGUNB, I_SGUW, I_SGUB, I_WOUT, I_NFFN, I_FWG, I_FWU, I_FWD, I_ROUTER, I_MWG, I_MWU, I_MWD, I_NFINAL };

struct P0Item { const float* W; const float* gain; void* dst; int N, K, c0, k0, f8; };
struct P0Buf { float v[32]; f32x4 g0, g1, g2, g3; };
__device__ __forceinline__ void p0_load(const P0Item& p, int lane, P0Buf& b) {
    const float* s = p.W + (size_t)(p.k0 + (lane >> 5)) * p.N + p.c0 + (lane & 31);
#pragma unroll
    for (int i = 0; i < 32; ++i) b.v[i] = s[(size_t)(2 * i) * p.N];
    const f32x4 one = (f32x4){1.f, 1.f, 1.f, 1.f};
    b.g0 = one; b.g1 = one; b.g2 = one; b.g3 = one;
    if (p.gain) {
        if (p.f8) { const float* gp = p.gain + p.k0 + 16 * (lane & 3); b.g0 = *(const f32x4*)gp; b.g1 = *(const f32x4*)(gp + 4); b.g2 = *(const f32x4*)(gp + 8); b.g3 = *(const f32x4*)(gp + 12); }
        else { const float* gp = p.gain + p.k0 + 8 * (lane & 7); b.g0 = *(const f32x4*)gp; b.g1 = *(const f32x4*)(gp + 4); }
    }
}
__device__ __forceinline__ void p0_finish(const P0Item& p, const P0Buf& b, LAS float* scr, int lane, const int mode = 0) {
    if (mode == 1) { float s = 0.f;
#pragma unroll
        for (int i = 0; i < 32; ++i) s += b.v[i];
        if (s == 1.2345678e30f) *(float*)p.dst = s; return; }
#pragma unroll
    for (int i = 0; i < 32; ++i) scr[(2 * i + (lane >> 5)) * 33 + (lane & 31)] = b.v[i];
    if (!p.f8) {
        const int c = lane & 7;
        const f32x4 g0 = b.g0, g1 = b.g1;
        asm volatile("s_waitcnt lgkmcnt(0)" ::: "memory");
        const WtBuf bd = wt_buf(p.dst);
#pragma unroll
        for (int j = 0; j < 4; ++j) { const int rho = (lane >> 3) + 8 * j; const LAS float* s = scr + (8 * c) * 33 + pg8::perm32(rho);
            u32x4 o; o.x = cvt_pk_bf16(s[0 * 33] * g0.x, s[1 * 33] * g0.y); o.y = cvt_pk_bf16(s[2 * 33] * g0.z, s[3 * 33] * g0.w); o.z = cvt_pk_bf16(s[4 * 33] * g1.x, s[5 * 33] * g1.y); o.w = cvt_pk_bf16(s[6 * 33] * g1.z, s[7 * 33] * g1.w);
            if (mode == 0 || o.x == 0x12345678u) wt_store16(bd, p.dst, ((size_t)rho * p.K + p.k0 + 8 * c) * 2, o); }
    } else {
        const int c4 = lane & 3;
        const f32x4 g[4] = {b.g0 * MOE_SW, b.g1 * MOE_SW, b.g2 * MOE_SW, b.g3 * MOE_SW};
        asm volatile("s_waitcnt lgkmcnt(0)" ::: "memory");
#pragma unroll
        for (int j = 0; j < 2; ++j) { const int rho = (lane >> 2) + 16 * j; const LAS float* s = scr + (16 * c4) * 33 + pg8::perm32(rho);
            u32x4 o;
            o.x = pk_fp8x4(s[0 * 33] * g[0].x, s[1 * 33] * g[0].y, s[2 * 33] * g[0].z, s[3 * 33] * g[0].w);
            o.y = pk_fp8x4(s[4 * 33] * g[1].x, s[5 * 33] * g[1].y, s[6 * 33] * g[1].z, s[7 * 33] * g[1].w);
            o.z = pk_fp8x4(s[8 * 33] * g[2].x, s[9 * 33] * g[2].y, s[10 * 33] * g[2].z, s[11 * 33] * g[2].w);
            o.w = pk_fp8x4(s[12 * 33] * g[3].x, s[13 * 33] * g[3].y, s[14 * 33] * g[3].z, s[15 * 33] * g[3].w);
            if (mode == 0 || o.x == 0x12345678u) *(u32x4*)((unsigned char*)p.dst + (size_t)rho * p.K + p.k0 + 16 * c4) = o; }
    }
    asm volatile("s_waitcnt lgkmcnt(0)" ::: "memory");
}
constexpr int IT_WIN = 16 * 64, IT_WOUT = 16 * 32, IT_GU = 16 * 176, IT_DN = 44 * 32;
constexpr int P0_NITEMS = 2 * IT_WIN + 2 * IT_WOUT + IT_GU + IT_DN;
constexpr int IT_GU8 = 8 * 176, IT_DN8 = 22 * 32, P0_NITEMS8 = NE * (IT_GU8 + IT_DN8);
__device__ __forceinline__ bool p0_decode(const Args& args, int it, P0Item& p) {
    if (it >= P0_NITEMS) return false;
    unsigned char* ws = args.ws; int r = it;
    if (r < 2 * IT_WIN) { const int l = r / IT_WIN; r -= l * IT_WIN; const int kb = r / 64, g32 = r % 64, Lb = 32 * g32;
        p.c0 = Lb < 1024 ? ((Lb >> 7) & 1) * 512 + (Lb >> 8) * 128 + (Lb & 127) : Lb;
        p.W = args.in[I_WIN] + (size_t)l * D * DIN; p.N = DIN; p.K = D; p.gain = args.in[I_NMIX] + l * D; p.dst = (bf16_t*)(ws + WS_WIN) + ((size_t)l * DIN + Lb) * D; p.k0 = 64 * kb; p.f8 = 0; return true; }
    r -= 2 * IT_WIN;
    if (r < 2 * IT_WOUT) { const int l = r / IT_WOUT; r -= l * IT_WOUT; const int kb = r / 32, g32 = r % 32, Lb = 32 * g32;
        p.c0 = Lb; p.W = args.in[I_WOUT] + (size_t)l * D * D; p.N = D; p.K = D; p.gain = nullptr; p.dst = (bf16_t*)(ws + WS_WOUT) + ((size_t)l * D + Lb) * D; p.k0 = 64 * kb; p.f8 = 0; return true; }
    r -= 2 * IT_WOUT;
    if (r < IT_GU) { const int kb = r / 176, g32 = r % 176, Lb = 32 * g32; const int kind = (Lb >> 7) & 1;
        p.c0 = (Lb >> 8) * 128 + (Lb & 127); p.W = args.in[kind ? I_FWU : I_FWG]; p.N = FF; p.K = D; p.gain = args.in[I_NFFN]; p.dst = (unsigned char*)(ws + WS_FGU) + (size_t)Lb * D * (DENSE_FP8 ? 1 : 2); p.k0 = 64 * kb; p.f8 = DENSE_FP8; return true; }
    r -= IT_GU;
    if (r < IT_DN) { const int kb = r / 32, g32 = r % 32, Lb = 32 * g32;
        p.c0 = Lb; p.W = args.in[I_FWD]; p.N = D; p.K = FF; p.gain = nullptr; p.dst = (unsigned char*)(ws + WS_FD) + (size_t)Lb * FF * (DENSE_FP8 ? 1 : 2); p.k0 = 64 * kb; p.f8 = DENSE_FP8; return true; }
    return false;
}
struct P8Buf { float v[64]; };
__device__ __forceinline__ bool p8_decode(const Args& args, int it, P0Item& p) {
    if (it >= P0_NITEMS8) return false;
    unsigned char* ws = args.ws; int r = it; p.f8 = 1;
    if (r < NE * IT_GU8) { const int e = r / IT_GU8; r -= e * IT_GU8; const int kb = r / 176, g32 = r % 176, Lb = 32 * g32; const int kind = (Lb >> 7) & 1;
        p.c0 = (Lb >> 8) * 128 + (Lb & 127); p.W = args.in[kind ? I_MWU : I_MWG] + (size_t)e * D * FF; p.N = FF; p.K = D; p.gain = args.in[I_NFFN] + D; p.dst = (unsigned char*)(ws + WS_MGU) + ((size_t)e * NFF2 + Lb) * D; p.k0 = 128 * kb; return true; }
    r -= NE * IT_GU8;
    { const int e = r / IT_DN8; r -= e * IT_DN8; const int kb = r / 32, g32 = r % 32, Lb = 32 * g32;
        p.c0 = Lb; p.W = args.in[I_MWD] + (size_t)e * FF * D; p.N = D; p.K = FF; p.gain = nullptr; p.dst = (unsigned char*)(ws + WS_MD) + ((size_t)e * D + Lb) * FF; p.k0 = 128 * kb; return true; }
}
__device__ __forceinline__ void p8_load(const P0Item& p, int lane, P8Buf& b) {
    const float* s = p.W + (size_t)(p.k0 + (lane >> 5)) * p.N + p.c0 + (lane & 31);
#pragma unroll
    for (int i = 0; i < 64; ++i) b.v[i] = s[(size_t)(2 * i) * p.N];
}
__device__ __forceinline__ void p8_finish(const P0Item& p, const P8Buf& b, LAS float* scr, int lane) {
    const int c8 = lane & 7;
    const f32x4 sw = (f32x4){MOE_SW, MOE_SW, MOE_SW, MOE_SW};
    f32x4 g[4] = {sw, sw, sw, sw};
    if (p.gain) { const float* gp = p.gain + p.k0 + 16 * c8; g[0] = *(const f32x4*)gp * MOE_SW; g[1] = *(const f32x4*)(gp + 4) * MOE_SW; g[2] = *(const f32x4*)(gp + 8) * MOE_SW; g[3] = *(const f32x4*)(gp + 12) * MOE_SW; }
#pragma unroll
    for (int i = 0; i < 64; ++i) scr[(2 * i + (lane >> 5)) * 33 + (lane & 31)] = b.v[i];
    asm volatile("s_waitcnt lgkmcnt(0)" ::: "memory");
#pragma unroll
    for (int j = 0; j < 4; ++j) { const int rho = (lane >> 3) + 8 * j; const LAS float* s = scr + (16 * c8) * 33 + pg8::perm32(rho);
        u32x4 o;
        o.x = pk_fp8x4(s[0 * 33] * g[0].x, s[1 * 33] * g[0].y, s[2 * 33] * g[0].z, s[3 * 33] * g[0].w);
        o.y = pk_fp8x4(s[4 * 33] * g[1].x, s[5 * 33] * g[1].y, s[6 * 33] * g[1].z, s[7 * 33] * g[1].w);
        o.z = pk_fp8x4(s[8 * 33] * g[2].x, s[9 * 33] * g[2].y, s[10 * 33] * g[2].z, s[11 * 33] * g[2].w);
        o.w = pk_fp8x4(s[12 * 33] * g[3].x, s[13 * 33] * g[3].y, s[14 * 33] * g[3].z, s[15 * 33] * g[3].w);
        *(u32x4*)((unsigned char*)p.dst + (size_t)rho * p.K + p.k0 + 16 * c8) = o; }
    asm volatile("s_waitcnt lgkmcnt(0)" ::: "memory");
}
struct PXBuf { f32x4 v[4][4]; };
__device__ __forceinline__ void px_load(const Args& args, int it, int lane, PXBuf& b) {
#pragma unroll
    for (int k = 0; k < 4; ++k) { const f32x4* xr = (const f32x4*)(args.in[I_X] + (size_t)(4 * it + k) * D) + lane;
#pragma unroll
        for (int j = 0; j < 4; ++j) b.v[k][j] = xr[64 * j]; }
}
__device__ __forceinline__ void px_finish(const Args& args, int it, int lane, const PXBuf& b) {
    bf16_t* XB = (bf16_t*)(args.ws + WS_XB); float* rss = (float*)(args.ws + WS_RSS);
#pragma unroll
    for (int k = 0; k < 4; ++k) { const int m = 4 * it + k; float s = 0.f;
#pragma unroll
        for (int j = 0; j < 4; ++j) s += (b.v[k][j].x * b.v[k][j].x + b.v[k][j].y * b.v[k][j].y) + (b.v[k][j].z * b.v[k][j].z + b.v[k][j].w * b.v[k][j].w);
        s = row16_allsum(s); s += __shfl_xor(s, 16); s += __shfl_xor(s, 32);
        u32x2* o8 = (u32x2*)(XB + (size_t)m * D) + lane;
#pragma unroll
        for (int j = 0; j < 4; ++j) { u32x2 w; w.x = cvt_pk_bf16(b.v[k][j].x, b.v[k][j].y); w.y = cvt_pk_bf16(b.v[k][j].z, b.v[k][j].w); o8[64 * j] = w; }
        if (lane < 4) rss[(size_t)m * 4 + lane] = lane == 0 ? s : 0.f; }
}
constexpr int CW_Q = 9216;
static_assert(P0_NITEMS % 8 == 0 && P0_NITEMS8 % 8 == 0 && T % 32 == 0 && (CW_Q + 4 * 64) * 4 <= (int)CTL_ZERO_BYTES, "prologue tasks");
#define P0_TICKET(dst, NS, CTR) do { if (kseq < (NS)) { dst = (int)blockIdx.x + kseq * (int)gridDim.x; } else { \
        if (threadIdx.x == 0) slot[kseq & 1] = (NS) * (int)gridDim.x + (int)__hip_atomic_fetch_add((CTR), 1u, RLX_AGENT); __syncthreads(); dst = slot[kseq & 1]; } ++kseq; } while (0)
#define P0_DYN(TBASE, NTASKS, SQ, CTR, BUFT, LOADSTMT, FINSTMT) do { \
        BUFT ba, bb; LAS int* slot = (LAS int*)(lds + LDSCTL_OFF + 448); int kseq = 0; \
        const int ns_ = (((NTASKS) * (SQ)) / 4) / (int)gridDim.x; \
        int t0, t1; P0_TICKET(t0, ns_, CTR); P0_TICKET(t1, ns_, CTR); \
        if (t0 < (NTASKS)) { const int it = ((TBASE) + t0) * 8 + wave; BUFT& b = ba; LOADSTMT; } \
        while (t0 < (NTASKS)) { \
            if (t1 < (NTASKS)) { const int it = ((TBASE) + t1) * 8 + wave; BUFT& b = bb; LOADSTMT; } \
            { const int it = ((TBASE) + t0) * 8 + wave; BUFT& b = ba; FINSTMT; } \
            if (t1 >= (NTASKS)) break; \
            int t2; P0_TICKET(t2, ns_, CTR); \
            if (t2 < (NTASKS)) { const int it = ((TBASE) + t2) * 8 + wave; BUFT& b = ba; LOADSTMT; } \
            { const int it = ((TBASE) + t1) * 8 + wave; BUFT& b = bb; FINSTMT; } \
            if (t2 >= (NTASKS)) break; \
            int t3; P0_TICKET(t3, ns_, CTR); \
            t0 = t2; t1 = t3; } \
        __syncthreads(); } while (0)
constexpr int P0_NT8 = P0_NITEMS8 / 8, P0_LATE8 = ((P0_NT8 * 3) / 10) & ~7, P0_EARLY8 = P0_NT8 - P0_LATE8;
__device__ __forceinline__ void late_weight_tasks(const Args& args, LAS unsigned char* lds, int lane, int wave) {
    unsigned* ctl = (unsigned*)(args.ws + WS_CTL);
    LAS float* scr = (LAS float*)(lds + (wave < 7 ? wave * 16896 : TOKTAB_OFF));
    P0_DYN(P0_EARLY8, P0_LATE8, 0, ctl + CW_Q + 192, P8Buf, { P0Item p; p8_decode(args, it, p); p8_load(p, lane, b); }, { P0Item p; p8_decode(args, it, p); p8_finish(p, b, scr, lane); });
}
__device__ __forceinline__ void prologue_phase(const Args& args, LAS unsigned char* lds, int gw, int NGW, int lane, int wave) {
    unsigned char* ws = args.ws; unsigned* ctl = (unsigned*)(ws + WS_CTL);
#if PROBE_P0 == 3
    { LAS float* scr0 = (LAS float*)(lds + (wave < 7 ? wave * 16896 : TOKTAB_OFF));
      for (int it = gw; it < P0_NITEMS8; it += NGW) { P0Item p; p8_decode(args, it, p); P8Buf b;
#pragma unroll
          for (int i = 0; i < 64; ++i) b.v[i] = (float)(lane + i);
          p.gain = nullptr; p8_finish(p, b, scr0, lane); } }
#endif
    LAS float* scr = (LAS float*)(lds + (wave < 7 ? wave * 16896 : TOKTAB_OFF));
    static_assert(7 * 16896 <= LDSCTL_OFF && TOKTAB_OFF + 16896 <= LDS_BYTES, "prologue scratch");
    P0_DYN(0, P0_EARLY8, 3, ctl + CW_Q, P8Buf, { P0Item p; p8_decode(args, it, p); p8_load(p, lane, b); }, { P0Item p; p8_decode(args, it, p); p8_finish(p, b, scr, lane); });
    P0_DYN(0, P0_NITEMS / 8, 3, ctl + CW_Q + 64, P0Buf, { P0Item p; p0_decode(args, it, p); p0_load(p, lane, b); }, { P0Item p; p0_decode(args, it, p); p0_finish(p, b, scr, lane); });
    P0_DYN(0, T / 32, 3, ctl + CW_Q + 128, PXBuf, { px_load(args, it, lane, b); }, { px_finish(args, it, lane, b); });
    { float* RT = (float*)(ws + WS_RT); const float* rt = args.in[I_ROUTER]; const float* g = args.in[I_NFFN] + D;
      for (int i = gw * 64 + lane; i < NE * D; i += NGW * 64) { const int e = i / D, k = i % D; RT[i] = rt[k * NE + e] * g[k]; } }
    { bf16_t* SW = (bf16_t*)(ws + WS_SGUW); const float* sw = args.in[I_SGUW];
      for (int i = gw * 64 + lane; i < 2 * 4 * 128 * 128 / 2; i += NGW * 64) { const int e0 = 2 * i, tt = (e0 >> 7) & 127, s0 = e0 & 127;
          const float a = s0 <= tt ? sw[e0] : 0.f, b = (s0 + 1) <= tt ? sw[e0 + 1] : 0.f; ((unsigned*)SW)[i] = cvt_pk_bf16(a, b); } }
}

__device__ __forceinline__ void mid_phase(const Args& args, LAS unsigned char* lds, int l, int gw, int NGW, int lane, int wave, const int parts = 3) {
    unsigned char* ws = args.ws;
    const bf16_t* CG = (const bf16_t*)(ws + WS_CG); const bf16_t* UA = (const bf16_t*)(ws + WS_UA); const bf16_t* VA = (const bf16_t*)(ws + WS_VA); bf16_t* Y = (bf16_t*)(ws + WS_Y);
    const int fr = lane & 15, fq = lane >> 4;
    const int cv_cg = gw & 3, cv_ch = cv_cg * 128 + 2 * lane, cv_step = NGW >> 2, cv_first = gw >> 2;
    unsigned cv_raw[62];
    if (parts & 2) {
        if (cv_first < NB * (SEQ / 32)) { const int b = cv_first >> 6, t0 = (cv_first & 63) * 32; const size_t rowb = (size_t)b * SEQ;
#pragma unroll
            for (int i = 0; i < 62; ++i) { const int ta = t0 - 30 + i; cv_raw[i] = ta >= 0 ? *(const unsigned*)(CG + (rowb + ta) * CC + cv_ch) : 0u; } }
    }
    if (parts & 1) {
        constexpr int VST = 264;
        const bf16_t* Wb = (const bf16_t*)(ws + WS_SGUW) + (size_t)l * 4 * 128 * 128;
        const float* ng = args.in[I_SGUNG] + l * CC; const float* nb = args.in[I_SGUNB] + l * CC; const float* sb = args.in[I_SGUB] + l * 4 * 128;
        for (int unit = blockIdx.x; unit < NB * 16 * 4; unit += gridDim.x) {
            const int b = unit >> 6, n = (unit >> 2) & 15, h = unit & 3; const int R0 = b * SEQ + n * 128;
            const f32x2 gg = *(const f32x2*)(ng + h * 128 + 2 * lane), bb = *(const f32x2*)(nb + h * 128 + 2 * lane);
            unsigned pv[16];
#pragma unroll
            for (int rr = 0; rr < 16; ++rr) pv[rr] = *(const unsigned*)(VA + (size_t)(R0 + wave * 16 + rr) * CC + h * 128 + 2 * lane);
            const int nks = ((16 * wave + 15) >> 5) + 1;
            bf16x8 bfrag[4];
#pragma unroll
            for (int ks = 0; ks < 4; ++ks) if (ks < nks) bfrag[ks] = *(const bf16x8*)(Wb + (size_t)h * 16384 + (16 * wave + fr) * 128 + 32 * ks + 8 * fq);
            float s1[16], s2[16];
#pragma unroll
            for (int rr = 0; rr < 16; ++rr) { const float v0 = bf_lo(pv[rr]), v1 = bf_hi(pv[rr]); s1[rr] = v0 + v1; s2[rr] = v0 * v0 + v1 * v1; }
#pragma unroll
            for (int rr = 0; rr < 16; ++rr) { s1[rr] = row16_allsum(s1[rr]); s2[rr] = row16_allsum(s2[rr]); }
#pragma unroll
            for (int rr = 0; rr < 16; ++rr) { s1[rr] += __shfl_xor(s1[rr], 16); s2[rr] += __shfl_xor(s2[rr], 16); }
#pragma unroll
            for (int rr = 0; rr < 16; ++rr) { s1[rr] += __shfl_xor(s1[rr], 32); s2[rr] += __shfl_xor(s2[rr], 32); }
#pragma unroll
            for (int rp = 0; rp < 8; ++rp) {
                float y[2][2];
#pragma unroll
                for (int q = 0; q < 2; ++q) { const int rr = 2 * rp + q; const float mean = s1[rr] * (1.0f / 128.0f); const float var = fmaxf(s2[rr] * (1.0f / 128.0f) - mean * mean, 0.f);
                    const float rstd = 1.0f / sqrtf(var + EPS); y[q][0] = (bf_lo(pv[rr]) - mean) * rstd * gg.x + bb.x; y[q][1] = (bf_hi(pv[rr]) - mean) * rstd * gg.y + bb.y; }
                const int s = wave * 16 + 2 * rp;
                *(LAS unsigned*)(lds + (2 * lane) * VST + s * 2) = cvt_pk_bf16(y[0][0], y[1][0]);
                *(LAS unsigned*)(lds + (2 * lane + 1) * VST + s * 2) = cvt_pk_bf16(y[0][1], y[1][1]);
            }
            const int t = 16 * wave + fr; const size_t row = (size_t)(R0 + t);
            u32x2 uu[8];
#pragma unroll
            for (int db = 0; db < 8; ++db) uu[db] = *(const u32x2*)(UA + row * CC + h * 128 + 16 * db + 4 * fq);
            const float bias = sb[h * 128 + t];
            __syncthreads();
            f32x4 acc[8];
#pragma unroll
            for (int db = 0; db < 8; ++db) acc[db] = (f32x4){0.f, 0.f, 0.f, 0.f};
#pragma unroll
            for (int ks = 0; ks < 4; ++ks) if (ks < nks) {
#pragma unroll
                for (int db = 0; db < 8; ++db) {
                    const LAS unsigned char* ap = lds + (16 * db + fr) * VST + (32 * ks + 8 * fq) * 2;
                    union { bf16x8 v; u32x2 h[2]; } af; af.h[0] = *(const LAS u32x2*)ap; af.h[1] = *(const LAS u32x2*)(ap + 8);
                    acc[db] = __builtin_amdgcn_mfma_f32_16x16x32_bf16(af.v, bfrag[ks], acc[db], 0, 0, 0);
                }
            }
#pragma unroll
            for (int db = 0; db < 8; ++db) { const int d = 16 * db + 4 * fq;
                const float o0 = bf_lo(uu[db].x) * (acc[db][0] + bias), o1 = bf_hi(uu[db].x) * (acc[db][1] + bias), o2 = bf_lo(uu[db].y) * (acc[db][2] + bias), o3 = bf_hi(uu[db].y) * (acc[db][3] + bias);
                u32x2 w; w.x = cvt_pk_bf16(o0, o1); w.y = cvt_pk_bf16(o2, o3);
                *(u32x2*)(Y + row * D + CC + h * 128 + d) = w; }
            __syncthreads();
        }
    }
    if (parts & 2) {
        typedef __bf16 bf2_t __attribute__((ext_vector_type(2)));
        const int ch = cv_ch;
        for (int item = cv_first; item < NB * (SEQ / 32); item += cv_step) {
            const int b = item >> 6, t0 = (item & 63) * 32; const size_t rowb = (size_t)b * SEQ;
            if (item != cv_first) {
#pragma unroll
                for (int i = 0; i < 62; ++i) { const int ta = t0 - 30 + i; cv_raw[i] = ta >= 0 ? *(const unsigned*)(CG + (rowb + ta) * CC + ch) : 0u; } }
            unsigned P0[31], P1[31];
#pragma unroll
            for (int k = 0; k < 31; ++k) { P0[k] = __builtin_amdgcn_perm(cv_raw[2 * k + 1], cv_raw[2 * k], 0x05040100u); P1[k] = __builtin_amdgcn_perm(cv_raw[2 * k + 1], cv_raw[2 * k], 0x07060302u); }
            asm volatile("" ::: "memory");
            unsigned Wa0[16], Wa1[16], Wb0[16], Wb1[16];
            { f32x2 cv_wf[32]; const float* cwp = args.in[I_CONVW] + (size_t)l * CW * CC + cv_ch;
#pragma unroll
              for (int j = 0; j < CW; ++j) cv_wf[j] = *(const f32x2*)(cwp + j * CC);
              cv_wf[31] = (f32x2){0.f, 0.f};
#pragma unroll
              for (int k = 0; k < 16; ++k) { Wa0[k] = cvt_pk_bf16(cv_wf[2 * k].x, cv_wf[2 * k + 1].x); Wa1[k] = cvt_pk_bf16(cv_wf[2 * k].y, cv_wf[2 * k + 1].y); }
              Wb0[0] = cvt_pk_bf16(0.f, cv_wf[0].x); Wb1[0] = cvt_pk_bf16(0.f, cv_wf[0].y);
#pragma unroll
              for (int k = 0; k < 15; ++k) { Wb0[k + 1] = cvt_pk_bf16(cv_wf[2 * k + 1].x, cv_wf[2 * k + 2].x); Wb1[k + 1] = cvt_pk_bf16(cv_wf[2 * k + 1].y, cv_wf[2 * k + 2].y); } }
            const f32x2 cb = *(const f32x2*)(args.in[I_CONVB] + l * CC + ch), ng = *(const f32x2*)(args.in[I_CONVNG] + l * CC + ch), nb = *(const f32x2*)(args.in[I_CONVNB] + l * CC + ch);
#pragma unroll
            for (int hf = 0; hf < 4; ++hf) {
                float a0[8], a1[8];
#pragma unroll
                for (int tt = 0; tt < 8; ++tt) {
                    const int t = 8 * hf + tt; float s0 = cb.x, s1 = cb.y;
                    if ((t & 1) == 0) {
#pragma unroll
                        for (int k = 0; k < 16; ++k) { s0 = __builtin_amdgcn_fdot2_f32_bf16(__builtin_bit_cast(bf2_t, P0[t / 2 + k]), __builtin_bit_cast(bf2_t, Wa0[k]), s0, false);
                                                       s1 = __builtin_amdgcn_fdot2_f32_bf16(__builtin_bit_cast(bf2_t, P1[t / 2 + k]), __builtin_bit_cast(bf2_t, Wa1[k]), s1, false); }
                    } else {
#pragma unroll
                        for (int k = 0; k < 16; ++k) { s0 = __builtin_amdgcn_fdot2_f32_bf16(__builtin_bit_cast(bf2_t, P0[(t - 1) / 2 + k]), __builtin_bit_cast(bf2_t, Wb0[k]), s0, false);
                                                       s1 = __builtin_amdgcn_fdot2_f32_bf16(__builtin_bit_cast(bf2_t, P1[(t - 1) / 2 + k]), __builtin_bit_cast(bf2_t, Wb1[k]), s1, false); }
                    }
                    a0[tt] = s0; a1[tt] = s1;
                }
                float s1[8], s2[8];
#pragma unroll
                for (int tt = 0; tt < 8; ++tt) { s1[tt] = row16_allsum(a0[tt] + a1[tt]); s2[tt] = row16_allsum(a0[tt] * a0[tt] + a1[tt] * a1[tt]); }
#pragma unroll
                for (int tt = 0; tt < 8; ++tt) { s1[tt] += __shfl_xor(s1[tt], 16); s2[tt] += __shfl_xor(s2[tt], 16); }
#pragma unroll
                for (int tt = 0; tt < 8; ++tt) {
                    const float mean = s1[tt] * (1.0f / 64.0f); const float var = fmaxf(s2[tt] * (1.0f / 64.0f) - mean * mean, 0.f);
                    const float rstd = 1.0f / sqrtf(var + EPS);
                    const float y0 = (a0[tt] - mean) * rstd * ng.x + nb.x, y1 = (a1[tt] - mean) * rstd * ng.y + nb.y;
                    *(unsigned*)(Y + (rowb + t0 + 8 * hf + tt) * D + ch) = cvt_pk_bf16(y0 * fast_sigmoid(y0), y1 * fast_sigmoid(y1));
                }
            }
        }
    }
}

__device__ __forceinline__ void router_phase(const Args& args, LAS unsigned char* lds, int lane, int wave) {
    unsigned char* ws = args.ws;
    const bf16_t* XB = (const bf16_t*)(ws + WS_XB); const float* RT = (const float*)(ws + WS_RT); const float* rss = (const float*)(ws + WS_RSS) + (size_t)3 * T * 4;
    int* toklist = (int*)(ws + WS_TOKLIST); u32x4* tokinfo = (u32x4*)(ws + WS_TOKINFO); unsigned* cntw = (unsigned*)(ws + WS_CTL) + CW_CNT;
    LAS int* wcnt = (LAS int*)lds;
    LAS int* wbase = (LAS int*)(lds + 256);
    LAS float* rwl = (LAS float*)(lds + 1024);
    for (int i = threadIdx.x; i < NE * D / 4; i += NWAVES * 64) *(LAS f32x4*)(rwl + 4 * i) = *(const f32x4*)(RT + 4 * i);
    __syncthreads();
    for (int blk = blockIdx.x; blk < T / 64; blk += gridDim.x) {
        int my_e0 = 0, my_e1 = 0; float my_g0 = 0.f, my_g1 = 0.f;
        const int tbase = blk * 64 + wave * 8;
#pragma unroll 1
        for (int jb = 0; jb < 2; ++jb) {
            u32x4 xv[4][2]; float pr[4];
#pragma unroll
            for (int j = 0; j < 4; ++j) { const int t = tbase + 4 * jb + j;
                xv[j][0] = *(const u32x4*)(XB + (size_t)t * D + 8 * lane); xv[j][1] = *(const u32x4*)(XB + (size_t)t * D + 512 + 8 * lane);
                pr[j] = rss[(size_t)t * 4 + (lane & 3)]; }
            float xf[4][16];
#pragma unroll
            for (int j = 0; j < 4; ++j)
#pragma unroll
                for (int i = 0; i < 2; ++i) { const u32x4 v = xv[j][i];
                    xf[j][8 * i + 0] = bf_lo(v.x); xf[j][8 * i + 1] = bf_hi(v.x); xf[j][8 * i + 2] = bf_lo(v.y); xf[j][8 * i + 3] = bf_hi(v.y); xf[j][8 * i + 4] = bf_lo(v.z); xf[j][8 * i + 5] = bf_hi(v.z); xf[j][8 * i + 6] = bf_lo(v.w); xf[j][8 * i + 7] = bf_hi(v.w); }
            float a[4][NE];
#pragma unroll
            for (int e = 0; e < NE; ++e) {
                f32x4 w[4];
#pragma unroll
                for (int i = 0; i < 2; ++i) { w[2 * i] = *(const LAS f32x4*)(rwl + e * D + 512 * i + 8 * lane); w[2 * i + 1] = *(const LAS f32x4*)(rwl + e * D + 512 * i + 8 * lane + 4); }
#pragma unroll
                for (int j = 0; j < 4; ++j) { float s = 0.f;
#pragma unroll
                    for (int q = 0; q < 4; ++q) s += (xf[j][4 * q] * w[q].x + xf[j][4 * q + 1] * w[q].y) + (xf[j][4 * q + 2] * w[q].z + xf[j][4 * q + 3] * w[q].w);
                    a[j][e] = s; }
                __builtin_amdgcn_sched_barrier(0);
            }
#pragma unroll
            for (int j = 0; j < 4; ++j)
#pragma unroll
                for (int e = 0; e < NE; ++e) a[j][e] = row16_allsum(a[j][e]);
#pragma unroll
            for (int j = 0; j < 4; ++j)
#pragma unroll
                for (int e = 0; e < NE; ++e) a[j][e] += __shfl_xor(a[j][e], 16);
#pragma unroll
            for (int j = 0; j < 4; ++j)
#pragma unroll
                for (int e = 0; e < NE; ++e) a[j][e] += __shfl_xor(a[j][e], 32);
#pragma unroll
            for (int j = 0; j < 4; ++j) {
                float p = pr[j]; p = dpp_add(p, 0); p = dpp_add(p, 1);
                const float rstd = 1.0f / sqrtf(p * (1.0f / D) + EPS);
                int e0 = 0; float l0 = a[j][0] * rstd;
#pragma unroll
                for (int e = 1; e < NE; ++e) { const float le = a[j][e] * rstd; if (le > l0) { l0 = le; e0 = e; } }
                int e1 = -1; float l1 = -3.0e38f;
#pragma unroll
                for (int e = 0; e < NE; ++e) { const float le = a[j][e] * rstd; if (e != e0 && le > l1) { l1 = le; e1 = e; } }
                const float g0 = 1.0f / (1.0f + __expf(l1 - l0)), g1 = 1.0f - g0;
                if (lane == 4 * jb + j) { my_e0 = e0; my_e1 = e1; my_g0 = g0; my_g1 = g1; }
            }
        }
        const bool act = lane < 8;
        unsigned long long m0[NE], m1[NE];
#pragma unroll
        for (int e = 0; e < NE; ++e) { m0[e] = __ballot(act && my_e0 == e); m1[e] = __ballot(act && my_e1 == e); }
        if (lane < NE) { int c = 0;
#pragma unroll
            for (int e = 0; e < NE; ++e) if (lane == e) c = __popcll(m0[e]) + __popcll(m1[e]);
            wcnt[wave * 8 + lane] = c; }
        __syncthreads();
        if (threadIdx.x < NE) { const int e = threadIdx.x; int tot = 0; int pre[8];
#pragma unroll
            for (int w = 0; w < 8; ++w) { pre[w] = tot; tot += wcnt[w * 8 + e]; }
            const int base = (int)__hip_atomic_fetch_add(cntw + 64 * e, (unsigned)tot, RLX_AGENT);
#pragma unroll
            for (int w = 0; w < 8; ++w) wbase[w * 8 + e] = base + pre[w]; }
        __syncthreads();
        if (act) {
            const unsigned long long lt = (1ull << lane) - 1ull;
            int pos0 = 0, pos1 = 0;
#pragma unroll
            for (int e = 0; e < NE; ++e) { const int wb = wbase[wave * 8 + e];
                if (my_e0 == e) pos0 = wb + __popcll(m0[e] & lt);
                if (my_e1 == e) pos1 = wb + __popcll(m0[e]) + __popcll(m1[e] & lt); }
            const int t = tbase + lane;
            toklist[my_e0 * T + pos0] = t; toklist[my_e1 * T + pos1] = t;
            u32x4 inf; inf.x = ((unsigned)my_e0 << 16) | (unsigned)pos0; inf.y = ((unsigned)my_e1 << 16) | (unsigned)pos1; inf.z = __float_as_uint(my_g0); inf.w = __float_as_uint(my_g1);
            tokinfo[t] = inf;
        }
        __syncthreads();
    }
}
__device__ __forceinline__ void moe_tab_build(const unsigned char* ws, LAS int* tab) {
    if (threadIdx.x < NE) tab[threadIdx.x] = (int)__hip_atomic_load((unsigned*)(ws + WS_CTL) + CW_CNT + 64 * threadIdx.x, RLX_AGENT);
    __syncthreads();
    if (threadIdx.x == 0) {
        int b = 0, p = 0, f = 0, np = 0;
        for (int e = 0; e < NE; ++e) { const int c = tab[e]; tab[8 + e] = b; tab[16 + e] = p; tab[25 + e] = f; b += c; p += (c + 255) >> 8; f += c >> 8;
            tab[43 + e] = -1; if (c & 255) { tab[35 + np] = e; tab[43 + e] = np; ++np; } }
        tab[24] = p; tab[33] = f; tab[34] = np;
    }
    __syncthreads();
}

__device__ __forceinline__ void final_phase(const Args& args, const LAS int* tab, int gw, int NGW, int lane) {
    unsigned char* ws = args.ws; float* out = args.out; const bf16_t* YS = (const bf16_t*)(ws + WS_YS); const u32x4* tokinfo = (const u32x4*)(ws + WS_TOKINFO); const float* YP = (const float*)(ws + WS_YP);
    f32x4 gn[4];
#pragma unroll
    for (int j = 0; j < 4; ++j) gn[j] = *((const f32x4*)args.in[I_NFINAL] + lane + 64 * j);
    for (int tb = gw; tb < T; tb += 4 * NGW) {
        f32x4 xv[4][4]; u32x2 ya[4][4], yb[4][4]; float g0[4], g1[4]; u32x4 inf[4];
#pragma unroll
        for (int k = 0; k < 4; ++k) { const int t = tb + k * NGW; inf[k] = tokinfo[t < T ? t : 0]; }
#pragma unroll
        for (int k = 0; k < 4; ++k) { const int t = tb + k * NGW; if (t < T) {
            const int e0 = __builtin_amdgcn_readfirstlane((int)(inf[k].x >> 16)), p0 = __builtin_amdgcn_readfirstlane((int)(inf[k].x & 0xffffu)), e1 = __builtin_amdgcn_readfirstlane((int)(inf[k].y >> 16)), p1 = __builtin_amdgcn_readfirstlane((int)(inf[k].y & 0xffffu));
            g0[k] = __uint_as_float(inf[k].z); g1[k] = __uint_as_float(inf[k].w);
            const int b0 = __builtin_amdgcn_readfirstlane(tab[8 + e0]), b1 = __builtin_amdgcn_readfirstlane(tab[8 + e1]);
            const int c0 = __builtin_amdgcn_readfirstlane(tab[e0]), c1 = __builtin_amdgcn_readfirstlane(tab[e1]);
            if (RES_BF16) { const u32x2* xr = (const u32x2*)((const bf16_t*)(ws + WS_XB) + (size_t)t * D) + lane;
#pragma unroll
                for (int j = 0; j < 4; ++j) { const u32x2 w = xr[64 * j]; xv[k][j] = (f32x4){bf_lo(w.x), bf_hi(w.x), bf_lo(w.y), bf_hi(w.y)}; } }
            else { const f32x4* xr = (const f32x4*)(out + (size_t)t * D) + lane;
#pragma unroll
                for (int j = 0; j < 4; ++j) xv[k][j] = xr[64 * j]; }
            if (p0 >= (c0 & ~255)) { const float* yp = YP + ((size_t)__builtin_amdgcn_readfirstlane(tab[43 + e0]) * 4 * 256 + (p0 & 255)) * D;
#pragma unroll
                for (int j = 0; j < 4; ++j) { f32x4 s = *((const f32x4*)yp + lane + 64 * j);
#pragma unroll
                    for (int q = 1; q < 4; ++q) s += *((const f32x4*)(yp + (size_t)q * 256 * D) + lane + 64 * j);
                    ya[k][j].x = cvt_pk_bf16(s.x, s.y); ya[k][j].y = cvt_pk_bf16(s.z, s.w); } }
            else { const u32x2* y0 = (const u32x2*)(YS + (size_t)(b0 + p0) * D) + lane;
#pragma unroll
                for (int j = 0; j < 4; ++j) ya[k][j] = y0[64 * j]; }
            if (p1 >= (c1 & ~255)) { const float* yp = YP + ((size_t)__builtin_amdgcn_readfirstlane(tab[43 + e1]) * 4 * 256 + (p1 & 255)) * D;
#pragma unroll
                for (int j = 0; j < 4; ++j) { f32x4 s = *((const f32x4*)yp + lane + 64 * j);
#pragma unroll
                    for (int q = 1; q < 4; ++q) s += *((const f32x4*)(yp + (size_t)q * 256 * D) + lane + 64 * j);
                    yb[k][j].x = cvt_pk_bf16(s.x, s.y); yb[k][j].y = cvt_pk_bf16(s.z, s.w); } }
            else { const u32x2* y1 = (const u32x2*)(YS + (size_t)(b1 + p1) * D) + lane;
#pragma unroll
                for (int j = 0; j < 4; ++j) yb[k][j] = y1[64 * j]; }
        } }
#pragma unroll
        for (int k = 0; k < 4; ++k) { const int t = tb + k * NGW; if (t < T) {
            f32x4 v[4]; float ss = 0.f;
#pragma unroll
            for (int j = 0; j < 4; ++j) { const f32x4 x = xv[k][j]; const u32x2 a = ya[k][j], b = yb[k][j];
                v[j].x = x.x + g0[k] * bf_lo(a.x) + g1[k] * bf_lo(b.x); v[j].y = x.y + g0[k] * bf_hi(a.x) + g1[k] * bf_hi(b.x); v[j].z = x.z + g0[k] * bf_lo(a.y) + g1[k] * bf_lo(b.y); v[j].w = x.w + g0[k] * bf_hi(a.y) + g1[k] * bf_hi(b.y);
                ss += (v[j].x * v[j].x + v[j].y * v[j].y) + (v[j].z * v[j].z + v[j].w * v[j].w); }
            ss = row16_allsum(ss); ss += __shfl_xor(ss, 16); ss += __shfl_xor(ss, 32);
            const float rstd = 1.0f / sqrtf(ss * (1.0f / D) + EPS);
            f32x4* xo = (f32x4*)(out + (size_t)t * D) + lane;
#pragma unroll
            for (int j = 0; j < 4; ++j) xo[64 * j] = v[j] * rstd * gn[j]; } }
    }
}

template <bool MOE, class Sched>
__device__ __forceinline__ void fill_unit_tables(const Sched& S, const float* rss, const int* toklist, float pre, LAS unsigned char* lds) {
    LAS int* tt = (LAS int*)(lds + TOKTAB_OFF); LAS float* rt = (LAS float*)(lds + RSTAB_OFF);
    const int lr = threadIdx.x & 255, par = threadIdx.x >> 8;
    int srow[MAXU / 2]; bool have[MAXU / 2];
#pragma unroll
    for (int k = 0; k < MAXU / 2; ++k) { pg8::Unit u; have[k] = S.next(2 * k + par, u); srow[k] = 0;
        if (have[k]) { if (MOE) { if (lr < u.valid) srow[k] = toklist[u.e * T + u.pm * 256 + lr]; } else srow[k] = u.rb + lr; } }
    f32x4 p[MAXU / 2];
#pragma unroll
    for (int k = 0; k < MAXU / 2; ++k) p[k] = have[k] ? *(const f32x4*)(rss + (size_t)srow[k] * 4) : (f32x4){0.f, 0.f, 0.f, 0.f};
#pragma unroll
    for (int k = 0; k < MAXU / 2; ++k) if (have[k]) { const int i = 2 * k + par; if (MOE) tt[i * 256 + lr] = srow[k];
        rt[i * 256 + lr] = pre / sqrtf(((p[k].x + p[k].y) + (p[k].z + p[k].w)) * (1.0f / D) + EPS); }
    __syncthreads();
}

__global__ void __launch_bounds__(NWAVES * 64, 2) mega_fwd(Args args) {
    extern __shared__ __attribute__((aligned(16))) unsigned char lds_raw[];
    LAS unsigned char* lds = (LAS unsigned char*)lds_raw;
    const int tid = threadIdx.x, lane = tid & 63, wave = __builtin_amdgcn_readfirstlane(tid >> 6);
    const int G = gridDim.x, bx = blockIdx.x;
    const int vcu = (G % 8 == 0) ? (bx % 8) * (G / 8) + bx / 8 : bx;
    const int gw = vcu * NWAVES + wave, NGW = G * NWAVES;
    unsigned char* ws = args.ws;
    unsigned* ctl = (unsigned*)(ws + WS_CTL);
    for (int u = tid; u < 512 / 4; u += NWAVES * 64) ((LAS unsigned*)(lds + LDSCTL_OFF))[u] = 0u;
    __syncthreads();
    XcdBarrier bar; bar.bar = ctl + CW_BAR; bar.x = 0; bar.st = nullptr;
    if (MK_N_LAUNCHES == 1) bar = xcd_barrier_post(ctl + CW_BAR, (volatile LAS unsigned*)(lds + LDSCTL_OFF) + 8);
    const int lo = args.ph_lo, hi = args.ph_hi;
#ifndef PHMASK
#define PHMASK 0xFFFF
#endif
#define IN(k) ((((PHMASK) >> (k)) & 1) && lo <= (k) && (k) < hi)
#ifndef DUP_PHASE
#define DUP_PHASE -1
#endif
#define REP(k) for (int rep_ = 0; rep_ < ((DUP_PHASE) == (k) ? 2 : 1); ++rep_)
#define SEAM(k) do { if (MK_N_LAUNCHES == 1 && IN((k) + 1)) xcd_barrier(bar); if (PROBE_TIME == (k)) pt1 = wall_clock64(); } while (0)
    unsigned long long pt0 = 0, pt1 = 0;
#define PT(k) do { if (PROBE_TIME == (k)) pt0 = wall_clock64(); } while (0)
    float* rss = (float*)(ws + WS_RSS);
    bf16_t* XB = (bf16_t*)(ws + WS_XB);

    PT(0); if (IN(0)) { REP(0) prologue_phase(args, lds, gw, NGW, lane, wave); SEAM(0); }

#ifndef MOE_FP8
#define MOE_FP8 1
#endif
    constexpr bool MF8 = (MOE_FP8 != 0); constexpr int MES = MF8 ? 1 : 2; constexpr bool DF8 = (DENSE_FP8 != 0); constexpr int DES = DF8 ? 1 : 2;
#define LAYER_MIX(l, pb) \
    PT(pb); if (IN(pb)) {       \
        pg8::DenseSched S; S.A = (const char*)XB; S.Bt = (const char*)(ws + WS_WIN) + (size_t)(l) * DIN * D * 2; S.KB = D * 2; S.so.init(T / 256, DIN / 256, G, vcu); S.g1 = 1; \
        fill_unit_tables<false>(S, rss + (size_t)(2 * (l)) * T * 4, nullptr, 1.0f, lds); \
        pg8::EpiMix E{(bf16_t*)(ws + WS_CG), (bf16_t*)(ws + WS_UA), (bf16_t*)(ws + WS_VA), (const LAS float*)(lds + RSTAB_OFF)}; \
        REP(pb) pg8::gemm_phase<pg8::EpiMix, pg8::DenseSched, true, false>(lds, D * 2, S, E); \
        SEAM(pb); \
    } \
    PT((pb) + 1); if (IN((pb) + 1)) { if (PROBE_MID != 0 && (l) == 0) mid_phase(args, lds, (l), gw, NGW, lane, wave, PROBE_MID); REP((pb) + 1) mid_phase(args, lds, (l), gw, NGW, lane, wave); SEAM((pb) + 1); } \
    PT((pb) + 2); if (IN((pb) + 2)) {       \
        pg8::DenseSched S; S.A = (const char*)(ws + WS_Y); S.Bt = (const char*)(ws + WS_WOUT) + (size_t)(l) * D * D * 2; S.KB = D * 2; S.so.init(T / 256, D / 256, G, bx); S.g1 = 0; \
        pg8::EpiRes E{(l) == 0 ? args.in[I_X] : args.out, args.out, XB, rss + (size_t)(2 * (l) + 1) * T * 4, (((l) == 1 && MF8) || ((l) == 0 && DF8)) ? (unsigned char*)(ws + WS_XB8) : nullptr, 1.0f, 1.0f}; \
        REP((pb) + 2) for (int r_ = 0; r_ * G < S.so.nwg; ++r_) { S.so.i0 = r_; S.so.nmax = 1; pg8::gemm_phase<pg8::EpiRes, pg8::DenseSched, false, false>(lds, D * 2, S, E); } \
        SEAM((pb) + 2); \
    }
    LAYER_MIX(0, 1)
    PT(4); if (IN(4)) {
        pg8::DenseSched S; S.A = DF8 ? (const char*)(ws + WS_XB8) : (const char*)XB; S.Bt = (const char*)(ws + WS_FGU); S.KB = D * DES; S.so.init(T / 256, NFF2 / 256, G, bx); S.g1 = 0;
        fill_unit_tables<false>(S, rss + (size_t)1 * T * 4, nullptr, DF8 ? 1.0f / MOE_SW : 1.0f, lds);
        pg8::EpiSwiglu<false, DF8> E{(void*)(ws + WS_ACT), (const LAS float*)(lds + RSTAB_OFF), DF8 ? MOE_SA : 1.0f};
        REP(4) pg8::gemm_phase<pg8::EpiSwiglu<false, DF8>, pg8::DenseSched, true, DF8>(lds, D * DES, S, E);
        late_weight_tasks(args, lds, lane, wave);
        SEAM(4);
    }
    PT(5); if (IN(5)) {
        pg8::DenseSched S; S.A = (const char*)(ws + WS_ACT); S.Bt = (const char*)(ws + WS_FD); S.KB = FF * DES; S.so.init(T / 256, D / 256, G, bx); S.g1 = 0;
        pg8::EpiRes E{args.out, args.out, XB, rss + (size_t)2 * T * 4, nullptr, DF8 ? MOE_SW * MOE_SA : 1.0f, DF8 ? 1.0f / (MOE_SW * MOE_SA) : 1.0f};
        for (int r_ = 0; r_ * G < S.so.nwg; ++r_) { S.so.i0 = r_; S.so.nmax = 1; pg8::gemm_phase<pg8::EpiRes, pg8::DenseSched, false, DF8>(lds, FF * DES, S, E); }
        SEAM(5);
    }
    LAYER_MIX(1, 6)
    LAS int* mtab = (LAS int*)(lds + LDSCTL_OFF + 64);
    PT(9); if (IN(9)) { router_phase(args, lds, lane, wave); SEAM(9); }
    PT(10); if (IN(10)) {
        moe_tab_build(ws, mtab);
        pg8::MoeUpSched<MES> S; S.tab = mtab;
        S.XA = MF8 ? (const char*)(ws + WS_XB8) : (const char*)XB; S.W = (const char*)(ws + WS_MGU); S.toktab = (const LAS int*)(lds + TOKTAB_OFF); S.so.init(__builtin_amdgcn_readfirstlane(mtab[24]), NFF2 / 256, G, bx);
        fill_unit_tables<true>(S, rss + (size_t)3 * T * 4, (const int*)(ws + WS_TOKLIST), MF8 ? 1.0f / MOE_SW : 1.0f, lds);
        pg8::EpiSwiglu<true, MF8> E{(void*)(ws + WS_ACT), (const LAS float*)(lds + RSTAB_OFF), MF8 ? MOE_SA : 1.0f};
#if PROBE_NULL == 10
        { pg8::EpiNull EN{(float*)(ws + WS_TOKINFO)}; pg8::gemm_phase<pg8::EpiNull, pg8::MoeUpSched<MES>, true, MF8>(lds, D * MES, S, EN); }
#endif
        REP(10) pg8::gemm_phase<pg8::EpiSwiglu<true, MF8>, pg8::MoeUpSched<MES>, true, MF8>(lds, D * MES, S, E);
        SEAM(10);
    }
    PT(11); if (IN(11)) {
        moe_tab_build(ws, mtab);
        pg8::MoeDownSched<MES> S; S.tab = mtab;
        S.ACT = (const char*)(ws + WS_ACT); S.W = (const char*)(ws + WS_MD); S.so.init(__builtin_amdgcn_readfirstlane(mtab[33]), D / 256, G, bx);
        pg8::EpiSlot E{(bf16_t*)(ws + WS_YS), (float*)(ws + WS_YP), MF8 ? 1.0f / (MOE_SW * MOE_SA) : 1.0f};
#if PROBE_NULL == 11
        { pg8::EpiNull EN{(float*)(ws + WS_TOKINFO)}; pg8::gemm_phase<pg8::EpiNull, pg8::MoeDownSched<MES>, true, MF8>(lds, FF * MES, S, EN); }
#endif
        REP(11) pg8::gemm_phase<pg8::EpiSlot, pg8::MoeDownSched<MES>, true, MF8>(lds, FF * MES, S, E);
        SEAM(11);
    }
    PT(12); if (IN(12)) { moe_tab_build(ws, mtab); final_phase(args, mtab, gw, NGW, lane); }
    if (PROBE_TIME == 12) pt1 = wall_clock64();
    if (PROBE_TIME >= 0) { const unsigned long long tgt = wall_clock64() + 4ull * (pt1 - pt0); while (wall_clock64() < tgt) __builtin_amdgcn_s_sleep(8); }
#undef IN
#undef SEAM
}

extern "C" void kernel_launch(void* const* d_in, const int* in_sizes, int n_in, void* d_out, int out_size, void* d_ws, size_t ws_size, hipStream_t stream) {
    static int grid = 0;
    if (grid == 0) {
        if (n_in != 21 || in_sizes[0] != T * D || out_size != T * D || ws_size < WS_END) { fprintf(stderr, "kernel_launch: unexpected shapes (n_in %d, in0 %d, out %d, ws %zu < %zu); nothing launched\n", n_in, n_in > 0 ? in_sizes[0] : -1, out_size, ws_size, (size_t)WS_END); grid = -1; return; }
        int dev = 0, cus = 0, per_cu = 0;
        if (hipGetDevice(&dev) != hipSuccess || hipDeviceGetAttribute(&cus, hipDeviceAttributeMultiprocessorCount, dev) != hipSuccess) { grid = -1; return; }
        if (hipFuncSetAttribute((const void*)mega_fwd, hipFuncAttributeMaxDynamicSharedMemorySize, LDS_BYTES) != hipSuccess) { fprintf(stderr, "kernel_launch: hipFuncSetAttribute failed\n"); grid = -1; return; }
        if (hipOccupancyMaxActiveBlocksPerMultiprocessor(&per_cu, (const void*)mega_fwd, NWAVES * 64, LDS_BYTES) != hipSuccess || per_cu < 1) { fprintf(stderr, "kernel_launch: occupancy query reports %d\n", per_cu); }
        (void)hipGetLastError();
        grid = cus;
    }
    if (grid < 0) return;
    if (hipMemsetAsync((char*)d_ws + WS_CTL, 0, CTL_ZERO_BYTES, stream) != hipSuccess) return;
    Args a{};
    for (int i = 0; i < 21; ++i) a.in[i] = (const float*)d_in[i];
    a.out = (float*)d_out; a.ws = (unsigned char*)d_ws;
    if (MK_N_LAUNCHES == 1) { a.ph_lo = 0; a.ph_hi = N_PHASES; hipLaunchKernelGGL(mega_fwd, dim3(grid), dim3(NWAVES * 64), LDS_BYTES, stream, a); }
    else for (int p = 0; p < N_PHASES; ++p) { a.ph_lo = p; a.ph_hi = p + 1; hipLaunchKernelGGL(mega_fwd, dim3(grid), dim3(NWAVES * 64), LDS_BYTES, stream, a); }
}
```

```cpp
#include <hip/hip_runtime.h>
#include <cstdio>
#include <cstdint>

#ifndef PROBE_TIME
#define PROBE_TIME -1
#endif
#ifndef PROBE_P0
#define PROBE_P0 0
#endif
#ifndef PROBE_MID
#define PROBE_MID 0
#endif
#ifndef PROBE_NULL
#define PROBE_NULL -1
#endif
#ifndef RES_BF16
#define RES_BF16 1
#endif
#ifndef DENSE_FP8
#define DENSE_FP8 0
#endif
#ifndef MK_N_LAUNCHES
#define MK_N_LAUNCHES 1
#endif
constexpr int N_PHASES = 13;

#define GAS __attribute__((address_space(1)))
#define LAS __attribute__((address_space(3)))
typedef unsigned short bf16_t;
typedef short bf16x8 __attribute__((ext_vector_type(8)));
typedef float f32x4 __attribute__((ext_vector_type(4)));
typedef float f32x2 __attribute__((ext_vector_type(2)));
typedef unsigned u32x4 __attribute__((ext_vector_type(4)));
typedef unsigned u32x2 __attribute__((ext_vector_type(2)));

constexpr int NB = 8, SEQ = 2048, T = NB * SEQ, D = 1024, DIN = 2048, CC = 512, FF = 2816, NE = 8, CW = 31, NFF2 = 2 * FF;
constexpr float EPS = 1e-6f;
constexpr int NWAVES = 8;

constexpr size_t KiB = 1024, MiB = 1024 * 1024;
constexpr size_t WS_CTL = 0, CTL_ZERO_BYTES = 64 * KiB;
constexpr int CW_BAR = 1024;
constexpr int CW_CNT = 8192;
constexpr size_t WS_TOKLIST = 64 * KiB;
constexpr size_t WS_TOKINFO = 576 * KiB;
constexpr size_t WS_RT = 832 * KiB;
constexpr size_t WS_SGUW = 1 * MiB;
constexpr size_t WS_RSS = 2 * MiB;
constexpr size_t WS_WIN = 6 * MiB;
constexpr size_t WS_WOUT = 14 * MiB;
constexpr size_t WS_FGU = 18 * MiB;
constexpr size_t WS_FD = 29 * MiB;
constexpr size_t WS_MGU = 35 * MiB;
constexpr size_t WS_MD = 79 * MiB;
constexpr size_t WS_XB = 101 * MiB;
constexpr size_t WS_XB8 = 133 * MiB;
constexpr size_t WS_ACT = 149 * MiB;
constexpr size_t WS_CG = WS_ACT, WS_UA = WS_ACT + 16 * MiB, WS_VA = WS_ACT + 32 * MiB, WS_Y = WS_ACT + 48 * MiB;
constexpr size_t WS_YS = 238 * MiB;
constexpr size_t WS_YP = 302 * MiB;
constexpr size_t WS_END = WS_YP + (size_t)8 * 4 * 256 * D * 4;
static_assert(WS_YS + (size_t)2 * T * D * 2 <= WS_YP, "workspace map 3");
constexpr float MOE_SW = 32.0f, MOE_SA = 8.0f;
static_assert(WS_END <= 380 * MiB, "workspace map");
static_assert(WS_MGU + (size_t)NE * NFF2 * D <= WS_MD && WS_MD + (size_t)NE * D * FF <= WS_XB && WS_FD + (size_t)D * FF * 2 <= WS_MGU && WS_ACT + (size_t)T * FF * 2 <= WS_YS && WS_ACT + (size_t)(2 * T + 256) * FF <= WS_YS, "workspace map 2");

constexpr int RING_BYTES = 131072;
constexpr int LDSCTL_OFF = RING_BYTES;
constexpr int MAXU = 12;
constexpr int TOKTAB_OFF = RING_BYTES + 512;
constexpr int RSTAB_OFF = TOKTAB_OFF + MAXU * 256 * 4;
constexpr int LDS_BYTES = RSTAB_OFF + MAXU * 256 * 4;
static_assert(LDS_BYTES <= 160 * 1024 && LDS_BYTES > 80 * 1024, "LDS map");

#define RLX_AGENT __ATOMIC_RELAXED, __HIP_MEMORY_SCOPE_AGENT
__device__ __forceinline__ unsigned cvt_pk_bf16(float lo, float hi) { unsigned r; asm volatile("v_cvt_pk_bf16_f32 %0, %1, %2" : "=v"(r) : "v"(lo), "v"(hi)); return r; }
__device__ __forceinline__ float clamp448(float v) { return __builtin_amdgcn_fmed3f(v, -448.0f, 448.0f); }
__device__ __forceinline__ unsigned pk_fp8x4(float a, float b, float c, float d) {
    int p = __builtin_amdgcn_cvt_pk_fp8_f32(clamp448(a), clamp448(b), 0, false); p = __builtin_amdgcn_cvt_pk_fp8_f32(clamp448(c), clamp448(d), p, true); return (unsigned)p; }
__device__ __forceinline__ float bf_lo(unsigned x) { return __uint_as_float(x << 16); }
__device__ __forceinline__ float bf_hi(unsigned x) { return __uint_as_float(x & 0xffff0000u); }
__device__ __forceinline__ float fast_sigmoid(float g) { return __builtin_amdgcn_rcpf(1.0f + __builtin_amdgcn_exp2f(-1.4426950408889634f * g)); }
__device__ __forceinline__ float wave_sum(float v) {
#pragma unroll
    for (int o = 1; o < 64; o <<= 1) v += __shfl_xor(v, o);
    return v;
}
__device__ __forceinline__ float dpp_add(float v, const int ctrl_sel) {
    int r;
    if (ctrl_sel == 0) r = __builtin_amdgcn_update_dpp(0, __float_as_int(v), 0xB1, 0xF, 0xF, false);
    else if (ctrl_sel == 1) r = __builtin_amdgcn_update_dpp(0, __float_as_int(v), 0x4E, 0xF, 0xF, false);
    else if (ctrl_sel == 2) r = __builtin_amdgcn_update_dpp(0, __float_as_int(v), 0x141, 0xF, 0xF, false);
    else r = __builtin_amdgcn_update_dpp(0, __float_as_int(v), 0x140, 0xF, 0xF, false);
    return v + __int_as_float(r);
}
__device__ __forceinline__ float row16_allsum(float v) { v = dpp_add(v, 0); v = dpp_add(v, 1); v = dpp_add(v, 2); v = dpp_add(v, 3); return v; }
__device__ __forceinline__ f32x2 gelu_pk(f32x2 v) {
    const f32x2 av = __builtin_elementwise_abs(v), d = av * 0.2316418882f + 1.0f;
    f32x2 t; t.x = __builtin_amdgcn_rcpf(d.x); t.y = __builtin_amdgcn_rcpf(d.y);
    f32x2 q = t * 0.5307027145f + (-0.7265760135f); q = q * t + 0.7107068705f; q = q * t + (-0.142248368f); q = q * t + 0.127414796f; q = q * t;
    const f32x2 s = (v * v) * (-0.72134752044f);
    f32x2 e; e.x = __builtin_amdgcn_exp2f(s.x); e.y = __builtin_amdgcn_exp2f(s.y);
    const f32x2 m = v * (q * e), r = v - m;
    f32x2 o; o.x = v.x < 0.f ? m.x : r.x; o.y = v.y < 0.f ? m.y : r.y; return o;
}

#ifndef WT_STORES
#define WT_STORES 0
#endif
struct WtBuf { __amdgpu_buffer_rsrc_t r; };
__device__ __forceinline__ WtBuf wt_buf(const void* base) { WtBuf b; b.r = __builtin_amdgcn_make_buffer_rsrc((void*)base, 0, 0xFFFFFFFFu, 0x00020000); return b; }
__device__ __forceinline__ void wt_store16(const WtBuf& b, const void* base, size_t byte_off, u32x4 v) {
#if WT_STORES
    __builtin_amdgcn_raw_buffer_store_b128(v, b.r, (int)(unsigned)byte_off, 0, 16);
#else
    *(u32x4*)((char*)base + byte_off) = v;
#endif
}
__device__ __forceinline__ void wt_store16f(const WtBuf& b, const void* base, size_t byte_off, f32x4 v) { wt_store16(b, base, byte_off, __builtin_bit_cast(u32x4, v)); }

#define XB_TMO      128
#define XB_XCNT(j)  (256  + 64 * (j))
#define XB_XSUB(j)  (1280 + 64 * (j))
#define XB_XGEN(j)  (2304 + 64 * (j))
#define XB_TOP      3328
#define XB_TOPGEN   3392
#define XCD_BAR_WORDS 3456
#define XB_SPIN_CAP (1u << 18)
__device__ __forceinline__ unsigned xb_ld(unsigned* p)              { return __hip_atomic_load(p, __ATOMIC_RELAXED, __HIP_MEMORY_SCOPE_AGENT); }
__device__ __forceinline__ unsigned xb_add(unsigned* p, unsigned v) { return __hip_atomic_fetch_add(p, v, __ATOMIC_RELAXED, __HIP_MEMORY_SCOPE_AGENT); }
__device__ __forceinline__ unsigned xb_xcc_id() { return (unsigned)__builtin_amdgcn_s_getreg((3 << 11) | 20) & 0xFu; }
#define XB_SPIN(cond, bar) do { unsigned _sp = 0; while (cond) { __builtin_amdgcn_s_sleep(1); \
    if ((++_sp & 255u) == 0u) { if (xb_ld(&(bar)[XB_TMO])) break; if (_sp > XB_SPIN_CAP) { atomicAdd(&(bar)[XB_TMO], 1u); break; } } } } while (0)
struct XcdBarrier { unsigned* bar; unsigned x; volatile LAS unsigned* st; };
__device__ __forceinline__ XcdBarrier xcd_barrier_post(unsigned* bar, volatile LAS unsigned* st) {
    XcdBarrier b; b.bar = bar; b.x = xb_xcc_id(); b.st = st;
    if (threadIdx.x == 0) (void)xb_add(&bar[XB_XCNT(b.x)], 1u);
    return b;
}
__device__ __forceinline__ void xcd_barrier_complete(unsigned* bar, unsigned x, unsigned& nloc, unsigned& nx) {
    const unsigned G = gridDim.x * gridDim.y * gridDim.z;
    unsigned sum, cnt, mine, sp = 0u;
    for (;;) {
        sum = 0u; cnt = 0u; mine = 0u;
#pragma unroll
        for (unsigned j = 0; j < 16; ++j) { const unsigned c = xb_ld(&bar[XB_XCNT(j)]); sum += c; cnt += (c > 0u) ? 1u : 0u; mine = (j == x) ? c : mine; }
        if (sum == G) break;
        __builtin_amdgcn_s_sleep(1);
        if ((++sp & 255u) == 0u) { if (xb_ld(&bar[XB_TMO])) break; if (sp > XB_SPIN_CAP) { atomicAdd(&bar[XB_TMO], 1u); break; } }
    }
    nloc = mine > 0u ? mine : 1u; nx = cnt > 0u ? cnt : 1u;
}
__device__ __forceinline__ void xcd_barrier(const XcdBarrier& b) {
    asm volatile("s_waitcnt vmcnt(0)" ::: "memory");
    __syncthreads();
    if (threadIdx.x == 0) {
        unsigned* bar = b.bar;
        __builtin_amdgcn_s_waitcnt(0);
        unsigned nloc = b.st[0], nx = b.st[1];
        if (nloc == 0u) { xcd_barrier_complete(bar, b.x, nloc, nx); b.st[0] = nloc; b.st[1] = nx; }
        const unsigned old = xb_add(&bar[XB_XSUB(b.x)], 1u);
        const unsigned gen = old / nloc;
        if (old + 1u == (gen + 1u) * nloc) {
            __builtin_amdgcn_fence(__ATOMIC_RELEASE, "agent");
            asm volatile("s_waitcnt vmcnt(0)" ::: "memory");
            const unsigned og = xb_add(&bar[XB_TOP], 1u);
            const unsigned tg = og / nx;
            if (og + 1u == (tg + 1u) * nx) xb_add(&bar[XB_TOPGEN], 1u);
            else XB_SPIN(xb_ld(&bar[XB_TOPGEN]) == tg, bar);
            __builtin_amdgcn_fence(__ATOMIC_ACQUIRE, "agent");
            xb_add(&bar[XB_XGEN(b.x)], 1u);
            asm volatile("s_waitcnt vmcnt(0)" ::: "memory");
        } else {
            XB_SPIN(xb_ld(&bar[XB_XGEN(b.x)]) == gen, bar);
            __builtin_amdgcn_fence(__ATOMIC_ACQUIRE, "agent");
            asm volatile("s_waitcnt vmcnt(0)" ::: "memory");
        }
    }
    __syncthreads();
}

namespace pg8 {
constexpr int BM = 256, BK = 64, HALF = 128, HTB = HALF * BK * 2, STAGE_BYTES = 8 * HTB, NXCD = 8, WGM = 4;
__host__ __device__ __forceinline__ int lds_byte(int r, int c) { const int st = (r >> 4) * 2 + (c >> 5), rr = r & 15, cc = c & 31, ob = rr * 64 + cc * 2; return st * 1024 + (ob ^ (((ob >> 9) & 1) << 5)); }
__host__ __device__ __forceinline__ void stage_rc(int b, int& R, int& C) { const int st = b / 1024, sb = b % 1024, swz = sb ^ (((sb >> 9) & 1) << 5); R = (st >> 1) * 16 + swz / 64; C = (st & 1) * 32 + (swz % 64) / 2; }
__host__ __device__ __forceinline__ int perm32(int rho) { const int n = rho >> 4, i = rho & 15; return 8 * (i >> 2) + 4 * n + (i & 3); }

struct Unit { int pm, pn, e, valid, rb, ui, nt, k0, part, pi; };

struct StaticOrder {
    int nM, nN, nwg, G, c, i0, nmax;
    __device__ __forceinline__ void init(int nM_, int nN_, int G_, int c_) { nM = nM_; nN = nN_; nwg = nM * nN; G = G_; c = c_; i0 = 0; nmax = 1 << 30; }
    __device__ __forceinline__ bool map(int i, int& pm, int& pn) const {
        if (i >= nmax) return false;
        const long L = (long)(i + i0) * G + c; if (L >= nwg) return false;
        int wgid = (int)L; { const int q = nwg / NXCD, r = nwg % NXCD, xcd = wgid % NXCD, off = wgid / NXCD; wgid = (xcd < r ? xcd * (q + 1) : r * (q + 1) + (xcd - r) * q) + off; }
        const int nig = WGM * nN, gid = wgid / nig, fm = gid * WGM, gsz = (nM - fm) < WGM ? (nM - fm) : WGM;
        pm = fm + ((wgid % nig) % gsz); pn = (wgid % nig) / gsz; return true;
    }
};

typedef int v4i32 __attribute__((ext_vector_type(4)));
typedef int v8i32 __attribute__((ext_vector_type(8)));
template <class Epi, class Sched, bool ALIGN_EPI, bool FP8>
__device__ __forceinline__ void gemm_phase(LAS unsigned char* lds, const int KB, const Sched& S, const Epi& E) {
    const int tid = threadIdx.x, wid = __builtin_amdgcn_readfirstlane(tid >> 6), lane = tid & 63, wr = wid >> 2, wc = wid & 3, fr = lane & 15, fq = lane >> 4;
    int Rs[2], Cs[2]; unsigned voffB[2];
#pragma unroll
    for (int i = 0; i < 2; ++i) { stage_rc(tid * 16 + i * 8192, Rs[i], Cs[i]); voffB[i] = (unsigned)(Rs[i] * KB + Cs[i] * 2); }
    const size_t kstep = (size_t)(BK * 2);
    const size_t hstep = (size_t)HALF * KB;
    const unsigned ldsw = (unsigned)wid * 1024u;
    const int aoff = lds_byte(wr * 64 + fr, fq * 8), boff = lds_byte(wc * 32 + fr, fq * 8);
#define PG8_SA(b, h) (((b) * 2 + (h)) * HTB)
#define PG8_SB(b, h) ((4 + (b) * 2 + (h)) * HTB)
#define PG8_STAGE(bufoff, gbase, voff) do { _Pragma("unroll") for (int _i = 0; _i < 2; ++_i) \
        __builtin_amdgcn_global_load_lds((const unsigned*)((const char*)(gbase) + (voff)[_i]), (LAS unsigned*)(lds + (bufoff) + ldsw + _i * 8192), 16, 0, 0); } while (0)
#define PG8_LDA(dst, b, h) do { _Pragma("unroll") for (int m = 0; m < 4; ++m) dst[m] = __builtin_shufflevector(*(const LAS v4i32*)(lds + PG8_SA(b, h) + aoff + m * 2048), *(const LAS v4i32*)(lds + PG8_SA(b, h) + aoff + m * 2048 + 1024), 0, 1, 2, 3, 4, 5, 6, 7); } while (0)
#define PG8_LDB(dst, b, h) do { _Pragma("unroll") for (int n = 0; n < 2; ++n) dst[n] = __builtin_shufflevector(*(const LAS v4i32*)(lds + PG8_SB(b, h) + boff + n * 2048), *(const LAS v4i32*)(lds + PG8_SB(b, h) + boff + n * 2048 + 1024), 0, 1, 2, 3, 4, 5, 6, 7); } while (0)
#define PG8_MMA(ai, bj, At, Bt) do { __builtin_amdgcn_s_setprio(1); _Pragma("unroll") for (int m = 0; m < 4; ++m) _Pragma("unroll") for (int n = 0; n < 2; ++n) { \
        if constexpr (FP8) asm volatile("v_mfma_f32_16x16x128_f8f6f4 %0, %1, %2, %0" : "+v"(acc[ai][bj][m][n]) : "v"(Bt[n]), "v"(At[m]));   \
        else { acc[ai][bj][m][n] = __builtin_amdgcn_mfma_f32_16x16x32_bf16(__builtin_bit_cast(bf16x8, __builtin_shufflevector(Bt[n], Bt[n], 0, 1, 2, 3)), __builtin_bit_cast(bf16x8, __builtin_shufflevector(At[m], At[m], 0, 1, 2, 3)), acc[ai][bj][m][n], 0, 0, 0); \
               acc[ai][bj][m][n] = __builtin_amdgcn_mfma_f32_16x16x32_bf16(__builtin_bit_cast(bf16x8, __builtin_shufflevector(Bt[n], Bt[n], 4, 5, 6, 7)), __builtin_bit_cast(bf16x8, __builtin_shufflevector(At[m], At[m], 4, 5, 6, 7)), acc[ai][bj][m][n], 0, 0, 0); } } \
        __builtin_amdgcn_s_setprio(0); } while (0)
#define PG8_WAIT_V(n) asm volatile("s_waitcnt vmcnt(" #n ")" ::: "memory")
#define PG8_WAIT_L(n) asm volatile("s_waitcnt lgkmcnt(" #n ")" ::: "memory")
#define PG8_BAR __builtin_amdgcn_s_barrier()
#define PG8_SCHED __builtin_amdgcn_sched_barrier(0)
    Unit cur, nxt; int ui = 0;
    if (!S.next(0, cur)) return;
    f32x4 acc[2][2][4][2];
    E.init_acc(acc, cur, wr, wc, fr, fq);
    v8i32 At[4], B0[2], B1[2];
    const char* cA = S.a_ptr(cur); const char* cB = S.b_ptr(cur);
    unsigned offC[2][2], offN[2][2];
    S.a_offs(cur, Rs, Cs, offC);
    PG8_STAGE(PG8_SB(0, 0), cB, voffB); PG8_STAGE(PG8_SB(0, 1), cB + hstep, voffB); PG8_STAGE(PG8_SA(0, 0), cA, offC[0]); PG8_STAGE(PG8_SA(0, 1), cA, offC[1]);
    if (wr == 1) PG8_BAR;
    PG8_WAIT_V(2); PG8_BAR;
    PG8_STAGE(PG8_SB(1, 0), cB + kstep, voffB); PG8_STAGE(PG8_SA(1, 0), cA + kstep, offC[0]); PG8_STAGE(PG8_SB(1, 1), cB + hstep + kstep, voffB);
    PG8_WAIT_V(6); PG8_BAR;
    bool has_next = false; const char* nA = cA; const char* nB = cB;
    constexpr bool NEXT_IN_LOOP = FP8;
#define PG8_NEXT() do { has_next = S.next(ui + 1, nxt); nA = has_next ? S.a_ptr(nxt) : cA; nB = has_next ? S.b_ptr(nxt) : cB; \
        if (has_next) S.a_offs(nxt, Rs, Cs, offN); else { _Pragma("unroll") for (int h = 0; h < 2; ++h) _Pragma("unroll") for (int i = 0; i < 2; ++i) offN[h][i] = offC[h][i]; } } while (0)
    for (;;) {
        if constexpr (!NEXT_IN_LOOP) PG8_NEXT();
        const int nt = cur.nt;
        for (int t = 0; t < nt; t += 2) {
            const bool last = (t == nt - 2);
            const char* a1 = cA + (size_t)(t + 1) * kstep;
            const char* a2 = last ? nA : cA + (size_t)(t + 2) * kstep; const char* b2 = last ? nB : cB + (size_t)(t + 2) * kstep;
            const char* a3 = a2 + kstep; const char* b3 = b2 + kstep;
            unsigned o2[2][2];
#pragma unroll
            for (int h = 0; h < 2; ++h)
#pragma unroll
                for (int i = 0; i < 2; ++i) o2[h][i] = last ? offN[h][i] : offC[h][i];
            PG8_LDB(B0, 0, 0); PG8_LDB(B1, 0, 1); PG8_SCHED; PG8_LDA(At, 0, 0); PG8_STAGE(PG8_SA(1, 1), a1, offC[1]);
            PG8_WAIT_V(8); PG8_WAIT_L(0); PG8_BAR; PG8_MMA(0, 0, At, B0); PG8_MMA(0, 1, At, B1);
            if constexpr (NEXT_IN_LOOP) { if (t == 0) PG8_NEXT(); }
            PG8_BAR; PG8_SCHED;
            PG8_LDA(At, 0, 1); PG8_STAGE(PG8_SB(0, 0), b2, voffB); PG8_STAGE(PG8_SB(0, 1), b2 + hstep, voffB); PG8_STAGE(PG8_SA(0, 0), a2, o2[0]);
            PG8_WAIT_V(8); PG8_WAIT_L(0); PG8_BAR; PG8_MMA(1, 0, At, B0); PG8_MMA(1, 1, At, B1); PG8_BAR; PG8_SCHED;
            PG8_LDB(B0, 1, 0); PG8_LDB(B1, 1, 1); PG8_SCHED; PG8_LDA(At, 1, 0); PG8_STAGE(PG8_SA(0, 1), a2, o2[1]);
            PG8_WAIT_V(8); PG8_WAIT_L(0); PG8_BAR; PG8_MMA(0, 0, At, B0); PG8_MMA(0, 1, At, B1); PG8_BAR; PG8_SCHED;
            PG8_LDA(At, 1, 1); PG8_STAGE(PG8_SB(1, 0), b3, voffB); PG8_STAGE(PG8_SB(1, 1), b3 + hstep, voffB); PG8_STAGE(PG8_SA(1, 0), a3, o2[0]);
            PG8_WAIT_V(8); PG8_WAIT_L(0); PG8_BAR; PG8_MMA(1, 0, At, B0); PG8_MMA(1, 1, At, B1); PG8_BAR; PG8_SCHED;
        }
        if constexpr (ALIGN_EPI) { if (wr == 0) PG8_BAR; }
        if constexpr (FP8) asm volatile("s_nop 15\n\ts_nop 15" ::: "memory");
        if constexpr (!Epi::AFTER_DRAIN) E(acc, cur, wr, wc, fr, fq);
        if (!has_next) break;
        E.init_acc(acc, nxt, wr, wc, fr, fq);
        cur = nxt; cA = nA; cB = nB; ++ui;
#pragma unroll
        for (int h = 0; h < 2; ++h)
#pragma unroll
            for (int i = 0; i < 2; ++i) offC[h][i] = offN[h][i];
        if constexpr (ALIGN_EPI) { if (wr == 1) PG8_BAR; }
    }
    PG8_WAIT_V(0);
    if constexpr (!ALIGN_EPI) { if (wr == 0) PG8_BAR; }
    PG8_BAR;
    if constexpr (Epi::AFTER_DRAIN) E.fused(acc, cur, wr, wc, fr, fq, lds);
#undef PG8_NEXT
#undef PG8_SA
#undef PG8_SB
#undef PG8_STAGE
#undef PG8_LDA
#undef PG8_LDB
#undef PG8_MMA
#undef PG8_WAIT_V
#undef PG8_WAIT_L
#undef PG8_BAR
#undef PG8_SCHED
}

struct DenseSched {
    const char* A; const char* Bt; int KB; StaticOrder so; int g1;
    __device__ __forceinline__ bool next(int i, Unit& u) const { int pm, pn;
        if (g1) { const int L = i * so.G + so.c; if (L >= 512) return false; pm = (L & 255) >> 2; pn = (L & 3) + 4 * (L >> 8); }
        else if (!so.map(i, pm, pn)) return false; u.pm = pm; u.pn = pn; u.e = 0; u.valid = 256; u.rb = pm * 256; u.ui = i; u.nt = KB / 128; u.k0 = 0; u.part = 0; u.pi = 0; return true; }
    __device__ __forceinline__ const char* a_ptr(const Unit& u) const { return A + (size_t)u.pm * 256 * KB; }
    __device__ __forceinline__ const char* b_ptr(const Unit& u) const { return Bt + (size_t)u.pn * 256 * KB; }
    __device__ __forceinline__ void a_offs(const Unit&, const int (&R)[2], const int (&C)[2], unsigned (&off)[2][2]) const {
#pragma unroll
        for (int h = 0; h < 2; ++h)
#pragma unroll
            for (int i = 0; i < 2; ++i) off[h][i] = (unsigned)((h * 128 + R[i]) * KB + C[i] * 2); }
};
__device__ __forceinline__ void moe_lookup(const LAS int* tab, int vt, Unit& u) {
    int e = 0;
#pragma unroll
    for (int k = 1; k < 8; ++k) e += (vt >= tab[16 + k]) ? 1 : 0;
    e = __builtin_amdgcn_readfirstlane(e);
    const int tpe = __builtin_amdgcn_readfirstlane(tab[16 + e]), ce = __builtin_amdgcn_readfirstlane(tab[e]), be = __builtin_amdgcn_readfirstlane(tab[8 + e]);
    const int li = vt - tpe; u.pm = li; u.e = e; const int rem = ce - 256 * li; u.valid = rem < 256 ? rem : 256; u.rb = be + 256 * li;
}
template <int ES> struct MoeUpSched {
    const char* XA; const char* W; const LAS int* toktab; const LAS int* tab; StaticOrder so;
    __device__ __forceinline__ bool next(int i, Unit& u) const { int vt, pn; if (!so.map(i, vt, pn)) return false; moe_lookup(tab, vt, u); u.pn = pn; u.ui = i; u.nt = D * ES / 128; u.k0 = 0; u.part = 0; u.pi = 0; return true; }
    __device__ __forceinline__ const char* a_ptr(const Unit&) const { return XA; }
    __device__ __forceinline__ const char* b_ptr(const Unit& u) const { return W + ((size_t)u.e * NFF2 + (size_t)u.pn * 256) * D * ES; }
    __device__ __forceinline__ void a_offs(const Unit& u, const int (&R)[2], const int (&C)[2], unsigned (&off)[2][2]) const {
#pragma unroll
        for (int h = 0; h < 2; ++h)
#pragma unroll
            for (int i = 0; i < 2; ++i) off[h][i] = (unsigned)toktab[u.ui * 256 + h * 128 + R[i]] * (unsigned)(D * ES) + (unsigned)C[i] * 2u; }
};
template <int ES> struct MoeDownSched {
    const char* ACT; const char* W; const LAS int* tab; StaticOrder so;
    __device__ __forceinline__ bool next(int i, Unit& u) const {
        const int L = i * so.G + so.c, nf4 = so.nwg, np = __builtin_amdgcn_readfirstlane(tab[34]);
        if (L >= nf4 + 16 * np) return false;
        u.ui = i;
        if (L < nf4) {
            int f, pn; so.map(i, f, pn);
            int e = 0;
#pragma unroll
            for (int k = 1; k < 8; ++k) e += (f >= tab[25 + k]) ? 1 : 0;
            e = __builtin_amdgcn_readfirstlane(e);
            const int li = f - __builtin_amdgcn_readfirstlane(tab[25 + e]);
            u.pm = li; u.pn = pn; u.e = e; u.valid = 256; u.rb = __builtin_amdgcn_readfirstlane(tab[8 + e]) + 256 * li; u.nt = FF * ES / 128; u.k0 = 0; u.part = 0; u.pi = 0;
        } else {
            const int s = L - nf4, p = s >> 4, r = s & 15, kp = r & 3;
            const int e = __builtin_amdgcn_readfirstlane(tab[35 + p]), ce = __builtin_amdgcn_readfirstlane(tab[e]);
            u.pm = ce >> 8; u.pn = r >> 2; u.e = e; u.valid = ce & 255; u.rb = __builtin_amdgcn_readfirstlane(tab[8 + e]) + (ce & ~255);
            constexpr int NTK = FF * ES / 128, Q = ((NTK / 4) + 1) & ~1;
            static_assert(NTK - 3 * Q >= 4 && ((NTK - 3 * Q) & 1) == 0, "K split");
            u.k0 = kp * Q; u.nt = kp < 3 ? Q : NTK - 3 * Q; u.part = 1; u.pi = p * 4 + kp;
        }
        return true;
    }
    __device__ __forceinline__ const char* a_ptr(const Unit& u) const { return ACT + (size_t)u.rb * FF * ES + (size_t)u.k0 * 128; }
    __device__ __forceinline__ const char* b_ptr(const Unit& u) const { return W + ((size_t)u.e * D + (size_t)u.pn * 256) * FF * ES + (size_t)u.k0 * 128; }
    __device__ __forceinline__ void a_offs(const Unit&, const int (&R)[2], const int (&C)[2], unsigned (&off)[2][2]) const {
#pragma unroll
        for (int h = 0; h < 2; ++h)
#pragma unroll
            for (int i = 0; i < 2; ++i) off[h][i] = (unsigned)((h * 128 + R[i]) * FF * ES + C[i] * 2); }
};

__device__ __forceinline__ void zero_acc(f32x4 (&acc)[2][2][4][2]) {
#pragma unroll
    for (int a = 0; a < 2; ++a)
#pragma unroll
        for (int b = 0; b < 2; ++b)
#pragma unroll
            for (int m = 0; m < 4; ++m)
#pragma unroll
                for (int n = 0; n < 2; ++n) acc[a][b][m][n] = (f32x4){0.f, 0.f, 0.f, 0.f};
}
__device__ __forceinline__ float rstd_of(float p) { p += __shfl_xor(p, 16); p += __shfl_xor(p, 32); return 1.0f / sqrtf(p * (1.0f / D) + EPS); }
struct EpiMix {
    static constexpr bool AFTER_DRAIN = false;
    bf16_t* CG; bf16_t* UA; bf16_t* VA; const LAS float* rstab;
    __device__ __forceinline__ void init_acc(f32x4 (&acc)[2][2][4][2], const Unit&, int, int, int, int) const { zero_acc(acc); }
    __device__ __forceinline__ void operator()(const f32x4 (&acc)[2][2][4][2], const Unit& u, int wr, int wc, int fr, int fq) const {
        const int row0 = u.rb + wr * 64 + fr;
        const WtBuf bcg = wt_buf(CG), bdst = wt_buf(u.pn < 6 ? UA : VA);
        float rsv[2][4];
#pragma unroll
        for (int ai = 0; ai < 2; ++ai)
#pragma unroll
            for (int m = 0; m < 4; ++m) rsv[ai][m] = rstab[u.ui * 256 + ai * HALF + wr * 64 + m * 16 + fr];
#pragma unroll
        for (int ai = 0; ai < 2; ++ai)
#pragma unroll
            for (int m = 0; m < 4; ++m) {
                const int row = row0 + ai * HALF + m * 16; const float rs = rsv[ai][m];
                if (u.pn < 4) {
                    float o[8];
#pragma unroll
                    for (int n = 0; n < 2; ++n)
#pragma unroll
                        for (int j = 0; j < 4; ++j) { const float a = acc[ai][0][m][n][j] * rs, g = acc[ai][1][m][n][j] * rs; o[4 * n + j] = a * fast_sigmoid(g); }
                    u32x4 w; w.x = cvt_pk_bf16(o[0], o[1]); w.y = cvt_pk_bf16(o[2], o[3]); w.z = cvt_pk_bf16(o[4], o[5]); w.w = cvt_pk_bf16(o[6], o[7]);
                    wt_store16(bcg, CG, ((size_t)row * CC + u.pn * 128 + wc * 32 + 8 * fq) * 2, w);
                } else {
                    bf16_t* dbase = (u.pn < 6 ? UA : VA); const size_t doff = ((size_t)row * CC + (u.pn & 1) * 256 + wc * 32 + 8 * fq) * 2;
#pragma unroll
                    for (int bj = 0; bj < 2; ++bj) {
                        const f32x4 v0 = acc[ai][bj][m][0] * rs, v1 = acc[ai][bj][m][1] * rs;
                        const f32x2 a = gelu_pk((f32x2){v0[0], v0[1]}), b = gelu_pk((f32x2){v0[2], v0[3]}), c = gelu_pk((f32x2){v1[0], v1[1]}), d = gelu_pk((f32x2){v1[2], v1[3]});
                        u32x4 w; w.x = cvt_pk_bf16(a.x, a.y); w.y = cvt_pk_bf16(b.x, b.y); w.z = cvt_pk_bf16(c.x, c.y); w.w = cvt_pk_bf16(d.x, d.y);
                        wt_store16(bdst, dbase, doff + bj * HALF * 2, w); }
                }
            }
    }
};
struct EpiRes {
    static constexpr bool AFTER_DRAIN = true;
    const float* XIN; float* XOUT; bf16_t* XB; float* rss_out; unsigned char* XB8; float sc_in, sc_out;
    __device__ __forceinline__ void init_acc(f32x4 (&acc)[2][2][4][2], const Unit& u, int wr, int wc, int fr, int fq) const {
        const int row0 = u.rb + wr * 64 + fr, col0 = u.pn * 256 + wc * 32 + 8 * fq;
#pragma unroll
        for (int ai = 0; ai < 2; ++ai)
#pragma unroll
            for (int m = 0; m < 4; ++m)
#pragma unroll
                for (int bj = 0; bj < 2; ++bj) { const size_t off = (size_t)(row0 + ai * HALF + m * 16) * D + col0 + bj * HALF;
                    if (RES_BF16) { const u32x4 w = __builtin_nontemporal_load((const u32x4*)(XB + off));
                        acc[ai][bj][m][0] = (f32x4){bf_lo(w.x), bf_hi(w.x), bf_lo(w.y), bf_hi(w.y)} * sc_in; acc[ai][bj][m][1] = (f32x4){bf_lo(w.z), bf_hi(w.z), bf_lo(w.w), bf_hi(w.w)} * sc_in; }
                    else { acc[ai][bj][m][0] = *(const f32x4*)(XIN + off) * sc_in; acc[ai][bj][m][1] = *(const f32x4*)(XIN + off + 4) * sc_in; } }
    }
    __device__ __forceinline__ void fused(const f32x4 (&acc)[2][2][4][2], const Unit& u, int wr, int wc, int fr, int fq, LAS unsigned char* lds) const {
        const int row0 = u.rb + wr * 64 + fr, col0 = u.pn * 256 + wc * 32 + 8 * fq;
        LAS float* P = (LAS float*)lds;
        const WtBuf bxo = wt_buf(XOUT), bxb = wt_buf(XB);
#pragma unroll
        for (int ai = 0; ai < 2; ++ai)
#pragma unroll
            for (int m = 0; m < 4; ++m) {
                const int lr = ai * HALF + wr * 64 + m * 16 + fr, row = u.rb + lr; float ss = 0.f;
#pragma unroll
                for (int bj = 0; bj < 2; ++bj) {
                    const size_t off = (size_t)row * D + col0 + bj * HALF;
                    const f32x4 x0 = acc[ai][bj][m][0] * sc_out, x1 = acc[ai][bj][m][1] * sc_out;
                    if (!RES_BF16) { wt_store16f(bxo, XOUT, off * 4, x0); wt_store16f(bxo, XOUT, off * 4 + 16, x1); }
                    u32x4 w; w.x = cvt_pk_bf16(x0[0], x0[1]); w.y = cvt_pk_bf16(x0[2], x0[3]); w.z = cvt_pk_bf16(x1[0], x1[1]); w.w = cvt_pk_bf16(x1[2], x1[3]);
                    wt_store16(bxb, XB, off * 2, w);
                    if (XB8) { u32x2 q; q.x = pk_fp8x4(x0[0], x0[1], x0[2], x0[3]); q.y = pk_fp8x4(x1[0], x1[1], x1[2], x1[3]); *(u32x2*)(XB8 + off) = q; }
                    ss += (x0[0] * x0[0] + x0[1] * x0[1]) + (x0[2] * x0[2] + x0[3] * x0[3]) + (x1[0] * x1[0] + x1[1] * x1[1]) + (x1[2] * x1[2] + x1[3] * x1[3]); }
                ss += __shfl_xor(ss, 16); ss += __shfl_xor(ss, 32);
                if (fq == 0) P[lr * 4 + wc] = ss;
            }
        (void)row0;
        __syncthreads();
        if (threadIdx.x < 256) { const f32x4 p = *(const LAS f32x4*)(P + threadIdx.x * 4); rss_out[(size_t)(u.rb + threadIdx.x) * 4 + u.pn] = (p.x + p.y) + (p.z + p.w); }
        __syncthreads();
    }
};
template <bool MOE, bool F8> struct EpiSwiglu {
    static constexpr bool AFTER_DRAIN = false;
    void* ACT; const LAS float* rstab; float post;
    __device__ __forceinline__ void init_acc(f32x4 (&acc)[2][2][4][2], const Unit&, int, int, int, int) const { zero_acc(acc); }
    __device__ __forceinline__ void operator()(const f32x4 (&acc)[2][2][4][2], const Unit& u, int wr, int wc, int fr, int fq) const {
        const int col = u.pn * 128 + wc * 32 + 8 * fq;
        const WtBuf bact = wt_buf(ACT);
        float rsv[2][4];
#pragma unroll
        for (int ai = 0; ai < 2; ++ai)
#pragma unroll
            for (int m = 0; m < 4; ++m) rsv[ai][m] = rstab[u.ui * 256 + ai * HALF + wr * 64 + m * 16 + fr];
#pragma unroll
        for (int ai = 0; ai < 2; ++ai)
#pragma unroll
            for (int m = 0; m < 4; ++m) {
                const int lr = ai * HALF + wr * 64 + m * 16 + fr;
                const float rs = rsv[ai][m];
                const float k1 = -1.4426950408889634f * rs, k2 = rs * rs * post;
                float o[8];
#pragma unroll
                for (int n = 0; n < 2; ++n) {
                    const f32x4 ag = acc[ai][0][m][n], au = acc[ai][1][m][n]; const f32x4 tt = ag * k1; f32x4 ee;
#pragma unroll
                    for (int j = 0; j < 4; ++j) ee[j] = __builtin_amdgcn_exp2f(tt[j]);
                    ee = ee + 1.0f; f32x4 rr;
#pragma unroll
                    for (int j = 0; j < 4; ++j) rr[j] = __builtin_amdgcn_rcpf(ee[j]);
                    const f32x4 oo = (ag * au) * (rr * k2);
#pragma unroll
                    for (int j = 0; j < 4; ++j) o[4 * n + j] = oo[j]; }
                if constexpr (F8) {
                    u32x2 q; q.x = pk_fp8x4(o[0], o[1], o[2], o[3]); q.y = pk_fp8x4(o[4], o[5], o[6], o[7]);
                    if (!MOE || lr < u.valid) *(u32x2*)((unsigned char*)ACT + (size_t)(u.rb + lr) * FF + col) = q;
                } else {
                    u32x4 w; w.x = cvt_pk_bf16(o[0], o[1]); w.y = cvt_pk_bf16(o[2], o[3]); w.z = cvt_pk_bf16(o[4], o[5]); w.w = cvt_pk_bf16(o[6], o[7]);
                    if (!MOE || lr < u.valid) wt_store16(bact, ACT, ((size_t)(u.rb + lr) * FF + col) * 2, w);
                }
            }
    }
};
struct EpiSlot {
    static constexpr bool AFTER_DRAIN = false;
    bf16_t* YS; float* YP; float sc;
    __device__ __forceinline__ void init_acc(f32x4 (&acc)[2][2][4][2], const Unit&, int, int, int, int) const { zero_acc(acc); }
    __device__ __forceinline__ void operator()(const f32x4 (&acc)[2][2][4][2], const Unit& u, int wr, int wc, int fr, int fq) const {
        const int col0 = u.pn * 256 + wc * 32 + 8 * fq;
        const WtBuf bys = wt_buf(YS);
#pragma unroll
        for (int ai = 0; ai < 2; ++ai)
#pragma unroll
            for (int m = 0; m < 4; ++m) {
                const int lr = ai * HALF + wr * 64 + m * 16 + fr;
                if (lr < u.valid) {
#pragma unroll
                    for (int bj = 0; bj < 2; ++bj) {
                        const f32x4 x0 = acc[ai][bj][m][0] * sc, x1 = acc[ai][bj][m][1] * sc;
                        if (u.part) { const char* ypb = (const char*)(YP + (size_t)u.pi * 256 * D); const unsigned yo = (unsigned)((lr * D + col0 + bj * HALF) * 4);
                            *(f32x4*)(ypb + yo) = x0; *(f32x4*)(ypb + yo + 16) = x1; continue; }
                        u32x4 w; w.x = cvt_pk_bf16(x0[0], x0[1]); w.y = cvt_pk_bf16(x0[2], x0[3]); w.z = cvt_pk_bf16(x1[0], x1[1]); w.w = cvt_pk_bf16(x1[2], x1[3]);
                        wt_store16(bys, YS, ((size_t)(u.rb + lr) * D + col0 + bj * HALF) * 2, w); }
                }
            }
    }
};
struct EpiNull {
    static constexpr bool AFTER_DRAIN = false;
    float* sink;
    __device__ __forceinline__ void init_acc(f32x4 (&acc)[2][2][4][2], const Unit&, int, int, int, int) const { zero_acc(acc); }
    __device__ __forceinline__ void operator()(const f32x4 (&acc)[2][2][4][2], const Unit& u, int wr, int wc, int fr, int fq) const {
        f32x4 s = (f32x4){0.f, 0.f, 0.f, 0.f};
#pragma unroll
        for (int a = 0; a < 2; ++a)
#pragma unroll
            for (int b = 0; b < 2; ++b)
#pragma unroll
                for (int m = 0; m < 4; ++m)
#pragma unroll
                    for (int n = 0; n < 2; ++n) s += acc[a][b][m][n];
        const float t = (s.x + s.y) + (s.z + s.w);
        if (t == 1.2345678e30f) sink[threadIdx.x] = t;
    }
};
}

struct Args { const float* in[21]; float* out; unsigned char* ws; int ph_lo, ph_hi; };
enum { I_X = 0, I_NMIX, I_WIN, I_CONVW, I_CONVB, I_CONVNG, I_CONVNB, I_SGUNG, I_SGUNB, I_SGUW, I_SGUB, I_WOUT, I_NFFN, I_FWG, I_FWU, I_FWD, I_ROUTER, I_MWG, I_MWU, I_MWD, I_NFINAL };

struct P0Item { const float* W; const float* gain; void* dst; int N, K, c0, k0, f8; };
struct P0Buf { float v[32]; f32x4 g0, g1, g2, g3; };
__device__ __forceinline__ void p0_load(const P0Item& p, int lane, P0Buf& b) {
    const float* s = p.W + (size_t)(p.k0 + (lane >> 5)) * p.N + p.c0 + (lane & 31);
#pragma unroll
    for (int i = 0; i < 32; ++i) b.v[i] = __builtin_nontemporal_load(s + (size_t)(2 * i) * p.N);
    const f32x4 one = (f32x4){1.f, 1.f, 1.f, 1.f};
    b.g0 = one; b.g1 = one; b.g2 = one; b.g3 = one;
    if (p.gain) {
        if (p.f8) { const float* gp = p.gain + p.k0 + 16 * (lane & 3); b.g0 = *(const f32x4*)gp; b.g1 = *(const f32x4*)(gp + 4); b.g2 = *(const f32x4*)(gp + 8); b.g3 = *(const f32x4*)(gp + 12); }
        else { const float* gp = p.gain + p.k0 + 8 * (lane & 7); b.g0 = *(const f32x4*)gp; b.g1 = *(const f32x4*)(gp + 4); }
    }
}
__device__ __forceinline__ void p0_finish(const P0Item& p, const P0Buf& b, LAS float* scr, int lane, const int mode = 0) {
    if (mode == 1) { float s = 0.f;
#pragma unroll
        for (int i = 0; i < 32; ++i) s += b.v[i];
        if (s == 1.2345678e30f) *(float*)p.dst = s; return; }
#pragma unroll
    for (int i = 0; i < 32; ++i) scr[(2 * i + (lane >> 5)) * 33 + (lane & 31)] = b.v[i];
    if (!p.f8) {
        const int c = lane & 7;
        const f32x4 g0 = b.g0, g1 = b.g1;
        asm volatile("s_waitcnt lgkmcnt(0)" ::: "memory");
        const WtBuf bd = wt_buf(p.dst);
#pragma unroll
        for (int j = 0; j < 4; ++j) { const int rho = (lane >> 3) + 8 * j; const LAS float* s = scr + (8 * c) * 33 + pg8::perm32(rho);
            u32x4 o; o.x = cvt_pk_bf16(s[0 * 33] * g0.x, s[1 * 33] * g0.y); o.y = cvt_pk_bf16(s[2 * 33] * g0.z, s[3 * 33] * g0.w); o.z = cvt_pk_bf16(s[4 * 33] * g1.x, s[5 * 33] * g1.y); o.w = cvt_pk_bf16(s[6 * 33] * g1.z, s[7 * 33] * g1.w);
            if (mode == 0 || o.x == 0x12345678u) wt_store16(bd, p.dst, ((size_t)rho * p.K + p.k0 + 8 * c) * 2, o); }
    } else {
        const int c4 = lane & 3;
        const f32x4 g[4] = {b.g0 * MOE_SW, b.g1 * MOE_SW, b.g2 * MOE_SW, b.g3 * MOE_SW};
        asm volatile("s_waitcnt lgkmcnt(0)" ::: "memory");
#pragma unroll
        for (int j = 0; j < 2; ++j) { const int rho = (lane >> 2) + 16 * j; const LAS float* s = scr + (16 * c4) * 33 + pg8::perm32(rho);
            u32x4 o;
            o.x = pk_fp8x4(s[0 * 33] * g[0].x, s[1 * 33] * g[0].y, s[2 * 33] * g[0].z, s[3 * 33] * g[0].w);
            o.y = pk_fp8x4(s[4 * 33] * g[1].x, s[5 * 33] * g[1].y, s[6 * 33] * g[1].z, s[7 * 33] * g[1].w);
            o.z = pk_fp8x4(s[8 * 33] * g[2].x, s[9 * 33] * g[2].y, s[10 * 33] * g[2].z, s[11 * 33] * g[2].w);
            o.w = pk_fp8x4(s[12 * 33] * g[3].x, s[13 * 33] * g[3].y, s[14 * 33] * g[3].z, s[15 * 33] * g[3].w);
            if (mode == 0 || o.x == 0x12345678u) *(u32x4*)((unsigned char*)p.dst + (size_t)rho * p.K + p.k0 + 16 * c4) = o; }
    }
    asm volatile("s_waitcnt lgkmcnt(0)" ::: "memory");
}
constexpr int IT_WIN = 16 * 64, IT_WOUT = 16 * 32, IT_GU = 16 * 176, IT_DN = 44 * 32;
constexpr int P0_NITEMS = 2 * IT_WIN + 2 * IT_WOUT + IT_GU + IT_DN;
constexpr int IT_GU8 = 8 * 176, IT_DN8 = 22 * 32, P0_NITEMS8 = NE * (IT_GU8 + IT_DN8);
__device__ __forceinline__ bool p0_decode(const Args& args, int it, P0Item& p) {
    if (it >= P0_NITEMS) return false;
    unsigned char* ws = args.ws; int r = it;
    if (r < 2 * IT_WIN) { const int l = r / IT_WIN; r -= l * IT_WIN; const int kb = r / 64, g32 = r % 64, Lb = 32 * g32;
        p.c0 = Lb < 1024 ? ((Lb >> 7) & 1) * 512 + (Lb >> 8) * 128 + (Lb & 127) : Lb;
        p.W = args.in[I_WIN] + (size_t)l * D * DIN; p.N = DIN; p.K = D; p.gain = args.in[I_NMIX] + l * D; p.dst = (bf16_t*)(ws + WS_WIN) + ((size_t)l * DIN + Lb) * D; p.k0 = 64 * kb; p.f8 = 0; return true; }
    r -= 2 * IT_WIN;
    if (r < 2 * IT_WOUT) { const int l = r / IT_WOUT; r -= l * IT_WOUT; const int kb = r / 32, g32 = r % 32, Lb = 32 * g32;
        p.c0 = Lb; p.W = args.in[I_WOUT] + (size_t)l * D * D; p.N = D; p.K = D; p.gain = nullptr; p.dst = (bf16_t*)(ws + WS_WOUT) + ((size_t)l * D + Lb) * D; p.k0 = 64 * kb; p.f8 = 0; return true; }
    r -= 2 * IT_WOUT;
    if (r < IT_GU) { const int kb = r / 176, g32 = r % 176, Lb = 32 * g32; const int kind = (Lb >> 7) & 1;
        p.c0 = (Lb >> 8) * 128 + (Lb & 127); p.W = args.in[kind ? I_FWU : I_FWG]; p.N = FF; p.K = D; p.gain = args.in[I_NFFN]; p.dst = (unsigned char*)(ws + WS_FGU) + (size_t)Lb * D * (DENSE_FP8 ? 1 : 2); p.k0 = 64 * kb; p.f8 = DENSE_FP8; return true; }
    r -= IT_GU;
    if (r < IT_DN) { const int kb = r / 32, g32 = r % 32, Lb = 32 * g32;
        p.c0 = Lb; p.W = args.in[I_FWD]; p.N = D; p.K = FF; p.gain = nullptr; p.dst = (unsigned char*)(ws + WS_FD) + (size_t)Lb * FF * (DENSE_FP8 ? 1 : 2); p.k0 = 64 * kb; p.f8 = DENSE_FP8; return true; }
    return false;
}
struct P8Buf { float v[64]; };
__device__ __forceinline__ bool p8_decode(const Args& args, int it, P0Item& p) {
    if (it >= P0_NITEMS8) return false;
    unsigned char* ws = args.ws; int r = it; p.f8 = 1;
    if (r < NE * IT_GU8) { const int e = r / IT_GU8; r -= e * IT_GU8; const int kb = r / 176, g32 = r % 176, Lb = 32 * g32; const int kind = (Lb >> 7) & 1;
        p.c0 = (Lb >> 8) * 128 + (Lb & 127); p.W = args.in[kind ? I_MWU : I_MWG] + (size_t)e * D * FF; p.N = FF; p.K = D; p.gain = args.in[I_NFFN] + D; p.dst = (unsigned char*)(ws + WS_MGU) + ((size_t)e * NFF2 + Lb) * D; p.k0 = 128 * kb; return true; }
    r -= NE * IT_GU8;
    { const int e = r / IT_DN8; r -= e * IT_DN8; const int kb = r / 32, g32 = r % 32, Lb = 32 * g32;
        p.c0 = Lb; p.W = args.in[I_MWD] + (size_t)e * FF * D; p.N = D; p.K = FF; p.gain = nullptr; p.dst = (unsigned char*)(ws + WS_MD) + ((size_t)e * D + Lb) * FF; p.k0 = 128 * kb; return true; }
}
__device__ __forceinline__ void p8_load(const P0Item& p, int lane, P8Buf& b) {
    const float* s = p.W + (size_t)(p.k0 + (lane >> 5)) * p.N + p.c0 + (lane & 31);
#pragma unroll
    for (int i = 0; i < 64; ++i) b.v[i] = __builtin_nontemporal_load(s + (size_t)(2 * i) * p.N);
}
__device__ __forceinline__ void p8_finish(const P0Item& p, const P8Buf& b, LAS float* scr, int lane) {
    const int c8 = lane & 7;
    const f32x4 sw = (f32x4){MOE_SW, MOE_SW, MOE_SW, MOE_SW};
    f32x4 g[4] = {sw, sw, sw, sw};
    if (p.gain) { const float* gp = p.gain + p.k0 + 16 * c8; g[0] = *(const f32x4*)gp * MOE_SW; g[1] = *(const f32x4*)(gp + 4) * MOE_SW; g[2] = *(const f32x4*)(gp + 8) * MOE_SW; g[3] = *(const f32x4*)(gp + 12) * MOE_SW; }
#pragma unroll
    for (int i = 0; i < 64; ++i) scr[(2 * i + (lane >> 5)) * 33 + (lane & 31)] = b.v[i];
    asm volatile("s_waitcnt lgkmcnt(0)" ::: "memory");
#pragma unroll
    for (int j = 0; j < 4; ++j) { const int rho = (lane >> 3) + 8 * j; const LAS float* s = scr + (16 * c8) * 33 + pg8::perm32(rho);
        u32x4 o;
        o.x = pk_fp8x4(s[0 * 33] * g[0].x, s[1 * 33] * g[0].y, s[2 * 33] * g[0].z, s[3 * 33] * g[0].w);
        o.y = pk_fp8x4(s[4 * 33] * g[1].x, s[5 * 33] * g[1].y, s[6 * 33] * g[1].z, s[7 * 33] * g[1].w);
        o.z = pk_fp8x4(s[8 * 33] * g[2].x, s[9 * 33] * g[2].y, s[10 * 33] * g[2].z, s[11 * 33] * g[2].w);
        o.w = pk_fp8x4(s[12 * 33] * g[3].x, s[13 * 33] * g[3].y, s[14 * 33] * g[3].z, s[15 * 33] * g[3].w);
        *(u32x4*)((unsigned char*)p.dst + (size_t)rho * p.K + p.k0 + 16 * c8) = o; }
    asm volatile("s_waitcnt lgkmcnt(0)" ::: "memory");
}
struct PXBuf { f32x4 v[4][4]; };
__device__ __forceinline__ void px_load(const Args& args, int it, int lane, PXBuf& b) {
#pragma unroll
    for (int k = 0; k < 4; ++k) { const f32x4* xr = (const f32x4*)(args.in[I_X] + (size_t)(4 * it + k) * D) + lane;
#pragma unroll
        for (int j = 0; j < 4; ++j) b.v[k][j] = __builtin_nontemporal_load(xr + 64 * j); }
}
__device__ __forceinline__ void px_finish(const Args& args, int it, int lane, const PXBuf& b) {
    bf16_t* XB = (bf16_t*)(args.ws + WS_XB); float* rss = (float*)(args.ws + WS_RSS);
#pragma unroll
    for (int k = 0; k < 4; ++k) { const int m = 4 * it + k; float s = 0.f;
#pragma unroll
        for (int j = 0; j < 4; ++j) s += (b.v[k][j].x * b.v[k][j].x + b.v[k][j].y * b.v[k][j].y) + (b.v[k][j].z * b.v[k][j].z + b.v[k][j].w * b.v[k][j].w);
        s = row16_allsum(s); s += __shfl_xor(s, 16); s += __shfl_xor(s, 32);
        u32x2* o8 = (u32x2*)(XB + (size_t)m * D) + lane;
#pragma unroll
        for (int j = 0; j < 4; ++j) { u32x2 w; w.x = cvt_pk_bf16(b.v[k][j].x, b.v[k][j].y); w.y = cvt_pk_bf16(b.v[k][j].z, b.v[k][j].w); o8[64 * j] = w; }
        if (lane < 4) rss[(size_t)m * 4 + lane] = lane == 0 ? s : 0.f; }
}
constexpr int CW_Q = 9216;
static_assert(P0_NITEMS % 8 == 0 && P0_NITEMS8 % 8 == 0 && T % 32 == 0 && (CW_Q + 4 * 64) * 4 <= (int)CTL_ZERO_BYTES, "prologue tasks");
#define P0_TICKET(dst, NS, CTR) do { if (kseq < (NS)) { dst = (int)blockIdx.x + kseq * (int)gridDim.x; } else { \
        if (threadIdx.x == 0) slot[kseq & 1] = (NS) * (int)gridDim.x + (int)__hip_atomic_fetch_add((CTR), 1u, RLX_AGENT); __syncthreads(); dst = slot[kseq & 1]; } ++kseq; } while (0)
#define P0_DYN(TBASE, NTASKS, SQ, CTR, BUFT, LOADSTMT, FINSTMT) do { \
        BUFT ba, bb; LAS int* slot = (LAS int*)(lds + LDSCTL_OFF + 448); int kseq = 0; \
        const int ns_ = (((NTASKS) * (SQ)) / 4) / (int)gridDim.x; \
        int t0, t1; P0_TICKET(t0, ns_, CTR); P0_TICKET(t1, ns_, CTR); \
        if (t0 < (NTASKS)) { const int it = ((TBASE) + t0) * 8 + wave; BUFT& b = ba; LOADSTMT; } \
        while (t0 < (NTASKS)) { \
            if (t1 < (NTASKS)) { const int it = ((TBASE) + t1) * 8 + wave; BUFT& b = bb; LOADSTMT; } \
            { const int it = ((TBASE) + t0) * 8 + wave; BUFT& b = ba; FINSTMT; } \
            if (t1 >= (NTASKS)) break; \
            int t2; P0_TICKET(t2, ns_, CTR); \
            if (t2 < (NTASKS)) { const int it = ((TBASE) + t2) * 8 + wave; BUFT& b = ba; LOADSTMT; } \
            { const int it = ((TBASE) + t1) * 8 + wave; BUFT& b = bb; FINSTMT; } \
            if (t2 >= (NTASKS)) break; \
            int t3; P0_TICKET(t3, ns_, CTR); \
            t0 = t2; t1 = t3; } \
        __syncthreads(); } while (0)
constexpr int P0_NT8 = P0_NITEMS8 / 8, P0_LATE8 = ((P0_NT8 * 3) / 10) & ~7, P0_EARLY8 = P0_NT8 - P0_LATE8;
__device__ __forceinline__ void late_weight_tasks(const Args& args, LAS unsigned char* lds, int lane, int wave) {
    unsigned* ctl = (unsigned*)(args.ws + WS_CTL);
    LAS float* scr = (LAS float*)(lds + (wave < 7 ? wave * 16896 : TOKTAB_OFF));
    P0_DYN(P0_EARLY8, P0_LATE8, 0, ctl + CW_Q + 192, P8Buf, { P0Item p; p8_decode(args, it, p); p8_load(p, lane, b); }, { P0Item p; p8_decode(args, it, p); p8_finish(p, b, scr, lane); });
}
__device__ __forceinline__ void prologue_phase(const Args& args, LAS unsigned char* lds, int gw, int NGW, int lane, int wave) {
    unsigned char* ws = args.ws; unsigned* ctl = (unsigned*)(ws + WS_CTL);
#if PROBE_P0 == 3
    { LAS float* scr0 = (LAS float*)(lds + (wave < 7 ? wave * 16896 : TOKTAB_OFF));
      for (int it = gw; it < P0_NITEMS8; it += NGW) { P0Item p; p8_decode(args, it, p); P8Buf b;
#pragma unroll
          for (int i = 0; i < 64; ++i) b.v[i] = (float)(lane + i);
          p.gain = nullptr; p8_finish(p, b, scr0, lane); } }
#endif
    LAS float* scr = (LAS float*)(lds + (wave < 7 ? wave * 16896 : TOKTAB_OFF));
    static_assert(7 * 16896 <= LDSCTL_OFF && TOKTAB_OFF + 16896 <= LDS_BYTES, "prologue scratch");
    P0_DYN(0, P0_EARLY8, 3, ctl + CW_Q, P8Buf, { P0Item p; p8_decode(args, it, p); p8_load(p, lane, b); }, { P0Item p; p8_decode(args, it, p); p8_finish(p, b, scr, lane); });
    P0_DYN(0, P0_NITEMS / 8, 3, ctl + CW_Q + 64, P0Buf, { P0Item p; p0_decode(args, it, p); p0_load(p, lane, b); }, { P0Item p; p0_decode(args, it, p); p0_finish(p, b, scr, lane); });
    P0_DYN(0, T / 32, 3, ctl + CW_Q + 128, PXBuf, { px_load(args, it, lane, b); }, { px_finish(args, it, lane, b); });
    { float* RT = (float*)(ws + WS_RT); const float* rt = args.in[I_ROUTER]; const float* g = args.in[I_NFFN] + D;
      for (int i = gw * 64 + lane; i < NE * D; i += NGW * 64) { const int e = i / D, k = i % D; RT[i] = rt[k * NE + e] * g[k]; } }
    { bf16_t* SW = (bf16_t*)(ws + WS_SGUW); const float* sw = args.in[I_SGUW];
      for (int i = gw * 64 + lane; i < 2 * 4 * 128 * 128 / 2; i += NGW * 64) { const int e0 = 2 * i, tt = (e0 >> 7) & 127, s0 = e0 & 127;
          const float a = s0 <= tt ? sw[e0] : 0.f, b = (s0 + 1) <= tt ? sw[e0 + 1] : 0.f; ((unsigned*)SW)[i] = cvt_pk_bf16(a, b); } }
}

__device__ __forceinline__ void mid_phase(const Args& args, LAS unsigned char* lds, int l, int gw, int NGW, int lane, int wave, const int parts = 3) {
    unsigned char* ws = args.ws;
    const bf16_t* CG = (const bf16_t*)(ws + WS_CG); const bf16_t* UA = (const bf16_t*)(ws + WS_UA); const bf16_t* VA = (const bf16_t*)(ws + WS_VA); bf16_t* Y = (bf16_t*)(ws + WS_Y);
    const int fr = lane & 15, fq = lane >> 4;
    const int cv_cg = gw & 3, cv_ch = cv_cg * 128 + 2 * lane, cv_step = NGW >> 2, cv_first = gw >> 2;
    unsigned cv_raw[62];
    if (parts & 2) {
        if (cv_first < NB * (SEQ / 32)) { const int b = cv_first >> 6, t0 = (cv_first & 63) * 32; const size_t rowb = (size_t)b * SEQ;
#pragma unroll
            for (int i = 0; i < 62; ++i) { const int ta = t0 - 30 + i; cv_raw[i] = ta >= 0 ? *(const unsigned*)(CG + (rowb + ta) * CC + cv_ch) : 0u; } }
    }
    if (parts & 1) {
        constexpr int VST = 264;
        const bf16_t* Wb = (const bf16_t*)(ws + WS_SGUW) + (size_t)l * 4 * 128 * 128;
        const float* ng = args.in[I_SGUNG] + l * CC; const float* nb = args.in[I_SGUNB] + l * CC; const float* sb = args.in[I_SGUB] + l * 4 * 128;
        for (int unit = blockIdx.x; unit < NB * 16 * 4; unit += gridDim.x) {
            const int b = unit >> 6, n = (unit >> 2) & 15, h = unit & 3; const int R0 = b * SEQ + n * 128;
            const f32x2 gg = *(const f32x2*)(ng + h * 128 + 2 * lane), bb = *(const f32x2*)(nb + h * 128 + 2 * lane);
            unsigned pv[16];
#pragma unroll
            for (int rr = 0; rr < 16; ++rr) pv[rr] = __builtin_nontemporal_load((const unsigned*)(VA + (size_t)(R0 + wave * 16 + rr) * CC + h * 128 + 2 * lane));
            const int nks = ((16 * wave + 15) >> 5) + 1;
            bf16x8 bfrag[4];
#pragma unroll
            for (int ks = 0; ks < 4; ++ks) if (ks < nks) bfrag[ks] = *(const bf16x8*)(Wb + (size_t)h * 16384 + (16 * wave + fr) * 128 + 32 * ks + 8 * fq);
            float s1[16], s2[16];
#pragma unroll
            for (int rr = 0; rr < 16; ++rr) { const float v0 = bf_lo(pv[rr]), v1 = bf_hi(pv[rr]); s1[rr] = v0 + v1; s2[rr] = v0 * v0 + v1 * v1; }
#pragma unroll
            for (int rr = 0; rr < 16; ++rr) { s1[rr] = row16_allsum(s1[rr]); s2[rr] = row16_allsum(s2[rr]); }
#pragma unroll
            for (int rr = 0; rr < 16; ++rr) { s1[rr] += __shfl_xor(s1[rr], 16); s2[rr] += __shfl_xor(s2[rr], 16); }
#pragma unroll
            for (int rr = 0; rr < 16; ++rr) { s1[rr] += __shfl_xor(s1[rr], 32); s2[rr] += __shfl_xor(s2[rr], 32); }
#pragma unroll
            for (int rp = 0; rp < 8; ++rp) {
                float y[2][2];
#pragma unroll
                for (int q = 0; q < 2; ++q) { const int rr = 2 * rp + q; const float mean = s1[rr] * (1.0f / 128.0f); const float var = fmaxf(s2[rr] * (1.0f / 128.0f) - mean * mean, 0.f);
                    const float rstd = 1.0f / sqrtf(var + EPS); y[q][0] = (bf_lo(pv[rr]) - mean) * rstd * gg.x + bb.x; y[q][1] = (bf_hi(pv[rr]) - mean) * rstd * gg.y + bb.y; }
                const int s = wave * 16 + 2 * rp;
                *(LAS unsigned*)(lds + (2 * lane) * VST + s * 2) = cvt_pk_bf16(y[0][0], y[1][0]);
                *(LAS unsigned*)(lds + (2 * lane + 1) * VST + s * 2) = cvt_pk_bf16(y[0][1], y[1][1]);
            }
            const int t = 16 * wave + fr; const size_t row = (size_t)(R0 + t);
            u32x2 uu[8];
#pragma unroll
            for (int db = 0; db < 8; ++db) uu[db] = __builtin_nontemporal_load((const u32x2*)(UA + row * CC + h * 128 + 16 * db + 4 * fq));
            const float bias = sb[h * 128 + t];
            __syncthreads();
            f32x4 acc[8];
#pragma unroll
            for (int db = 0; db < 8; ++db) acc[db] = (f32x4){0.f, 0.f, 0.f, 0.f};
#pragma unroll
            for (int ks = 0; ks < 4; ++ks) if (ks < nks) {
#pragma unroll
                for (int db = 0; db < 8; ++db) {
                    const LAS unsigned char* ap = lds + (16 * db + fr) * VST + (32 * ks + 8 * fq) * 2;
                    union { bf16x8 v; u32x2 h[2]; } af; af.h[0] = *(const LAS u32x2*)ap; af.h[1] = *(const LAS u32x2*)(ap + 8);
                    acc[db] = __builtin_amdgcn_mfma_f32_16x16x32_bf16(af.v, bfrag[ks], acc[db], 0, 0, 0);
                }
            }
#pragma unroll
            for (int db = 0; db < 8; ++db) { const int d = 16 * db + 4 * fq;
                const float o0 = bf_lo(uu[db].x) * (acc[db][0] + bias), o1 = bf_hi(uu[db].x) * (acc[db][1] + bias), o2 = bf_lo(uu[db].y) * (acc[db][2] + bias), o3 = bf_hi(uu[db].y) * (acc[db][3] + bias);
                u32x2 w; w.x = cvt_pk_bf16(o0, o1); w.y = cvt_pk_bf16(o2, o3);
                *(u32x2*)(Y + row * D + CC + h * 128 + d) = w; }
            __syncthreads();
        }
    }
    if (parts & 2) {
        typedef __bf16 bf2_t __attribute__((ext_vector_type(2)));
        const int ch = cv_ch;
        for (int item = cv_first; item < NB * (SEQ / 32); item += cv_step) {
            const int b = item >> 6, t0 = (item & 63) * 32; const size_t rowb = (size_t)b * SEQ;
            if (item != cv_first) {
#pragma unroll
                for (int i = 0; i < 62; ++i) { const int ta = t0 - 30 + i; cv_raw[i] = ta >= 0 ? *(const unsigned*)(CG + (rowb + ta) * CC + ch) : 0u; } }
            unsigned P0[31], P1[31];
#pragma unroll
            for (int k = 0; k < 31; ++k) { P0[k] = __builtin_amdgcn_perm(cv_raw[2 * k + 1], cv_raw[2 * k], 0x05040100u); P1[k] = __builtin_amdgcn_perm(cv_raw[2 * k + 1], cv_raw[2 * k], 0x07060302u); }
            asm volatile("" ::: "memory");
            unsigned Wa0[16], Wa1[16], Wb0[16], Wb1[16];
            { f32x2 cv_wf[32]; const float* cwp = args.in[I_CONVW] + (size_t)l * CW * CC + cv_ch;
#pragma unroll
              for (int j = 0; j < CW; ++j) cv_wf[j] = *(const f32x2*)(cwp + j * CC);
              cv_wf[31] = (f32x2){0.f, 0.f};
#pragma unroll
              for (int k = 0; k < 16; ++k) { Wa0[k] = cvt_pk_bf16(cv_wf[2 * k].x, cv_wf[2 * k + 1].x); Wa1[k] = cvt_pk_bf16(cv_wf[2 * k].y, cv_wf[2 * k + 1].y); }
              Wb0[0] = cvt_pk_bf16(0.f, cv_wf[0].x); Wb1[0] = cvt_pk_bf16(0.f, cv_wf[0].y);
#pragma unroll
              for (int k = 0; k < 15; ++k) { Wb0[k + 1] = cvt_pk_bf16(cv_wf[2 * k + 1].x, cv_wf[2 * k + 2].x); Wb1[k + 1] = cvt_pk_bf16(cv_wf[2 * k + 1].y, cv_wf[2 * k + 2].y); } }
            const f32x2 cb = *(const f32x2*)(args.in[I_CONVB] + l * CC + ch), ng = *(const f32x2*)(args.in[I_CONVNG] + l * CC + ch), nb = *(const f32x2*)(args.in[I_CONVNB] + l * CC + ch);
#pragma unroll
            for (int hf = 0; hf < 4; ++hf) {
                float a0[8], a1[8];
#pragma unroll
                for (int tt = 0; tt < 8; ++tt) {
                    const int t = 8 * hf + tt; float s0 = cb.x, s1 = cb.y;
                    if ((t & 1) == 0) {
#pragma unroll
                        for (int k = 0; k < 16; ++k) { s0 = __builtin_amdgcn_fdot2_f32_bf16(__builtin_bit_cast(bf2_t, P0[t / 2 + k]), __builtin_bit_cast(bf2_t, Wa0[k]), s0, false);
                                                       s1 = __builtin_amdgcn_fdot2_f32_bf16(__builtin_bit_cast(bf2_t, P1[t / 2 + k]), __builtin_bit_cast(bf2_t, Wa1[k]), s1, false); }
                    } else {
#pragma unroll
                        for (int k = 0; k < 16; ++k) { s0 = __builtin_amdgcn_fdot2_f32_bf16(__builtin_bit_cast(bf2_t, P0[(t - 1) / 2 + k]), __builtin_bit_cast(bf2_t, Wb0[k]), s0, false);
                                                       s1 = __builtin_amdgcn_fdot2_f32_bf16(__builtin_bit_cast(bf2_t, P1[(t - 1) / 2 + k]), __builtin_bit_cast(bf2_t, Wb1[k]), s1, false); }
                    }
                    a0[tt] = s0; a1[tt] = s1;
                }
                float s1[8], s2[8];
#pragma unroll
                for (int tt = 0; tt < 8; ++tt) { s1[tt] = row16_allsum(a0[tt] + a1[tt]); s2[tt] = row16_allsum(a0[tt] * a0[tt] + a1[tt] * a1[tt]); }
#pragma unroll
                for (int tt = 0; tt < 8; ++tt) { s1[tt] += __shfl_xor(s1[tt], 16); s2[tt] += __shfl_xor(s2[tt], 16); }
#pragma unroll
                for (int tt = 0; tt < 8; ++tt) {
                    const float mean = s1[tt] * (1.0f / 64.0f); const float var = fmaxf(s2[tt] * (1.0f / 64.0f) - mean * mean, 0.f);
                    const float rstd = 1.0f / sqrtf(var + EPS);
                    const float y0 = (a0[tt] - mean) * rstd * ng.x + nb.x, y1 = (a1[tt] - mean) * rstd * ng.y + nb.y;
                    *(unsigned*)(Y + (rowb + t0 + 8 * hf + tt) * D + ch) = cvt_pk_bf16(y0 * fast_sigmoid(y0), y1 * fast_sigmoid(y1));
                }
            }
        }
    }
}

__device__ __forceinline__ void router_phase(const Args& args, LAS unsigned char* lds, int lane, int wave) {
    unsigned char* ws = args.ws;
    const bf16_t* XB = (const bf16_t*)(ws + WS_XB); const float* RT = (const float*)(ws + WS_RT); const float* rss = (const float*)(ws + WS_RSS) + (size_t)3 * T * 4;
    int* toklist = (int*)(ws + WS_TOKLIST); u32x4* tokinfo = (u32x4*)(ws + WS_TOKINFO); unsigned* cntw = (unsigned*)(ws + WS_CTL) + CW_CNT;
    LAS int* wcnt = (LAS int*)lds;
    LAS int* wbase = (LAS int*)(lds + 256);
    LAS float* rwl = (LAS float*)(lds + 1024);
    for (int i = threadIdx.x; i < NE * D / 4; i += NWAVES * 64) *(LAS f32x4*)(rwl + 4 * i) = *(const f32x4*)(RT + 4 * i);
    __syncthreads();
    for (int blk = blockIdx.x; blk < T / 64; blk += gridDim.x) {
        int my_e0 = 0, my_e1 = 0; float my_g0 = 0.f, my_g1 = 0.f;
        const int tbase = blk * 64 + wave * 8;
#pragma unroll 1
        for (int jb = 0; jb < 2; ++jb) {
            u32x4 xv[4][2]; float pr[4];
#pragma unroll
            for (int j = 0; j < 4; ++j) { const int t = tbase + 4 * jb + j;
                xv[j][0] = __builtin_nontemporal_load((const u32x4*)(XB + (size_t)t * D + 8 * lane)); xv[j][1] = __builtin_nontemporal_load((const u32x4*)(XB + (size_t)t * D + 512 + 8 * lane));
                pr[j] = rss[(size_t)t * 4 + (lane & 3)]; }
            float xf[4][16];
#pragma unroll
            for (int j = 0; j < 4; ++j)
#pragma unroll
                for (int i = 0; i < 2; ++i) { const u32x4 v = xv[j][i];
                    xf[j][8 * i + 0] = bf_lo(v.x); xf[j][8 * i + 1] = bf_hi(v.x); xf[j][8 * i + 2] = bf_lo(v.y); xf[j][8 * i + 3] = bf_hi(v.y); xf[j][8 * i + 4] = bf_lo(v.z); xf[j][8 * i + 5] = bf_hi(v.z); xf[j][8 * i + 6] = bf_lo(v.w); xf[j][8 * i + 7] = bf_hi(v.w); }
            float a[4][NE];
#pragma unroll
            for (int e = 0; e < NE; ++e) {
                f32x4 w[4];
#pragma unroll
                for (int i = 0; i < 2; ++i) { w[2 * i] = *(const LAS f32x4*)(rwl + e * D + 512 * i + 8 * lane); w[2 * i + 1] = *(const LAS f32x4*)(rwl + e * D + 512 * i + 8 * lane + 4); }
#pragma unroll
                for (int j = 0; j < 4; ++j) { float s = 0.f;
#pragma unroll
                    for (int q = 0; q < 4; ++q) s += (xf[j][4 * q] * w[q].x + xf[j][4 * q + 1] * w[q].y) + (xf[j][4 * q + 2] * w[q].z + xf[j][4 * q + 3] * w[q].w);
                    a[j][e] = s; }
                __builtin_amdgcn_sched_barrier(0);
            }
#pragma unroll
            for (int j = 0; j < 4; ++j)
#pragma unroll
                for (int e = 0; e < NE; ++e) a[j][e] = row16_allsum(a[j][e]);
#pragma unroll
            for (int j = 0; j < 4; ++j)
#pragma unroll
                for (int e = 0; e < NE; ++e) a[j][e] += __shfl_xor(a[j][e], 16);
#pragma unroll
            for (int j = 0; j < 4; ++j)
#pragma unroll
                for (int e = 0; e < NE; ++e) a[j][e] += __shfl_xor(a[j][e], 32);
#pragma unroll
            for (int j = 0; j < 4; ++j) {
                float p = pr[j]; p = dpp_add(p, 0); p = dpp_add(p, 1);
                const float rstd = 1.0f / sqrtf(p * (1.0f / D) + EPS);
                int e0 = 0; float l0 = a[j][0] * rstd;
#pragma unroll
                for (int e = 1; e < NE; ++e) { const float le = a[j][e] * rstd; if (le > l0) { l0 = le; e0 = e; } }
                int e1 = -1; float l1 = -3.0e38f;
#pragma unroll
                for (int e = 0; e < NE; ++e) { const float le = a[j][e] * rstd; if (e != e0 && le > l1) { l1 = le; e1 = e; } }
                const float g0 = 1.0f / (1.0f + __expf(l1 - l0)), g1 = 1.0f - g0;
                if (lane == 4 * jb + j) { my_e0 = e0; my_e1 = e1; my_g0 = g0; my_g1 = g1; }
            }
        }
        const bool act = lane < 8;
        unsigned long long m0[NE], m1[NE];
#pragma unroll
        for (int e = 0; e < NE; ++e) { m0[e] = __ballot(act && my_e0 == e); m1[e] = __ballot(act && my_e1 == e); }
        if (lane < NE) { int c = 0;
#pragma unroll
            for (int e = 0; e < NE; ++e) if (lane == e) c = __popcll(m0[e]) + __popcll(m1[e]);
            wcnt[wave * 8 + lane] = c; }
        __syncthreads();
        if (threadIdx.x < NE) { const int e = threadIdx.x; int tot = 0; int pre[8];
#pragma unroll
            for (int w = 0; w < 8; ++w) { pre[w] = tot; tot += wcnt[w * 8 + e]; }
            const int base = (int)__hip_atomic_fetch_add(cntw + 64 * e, (unsigned)tot, RLX_AGENT);
#pragma unroll
            for (int w = 0; w < 8; ++w) wbase[w * 8 + e] = base + pre[w]; }
        __syncthreads();
        if (act) {
            const unsigned long long lt = (1ull << lane) - 1ull;
            int pos0 = 0, pos1 = 0;
#pragma unroll
            for (int e = 0; e < NE; ++e) { const int wb = wbase[wave * 8 + e];
                if (my_e0 == e) pos0 = wb + __popcll(m0[e] & lt);
                if (my_e1 == e) pos1 = wb + __popcll(m0[e]) + __popcll(m1[e] & lt); }
            const int t = tbase + lane;
            toklist[my_e0 * T + pos0] = t; toklist[my_e1 * T + pos1] = t;
            u32x4 inf; inf.x = ((unsigned)my_e0 << 16) | (unsigned)pos0; inf.y = ((unsigned)my_e1 << 16) | (unsigned)pos1; inf.z = __float_as_uint(my_g0); inf.w = __float_as_uint(my_g1);
            tokinfo[t] = inf;
        }
        __syncthreads();
    }
}
__device__ __forceinline__ void moe_tab_build(const unsigned char* ws, LAS int* tab) {
    if (threadIdx.x < NE) tab[threadIdx.x] = (int)__hip_atomic_load((unsigned*)(ws + WS_CTL) + CW_CNT + 64 * threadIdx.x, RLX_AGENT);
    __syncthreads();
    if (threadIdx.x == 0) {
        int b = 0, p = 0, f = 0, np = 0;
        for (int e = 0; e < NE; ++e) { const int c = tab[e]; tab[8 + e] = b; tab[16 + e] = p; tab[25 + e] = f; b += c; p += (c + 255) >> 8; f += c >> 8;
            tab[43 + e] = -1; if (c & 255) { tab[35 + np] = e; tab[43 + e] = np; ++np; } }
        tab[24] = p; tab[33] = f; tab[34] = np;
    }
    __syncthreads();
}

__device__ __forceinline__ void final_phase(const Args& args, const LAS int* tab, int gw, int NGW, int lane) {
    unsigned char* ws = args.ws; float* out = args.out; const bf16_t* YS = (const bf16_t*)(ws + WS_YS); const u32x4* tokinfo = (const u32x4*)(ws + WS_TOKINFO); const float* YP = (const float*)(ws + WS_YP);
    f32x4 gn[4];
#pragma unroll
    for (int j = 0; j < 4; ++j) gn[j] = *((const f32x4*)args.in[I_NFINAL] + lane + 64 * j);
    for (int tb = gw; tb < T; tb += 4 * NGW) {
        f32x4 xv[4][4]; u32x2 ya[4][4], yb[4][4]; float g0[4], g1[4]; u32x4 inf[4];
#pragma unroll
        for (int k = 0; k < 4; ++k) { const int t = tb + k * NGW; inf[k] = tokinfo[t < T ? t : 0]; }
#pragma unroll
        for (int k = 0; k < 4; ++k) { const int t = tb + k * NGW; if (t < T) {
            const int e0 = __builtin_amdgcn_readfirstlane((int)(inf[k].x >> 16)), p0 = __builtin_amdgcn_readfirstlane((int)(inf[k].x & 0xffffu)), e1 = __builtin_amdgcn_readfirstlane((int)(inf[k].y >> 16)), p1 = __builtin_amdgcn_readfirstlane((int)(inf[k].y & 0xffffu));
            g0[k] = __uint_as_float(inf[k].z); g1[k] = __uint_as_float(inf[k].w);
            const int b0 = __builtin_amdgcn_readfirstlane(tab[8 + e0]), b1 = __builtin_amdgcn_readfirstlane(tab[8 + e1]);
            const int c0 = __builtin_amdgcn_readfirstlane(tab[e0]), c1 = __builtin_amdgcn_readfirstlane(tab[e1]);
            if (RES_BF16) { const u32x2* xr = (const u32x2*)((const bf16_t*)(ws + WS_XB) + (size_t)t * D) + lane;
#pragma unroll
                for (int j = 0; j < 4; ++j) { const u32x2 w = __builtin_nontemporal_load(xr + 64 * j); xv[k][j] = (f32x4){bf_lo(w.x), bf_hi(w.x), bf_lo(w.y), bf_hi(w.y)}; } }
            else { const f32x4* xr = (const f32x4*)(out + (size_t)t * D) + lane;
#pragma unroll
                for (int j = 0; j < 4; ++j) xv[k][j] = xr[64 * j]; }
            if (p0 >= (c0 & ~255)) { const float* yp = YP + ((size_t)__builtin_amdgcn_readfirstlane(tab[43 + e0]) * 4 * 256 + (p0 & 255)) * D;
#pragma unroll
                for (int j = 0; j < 4; ++j) { f32x4 s = *((const f32x4*)yp + lane + 64 * j);
#pragma unroll
                    for (int q = 1; q < 4; ++q) s += *((const f32x4*)(yp + (size_t)q * 256 * D) + lane + 64 * j);
                    ya[k][j].x = cvt_pk_bf16(s.x, s.y); ya[k][j].y = cvt_pk_bf16(s.z, s.w); } }
            else { const u32x2* y0 = (const u32x2*)(YS + (size_t)(b0 + p0) * D) + lane;
#pragma unroll
                for (int j = 0; j < 4; ++j) ya[k][j] = __builtin_nontemporal_load(y0 + 64 * j); }
            if (p1 >= (c1 & ~255)) { const float* yp = YP + ((size_t)__builtin_amdgcn_readfirstlane(tab[43 + e1]) * 4 * 256 + (p1 & 255)) * D;
#pragma unroll
                for (int j = 0; j < 4; ++j) { f32x4 s = *((const f32x4*)yp + lane + 64 * j);
#pragma unroll
                    for (int q = 1; q < 4; ++q) s += *((const f32x4*)(yp + (size_t)q * 256 * D) + lane + 64 * j);
                    yb[k][j].x = cvt_pk_bf16(s.x, s.y); yb[k][j].y = cvt_pk_bf16(s.z, s.w); } }
            else { const u32x2* y1 = (const u32x2*)(YS + (size_t)(b1 + p1) * D) + lane;
#pragma unroll
                for (int j = 0; j < 4; ++j) yb[k][j] = __builtin_nontemporal_load(y1 + 64 * j); }
        } }
#pragma unroll
        for (int k = 0; k < 4; ++k) { const int t = tb + k * NGW; if (t < T) {
            f32x4 v[4]; float ss = 0.f;
#pragma unroll
            for (int j = 0; j < 4; ++j) { const f32x4 x = xv[k][j]; const u32x2 a = ya[k][j], b = yb[k][j];
                v[j].x = x.x + g0[k] * bf_lo(a.x) + g1[k] * bf_lo(b.x); v[j].y = x.y + g0[k] * bf_hi(a.x) + g1[k] * bf_hi(b.x); v[j].z = x.z + g0[k] * bf_lo(a.y) + g1[k] * bf_lo(b.y); v[j].w = x.w + g0[k] * bf_hi(a.y) + g1[k] * bf_hi(b.y);
                ss += (v[j].x * v[j].x + v[j].y * v[j].y) + (v[j].z * v[j].z + v[j].w * v[j].w); }
            ss = row16_allsum(ss); ss += __shfl_xor(ss, 16); ss += __shfl_xor(ss, 32);
            const float rstd = 1.0f / sqrtf(ss * (1.0f / D) + EPS);
            f32x4* xo = (f32x4*)(out + (size_t)t * D) + lane;
#pragma unroll
            for (int j = 0; j < 4; ++j) xo[64 * j] = v[j] * rstd * gn[j]; } }
    }
}

template <bool MOE, class Sched>
__device__ __forceinline__ void fill_unit_tables(const Sched& S, const float* rss, const int* toklist, float pre, LAS unsigned char* lds) {
    LAS int* tt = (LAS int*)(lds + TOKTAB_OFF); LAS float* rt = (LAS float*)(lds + RSTAB_OFF);
    const int lr = threadIdx.x & 255, par = threadIdx.x >> 8;
    int srow[MAXU / 2]; bool have[MAXU / 2];
#pragma unroll
    for (int k = 0; k < MAXU / 2; ++k) { pg8::Unit u; have[k] = S.next(2 * k + par, u); srow[k] = 0;
        if (have[k]) { if (MOE) { if (lr < u.valid) srow[k] = toklist[u.e * T + u.pm * 256 + lr]; } else srow[k] = u.rb + lr; } }
    f32x4 p[MAXU / 2];
#pragma unroll
    for (int k = 0; k < MAXU / 2; ++k) p[k] = have[k] ? *(const f32x4*)(rss + (size_t)srow[k] * 4) : (f32x4){0.f, 0.f, 0.f, 0.f};
#pragma unroll
    for (int k = 0; k < MAXU / 2; ++k) if (have[k]) { const int i = 2 * k + par; if (MOE) tt[i * 256 + lr] = srow[k];
        rt[i * 256 + lr] = pre / sqrtf(((p[k].x + p[k].y) + (p[k].z + p[k].w)) * (1.0f / D) + EPS); }
    __syncthreads();
}

__global__ void __launch_bounds__(NWAVES * 64, 2) mega_fwd(Args args) {
    extern __shared__ __attribute__((aligned(16))) unsigned char lds_raw[];
    LAS unsigned char* lds = (LAS unsigned char*)lds_raw;
    const int tid = threadIdx.x, lane = tid & 63, wave = __builtin_amdgcn_readfirstlane(tid >> 6);
    const int G = gridDim.x, bx = blockIdx.x;
    const int vcu = (G % 8 == 0) ? (bx % 8) * (G / 8) + bx / 8 : bx;
    const int gw = vcu * NWAVES + wave, NGW = G * NWAVES;
    unsigned char* ws = args.ws;
    unsigned* ctl = (unsigned*)(ws + WS_CTL);
    for (int u = tid; u < 512 / 4; u += NWAVES * 64) ((LAS unsigned*)(lds + LDSCTL_OFF))[u] = 0u;
    __syncthreads();
    XcdBarrier bar; bar.bar = ctl + CW_BAR; bar.x = 0; bar.st = nullptr;
    if (MK_N_LAUNCHES == 1) bar = xcd_barrier_post(ctl + CW_BAR, (volatile LAS unsigned*)(lds + LDSCTL_OFF) + 8);
    const int lo = args.ph_lo, hi = args.ph_hi;
#ifndef PHMASK
#define PHMASK 0xFFFF
#endif
#define IN(k) ((((PHMASK) >> (k)) & 1) && lo <= (k) && (k) < hi)
#ifndef DUP_PHASE
#define DUP_PHASE -1
#endif
#define REP(k) for (int rep_ = 0; rep_ < ((DUP_PHASE) == (k) ? 2 : 1); ++rep_)
#define SEAM(k) do { if (MK_N_LAUNCHES == 1 && IN((k) + 1)) xcd_barrier(bar); if (PROBE_TIME == (k)) pt1 = wall_clock64(); } while (0)
    unsigned long long pt0 = 0, pt1 = 0;
#define PT(k) do { if (PROBE_TIME == (k)) pt0 = wall_clock64(); } while (0)
    float* rss = (float*)(ws + WS_RSS);
    bf16_t* XB = (bf16_t*)(ws + WS_XB);

    PT(0); if (IN(0)) { REP(0) prologue_phase(args, lds, gw, NGW, lane, wave); SEAM(0); }

#ifndef MOE_FP8
#define MOE_FP8 1
#endif
    constexpr bool MF8 = (MOE_FP8 != 0); constexpr int MES = MF8 ? 1 : 2; constexpr bool DF8 = (DENSE_FP8 != 0); constexpr int DES = DF8 ? 1 : 2;
#define LAYER_MIX(l, pb) \
    PT(pb); if (IN(pb)) {       \
        pg8::DenseSched S; S.A = (const char*)XB; S.Bt = (const char*)(ws + WS_WIN) + (size_t)(l) * DIN * D * 2; S.KB = D * 2; S.so.init(T / 256, DIN / 256, G, vcu); S.g1 = 1; \
        fill_unit_tables<false>(S, rss + (size_t)(2 * (l)) * T * 4, nullptr, 1.0f, lds); \
        pg8::EpiMix E{(bf16_t*)(ws + WS_CG), (bf16_t*)(ws + WS_UA), (bf16_t*)(ws + WS_VA), (const LAS float*)(lds + RSTAB_OFF)}; \
        REP(pb) pg8::gemm_phase<pg8::EpiMix, pg8::DenseSched, true, false>(lds, D * 2, S, E); \
        SEAM(pb); \
    } \
    PT((pb) + 1); if (IN((pb) + 1)) { if (PROBE_MID != 0 && (l) == 0) mid_phase(args, lds, (l), gw, NGW, lane, wave, PROBE_MID); REP((pb) + 1) mid_phase(args, lds, (l), gw, NGW, lane, wave); SEAM((pb) + 1); } \
    PT((pb) + 2); if (IN((pb) + 2)) {       \
        pg8::DenseSched S; S.A = (const char*)(ws + WS_Y); S.Bt = (const char*)(ws + WS_WOUT) + (size_t)(l) * D * D * 2; S.KB = D * 2; S.so.init(T / 256, D / 256, G, bx); S.g1 = 0; \
        pg8::EpiRes E{(l) == 0 ? args.in[I_X] : args.out, args.out, XB, rss + (size_t)(2 * (l) + 1) * T * 4, (((l) == 1 && MF8) || ((l) == 0 && DF8)) ? (unsigned char*)(ws + WS_XB8) : nullptr, 1.0f, 1.0f}; \
        REP((pb) + 2) for (int r_ = 0; r_ * G < S.so.nwg; ++r_) { S.so.i0 = r_; S.so.nmax = 1; pg8::gemm_phase<pg8::EpiRes, pg8::DenseSched, false, false>(lds, D * 2, S, E); } \
        SEAM((pb) + 2); \
    }
    LAYER_MIX(0, 1)
    PT(4); if (IN(4)) {
        pg8::DenseSched S; S.A = DF8 ? (const char*)(ws + WS_XB8) : (const char*)XB; S.Bt = (const char*)(ws + WS_FGU); S.KB = D * DES; S.so.init(T / 256, NFF2 / 256, G, bx); S.g1 = 0;
        fill_unit_tables<false>(S, rss + (size_t)1 * T * 4, nullptr, DF8 ? 1.0f / MOE_SW : 1.0f, lds);
        pg8::EpiSwiglu<false, DF8> E{(void*)(ws + WS_ACT), (const LAS float*)(lds + RSTAB_OFF), DF8 ? MOE_SA : 1.0f};
        REP(4) pg8::gemm_phase<pg8::EpiSwiglu<false, DF8>, pg8::DenseSched, true, DF8>(lds, D * DES, S, E);
        late_weight_tasks(args, lds, lane, wave);
        SEAM(4);
    }
    PT(5); if (IN(5)) {
        pg8::DenseSched S; S.A = (const char*)(ws + WS_ACT); S.Bt = (const char*)(ws + WS_FD); S.KB = FF * DES; S.so.init(T / 256, D / 256, G, bx); S.g1 = 0;
        pg8::EpiRes E{args.out, args.out, XB, rss + (size_t)2 * T * 4, nullptr, DF8 ? MOE_SW * MOE_SA : 1.0f, DF8 ? 1.0f / (MOE_SW * MOE_SA) : 1.0f};
        for (int r_ = 0; r_ * G < S.so.nwg; ++r_) { S.so.i0 = r_; S.so.nmax = 1; pg8::gemm_phase<pg8::EpiRes, pg8::DenseSched, false, DF8>(lds, FF * DES, S, E); }
        SEAM(5);
    }
    LAYER_MIX(1, 6)
    LAS int* mtab = (LAS int*)(lds + LDSCTL_OFF + 64);
    PT(9); if (IN(9)) { router_phase(args, lds, lane, wave); SEAM(9); }
    PT(10); if (IN(10)) {
        moe_tab_build(ws, mtab);
        pg8::MoeUpSched<MES> S; S.tab = mtab;
        S.XA = MF8 ? (const char*)(ws + WS_XB8) : (const char*)XB; S.W = (const char*)(ws + WS_MGU); S.toktab = (const LAS int*)(lds + TOKTAB_OFF); S.so.init(__builtin_amdgcn_readfirstlane(mtab[24]), NFF2 / 256, G, bx);
        fill_unit_tables<true>(S, rss + (size_t)3 * T * 4, (const int*)(ws + WS_TOKLIST), MF8 ? 1.0f / MOE_SW : 1.0f, lds);
        pg8::EpiSwiglu<true, MF8> E{(void*)(ws + WS_ACT), (const LAS float*)(lds + RSTAB_OFF), MF8 ? MOE_SA : 1.0f};
#if PROBE_NULL == 10
        { pg8::EpiNull EN{(float*)(ws + WS_TOKINFO)}; pg8::gemm_phase<pg8::EpiNull, pg8::MoeUpSched<MES>, true, MF8>(lds, D * MES, S, EN); }
#endif
        REP(10) pg8::gemm_phase<pg8::EpiSwiglu<true, MF8>, pg8::MoeUpSched<MES>, true, MF8>(lds, D * MES, S, E);
        SEAM(10);
    }
    PT(11); if (IN(11)) {
        moe_tab_build(ws, mtab);
        pg8::MoeDownSched<MES> S; S.tab = mtab;
        S.ACT = (const char*)(ws + WS_ACT); S.W = (const char*)(ws + WS_MD); S.so.init(__builtin_amdgcn_readfirstlane(mtab[33]), D / 256, G, bx);
        pg8::EpiSlot E{(bf16_t*)(ws + WS_YS), (float*)(ws + WS_YP), MF8 ? 1.0f / (MOE_SW * MOE_SA) : 1.0f};
#if PROBE_NULL == 11
        { pg8::EpiNull EN{(float*)(ws + WS_TOKINFO)}; pg8::gemm_phase<pg8::EpiNull, pg8::MoeDownSched<MES>, true, MF8>(lds, FF * MES, S, EN); }
#endif
        REP(11) pg8::gemm_phase<pg8::EpiSlot, pg8::MoeDownSched<MES>, true, MF8>(lds, FF * MES, S, E);
        SEAM(11);
    }
    PT(12); if (IN(12)) { moe_tab_build(ws, mtab); final_phase(args, mtab, gw, NGW, lane); }
    if (PROBE_TIME == 12) pt1 = wall_clock64();
    if (PROBE_TIME >= 0) { const unsigned long long tgt = wall_clock64() + 4ull * (pt1 - pt0); while (wall_clock64() < tgt) __builtin_amdgcn_s_sleep(8); }
#undef IN
#undef SEAM
}

extern "C" void kernel_launch(void* const* d_in, const int* in_sizes, int n_in, void* d_out, int out_size, void* d_ws, size_t ws_size, hipStream_t stream) {
    static int grid = 0;
    if (grid == 0) {
        if (n_in != 21 || in_sizes[0] != T * D || out_size != T * D || ws_size < WS_END) { fprintf(stderr, "kernel_launch: unexpected shapes (n_in %d, in0 %d, out %d, ws %zu < %zu); nothing launched\n", n_in, n_in > 0 ? in_sizes[0] : -1, out_size, ws_size, (size_t)WS_END); grid = -1; return; }
        int dev = 0, cus = 0, per_cu = 0;
        if (hipGetDevice(&dev) != hipSuccess || hipDeviceGetAttribute(&cus, hipDeviceAttributeMultiprocessorCount, dev) != hipSuccess) { grid = -1; return; }
        if (hipFuncSetAttribute((const void*)mega_fwd, hipFuncAttributeMaxDynamicSharedMemorySize, LDS_BYTES) != hipSuccess) { fprintf(stderr, "kernel_launch: hipFuncSetAttribute failed\n"); grid = -1; return; }
        if (hipOccupancyMaxActiveBlocksPerMultiprocessor(&per_cu, (const void*)mega_fwd, NWAVES * 64, LDS_BYTES) != hipSuccess || per_cu < 1) { fprintf(stderr, "kernel_launch: occupancy query reports %d\n", per_cu); }
        (void)hipGetLastError();
        grid = cus;
    }
    if (grid < 0) return;
    if (hipMemsetAsync((char*)d_ws + WS_CTL, 0, CTL_ZERO_BYTES, stream) != hipSuccess) return;
    Args a{};
    for (int i = 0; i < 21; ++i) a.in[i] = (const float*)d_in[i];
    a.out = (float*)d_out; a.ws = (unsigned char*)d_ws;
    if (MK_N_LAUNCHES == 1) { a.ph_lo = 0; a.ph_hi = N_PHASES; hipLaunchKernelGGL(mega_fwd, dim3(grid), dim3(NWAVES * 64), LDS_BYTES, stream, a); }
    else for (int p = 0; p < N_PHASES; ++p) { a.ph_lo = p; a.ph_hi = p + 1; hipLaunchKernelGGL(mega_fwd, dim3(grid), dim3(NWAVES * 64), LDS_BYTES, stream, a); }
}
```
